# Optimizing an MI355X kernel written in HIP

```python
import numpy as np
import jax
import jax.numpy as jnp
from jax import lax

D_MODEL = 1024
BATCH = 32
SEQ = 256
DEPTH = 4
DEC_BATCH = 8
DEC_SEQ = 4096
PAST_LEN = 512

GRID_W = 64
HEAD_DIM = 64
BRANCH_W = D_MODEL // 4
POOL_WINDOWS = (2, 4, 8, 16)
POOL_GROUP_W = BRANCH_W // len(POOL_WINDOWS)
NAT_HEADS = BRANCH_W // HEAD_DIM
NAT_ROWS = 8
NAT_COLS = 16
CONV_WIDTH = 31
GQA_HEADS = BRANCH_W // HEAD_DIM
GQA_KV_HEADS = GQA_HEADS // 2
ROPE_THETA = 10000.0
Q_BLOCK = 128
LN_EPS = 1e-5
RMS_EPS = 1e-6
NEG_INF = -1e30
DEEPNORM_ALPHA = (2 * DEPTH) ** 0.25
DEEPNORM_BETA = (8 * DEPTH) ** -0.25
IN_SPLITS = (BRANCH_W, BRANCH_W,
             BRANCH_W, BRANCH_W, BRANCH_W, BRANCH_W,
             BRANCH_W, BRANCH_W, BRANCH_W,
             GQA_HEADS * HEAD_DIM, GQA_KV_HEADS * HEAD_DIM, GQA_KV_HEADS * HEAD_DIM, BRANCH_W)
IN_WIDTH = sum(IN_SPLITS)
SPLIT_POINTS = tuple(np.cumsum(IN_SPLITS)[:-1].tolist())

kernel_name = 'hybrid_diffusion_prefix_step'


def layer_norm(x, g, b):
    xf = x.astype(jnp.float32)
    mu = jnp.mean(xf, axis=-1, keepdims=True)
    var = jnp.mean(jnp.square(xf - mu), axis=-1, keepdims=True)
    return ((xf - mu) * lax.rsqrt(var + LN_EPS)).astype(x.dtype) * g + b


def rms_norm(x, g):
    xf = x.astype(jnp.float32)
    return (xf * lax.rsqrt(jnp.mean(xf * xf, axis=-1, keepdims=True) + RMS_EPS)).astype(x.dtype) * g


def axial_rope(x):
    L = x.shape[1]
    half = HEAD_DIM // 2
    nf = half // 2
    t = jnp.arange(L)
    inv = ROPE_THETA ** (-jnp.arange(nf, dtype=jnp.float32) * 2.0 / half)

    def rot(xa, pos):
        ang = pos.astype(jnp.float32)[:, None] * inv[None, :]
        cos = jnp.cos(ang)[None, :, None, :].astype(x.dtype)
        sin = jnp.sin(ang)[None, :, None, :].astype(x.dtype)
        x1, x2 = xa[..., :nf], xa[..., nf:]
        return jnp.concatenate([x1 * cos - x2 * sin, x2 * cos + x1 * sin], axis=-1)

    return jnp.concatenate([rot(x[..., :half], t // GRID_W), rot(x[..., half:], t % GRID_W)], axis=-1)


def blocked_attention(q, k, v):
    B, Lq, H, dh = q.shape
    KV = k.shape[2]
    G = H // KV
    qb = jnp.moveaxis(q.reshape(B, Lq // Q_BLOCK, Q_BLOCK, KV, G, dh), 1, 0)

    def one_block(qi):
        s = jnp.einsum('bqkgd,bskd->bkgqs', qi, k).astype(jnp.float32) * (dh ** -0.5)
        p = jax.nn.softmax(s, axis=-1).astype(v.dtype)
        return jnp.einsum('bkgqs,bskd->bqkgd', p, v)

    o = lax.map(one_block, qb)
    return jnp.moveaxis(o, 0, 1).reshape(B, Lq, H * dh)


def nat_attention(q, k, v, k_ctx, v_ctx, bias_tab):
    B, L, H, dh = q.shape
    rows = L // GRID_W
    wr = min(NAT_ROWS, rows)
    r = np.arange(rows)
    row_start = np.clip(r - wr // 2, 0, rows - wr)
    row_idx = row_start[:, None] + np.arange(wr)[None, :]
    col = np.arange(GRID_W)
    col_start = np.clip(col - NAT_COLS // 2, 0, GRID_W - NAT_COLS)
    col_in = (col[None, :] >= col_start[:, None]) & (col[None, :] < col_start[:, None] + NAT_COLS)
    dc = np.clip(col[None, :] - col[:, None], -(NAT_COLS - 1), NAT_COLS - 1) + NAT_COLS - 1
    dr = row_idx - r[:, None] + NAT_ROWS - 1
    scale = dh ** -0.5

    qg = q.reshape(B, rows, GRID_W, H, dh)
    kg = jnp.take(k.reshape(B, rows, GRID_W, H, dh), row_idx, axis=1)
    vg = jnp.take(v.reshape(B, rows, GRID_W, H, dh), row_idx, axis=1)
    s_loc = jnp.einsum('brchd,brjwhd->brhcjw', qg, kg).astype(jnp.float32) * scale
    bias = bias_tab[:, dr[:, :, None, None], dc[None, None, :, :]]
    bias = jnp.transpose(bias, (1, 0, 3, 2, 4)).astype(jnp.float32)
    s_loc = jnp.where(col_in[:, None, :], s_loc + bias[None], NEG_INF)
    s_ctx = jnp.einsum('brchd,bshd->brhcs', qg, k_ctx).astype(jnp.float32) * scale
    n_loc = wr * GRID_W
    s_all = jnp.concatenate([s_loc.reshape(B, rows, H, GRID_W, n_loc), s_ctx], axis=-1)
    p = jax.nn.softmax(s_all, axis=-1).astype(v.dtype)
    p_loc = p[..., :n_loc].reshape(B, rows, H, GRID_W, wr, GRID_W)
    p_ctx = p[..., n_loc:]
    o = jnp.einsum('brhcjw,brjwhd->brchd', p_loc, vg) + jnp.einsum('brhcs,bshd->brchd', p_ctx, v_ctx)
    return o.reshape(B, L, H * dh)


def pool_mix(x, w, scale):
    B, L, C = x.shape
    xf = x.astype(jnp.float32)
    cs = jnp.concatenate([jnp.zeros((B, 1, C), jnp.float32), jnp.cumsum(xf, axis=1)], axis=1)
    t = np.arange(L)
    outs = []
    for g, win in enumerate(POOL_WINDOWS):
        lo = np.clip(t - win // 2, 0, L)
        hi = np.clip(t - win // 2 + win, 0, L)
        sl = slice(g * POOL_GROUP_W, (g + 1) * POOL_GROUP_W)
        cg = cs[..., sl]
        mean = (cg[:, hi] - cg[:, lo]) / jnp.asarray(hi - lo, jnp.float32)[None, :, None]
        outs.append(mean - xf[..., sl])
    y = jnp.stack(outs, axis=2).astype(x.dtype)
    y = jnp.einsum('blgc,gcd->blgd', y, w)
    return y.reshape(B, L, C) * scale


def conv_mix(val, glu, w_dw, b_dw, g, b, w_pw):
    z = val * jax.nn.sigmoid(glu)
    z = lax.conv_general_dilated(z, w_dw[:, None, :], window_strides=(1,),
                                 padding=[(CONV_WIDTH // 2, CONV_WIDTH // 2)],
                                 dimension_numbers=('NWC', 'WIO', 'NWC'),
                                 feature_group_count=z.shape[-1]) + b_dw
    z = jax.nn.silu(layer_norm(z, g, b))
    return z @ w_pw


def trunk_layer(x, cond, p, ctx=None):
    B, L, _ = x.shape
    mod = jax.nn.silu(cond) @ p['w_mod'] + p['b_mod']
    shift, scale, gate = jnp.split(mod, 3, axis=-1)
    h = x * (1 + scale) + shift
    u = h @ p['w_in'] + p['b_in']
    (a_x, a_g, nq, nk, nv, n_g, c_v, c_glu, c_g, gq, gk, gv, g_g) = jnp.split(u, SPLIT_POINTS, axis=-1)

    a_out = pool_mix(a_x, p['pool_w'], p['pool_scale'])
    c_out = conv_mix(c_v, c_glu, p['conv_w'], p['conv_b'], p['conv_ln_g'], p['conv_ln_b'], p['conv_pw'])

    nq = nq.reshape(B, L, NAT_HEADS, HEAD_DIM)
    nk = nk.reshape(B, L, NAT_HEADS, HEAD_DIM)
    nv = nv.reshape(B, L, NAT_HEADS, HEAD_DIM)
    gq = rms_norm(gq.reshape(B, L, GQA_HEADS, HEAD_DIM), p['q_norm'])
    gk = rms_norm(gk.reshape(B, L, GQA_KV_HEADS, HEAD_DIM), p['k_norm'])
    gv = gv.reshape(B, L, GQA_KV_HEADS, HEAD_DIM)

    if ctx is None:
        n_out = blocked_attention(nq, nk, nv)
        g_out = blocked_attention(gq, gk, gv)
        new = (nk, nv, gk, gv)
    else:
        ck_n, cv_n, ck_g, cv_g = ctx
        n_out = nat_attention(nq, nk, nv, ck_n, cv_n, p['nat_bias'])
        g_out = blocked_attention(axial_rope(gq),
                                  jnp.concatenate([axial_rope(gk), ck_g], axis=1),
                                  jnp.concatenate([gv, cv_g], axis=1))
        new = None

    mixed = jnp.concatenate([a_out * jax.nn.silu(a_g), n_out * jax.nn.silu(n_g),
                             c_out * jax.nn.silu(c_g), g_out * jax.nn.silu(g_g)], axis=-1)
    out = mixed @ p['w_out'] + p['b_out']
    x = layer_norm(DEEPNORM_ALPHA * x + gate * out, p['ln_g'], p['ln_b'])
    return x, new


def setup_inputs(seed: int = 0) -> dict:
    key = jax.random.key(seed)
    ks = jax.random.split(key, 26)
    D = D_MODEL

    def nrm(k, shape, s):
        return jax.random.normal(k, shape, jnp.float32) * s

    return {
        'x_prompt': nrm(ks[0], (BATCH, SEQ, D), 1.0),
        'x_sample': nrm(ks[1], (DEC_BATCH, DEC_SEQ, D), 1.0),
        'c': nrm(ks[2], (DEC_BATCH, D), 1.0),
        'cache_nat_k': nrm(ks[3], (DEC_BATCH, DEPTH, PAST_LEN, NAT_HEADS, HEAD_DIM), 1.0),
        'cache_nat_v': nrm(ks[4], (DEC_BATCH, DEPTH, PAST_LEN, NAT_HEADS, HEAD_DIM), 1.0),
        'cache_gqa_k': nrm(ks[5], (DEC_BATCH, DEPTH, PAST_LEN, GQA_KV_HEADS, HEAD_DIM), 1.0),
        'cache_gqa_v': nrm(ks[6], (DEC_BATCH, DEPTH, PAST_LEN, GQA_KV_HEADS, HEAD_DIM), 1.0),
        'c_ctx': nrm(ks[7], (D,), 1.0),
        'w_mod': nrm(ks[8], (DEPTH, D, 3 * D), 0.5 * D ** -0.5),
        'b_mod': nrm(ks[9], (DEPTH, 3 * D), 0.01),
        'w_in': nrm(ks[10], (DEPTH, D, IN_WIDTH), D ** -0.5),
        'b_in': nrm(ks[11], (DEPTH, IN_WIDTH), 0.01),
        'pool_w': nrm(ks[12], (DEPTH, len(POOL_WINDOWS), POOL_GROUP_W, POOL_GROUP_W), POOL_GROUP_W ** -0.5),
        'pool_scale': 1.0 + nrm(ks[13], (DEPTH, BRANCH_W), 0.1),
        'nat_bias': nrm(ks[14], (DEPTH, NAT_HEADS, 2 * NAT_ROWS - 1, 2 * NAT_COLS - 1), 0.1),
        'q_norm': 1.0 + nrm(ks[15], (DEPTH, HEAD_DIM), 0.05),
        'k_norm': 1.0 + nrm(ks[16], (DEPTH, HEAD_DIM), 0.05),
        'conv_w': nrm(ks[17], (DEPTH, CONV_WIDTH, BRANCH_W), CONV_WIDTH ** -0.5),
        'conv_b': nrm(ks[18], (DEPTH, BRANCH_W), 0.01),
        'conv_ln_g': 1.0 + nrm(ks[19], (DEPTH, BRANCH_W), 0.05),
        'conv_ln_b': nrm(ks[20], (DEPTH, BRANCH_W), 0.01),
        'conv_pw': nrm(ks[21], (DEPTH, BRANCH_W, BRANCH_W), BRANCH_W ** -0.5 * DEEPNORM_BETA),
        'w_out': nrm(ks[22], (DEPTH, D, D), D ** -0.5 * DEEPNORM_BETA),
        'b_out': nrm(ks[23], (DEPTH, D), 0.01),
        'ln_g': 1.0 + nrm(ks[24], (DEPTH, D), 0.05),
        'ln_b': nrm(ks[25], (DEPTH, D), 0.01),
    }


def reference(x_prompt, x_sample, c, cache_nat_k, cache_nat_v, cache_gqa_k, cache_gqa_v, c_ctx,
              w_mod, b_mod, w_in, b_in, pool_w, pool_scale, nat_bias, q_norm, k_norm,
              conv_w, conv_b, conv_ln_g, conv_ln_b, conv_pw, w_out, b_out, ln_g, ln_b):
    cond_ctx = c_ctx[None, None, :]
    cond_lat = c[:, None, :]
    y_prompt = x_prompt
    y_sample = x_sample
    nat_k, nat_v, gqa_k, gqa_v = [], [], [], []
    for l in range(DEPTH):
        p = {'w_mod': w_mod[l], 'b_mod': b_mod[l], 'w_in': w_in[l], 'b_in': b_in[l],
             'pool_w': pool_w[l], 'pool_scale': pool_scale[l], 'nat_bias': nat_bias[l],
             'q_norm': q_norm[l], 'k_norm': k_norm[l], 'conv_w': conv_w[l], 'conv_b': conv_b[l],
             'conv_ln_g': conv_ln_g[l], 'conv_ln_b': conv_ln_b[l], 'conv_pw': conv_pw[l],
             'w_out': w_out[l], 'b_out': b_out[l], 'ln_g': ln_g[l], 'ln_b': ln_b[l]}
        y_prompt, (nk, nv, gk, gv) = trunk_layer(y_prompt, cond_ctx, p)
        nat_k.append(nk)
        nat_v.append(nv)
        gqa_k.append(gk)
        gqa_v.append(gv)
        ctx = (cache_nat_k[:, l], cache_nat_v[:, l], cache_gqa_k[:, l], cache_gqa_v[:, l])
        y_sample, _ = trunk_layer(y_sample, cond_lat, p, ctx)
    new_nat_k = jnp.stack(nat_k, axis=1)
    new_nat_v = jnp.stack(nat_v, axis=1)
    new_gqa_k = jnp.stack(gqa_k, axis=1)
    new_gqa_v = jnp.stack(gqa_v, axis=1)
    return (y_prompt, y_sample, new_nat_k, new_nat_v, new_gqa_k, new_gqa_v)
```

```cpp
#include <hip/hip_runtime.h>
#include <hip/hip_cooperative_groups.h>
#include <cstdio>
#include <cstdint>
namespace cg = cooperative_groups;

typedef unsigned short bf16_t;
typedef short bf16x8 __attribute__((ext_vector_type(8)));
typedef short s16x4 __attribute__((ext_vector_type(4)));
typedef float f32x4 __attribute__((ext_vector_type(4)));
typedef float f32x2 __attribute__((ext_vector_type(2)));
typedef __bf16 bf16x2_t __attribute__((ext_vector_type(2)));
typedef unsigned u32x4 __attribute__((ext_vector_type(4)));
typedef unsigned u32x2 __attribute__((ext_vector_type(2)));
#define DEV __device__ __forceinline__
__device__ const float ROPE_COS[1024] = {
1.f,1.f,1.f,1.f,1.f,1.f,1.f,1.f,
1.f,1.f,1.f,1.f,1.f,1.f,1.f,1.f,
0.540302277f,0.846009135f,0.950415254f,0.98423022f,0.995004177f,0.998419285f,0.999500036f,0.999841869f,
0.999949992f,0.999984205f,0.999994993f,0.999998391f,0.999999523f,0.999999821f,0.99999994f,1.f,
-0.416146845f,0.431462824f,0.806578398f,0.937418282f,0.980066597f,0.993682086f,0.998000681f,0.999367595f,
0.999800026f,0.999936759f,0.999979973f,0.999993682f,0.999997973f,0.999999344f,0.999999821f,0.99999994f,
-0.989992499f,-0.115966164f,0.582753658f,0.861040652f,0.955336511f,0.985803485f,0.995503366f,0.998577297f,
0.999550045f,0.999857724f,0.999954998f,0.999985754f,0.99999553f,0.999998569f,0.999999523f,0.999999881f,
-0.653643608f,-0.627679706f,0.301137477f,0.757506192f,0.921060979f,0.974808276f,0.992010653f,0.997471273f,
0.999200106f,0.999747038f,0.999920011f,0.999974728f,0.999992013f,0.999997497f,0.999999225f,0.999999762f,
0.2836622f,-0.946079254f,-0.0103423381f,0.630080283f,0.87758255f,0.960731268f,0.987526f,0.996049762f,
0.998750269f,0.999604762f,0.999875009f,0.999960482f,0.999987483f,0.999996066f,0.999998748f,0.999999583f,
0.960170269f,-0.973103702f,-0.3207964f,0.482782036f,0.825335622f,0.943616986f,0.982053936f,0.9943133f,
0.998200536f,0.999430835f,0.999819994f,0.999943078f,0.999981999f,0.999994338f,0.999998212f,0.999999404f,
0.753902256f,-0.700429797f,-0.599437475f,0.320257008f,0.764842212f,0.923519433f,0.975599885f,0.992262423f,
0.997551024f,0.999225318f,0.999755025f,0.999922514f,0.999975502f,0.999992251f,0.999997556f,0.999999225f,
-0.145500034f,-0.212036446f,-0.818632424f,0.147631213f,0.696706712f,0.900502324f,0.968170285f,0.989897788f,
0.996801734f,0.998988271f,0.999680042f,0.999898791f,0.999967992f,0.999989867f,0.999996781f,0.999998987f,
-0.91113025f,0.341660261f,-0.956644177f,-0.0296507962f,0.621609926f,0.874638259f,0.959772646f,0.987220109f,
0.995952725f,0.998719573f,0.999595046f,0.99987191f,0.999959528f,0.999987185f,0.999995947f,0.999998748f,
-0.839071512f,0.790131867f,-0.999786079f,-0.205997631f,0.540302277f,0.846009135f,0.950415313f,0.98423022f,
0.995004177f,0.998419285f,0.999500036f,0.999841869f,0.999949992f,0.999984205f,0.999994993f,0.999998391f,
0.00442569796f,0.995257378f,-0.943779767f,-0.375847399f,0.453596085f,0.814705312f,0.940107584f,0.980929136f,
0.993956089f,0.998087406f,0.999395072f,0.999808669f,0.999939501f,0.999980867f,0.99999392f,0.999998093f,
0.843853951f,0.893861592f,-0.79417938f,-0.53384304f,0.362357706f,0.780825913f,0.92885989f,0.97731787f,
0.99280864f,0.997723997f,0.999280095f,0.99977231f,0.999927998f,0.999977231f,0.999992788f,0.999997735f,
0.907446802f,0.517172873f,-0.565820515f,-0.675001681f,0.267498761f,0.744477987f,0.916683376f,0.973397553f,
0.99156189f,0.997329056f,0.999155104f,0.999732792f,0.999915481f,0.999973297f,0.999991536f,0.999997318f,
0.136737213f,-0.0187961515f,-0.28134948f,-0.794870913f,0.16996716f,0.705776393f,0.903590262f,0.969169438f,
0.990216017f,0.996902585f,0.999020159f,0.999690115f,0.99990201f,0.999969006f,0.999990225f,0.999996901f,
-0.759687901f,-0.548975468f,0.0310223512f,-0.889670432f,0.070737198f,0.6648435f,0.889593601f,0.964634836f,
0.988771081f,0.996444523f,0.998875201f,0.999644279f,0.999887526f,0.999964416f,0.999988735f,0.999996424f,
-0.957659483f,-0.910081089f,0.340318173f,-0.95641005f,-0.0291995462f,0.621808827f,0.87470746f,0.959795177f,
0.987227261f,0.99595499f,0.998720288f,0.999595284f,0.999872029f,0.999959528f,0.999987185f,0.999995947f,
-0.275163352f,-0.990897954f,0.615864813f,-0.99298501f,-0.128844544f,0.576808274f,0.858946681f,0.954652011f,
0.985584795f,0.995433986f,0.998555362f,0.999543071f,0.999855518f,0.999954283f,0.999985576f,0.99999541f,
0.660316706f,-0.766536534f,0.830336154f,-0.998241663f,-0.227202162f,0.529984176f,0.842327058f,0.949207008f,
0.983843684f,0.994881511f,0.998380423f,0.999487758f,0.999837995f,0.9999488f,0.999983788f,0.999994874f,
0.988704622f,-0.306095392f,0.962463796f,-0.972014248f,-0.323289543f,0.481484592f,0.824865162f,0.943461835f,
0.982004225f,0.994297504f,0.998195529f,0.999429286f,0.999819517f,0.999942899f,0.99998194f,0.999994278f,
0.408082068f,0.248616725f,0.999144375f,-0.91512996f,-0.416146845f,0.431462824f,0.806578457f,0.937418282f,
0.980066597f,0.993682086f,0.998000681f,0.999367595f,0.999800026f,0.999936759f,0.999979973f,0.999993682f,
-0.547729254f,0.726760268f,0.936740458f,-0.829382956f,-0.504846215f,0.380077004f,0.787485182f,0.931078374f,
0.97803092f,0.993035257f,0.99779582f,0.999302804f,0.999779522f,0.999930263f,0.999977946f,0.999993026f,
-0.99996084f,0.981074572f,0.781440377f,-0.717477441f,-0.588501155f,0.327489585f,0.767604589f,0.92444396f,
0.975897431f,0.992357016f,0.997581005f,0.999234855f,0.999758005f,0.999923468f,0.999975801f,0.999992371f,
-0.53283304f,0.933235765f,0.548645258f,-0.582943261f,-0.666275978f,0.273866832f,0.746956408f,0.917517304f,
0.97366637f,0.991647422f,0.997356176f,0.999163687f,0.999735534f,0.999916375f,0.999973536f,0.999991655f,
0.424179018f,0.597977161f,0.261441678f,-0.430023283f,-0.737393796f,0.219378278f,0.725561321f,0.910300434f,
0.971337974f,0.990906477f,0.997121394f,0.99908942f,0.99971199f,0.999908924f,0.999971211f,0.99999088f,
0.991202831f,0.078552261f,-0.0516893305f,-0.263540596f,-0.801143587f,0.164196163f,0.703440726f,0.902795732f,
0.968912423f,0.99013412f,0.996876657f,0.999011934f,0.999687493f,0.999901175f,0.999968767f,0.999990106f,
0.64691931f,-0.465064496f,-0.359694332f,-0.0887455046f,-0.856888831f,0.108494945f,0.680616796f,0.895005584f,
0.966389954f,0.98933053f,0.996621907f,0.998931348f,0.999662042f,0.999893129f,0.999966204f,0.999989331f,
-0.292138815f,-0.865450621f,-0.632028639f,0.088848114f,-0.904072165f,0.0524506159f,0.6571123f,0.886932373f,
0.963770926f,0.988495648f,0.996357203f,0.998847544f,0.999635518f,0.999884725f,0.999963522f,0.999988496f,
-0.962605894f,-0.999293387f,-0.841684937f,0.26363951f,-0.942222297f,-0.00375941908f,0.632950664f,0.878578722f,
0.961055458f,0.987629473f,0.996082544f,0.998760641f,0.99960804f,0.999876022f,0.99996078f,0.999987602f,
-0.748057544f,-0.825371623f,-0.967871487f,0.430115849f,-0.970958173f,-0.0599575676f,0.608156204f,0.869947195f,
0.958243906f,0.986732066f,0.995797932f,0.998670578f,0.999579549f,0.999867022f,0.999957979f,0.999986708f,
0.154251456f,-0.397251874f,-0.998075247f,0.583026946f,-0.989992499f,-0.115966164f,0.582753658f,0.861040652f,
0.955336511f,0.985803485f,0.995503366f,0.998577297f,0.999550045f,0.999857724f,0.999954998f,0.999985754f,
0.914742351f,0.153215483f,-0.929300308f,0.717549205f,-0.999135137f,-0.171608135f,0.556768358f,0.851861775f,
0.95233357f,0.984843671f,0.995198846f,0.998480916f,0.999519527f,0.999848068f,0.999951959f,0.999984801f,
0.83422339f,0.656495154f,-0.768367112f,0.829440355f,-0.998294771f,-0.226707578f,0.53022635f,0.842413545f,
0.949235439f,0.983852804f,0.994884372f,0.998381376f,0.999488056f,0.999838114f,0.9999488f,0.999983788f,
-0.0132767474f,0.95758605f,-0.531235278f,0.915171385f,-0.987479806f,-0.281090319f,0.503154159f,0.832698941f,
0.946042359f,0.982830763f,0.994559944f,0.998278618f,0.999455571f,0.999827802f,0.999945521f,0.999982774f,
-0.848570287f,0.963757515f,-0.241421118f,0.972038329f,-0.966798186f,-0.334584385f,0.475578904f,0.822721004f,
0.942754686f,0.981777668f,0.994225562f,0.99817276f,0.999422073f,0.999817252f,0.999942183f,0.999981701f,
-0.903692186f,0.673110247f,0.0723346695f,0.998247743f,-0.93645668f,-0.387020677f,0.447528064f,0.812482953f,
0.939372718f,0.980693519f,0.993881226f,0.998063743f,0.999387562f,0.999806345f,0.999938726f,0.999980628f,
-0.127963692f,0.175156534f,0.378916174f,0.992972851f,-0.896758378f,-0.438233554f,0.419029742f,0.801987886f,
0.935896814f,0.979578316f,0.993526995f,0.997951567f,0.999352098f,0.999795079f,0.99993521f,0.999979496f,
0.765414059f,-0.376742303f,0.647921681f,0.95638001f,-0.848100007f,-0.488060862f,0.39011243f,0.791239262f,
0.93232733f,0.978432178f,0.993162811f,0.997836173f,0.99931556f,0.999783576f,0.999931574f,0.999978364f,
0.955073655f,-0.812611222f,0.852673113f,0.889623463f,-0.790967762f,-0.536345184f,0.360805035f,0.780240417f,
0.928664625f,0.977255106f,0.992788672f,0.997717679f,0.999278069f,0.999771714f,0.999927819f,0.999977171f,
0.266642928f,-0.998210371f,0.972865343f,0.794808388f,-0.72593224f,-0.582933903f,0.331136853f,0.768994927f,
0.924909055f,0.976047099f,0.99240464f,0.997596025f,0.999239624f,0.999759495f,0.999923944f,0.999975979f,
-0.666938066f,-0.87637943f,0.996578991f,0.674925625f,-0.653643608f,-0.627679706f,0.301137596f,0.757506192f,
0.921060979f,0.974808276f,0.992010653f,0.997471273f,0.999200106f,0.999747038f,0.999920011f,0.999974728f,
-0.987339258f,-0.484639406f,0.921462357f,0.533756077f,-0.574824035f,-0.670441091f,0.270837069f,0.745777905f,
0.917120814f,0.973538578f,0.991606772f,0.997343302f,0.999159634f,0.999734223f,0.999915957f,0.999973416f,
-0.399985313f,0.0563609414f,0.754965365f,0.375752151f,-0.490260571f,-0.711082935f,0.240265876f,0.733813822f,
0.913088918f,0.972238123f,0.991192937f,0.997212172f,0.999118149f,0.99972111f,0.999911785f,0.999972105f,
0.555113316f,0.580003142f,0.513598442f,0.205897167f,-0.400799006f,-0.749476731f,0.209454417f,0.721617639f,
0.908965766f,0.970906913f,0.990769207f,0.997077882f,0.999075651f,0.999707639f,0.999907553f,0.999970794f,
0.999843299f,0.925014675f,0.221298173f,0.0295478199f,-0.307332784f,-0.785501122f,0.178433523f,0.709193349f,
0.904751658f,0.969545007f,0.990335584f,0.996940494f,0.99903214f,0.99969393f,0.999903202f,0.999969363f,
0.52532196f,0.985138178f,-0.0929481089f,-0.147732988f,-0.210795805f,-0.819042206f,0.147234216f,0.696544766f,
0.90044713f,0.968152404f,0.989892066f,0.996799886f,0.998987675f,0.999679863f,0.999898732f,0.999967992f,
-0.432177931f,0.741858006f,-0.397976756f,-0.320354372f,-0.112152621f,-0.849993885f,0.115887694f,0.683675885f,
0.89605248f,0.966729224f,0.989438653f,0.996656179f,0.998942196f,0.999665439f,0.999894202f,0.999966562f,
-0.992335498f,0.270098448f,-0.663538277f,-0.48287195f,-0.0123883775f,-0.878258407f,0.0844252855f,0.670590878f,
0.891568303f,0.965275466f,0.988975346f,0.996509314f,0.998895705f,0.999650776f,0.999889553f,0.999965072f,
-0.640144348f,-0.284846604f,-0.863296509f,-0.630159974f,0.0874991715f,-0.903746367f,0.0528784581f,0.657293737f,
0.886994898f,0.963791192f,0.988502085f,0.996359289f,0.9988482f,0.999635756f,0.999884784f,0.999963582f,
0.300592542f,-0.75206399f,-0.977442741f,-0.757573068f,0.18651247f,-0.926377118f,0.0212787576f,0.643788815f,
0.882332861f,0.962276459f,0.98801899f,0.996206105f,0.998799741f,0.999620378f,0.999879956f,0.999962032f,
0.964965999f,-0.987659097f,-0.994656444f,-0.861092687f,0.2836622f,-0.946079254f,-0.0103422189f,0.630080283f,
0.87758255f,0.960731268f,0.987526f,0.996049762f,0.998750269f,0.999604762f,0.999875009f,0.999960482f,
0.742154181f,-0.919073522f,-0.913230121f,-0.937454224f,0.377977669f,-0.96279037f,-0.0419528559f,0.616172493f,
0.872744501f,0.959155679f,0.987023175f,0.99589026f,0.998699784f,0.999588788f,0.999869943f,0.999958873f,
-0.162990779f,-0.567430019f,-0.741239965f,-0.984248459f,0.468516916f,-0.976457715f,-0.0735215396f,0.602069914f,
0.86781919f,0.95754981f,0.986510456f,0.995727658f,0.998648286f,0.999572515f,0.999864817f,0.999957263f,
-0.918282807f,-0.0410281904f,-0.495741814f,-1.f,0.554374516f,-0.987038016f,-0.105016708f,0.587776959f,
0.862807095f,0.955913603f,0.985987842f,0.995561838f,0.998595834f,0.999555886f,0.999859571f,0.999955595f,
-0.829309821f,0.498009592f,-0.201079622f,-0.984212041f,0.634692967f,-0.994497895f,-0.136406869f,0.573298037f,
0.857708693f,0.954247177f,0.985455394f,0.995392919f,0.998542368f,0.999538958f,0.999854207f,0.999953866f,
0.0221267566f,0.883669317f,0.113521777f,-0.937382519f,0.708669782f,-0.998813629f,-0.167660639f,0.558637917f,
0.852524519f,0.95255059f,0.984913111f,0.99522084f,0.99848789f,0.999521732f,0.999848783f,0.999952197f,
0.853220105f,0.997174621f,0.416867077f,-0.860988438f,0.775565803f,-0.999971747f,-0.198746875f,0.543801069f,
0.847255111f,0.950823903f,0.984360933f,0.995045662f,0.998432398f,0.999504209f,0.99984318f,0.999950409f,
0.899866819f,0.803569078f,0.678870201f,-0.757439196f,0.834712923f,-0.997968495f,-0.22963427f,0.528792322f,
0.841901004f,0.949067116f,0.983798921f,0.994867265f,0.998375952f,0.999486327f,0.999837577f,0.999948621f,
0.119180135f,0.362476677f,0.873550534f,-0.63000071f,0.885519624f,-0.99281019f,-0.260292053f,0.513616323f,
0.836462677f,0.947280347f,0.983227074f,0.994685769f,0.998318493f,0.999468148f,0.999831796f,0.999946833f,
-0.771080196f,-0.1902491f,0.981602073f,-0.482692331f,0.927478492f,-0.984513164f,-0.290689558f,0.498277903f,
0.830940723f,0.945463598f,0.982645452f,0.994501114f,0.998260021f,0.99944967f,0.999825954f,0.999944985f,
-0.952412963f,-0.684381902f,0.992308319f,-0.320159167f,0.960170269f,-0.973103702f,-0.3207964f,0.482782036f,
0.825335622f,0.943616986f,0.982053936f,0.9943133f,0.998200536f,0.999430835f,0.999819994f,0.999943078f,
-0.258101642f,-0.967739642f,0.904607594f,-0.1475292f,0.98326844f,-0.958617806f,-0.350582451f,0.467133403f,
0.819648027f,0.941740453f,0.981452644f,0.994122326f,0.998140097f,0.999411702f,0.999813974f,0.99994117f,
0.673507154f,-0.953050017f,0.727198064f,0.0297537707f,0.996542096f,-0.941101313f,-0.380017966f,0.451337039f,
0.813878477f,0.939834237f,0.980841517f,0.993928254f,0.998078644f,0.999392271f,0.999807835f,0.999939203f,
0.985896587f,-0.644837022f,0.477671444f,0.206098333f,0.999858618f,-0.920609534f,-0.409073502f,0.435397953f,
0.808027506f,0.937898219f,0.980220556f,0.993731022f,0.998016179f,0.999372482f,0.999801576f,0.999937236f,
};
__device__ const float ROPE_SIN[1024] = {
0.f,0.f,0.f,0.f,0.f,0.f,0.f,0.f,
0.f,0.f,0.f,0.f,0.f,0.f,0.f,0.f,
0.841470957f,0.533168435f,0.310983598f,0.176892191f,0.0998334214f,0.0562044978f,0.0316175036f,0.0177818574f,
0.00999983307f,0.00562338345f,0.00316227227f,0.0017782785f,0.000999999931f,0.000562341243f,0.000316227757f,0.00017782794f,
0.909297407f,0.902130723f,0.591127098f,0.348205268f,0.198669329f,0.112231314f,0.0632033944f,0.0355580896f,
0.0199986659f,0.011246589f,0.00632451288f,0.00355655141f,0.0019999987f,0.00112468237f,0.000632455456f,0.00035565588f,
0.141120002f,0.993253171f,0.812648892f,0.5085361f,0.295520216f,0.167903304f,0.0947260857f,0.0533230826f,
0.0299954992f,0.0168694388f,0.00948669016f,0.00533481315f,0.0029999956f,0.00168702309f,0.000948683126f,0.000533483806f,
-0.756802499f,0.778471708f,0.953580737f,0.652827978f,0.389418334f,0.223044485f,0.126154065f,0.0710712075f,
0.0399893336f,0.0224917568f,0.0126487734f,0.00711305765f,0.00399998948f,0.00224936334f,0.00126491068f,0.000711311703f,
-0.958924294f,0.32393527f,0.999946535f,0.776529968f,0.47942555f,0.277480543f,0.157455876f,0.0887968615f,
0.0499791652f,0.0281133614f,0.0158107281f,0.00889127981f,0.0049999794f,0.0028117029f,0.00158113812f,0.000889139599f,
-0.279415488f,-0.230367512f,0.947148204f,0.875740528f,0.564642489f,0.33103931f,0.188600272f,0.106494442f,
0.0599640049f,0.0337340795f,0.0189725272f,0.0106694745f,0.0059999642f,0.00337404152f,0.00189736532f,0.00106696738f,
0.656986594f,-0.713721275f,0.800421596f,0.947330713f,0.64421767f,0.383551568f,0.219556093f,0.124158338f,
0.0699428469f,0.0393537246f,0.0221341345f,0.0124476347f,0.00699994294f,0.00393637875f,0.00221359241f,0.00124479528f,
0.989358246f,-0.977261782f,0.574317753f,0.989042461f,0.717356086f,0.434851229f,0.250292331f,0.141782969f,
0.0799146891f,0.0449721329f,0.0252955221f,0.0142257558f,0.0079999147f,0.00449871505f,0.00252981926f,0.00142262306f,
0.412118495f,-0.939823508f,0.291259229f,0.999560297f,0.783326924f,0.484776139f,0.280778319f,0.159362778f,
0.0898785442f,0.0505891182f,0.0284566563f,0.0160038304f,0.00899987947f,0.00506105041f,0.00284604589f,0.00160045072f,
-0.54402113f,-0.612936914f,-0.0206835698f,0.978552461f,0.841470957f,0.533168435f,0.310983568f,0.176892191f,
0.099833414f,0.0562044978f,0.0316175036f,0.0177818574f,0.009999834f,0.00562338345f,0.00316227227f,0.0017782785f,
-0.999990225f,-0.0972764567f,-0.33057496f,0.926681578f,0.891207397f,0.579875171f,0.340877861f,0.19436565f,
0.1097783f,0.0618181042f,0.0347780399f,0.0195598267f,0.0109997792f,0.00618571462f,0.00347849843f,0.00195610616f,
-0.536572933f,0.448342979f,-0.60768342f,0.845583618f,0.932039082f,0.624748647f,0.370431304f,0.211777672f,
0.119712204f,0.0674297586f,0.0379382223f,0.0213377345f,0.0119997123f,0.0067480444f,0.00379472389f,0.00213393359f,
0.420167029f,0.855880976f,-0.824528456f,0.737816215f,0.963558197f,0.667647004f,0.399614304f,0.229122713f,
0.129634142f,0.0730392784f,0.0410980321f,0.0231155735f,0.0129996343f,0.00731037185f,0.00411094911f,0.00231176103f,
0.990607381f,0.999823332f,-0.959605396f,0.606778562f,0.985449731f,0.708434701f,0.428397775f,0.246395305f,
0.139543116f,0.078646481f,0.0442574248f,0.0248933397f,0.0139995432f,0.00787269697f,0.00442717411f,0.00248958869f,
0.650287867f,0.835838437f,-0.999518692f,0.456603259f,0.997494996f,0.746982634f,0.456752867f,0.263589978f,
0.149438128f,0.0842512026f,0.0474163815f,0.0266710296f,0.0149994381f,0.00843502022f,0.00474339863f,0.00266741589f,
-0.287903309f,0.414430231f,-0.940310359f,0.292027086f,0.999573588f,0.783169091f,0.484651238f,0.280701309f,
0.159318209f,0.0898532644f,0.0505748577f,0.028448632f,0.015999319f,0.00899733976f,0.00505962269f,0.00284524332f,
-0.961397469f,-0.134615138f,-0.78785187f,0.11824052f,0.991664827f,0.81687957f,0.512064993f,0.29772386f,
0.169182345f,0.09545248f,0.0537328273f,0.0302261449f,0.0169991814f,0.00955965649f,0.00537584582f,0.00302307028f,
-0.750987232f,-0.642200708f,-0.557262897f,-0.0592755191f,0.973847628f,0.84800756f,0.538966715f,0.314652264f,
0.179029569f,0.101048686f,0.0568902642f,0.0320035629f,0.0179990288f,0.0101219704f,0.00569206895f,0.00320089748f,
0.149877205f,-0.952000856f,-0.271410108f,-0.234921798f,0.946300089f,0.876454532f,0.565329552f,0.331481189f,
0.188858896f,0.10664168f,0.060047131f,0.0337808803f,0.0189988576f,0.0106842816f,0.00600829115f,0.00337872445f,
0.912945271f,-0.968601942f,0.0413582884f,-0.403158993f,0.909297407f,0.902130723f,0.591127038f,0.348205268f,
0.198669314f,0.112231314f,0.0632033944f,0.0355580896f,0.0199986678f,0.011246589f,0.00632451288f,0.00355655141f,
0.836655617f,-0.686891198f,0.35002476f,-0.558680534f,0.863209307f,0.924954832f,0.616333544f,0.364819258f,
0.208459899f,0.117817394f,0.0663590282f,0.0373351872f,0.0209984574f,0.0118088927f,0.00664073415f,0.00373437814f,
-0.00885130931f,-0.193630233f,0.623979926f,-0.696581721f,0.808496356f,0.944854796f,0.640923738f,0.381317884f,
0.218229622f,0.123399742f,0.0695140064f,0.0391121693f,0.0219982266f,0.0123711927f,0.00695695449f,0.00391220488f,
-0.846220434f,0.359264523f,0.836055279f,-0.812512875f,0.745705247f,0.961767614f,0.664873064f,0.397695929f,
0.227977514f,0.128978193f,0.0726682767f,0.0408890247f,0.0229979735f,0.0129334899f,0.00727317436f,0.00409003161f,
-0.905578375f,0.801513135f,0.965219259f,-0.902817786f,0.67546314f,0.97563988f,0.688157499f,0.413948208f,
0.237702623f,0.134552568f,0.0758218244f,0.0426657498f,0.0239976961f,0.0134957815f,0.0075893933f,0.00426785741f,
-0.132351756f,0.996909976f,0.998663187f,-0.964648306f,0.598472118f,0.986427724f,0.710753918f,0.430069596f,
0.247403964f,0.140122697f,0.0789746121f,0.0444423407f,0.0249973964f,0.0140580693f,0.00790561177f,0.00444568414f,
0.76255846f,0.885276794f,0.933070183f,-0.996054351f,0.515501261f,0.994096994f,0.732639611f,0.446054995f,
0.257080555f,0.145688385f,0.0821266174f,0.0462187938f,0.0259970706f,0.0146203535f,0.00822182931f,0.00462350994f,
0.956375957f,0.500994205f,0.774945021f,-0.996045172f,0.427379847f,0.99862349f,0.753792703f,0.46189931f,
0.266731411f,0.151249468f,0.0852777958f,0.0479951017f,0.0269967206f,0.015182632f,0.00853804592f,0.00480133574f,
0.270905793f,-0.0375856608f,0.539968967f,-0.964621305f,0.334988207f,0.999992907f,0.774192095f,0.477597594f,
0.276355654f,0.156805754f,0.0884281173f,0.049771253f,0.0279963426f,0.0157449059f,0.0088542616f,0.00497916201f,
-0.663633883f,-0.564589798f,0.251445323f,-0.902773678f,0.239249229f,0.998200953f,0.793817401f,0.49314484f,
0.28595221f,0.162357092f,0.0915775672f,0.0515472479f,0.0289959367f,0.0163071752f,0.00917047635f,0.00515698735f,
-0.988031626f,-0.917709649f,-0.0620148405f,-0.812452853f,0.141120002f,0.993253171f,0.812648892f,0.5085361f,
0.295520186f,0.167903304f,0.0947260931f,0.0533230826f,0.029995501f,0.0168694388f,0.00948669016f,0.00533481315f,
-0.404037654f,-0.988192797f,-0.369325012f,-0.696507812f,0.0415805206f,0.985165298f,0.830667794f,0.523766637f,
0.305058628f,0.173444211f,0.0978736654f,0.055098746f,0.0309950355f,0.0174316969f,0.00980290305f,0.00551263802f,
0.551426709f,-0.754330218f,-0.640009403f,-0.5585953f,-0.0583741926f,0.973962843f,0.847856104f,0.538831532f,
0.314566553f,0.17897962f,0.101020269f,0.0568742342f,0.0319945402f,0.0179939512f,0.0101191159f,0.00569046335f,
0.999911845f,-0.28814739f,-0.847224355f,-0.403064936f,-0.157745644f,0.959681332f,0.864196658f,0.553726017f,
0.324043006f,0.184509367f,0.10416586f,0.0586495437f,0.0329940096f,0.0185561981f,0.010435327f,0.00586828869f,
0.529082716f,0.266779721f,-0.97042042f,-0.234822124f,-0.255541205f,0.942365825f,0.879673064f,0.568445385f,
0.333487093f,0.190033287f,0.107310407f,0.0604246669f,0.0339934528f,0.0191184394f,0.010751537f,0.00604611309f,
-0.428182662f,0.739542127f,-0.997380435f,-0.0591726787f,-0.350783229f,0.92207104f,0.894269884f,0.582984984f,
0.342897803f,0.195551202f,0.110453881f,0.0621996038f,0.034992855f,0.0196806751f,0.0110677453f,0.00622393796f,
-0.991778851f,0.984540582f,-0.925431013f,0.118342586f,-0.442520559f,0.89886117f,0.907972515f,0.597340286f,
0.352274209f,0.201062918f,0.113596253f,0.0639743358f,0.0359922275f,0.0202429052f,0.0113839535f,0.0064017619f,
-0.643538117f,0.926318109f,-0.761706948f,0.292125374f,-0.529836178f,0.872809589f,0.920767248f,0.611506701f,
0.361615449f,0.206568271f,0.116737492f,0.0657488778f,0.036991559f,0.0208051261f,0.0117001599f,0.0065795863f,
0.296368569f,0.58280617f,-0.522444785f,0.456694692f,-0.611857831f,0.84399873f,0.932641268f,0.625479698f,
0.370920479f,0.212067112f,0.119877554f,0.0675232038f,0.0379908569f,0.0213673431f,0.0120163653f,0.00675741071f,
0.963795364f,0.0598003156f,-0.231372014f,0.606860459f,-0.687766254f,0.81251961f,0.943582714f,0.639254928f,
0.380188406f,0.217559248f,0.123016424f,0.0692973137f,0.0389901139f,0.0219295528f,0.0123325698f,0.00693523418f,
0.745113134f,-0.481621295f,0.0826458037f,0.737885714f,-0.756802499f,0.778471708f,0.953580678f,0.652827978f,
0.389418334f,0.223044485f,0.126154065f,0.0710712075f,0.0399893373f,0.0224917568f,0.0126487734f,0.00711305765f,
-0.158622667f,-0.874714017f,0.388467699f,0.845638454f,-0.818277061f,0.74196279f,0.962625206f,0.666194677f,
0.39860931f,0.228522688f,0.129290432f,0.0728448778f,0.0409885161f,0.0230539497f,0.0129649751f,0.00729088066f,
-0.916521549f,-0.998410463f,0.655764699f,0.926720202f,-0.871575892f,0.703108132f,0.970707119f,0.679350674f,
0.407760441f,0.233993664f,0.132425532f,0.0746183172f,0.0419876575f,0.0236161388f,0.0132811759f,0.00746870413f,
-0.831774771f,-0.814614236f,0.858030677f,0.97857362f,-0.916166008f,0.662030637f,0.977818429f,0.692291796f,
0.416870773f,0.23945722f,0.135559291f,0.0763915181f,0.0429867506f,0.0241783205f,0.0135973748f,0.00764652714f,
0.0177019257f,-0.37993139f,0.975206196f,0.999563396f,-0.951602101f,0.618860185f,0.983951986f,0.70501405f,
0.425939471f,0.244913206f,0.138691694f,0.0781644881f,0.0439858064f,0.0247404929f,0.0139135728f,0.00782434922f,
0.850903511f,0.171763569f,0.995670974f,0.989027262f,-0.977530122f,0.57373327f,0.989101648f,0.717513323f,
0.434965521f,0.250361472f,0.141822711f,0.0799371973f,0.0449848175f,0.0253026579f,0.0142297689f,0.00800217129f,
0.901788354f,0.670557022f,0.917395473f,0.947297752f,-0.993690968f,0.526792526f,0.993262351f,0.72978574f,
0.44394809f,0.255801797f,0.144952312f,0.0817096606f,0.0459837839f,0.0258648153f,0.0145459641f,0.0081799943f,
0.123573124f,0.962832689f,0.748142362f,0.875690997f,-0.999923289f,0.478186339f,0.996429801f,0.741827428f,
0.452886283f,0.261234075f,0.148080453f,0.0834818557f,0.0469827019f,0.0264269635f,0.0148621574f,0.00835781638f,
-0.768254638f,0.958573103f,0.504697084f,0.776465356f,-0.99616462f,0.428068399f,0.99860096f,0.753634512f,
0.461779177f,0.266658038f,0.151207119f,0.0852537975f,0.0479815714f,0.0269891042f,0.0151783489f,0.00853563752f,
-0.953752637f,0.659090102f,0.211200655f,0.652750373f,-0.982452571f,0.376597136f,0.999773562f,0.765203178f,
0.470625877f,0.272073567f,0.15433228f,0.087025471f,0.0489803962f,0.0275512375f,0.0154945394f,0.0087134596f,
-0.262374848f,0.156619072f,-0.10324046f,0.508447945f,-0.958924294f,0.32393527f,0.999946535f,0.776529968f,
0.47942555f,0.277480543f,0.157455891f,0.0887968615f,0.0499791689f,0.0281133596f,0.0158107281f,0.00889127981f,
0.670229197f,-0.394086063f,-0.407444149f,0.3481085f,-0.925814748f,0.270249337f,0.99911958f,0.787611187f,
0.48817724f,0.282878697f,0.160577938f,0.0905679762f,0.0509778969f,0.0286754742f,0.0161269177f,0.00906910095f,
0.986627579f,-0.823421597f,-0.671240151f,0.176790684f,-0.883454502f,0.215709001f,0.997293651f,0.798443377f,
0.496880114f,0.28826794f,0.163698375f,0.0923388004f,0.051976569f,0.0292375814f,0.0164431017f,0.00924692024f,
0.395925164f,-0.999157965f,-0.868469954f,-0.000103020677f,-0.832267344f,0.160486728f,0.994470477f,0.809023023f,
0.505533338f,0.293648034f,0.166817173f,0.0941093415f,0.0529751927f,0.0297996756f,0.0167592876f,0.00942474138f,
-0.558789074f,-0.867171526f,-0.979574919f,-0.176993474f,-0.772764444f,0.104756832f,0.990652919f,0.819346905f,
0.514135957f,0.29901889f,0.169934288f,0.0958795771f,0.0539737605f,0.0303617641f,0.0170754679f,0.00960256159f,
-0.999755144f,-0.468111664f,-0.993535519f,-0.348301649f,-0.705540299f,0.0486960001f,0.985844791f,0.829411685f,
0.522687256f,0.304380238f,0.173049718f,0.0976495072f,0.0549722798f,0.0309238415f,0.01739165f,0.00978038087f,
-0.521551013f,0.0751182064f,-0.908967435f,-0.508624554f,-0.631266713f,-0.00751878507f,0.980050862f,0.839214146f,
0.531186223f,0.30973196f,0.17616342f,0.0994191393f,0.0559707358f,0.0314859077f,0.0177078284f,0.00995820016f,
0.436164767f,0.595211506f,-0.734258294f,-0.652905703f,-0.550685287f,-0.0637097955f,0.973276973f,0.848751247f,
0.539632022f,0.315073937f,0.179275364f,0.101188451f,0.0569691435f,0.0320479684f,0.0180240069f,0.0101360194f,
0.992872655f,0.931992829f,-0.486733496f,-0.776594579f,-0.464602023f,-0.119699396f,0.965529919f,0.858020008f,
0.548023939f,0.3204059f,0.182385504f,0.102957435f,0.0579674877f,0.0326100141f,0.0183401816f,0.0103138378f,
0.636738002f,0.981735826f,-0.190938011f,-0.87579f,-0.373876572f,-0.175310582f,0.956817448f,0.867017388f,
0.55636102f,0.325727791f,0.185493827f,0.104726106f,0.0589657798f,0.0331720486f,0.0186563563f,0.0104916561f,
-0.304810613f,0.729123712f,0.12379095f,-0.947363734f,-0.279415488f,-0.230367512f,0.947148204f,0.875740528f,
0.564642429f,0.33103931f,0.188600287f,0.106494442f,0.0599640086f,0.0337340795f,0.0189725272f,0.0106694745f,
-0.966117799f,0.251952261f,0.426245421f,-0.98905772f,-0.182162598f,-0.284696162f,0.936531842f,0.884186864f,
0.572867453f,0.336340427f,0.191704854f,0.108262435f,0.0609621815f,0.0342960916f,0.0192886982f,0.0108472919f,
-0.739180684f,-0.302812874f,0.686427653f,-0.999557257f,-0.0830891207f,-0.338124752f,0.924979091f,0.892353535f,
0.581035137f,0.341630876f,0.194807529f,0.110030092f,0.0619602874f,0.0348580964f,0.0196048655f,0.0110251084f,
0.167355701f,-0.764320076f,0.878538549f,-0.978531301f,0.0168140903f,-0.390484393f,0.912501454f,0.900238097f,
0.589144766f,0.346910536f,0.197908238f,0.111797392f,0.0629583374f,0.0354200937f,0.0199210308f,0.0112029258f,
};

constexpr int TP = 8192;
constexpr int TS = 32768;
constexpr int TT = TP + TS;
constexpr int DM = 1024;
constexpr int NIN = 3072;
constexpr int NLAYER = 4;
constexpr float ALPHA = 1.6817928305074292f;
constexpr float LOG2E = 1.4426950408889634f;
constexpr float C1 = 0.125f * LOG2E;
constexpr size_t OUT_NK = (size_t)TT * DM;
constexpr size_t OUT_NV = OUT_NK + (size_t)32 * 4 * 256 * 256;
constexpr size_t OUT_GK = OUT_NV + (size_t)32 * 4 * 256 * 256;
constexpr size_t OUT_GV = OUT_GK + (size_t)32 * 4 * 256 * 128;

struct Params {
  const float *x_prompt, *x_sample, *c, *cnk, *cnv, *cgk, *cgv, *c_ctx, *w_mod, *b_mod, *w_in, *b_in, *pool_w, *pool_scale,
      *nat_bias, *q_norm, *k_norm, *conv_w, *conv_b, *conv_ln_g, *conv_ln_b, *conv_pw, *w_out, *b_out, *ln_g, *ln_b;
  float* out;
  char* ws;
  int ph0, ph1;
};
constexpr size_t WS_WINT = 0;
constexpr size_t WS_WOUTT = WS_WINT + (size_t)4 * 3072 * 1024 * 2;
constexpr size_t WS_PWT = WS_WOUTT + (size_t)4 * 1024 * 1024 * 2;
constexpr size_t WS_POOLT = WS_PWT + (size_t)4 * 256 * 256 * 2;
constexpr size_t WS_CNK = WS_POOLT + (size_t)16 * 4096 * 2;
constexpr size_t WS_CNV = WS_CNK + (size_t)4194304 * 2;
constexpr size_t WS_CGK = WS_CNV + (size_t)4194304 * 2;
constexpr size_t WS_CGV = WS_CGK + (size_t)2097152 * 2;
constexpr size_t WS_U = WS_CGV + (size_t)2097152 * 2;
constexpr size_t WS_H = WS_U + (size_t)TT * NIN * 2;
constexpr size_t WS_MX = WS_H + (size_t)TT * DM * 2;
constexpr size_t WS_MOD = WS_MX + (size_t)TT * DM * 2;
constexpr size_t WS_STATS = WS_MOD + (size_t)4 * 9 * 3072 * 4;
constexpr size_t WS_CNT = WS_STATS + (size_t)TT * 2 * 4;
#define P_WinT ((bf16_t*)(p.ws + WS_WINT))
#define P_WoutT ((bf16_t*)(p.ws + WS_WOUTT))
#define P_pwT ((bf16_t*)(p.ws + WS_PWT))
#define P_poolT ((bf16_t*)(p.ws + WS_POOLT))
#define P_cnk_b ((bf16_t*)(p.ws + WS_CNK))
#define P_cnv_b ((bf16_t*)(p.ws + WS_CNV))
#define P_cgk_b ((bf16_t*)(p.ws + WS_CGK))
#define P_cgv_b ((bf16_t*)(p.ws + WS_CGV))
#define P_U ((bf16_t*)(p.ws + WS_U))
#define P_H ((bf16_t*)(p.ws + WS_H))
#define P_MX ((bf16_t*)(p.ws + WS_MX))
#define P_mod ((float*)(p.ws + WS_MOD))
#define P_stats ((float*)(p.ws + WS_STATS))
#define P_cnt ((unsigned*)(p.ws + WS_CNT))

DEV float bf2f(bf16_t h) { return __uint_as_float(((unsigned)h) << 16); }
DEV unsigned pk2(float lo, float hi) { f32x2 v = {lo, hi}; bf16x2_t b = __builtin_convertvector(v, bf16x2_t); return __builtin_bit_cast(unsigned, b); }
DEV bf16_t f2bf(float f) { return (bf16_t)(pk2(f, 0.f) & 0xffffu); }
DEV float bflo(unsigned w) { return __uint_as_float(w << 16); }
DEV float bfhi(unsigned w) { return __uint_as_float(w & 0xffff0000u); }
DEV float silu_f(float x) { return x / (1.f + __expf(-x)); }
DEV float sigm_f(float x) { return 1.f / (1.f + __expf(-x)); }
DEV f32x4 mfma16(bf16x8 a, bf16x8 b, f32x4 c) { return __builtin_amdgcn_mfma_f32_16x16x32_bf16(a, b, c, 0, 0, 0); }
typedef short v4i16_t __attribute__((ext_vector_type(4)));
DEV s16x4 tr16(const char* p) {
  return __builtin_bit_cast(s16x4, __builtin_amdgcn_ds_read_tr16_b64_v4i16((__attribute__((address_space(3))) v4i16_t*)p));
}
DEV float wave_sum(float v) {
  v += __shfl_xor(v, 1); v += __shfl_xor(v, 2); v += __shfl_xor(v, 4); v += __shfl_xor(v, 8); v += __shfl_xor(v, 16); v += __shfl_xor(v, 32);
  return v;
}
DEV int get_tid() { int t = threadIdx.x; asm volatile("" : "+v"(t)); return t; }
DEV int cond_of_row(int row) { return row < TP ? 0 : 1 + ((row - TP) >> 12); }

DEV void tconv_tile(const float* src, int sld, bf16_t* dst, int dld, char* smem) {
  float* t = (float*)smem;
  const int tid = get_tid();
#pragma unroll
  for (int i = 0; i < 16; ++i) { int idx = tid + i * 256; int r = idx >> 6, c = idx & 63; t[r * 65 + c] = src[(size_t)r * sld + c]; }
  __syncthreads();
#pragma unroll
  for (int i = 0; i < 16; ++i) { int idx = tid + i * 256; int n = idx >> 6, k = idx & 63; dst[(size_t)n * dld + k] = f2bf(t[k * 65 + n]); }
  __syncthreads();
}

DEV void cvt_unit(const float* src, bf16_t* dst, int u) {
  const size_t base = (size_t)u * 16384;
  const int tid = get_tid();
#pragma unroll
  for (int i = 0; i < 16; ++i) {
    size_t e = base + (size_t)(i * 256 + tid) * 4;
    f32x4 v = *(const f32x4*)(src + e);
    u32x2 w; w.x = pk2(v[0], v[1]); w.y = pk2(v[2], v[3]);
    *(u32x2*)(dst + e) = w;
  }
}

DEV void mod_unit(const Params& p, int u, char* smem) {
  const int l = u / 48, n0 = (u % 48) * 64, tid = get_tid();
  float* sc = (float*)smem;
  float* red = (float*)(smem + 36864);
  for (int i = tid; i < 9216; i += 256) { int c = i >> 10, k = i & 1023; float v = (c == 0) ? p.c_ctx[k] : p.c[(c - 1) * 1024 + k]; sc[i] = silu_f(v); }
  __syncthreads();
  const int kq = tid >> 6, col = n0 + (tid & 63);
  float acc[9];
#pragma unroll
  for (int c = 0; c < 9; ++c) acc[c] = 0.f;
  const float* wp = p.w_mod + ((size_t)l * 1024 + kq * 256) * 3072 + col;
#pragma unroll 8
  for (int k = 0; k < 256; ++k) {
    float w = wp[(size_t)k * 3072];
#pragma unroll
    for (int c = 0; c < 9; ++c) acc[c] += sc[c * 1024 + kq * 256 + k] * w;
  }
#pragma unroll
  for (int c = 0; c < 9; ++c) red[(kq * 9 + c) * 64 + (tid & 63)] = acc[c];
  __syncthreads();
  for (int i = tid; i < 576; i += 256) {
    int c = i >> 6, j = i & 63;
    float s = red[(0 * 9 + c) * 64 + j] + red[(1 * 9 + c) * 64 + j] + red[(2 * 9 + c) * 64 + j] + red[(3 * 9 + c) * 64 + j];
    P_mod[((size_t)l * 9 + c) * 3072 + n0 + j] = s + p.b_mod[l * 3072 + n0 + j];
  }
  __syncthreads();
}

DEV void h0_unit(const Params& p, int u) {
  const int tid = get_tid(), col = tid * 4;
  const int row0 = u * 32;
  const int cond = cond_of_row(row0);
  const float* md = P_mod + (size_t)cond * 3072;
  const f32x4 sh = *(const f32x4*)(md + col), sc = *(const f32x4*)(md + 1024 + col);
#pragma unroll 4
  for (int i = 0; i < 32; ++i) {
    const int row = row0 + i;
    const float* xr = (row < TP) ? p.x_prompt + (size_t)row * DM : p.x_sample + (size_t)(row - TP) * DM;
    f32x4 x = *(const f32x4*)(xr + col);
    u32x2 w; w.x = pk2(x[0] * (1.f + sc[0]) + sh[0], x[1] * (1.f + sc[1]) + sh[1]); w.y = pk2(x[2] * (1.f + sc[2]) + sh[2], x[3] * (1.f + sc[3]) + sh[3]);
    *(u32x2*)(P_H + (size_t)row * DM + col) = w;
  }
}

DEV void gemm_core(const bf16_t* Ag, const bf16_t* Bg, f32x4 (&acc)[4][4], char* smem) {
  const int tid = get_tid(), lane = tid & 63, wid = tid >> 6, wr = wid >> 1, wc = wid & 1, fr = lane & 15, fq = lane >> 4;
  u32x4 ra[4], rb[4];
#pragma unroll
  for (int m = 0; m < 4; ++m)
#pragma unroll
    for (int n = 0; n < 4; ++n) acc[m][n] = (f32x4){0.f, 0.f, 0.f, 0.f};
  const int lr = tid >> 3, lc = tid & 7;
  const bf16_t* ap = Ag + (size_t)lr * 1024 + lc * 8;
  const bf16_t* bp = Bg + (size_t)lr * 1024 + lc * 8;
#pragma unroll
  for (int i = 0; i < 4; ++i) { ra[i] = *(const u32x4*)(ap + (size_t)i * 32 * 1024); rb[i] = *(const u32x4*)(bp + (size_t)i * 32 * 1024); }
  char* sa = smem; char* sb = smem + 18432;
  for (int kt = 0; kt < 16; ++kt) {
    __syncthreads();
#pragma unroll
    for (int i = 0; i < 4; ++i) { *(u32x4*)(sa + (lr + i * 32) * 144 + lc * 16) = ra[i]; *(u32x4*)(sb + (lr + i * 32) * 144 + lc * 16) = rb[i]; }
    __syncthreads();
    if (kt + 1 < 16) {
#pragma unroll
      for (int i = 0; i < 4; ++i) { ra[i] = *(const u32x4*)(ap + (size_t)i * 32 * 1024 + (kt + 1) * 64); rb[i] = *(const u32x4*)(bp + (size_t)i * 32 * 1024 + (kt + 1) * 64); }
    }
#pragma unroll
    for (int ks = 0; ks < 2; ++ks) {
      bf16x8 af[4], bfr[4];
#pragma unroll
      for (int m = 0; m < 4; ++m) af[m] = *(const bf16x8*)(sa + (wr * 64 + m * 16 + fr) * 144 + ks * 64 + fq * 16);
#pragma unroll
      for (int n = 0; n < 4; ++n) bfr[n] = *(const bf16x8*)(sb + (wc * 64 + n * 16 + fr) * 144 + ks * 64 + fq * 16);
#pragma unroll
      for (int m = 0; m < 4; ++m)
#pragma unroll
        for (int n = 0; n < 4; ++n) acc[m][n] = mfma16(bfr[n], af[m], acc[m][n]);
    }
  }
}

DEV void phaseA_tile(const Params& p, int l, int tile, char* smem) {
  const int mt = tile / 24, nt = tile % 24;
  f32x4 acc[4][4];
  gemm_core(P_H + (size_t)mt * 128 * 1024, P_WinT + ((size_t)l * 3072 + nt * 128) * 1024, acc, smem);
  const int tid = get_tid(), lane = tid & 63, wid = tid >> 6, wr = wid >> 1, wc = wid & 1, fr = lane & 15, fq = lane >> 4;
  const int colb = nt * 128 + wc * 64;
  const int reg = colb >> 6;
  const bool prompt = (mt * 128) < TP;
  f32x4 bias[4];
#pragma unroll
  for (int n = 0; n < 4; ++n) bias[n] = *(const f32x4*)(p.b_in + l * 3072 + colb + n * 16 + 4 * fq);
#pragma unroll
  for (int m = 0; m < 4; ++m)
#pragma unroll
    for (int n = 0; n < 4; ++n) acc[m][n] += bias[n];
  if (reg >= 36 && reg < 42) {
    const float* gptr = (reg < 40 ? p.q_norm : p.k_norm) + l * 64;
    f32x4 gg[4];
#pragma unroll
    for (int n = 0; n < 4; ++n) gg[n] = *(const f32x4*)(gptr + n * 16 + 4 * fq);
#pragma unroll
    for (int m = 0; m < 4; ++m) {
      float ss = 0.f;
#pragma unroll
      for (int n = 0; n < 4; ++n)
#pragma unroll
        for (int j = 0; j < 4; ++j) ss += acc[m][n][j] * acc[m][n][j];
      ss += __shfl_xor(ss, 16); ss += __shfl_xor(ss, 32);
      const float r = rsqrtf(ss * (1.f / 64.f) + 1e-6f);
#pragma unroll
      for (int n = 0; n < 4; ++n) acc[m][n] = acc[m][n] * r * gg[n];
      if (!prompt) {
        const int row = mt * 128 + wr * 64 + m * 16 + fr;
        const int t = (row - TP) & 4095, pr = t >> 6, pc = t & 63;
        const f32x4 c0 = *(const f32x4*)(ROPE_COS + pr * 16 + 4 * fq), s0 = *(const f32x4*)(ROPE_SIN + pr * 16 + 4 * fq);
        const f32x4 c1 = *(const f32x4*)(ROPE_COS + pc * 16 + 4 * fq), s1 = *(const f32x4*)(ROPE_SIN + pc * 16 + 4 * fq);
        const f32x4 x1 = acc[m][0], x2 = acc[m][1], y1 = acc[m][2], y2 = acc[m][3];
        acc[m][0] = x1 * c0 - x2 * s0; acc[m][1] = x2 * c0 + x1 * s0;
        acc[m][2] = y1 * c1 - y2 * s1; acc[m][3] = y2 * c1 + y1 * s1;
      }
    }
  }
#pragma unroll
  for (int m = 0; m < 4; ++m) {
    const int row = mt * 128 + wr * 64 + m * 16 + fr;
    bf16_t* up = P_U + (size_t)row * NIN + colb + 4 * fq;
#pragma unroll
    for (int n = 0; n < 4; ++n) { u32x2 w; w.x = pk2(acc[m][n][0], acc[m][n][1]); w.y = pk2(acc[m][n][2], acc[m][n][3]); *(u32x2*)(up + n * 16) = w; }
  }
  if (prompt) {
    float* ob = nullptr; int hw = 0, cofs = 0;
    if (reg >= 12 && reg < 16) { ob = p.out + OUT_NK; hw = 256; cofs = colb - 768; }
    else if (reg >= 16 && reg < 20) { ob = p.out + OUT_NV; hw = 256; cofs = colb - 1024; }
    else if (reg >= 40 && reg < 42) { ob = p.out + OUT_GK; hw = 128; cofs = colb - 2560; }
    else if (reg >= 42 && reg < 44) { ob = p.out + OUT_GV; hw = 128; cofs = colb - 2688; }
    if (ob) {
#pragma unroll
      for (int m = 0; m < 4; ++m) {
        const int row = mt * 128 + wr * 64 + m * 16 + fr;
        const int b = row >> 8, s = row & 255;
        float* op = ob + ((size_t)(b * 4 + l) * 256 + s) * hw + cofs + 4 * fq;
#pragma unroll
        for (int n = 0; n < 4; ++n) *(f32x4*)(op + n * 16) = acc[m][n];
      }
    }
  }
}

DEV void ln_rows(const Params& p, int l, int mt) {
  const int tid = get_tid(), lane = tid & 63, wid = tid >> 6;
  float* Y = p.out;
  for (int i = 0; i < 32; ++i) {
    const int row = mt * 128 + wid * 32 + i;
    float* yr = Y + (size_t)row * DM;
    f32x4 v[4];
#pragma unroll
    for (int q = 0; q < 4; ++q) v[q] = *(const f32x4*)(yr + q * 256 + lane * 4);
    float s = 0.f;
#pragma unroll
    for (int q = 0; q < 4; ++q) s += (v[q][0] + v[q][1]) + (v[q][2] + v[q][3]);
    const float mean = wave_sum(s) * (1.f / 1024.f);
    float s2 = 0.f;
#pragma unroll
    for (int q = 0; q < 4; ++q) { v[q] = v[q] - mean; s2 += (v[q][0] * v[q][0] + v[q][1] * v[q][1]) + (v[q][2] * v[q][2] + v[q][3] * v[q][3]); }
    const float rstd = rsqrtf(wave_sum(s2) * (1.f / 1024.f) + 1e-5f);
    const int cond = cond_of_row(row);
#pragma unroll
    for (int q = 0; q < 4; ++q) {
      const int col = q * 256 + lane * 4;
      const f32x4 g = *(const f32x4*)(p.ln_g + l * 1024 + col), b = *(const f32x4*)(p.ln_b + l * 1024 + col);
      f32x4 x = v[q] * rstd * g + b;
      if (l < NLAYER - 1) {
        const float* md = P_mod + ((size_t)(l + 1) * 9 + cond) * 3072;
        const f32x4 sh = *(const f32x4*)(md + col), sc = *(const f32x4*)(md + 1024 + col);
        f32x4 h = x * (sc + 1.f) + sh;
        u32x2 w; w.x = pk2(h[0], h[1]); w.y = pk2(h[2], h[3]);
        *(u32x2*)(P_H + (size_t)row * DM + col) = w;
      } else {
        *(f32x4*)(yr + col) = x;
      }
    }
    if (l < NLAYER - 1 && lane == 0) { P_stats[row * 2] = mean; P_stats[row * 2 + 1] = rstd; }
  }
}

DEV void phaseC_tile(const Params& p, int l, int tile, char* smem) {
  const int mt = tile >> 3, nt = tile & 7;
  f32x4 acc[4][4];
  gemm_core(P_MX + (size_t)mt * 128 * 1024, P_WoutT + ((size_t)l * 1024 + nt * 128) * 1024, acc, smem);
  const int tid = get_tid(), lane = tid & 63, wid = tid >> 6, wr = wid >> 1, wc = wid & 1, fr = lane & 15, fq = lane >> 4;
  const int colb = nt * 128 + wc * 64 + 4 * fq;
  const int cond = cond_of_row(mt * 128);
  const float* gatep = P_mod + ((size_t)l * 9 + cond) * 3072 + 2048;
  float* Y = p.out;
#pragma unroll
  for (int m = 0; m < 4; ++m) {
    const int row = mt * 128 + wr * 64 + m * 16 + fr;
    float mean = 0.f, rstd = 1.f;
    const float* xr;
    if (l == 0) xr = (row < TP) ? p.x_prompt + (size_t)row * DM : p.x_sample + (size_t)(row - TP) * DM;
    else { xr = Y + (size_t)row * DM; mean = P_stats[row * 2]; rstd = P_stats[row * 2 + 1]; }
#pragma unroll
    for (int n = 0; n < 4; ++n) {
      const int col = colb + n * 16;
      f32x4 xo = *(const f32x4*)(xr + col);
      if (l > 0) {
        const f32x4 g = *(const f32x4*)(p.ln_g + (l - 1) * 1024 + col), b = *(const f32x4*)(p.ln_b + (l - 1) * 1024 + col);
        xo = (xo - mean) * rstd * g + b;
      }
      const f32x4 gt = *(const f32x4*)(gatep + col), bo = *(const f32x4*)(p.b_out + l * 1024 + col);
      f32x4 y = xo * ALPHA + gt * (acc[m][n] + bo);
      *(f32x4*)(Y + (size_t)row * DM + col) = y;
    }
  }
  __threadfence();
  __syncthreads();
  unsigned* flag = (unsigned*)smem;
  if (tid == 0) { unsigned old = atomicAdd(P_cnt + l * 320 + mt, 1u); *flag = (old == 7u) ? 1u : 0u; }
  __syncthreads();
  const bool last = (*flag != 0u);
  if (last) { __threadfence(); ln_rows(p, l, mt); }
}

template <int NQ, int NKT, bool NATL>
DEV void attn_tile(const char* ks, const char* vs, int koff, const bf16x8 (&qf)[NQ][2], f32x4 (&o)[NQ][4], float (&mrun)[NQ], float (&lrun)[NQ],
                   int fr, int fq, const float* biasrow, int qc) {
  f32x4 s[NQ][NKT];
#pragma unroll
  for (int t = 0; t < NKT; ++t) {
    const char* kp = ks + (koff + 16 * t + fr) * 144 + fq * 16;
    const bf16x8 k0 = *(const bf16x8*)kp, k1 = *(const bf16x8*)(kp + 64);
#pragma unroll
    for (int g = 0; g < NQ; ++g) { f32x4 z = {0.f, 0.f, 0.f, 0.f}; z = mfma16(k0, qf[g][0], z); z = mfma16(k1, qf[g][1], z); s[g][t] = z; }
  }
#pragma unroll
  for (int g = 0; g < NQ; ++g) {
    float mx = -1e30f;
#pragma unroll
    for (int t = 0; t < NKT; ++t)
#pragma unroll
      for (int j = 0; j < 4; ++j) {
        float x = s[g][t][j] * C1;
        if (NATL) {
          const int kc = koff + 16 * t + 4 * fq + j;
          const int cs = min(max(qc - 8, 0), 48);
          const bool valid = (kc >= cs) && (kc < cs + 16);
          const int dc = min(max(kc - qc + 15, 0), 30);
          x = valid ? x + biasrow[dc] : -1e30f;
        }
        s[g][t][j] = x; mx = fmaxf(mx, x);
      }
    mx = fmaxf(mx, __shfl_xor(mx, 16)); mx = fmaxf(mx, __shfl_xor(mx, 32));
    const float mn = fmaxf(mrun[g], mx);
    const float al = __builtin_amdgcn_exp2f(mrun[g] - mn);
    mrun[g] = mn;
    float ps = 0.f;
#pragma unroll
    for (int t = 0; t < NKT; ++t)
#pragma unroll
      for (int j = 0; j < 4; ++j) { const float pp = __builtin_amdgcn_exp2f(s[g][t][j] - mn); s[g][t][j] = pp; ps += pp; }
    lrun[g] = lrun[g] * al + ps;
#pragma unroll
    for (int dt = 0; dt < 4; ++dt) o[g][dt] = o[g][dt] * al;
  }
#pragma unroll
  for (int u = 0; u < NKT / 2; ++u) {
    bf16x8 pf[NQ];
#pragma unroll
    for (int g = 0; g < NQ; ++g) {
      u32x4 w;
      w.x = pk2(s[g][2 * u][0], s[g][2 * u][1]); w.y = pk2(s[g][2 * u][2], s[g][2 * u][3]);
      w.z = pk2(s[g][2 * u + 1][0], s[g][2 * u + 1][1]); w.w = pk2(s[g][2 * u + 1][2], s[g][2 * u + 1][3]);
      pf[g] = __builtin_bit_cast(bf16x8, w);
    }
#pragma unroll
    for (int dt = 0; dt < 4; ++dt) {
      const char* vp = vs + (koff + 32 * u + 4 * fq + (fr >> 2)) * 160 + dt * 32 + (fr & 3) * 8;
      const s16x4 lo = tr16(vp), hi = tr16(vp + 16 * 160);
      const bf16x8 vf = {lo[0], lo[1], lo[2], lo[3], hi[0], hi[1], hi[2], hi[3]};
#pragma unroll
      for (int g = 0; g < NQ; ++g) o[g][dt] = mfma16(vf, pf[g], o[g][dt]);
    }
  }
}

template <int MODE>
DEV void attn_unit(const Params& p, int l, int u, char* smem) {
  constexpr int NQ = (MODE == 1) ? 1 : 2;
  const int tid = get_tid(), lane = tid & 63, wid = tid >> 6, fr = lane & 15, fq = lane >> 4;
  int qrow0, qcol, gcol, ocol, NT, NLOC, cstride = 0;
  const bf16_t *kU, *vU, *kC = nullptr, *vC = nullptr;
  int nat_r = 0, nat_rs = 0;
  if (MODE == 0) {
    const int qb = u & 31, g = (u >> 5) & 1, kvh = (u >> 6) & 1, b = u >> 7, h = kvh * 2 + g;
    qrow0 = TP + b * 4096 + qb * 128 + wid * 32; qcol = 2304 + h * 64; gcol = 2816 + h * 64; ocol = 768 + h * 64;
    kU = P_U + (size_t)(TP + b * 4096) * NIN + 2560 + kvh * 64; vU = kU + 128; NLOC = 64; NT = 72;
    kC = P_cgk_b + ((size_t)(b * 4 + l) * 512 * 2 + kvh) * 64; vC = P_cgv_b + ((size_t)(b * 4 + l) * 512 * 2 + kvh) * 64; cstride = 128;
  } else if (MODE == 1) {
    const int r = u & 63, h = (u >> 6) & 3, b = u >> 8;
    nat_r = r; nat_rs = min(max(r - 4, 0), 56);
    qrow0 = TP + b * 4096 + r * 64 + wid * 16; qcol = 512 + h * 64; gcol = 1280 + h * 64; ocol = 256 + h * 64;
    kU = P_U + (size_t)(TP + b * 4096 + nat_rs * 64) * NIN + 768 + h * 64; vU = kU + 256; NLOC = 8; NT = 16;
    kC = P_cnk_b + ((size_t)(b * 4 + l) * 512 * 4 + h) * 64; vC = P_cnv_b + ((size_t)(b * 4 + l) * 512 * 4 + h) * 64; cstride = 256;
    float* bl = (float*)(smem + 38912);
    for (int i = tid; i < 465; i += 256) bl[i] = p.nat_bias[(size_t)(l * 4 + h) * 465 + i] * LOG2E;
  } else {
    const int qb = u & 1, hh = (u >> 1) & 7, b = u >> 4;
    qrow0 = b * 256 + qb * 128 + wid * 32; NLOC = 4; NT = 4;
    int kcol;
    if (hh < 4) { qcol = 512 + hh * 64; kcol = 768 + hh * 64; gcol = 1280 + hh * 64; ocol = 256 + hh * 64; kU = P_U + (size_t)(b * 256) * NIN + kcol; vU = kU + 256; }
    else { const int h = hh - 4; qcol = 2304 + h * 64; kcol = 2560 + (h >> 1) * 64; gcol = 2816 + h * 64; ocol = 768 + h * 64; kU = P_U + (size_t)(b * 256) * NIN + kcol; vU = kU + 128; }
  }
  bf16x8 qf[NQ][2];
#pragma unroll
  for (int g = 0; g < NQ; ++g)
#pragma unroll
    for (int ks = 0; ks < 2; ++ks) qf[g][ks] = *(const bf16x8*)(P_U + (size_t)(qrow0 + g * 16 + fr) * NIN + qcol + ks * 32 + fq * 8);
  f32x4 o[NQ][4]; float mrun[NQ], lrun[NQ];
#pragma unroll
  for (int g = 0; g < NQ; ++g) { mrun[g] = -1e30f; lrun[g] = 0.f;
#pragma unroll
    for (int dt = 0; dt < 4; ++dt) o[g][dt] = (f32x4){0.f, 0.f, 0.f, 0.f}; }
  u32x4 rk[2], rv[2];
  const int lrow = tid >> 3, lc = tid & 7;
  auto gl = [&](int t) {
    const bf16_t *kp, *vp; int st;
    if (t < NLOC) { kp = kU + (size_t)t * 64 * NIN; vp = vU + (size_t)t * 64 * NIN; st = NIN; }
    else { kp = kC + (size_t)(t - NLOC) * 64 * cstride; vp = vC + (size_t)(t - NLOC) * 64 * cstride; st = cstride; }
#pragma unroll
    for (int i = 0; i < 2; ++i) { const size_t off = (size_t)(lrow + i * 32) * st + lc * 8; rk[i] = *(const u32x4*)(kp + off); rv[i] = *(const u32x4*)(vp + off); }
  };
  auto stl = [&](int buf) {
#pragma unroll
    for (int i = 0; i < 2; ++i) {
      *(u32x4*)(smem + buf * 9216 + (lrow + i * 32) * 144 + lc * 16) = rk[i];
      *(u32x4*)(smem + 18432 + buf * 10240 + (lrow + i * 32) * 160 + lc * 16) = rv[i];
    }
  };
  gl(0); stl(0);
  __syncthreads();
  const float* bl = (const float*)(smem + 38912);
#pragma unroll 1
  for (int t = 0; t < NT; ++t) {
    if (t + 1 < NT) gl(t + 1);
    const char* ks = smem + (t & 1) * 9216; const char* vs = smem + 18432 + (t & 1) * 10240;
    if constexpr (MODE == 1) {
      if (t < 8) {
        const int kcw = (wid == 0) ? 0 : (wid == 1) ? 8 : (wid == 2) ? 24 : 32;
        attn_tile<1, 2, true>(ks, vs, kcw, qf, o, mrun, lrun, fr, fq, bl + (nat_rs + t - nat_r + 7) * 31, wid * 16 + fr);
      } else {
        attn_tile<1, 4, false>(ks, vs, 0, qf, o, mrun, lrun, fr, fq, nullptr, 0);
      }
    } else {
      attn_tile<NQ, 4, false>(ks, vs, 0, qf, o, mrun, lrun, fr, fq, nullptr, 0);
    }
    if (t + 1 < NT) stl((t + 1) & 1);
    __syncthreads();
  }
#pragma unroll
  for (int g = 0; g < NQ; ++g) {
    float lt = lrun[g]; lt += __shfl_xor(lt, 16); lt += __shfl_xor(lt, 32);
    const float inv = 1.f / lt;
    const int row = qrow0 + g * 16 + fr;
#pragma unroll
    for (int dt = 0; dt < 4; ++dt) {
      const int d0 = dt * 16 + 4 * fq;
      const u32x2 gw = *(const u32x2*)(P_U + (size_t)row * NIN + gcol + d0);
      u32x2 w;
      w.x = pk2(o[g][dt][0] * inv * silu_f(bflo(gw.x)), o[g][dt][1] * inv * silu_f(bfhi(gw.x)));
      w.y = pk2(o[g][dt][2] * inv * silu_f(bflo(gw.y)), o[g][dt][3] * inv * silu_f(bfhi(gw.y)));
      *(u32x2*)(P_MX + (size_t)row * DM + ocol + d0) = w;
    }
  }
}

DEV void pool_unit(const Params& p, int l, int u, char* smem) {
  const int tid = get_tid(), lane = tid & 63, wid = tid >> 6, fr = lane & 15, fq = lane >> 4;
  const int R0 = u * 32;
  int L, sb;
  if (R0 < TP) { L = 256; sb = R0 & ~255; } else { L = 4096; sb = TP + ((R0 - TP) & ~4095); }
  const int t0 = R0 - sb;
  bf16_t* ya = (bf16_t*)smem;
  {
    const int c = tid, g = c >> 6, win = 2 << g, half = win >> 1;
    const bf16_t* xc = P_U + (size_t)sb * NIN + c;
    float sum = 0.f;
    for (int i = t0 - half; i < t0 - half + win; ++i) if (i >= 0 && i < L) sum += bf2f(xc[(size_t)i * NIN]);
    for (int tt = 0; tt < 32; ++tt) {
      const int t = t0 + tt;
      const int lo = max(t - half, 0), hi = min(t - half + win, L);
      const float y = sum / (float)(hi - lo) - bf2f(xc[(size_t)t * NIN]);
      ya[tt * 264 + c] = f2bf(y);
      const int ia = t - half + win; if (ia < L) sum += bf2f(xc[(size_t)ia * NIN]);
      const int ir = t - half; if (ir >= 0) sum -= bf2f(xc[(size_t)ir * NIN]);
    }
  }
  __syncthreads();
  const int g = wid;
  f32x4 acc[2][4];
#pragma unroll
  for (int m = 0; m < 2; ++m)
#pragma unroll
    for (int n = 0; n < 4; ++n) acc[m][n] = (f32x4){0.f, 0.f, 0.f, 0.f};
  const bf16_t* wt = P_poolT + (size_t)(l * 4 + g) * 4096;
#pragma unroll
  for (int ks = 0; ks < 2; ++ks) {
    bf16x8 af[2], bfr[4];
#pragma unroll
    for (int m = 0; m < 2; ++m) af[m] = *(const bf16x8*)(smem + (m * 16 + fr) * 528 + (g * 64 + ks * 32 + fq * 8) * 2);
#pragma unroll
    for (int n = 0; n < 4; ++n) bfr[n] = *(const bf16x8*)(wt + (n * 16 + fr) * 64 + ks * 32 + fq * 8);
#pragma unroll
    for (int m = 0; m < 2; ++m)
#pragma unroll
      for (int n = 0; n < 4; ++n) acc[m][n] = mfma16(bfr[n], af[m], acc[m][n]);
  }
#pragma unroll
  for (int m = 0; m < 2; ++m) {
    const int row = R0 + m * 16 + fr;
#pragma unroll
    for (int n = 0; n < 4; ++n) {
      const int ch = g * 64 + n * 16 + 4 * fq;
      const f32x4 sc = *(const f32x4*)(p.pool_scale + l * 256 + ch);
      const u32x2 gw = *(const u32x2*)(P_U + (size_t)row * NIN + 256 + ch);
      u32x2 w;
      w.x = pk2(acc[m][n][0] * sc[0] * silu_f(bflo(gw.x)), acc[m][n][1] * sc[1] * silu_f(bfhi(gw.x)));
      w.y = pk2(acc[m][n][2] * sc[2] * silu_f(bflo(gw.y)), acc[m][n][3] * sc[3] * silu_f(bfhi(gw.y)));
      *(u32x2*)(P_MX + (size_t)row * DM + ch) = w;
    }
  }
  __syncthreads();
}

DEV void conv_unit(const Params& p, int l, int u, char* smem) {
  const int tid = get_tid(), lane = tid & 63, wid = tid >> 6, fr = lane & 15, fq = lane >> 4;
  const int R0 = u * 32;
  int L, sb;
  if (R0 < TP) { L = 256; sb = R0 & ~255; } else { L = 4096; sb = TP + ((R0 - TP) & ~4095); }
  const int t0 = R0 - sb;
  bf16_t* zs = (bf16_t*)smem;
  bf16_t* za = (bf16_t*)(smem + 31744);
  float* red = (float*)(smem + 48640);
  for (int idx = tid; idx < 62 * 64; idx += 256) {
    const int i = idx >> 6, cq = (idx & 63) * 4, t = t0 - 15 + i;
    u32x2 w = {0u, 0u};
    if (t >= 0 && t < L) {
      const bf16_t* ur = P_U + (size_t)(sb + t) * NIN;
      const u32x2 vv = *(const u32x2*)(ur + 1536 + cq), gg = *(const u32x2*)(ur + 1792 + cq);
      w.x = pk2(bflo(vv.x) * sigm_f(bflo(gg.x)), bfhi(vv.x) * sigm_f(bfhi(gg.x)));
      w.y = pk2(bflo(vv.y) * sigm_f(bflo(gg.y)), bfhi(vv.y) * sigm_f(bfhi(gg.y)));
    }
    *(u32x2*)(zs + i * 256 + cq) = w;
  }
  __syncthreads();
  const int c = tid;
  float wj[31];
#pragma unroll
  for (int j = 0; j < 31; ++j) wj[j] = p.conv_w[(size_t)(l * 31 + j) * 256 + c];
  const float cb = p.conv_b[l * 256 + c], lg = p.conv_ln_g[l * 256 + c], lb = p.conv_ln_b[l * 256 + c];
  float a[2][16];
#pragma unroll
  for (int ch = 0; ch < 2; ++ch) {
    float zr[46];
#pragma unroll
    for (int i = 0; i < 46; ++i) zr[i] = bf2f(zs[(ch * 16 + i) * 256 + c]);
#pragma unroll
    for (int i = 0; i < 16; ++i) {
      float s = cb;
#pragma unroll
      for (int j = 0; j < 31; ++j) s += zr[i + j] * wj[j];
      a[ch][i] = s;
      const float s1 = wave_sum(s), s2 = wave_sum(s * s);
      if (lane == 0) { red[((ch * 16 + i) * 4 + wid) * 2] = s1; red[((ch * 16 + i) * 4 + wid) * 2 + 1] = s2; }
    }
  }
  __syncthreads();
#pragma unroll
  for (int ch = 0; ch < 2; ++ch)
#pragma unroll
    for (int i = 0; i < 16; ++i) {
      const int tt = ch * 16 + i;
      const float s1 = red[(tt * 4 + 0) * 2] + red[(tt * 4 + 1) * 2] + red[(tt * 4 + 2) * 2] + red[(tt * 4 + 3) * 2];
      const float s2 = red[(tt * 4 + 0) * 2 + 1] + red[(tt * 4 + 1) * 2 + 1] + red[(tt * 4 + 2) * 2 + 1] + red[(tt * 4 + 3) * 2 + 1];
      const float mean = s1 * (1.f / 256.f);
      const float var = fmaxf(s2 * (1.f / 256.f) - mean * mean, 0.f);
      const float rstd = rsqrtf(var + 1e-5f);
      const float v = (a[ch][i] - mean) * rstd * lg + lb;
      za[tt * 264 + c] = f2bf(silu_f(v));
    }
  __syncthreads();
  f32x4 acc[2][4];
#pragma unroll
  for (int m = 0; m < 2; ++m)
#pragma unroll
    for (int n = 0; n < 4; ++n) acc[m][n] = (f32x4){0.f, 0.f, 0.f, 0.f};
  const bf16_t* wt = P_pwT + (size_t)l * 65536;
#pragma unroll
  for (int ks = 0; ks < 8; ++ks) {
    bf16x8 af[2], bfr[4];
#pragma unroll
    for (int m = 0; m < 2; ++m) af[m] = *(const bf16x8*)(smem + 31744 + (m * 16 + fr) * 528 + (ks * 32 + fq * 8) * 2);
#pragma unroll
    for (int n = 0; n < 4; ++n) bfr[n] = *(const bf16x8*)(wt + (size_t)(wid * 64 + n * 16 + fr) * 256 + ks * 32 + fq * 8);
#pragma unroll
    for (int m = 0; m < 2; ++m)
#pragma unroll
      for (int n = 0; n < 4; ++n) acc[m][n] = mfma16(bfr[n], af[m], acc[m][n]);
  }
#pragma unroll
  for (int m = 0; m < 2; ++m) {
    const int row = R0 + m * 16 + fr;
#pragma unroll
    for (int n = 0; n < 4; ++n) {
      const int ch = wid * 64 + n * 16 + 4 * fq;
      const u32x2 gw = *(const u32x2*)(P_U + (size_t)row * NIN + 2048 + ch);
      u32x2 w;
      w.x = pk2(acc[m][n][0] * silu_f(bflo(gw.x)), acc[m][n][1] * silu_f(bfhi(gw.x)));
      w.y = pk2(acc[m][n][2] * silu_f(bflo(gw.y)), acc[m][n][3] * silu_f(bfhi(gw.y)));
      *(u32x2*)(P_MX + (size_t)row * DM + 512 + ch) = w;
    }
  }
  __syncthreads();
}

constexpr int P0_WIN = 3072, P0_WOUT = 1024, P0_PW = 64, P0_POOL = 16, P0_CVT = 768, P0_MOD = 192;
constexpr int P0_UNITS = P0_WIN + P0_WOUT + P0_PW + P0_POOL + P0_CVT + P0_MOD;

DEV void phase0(const Params& p, char* smem) {
  if (blockIdx.x == 0) for (int i = threadIdx.x; i < 1280 + 8; i += 256) P_cnt[i] = 0u;
  for (int u = blockIdx.x; u < P0_UNITS; u += gridDim.x) {
    int v = u;
    if (v < P0_MOD) { mod_unit(p, v, smem); continue; }
    v -= P0_MOD;
    if (v < P0_WIN) { const int l = v / 768, r = v % 768, kt = r / 48, nt = r % 48;
      tconv_tile(p.w_in + ((size_t)l * 1024 + kt * 64) * 3072 + nt * 64, 3072, P_WinT + ((size_t)l * 3072 + nt * 64) * 1024 + kt * 64, 1024, smem); continue; }
    v -= P0_WIN;
    if (v < P0_WOUT) { const int l = v >> 8, r = v & 255, kt = r >> 4, nt = r & 15;
      tconv_tile(p.w_out + ((size_t)l * 1024 + kt * 64) * 1024 + nt * 64, 1024, P_WoutT + ((size_t)l * 1024 + nt * 64) * 1024 + kt * 64, 1024, smem); continue; }
    v -= P0_WOUT;
    if (v < P0_PW) { const int l = v >> 4, r = v & 15, kt = r >> 2, nt = r & 3;
      tconv_tile(p.conv_pw + ((size_t)l * 256 + kt * 64) * 256 + nt * 64, 256, P_pwT + ((size_t)l * 256 + nt * 64) * 256 + kt * 64, 256, smem); continue; }
    v -= P0_PW;
    if (v < P0_POOL) { tconv_tile(p.pool_w + (size_t)v * 4096, 64, P_poolT + (size_t)v * 4096, 64, smem); continue; }
    v -= P0_POOL;
    if (v < 256) { cvt_unit(p.cnk, P_cnk_b, v); continue; }
    v -= 256;
    if (v < 256) { cvt_unit(p.cnv, P_cnv_b, v); continue; }
    v -= 256;
    if (v < 128) { cvt_unit(p.cgk, P_cgk_b, v); continue; }
    v -= 128;
    cvt_unit(p.cgv, P_cgv_b, v);
  }
}

constexpr int PB_GQA = 1024, PB_NAT = 2048, PB_CONV = 1280, PB_PATT = 512, PB_POOL = 1280;
constexpr int PB_UNITS = PB_GQA + PB_NAT + PB_CONV + PB_PATT + PB_POOL;

DEV void phaseB(const Params& p, int l_in, char* smem) {
  unsigned* q = P_cnt + 1280 + l_in;
  int* slot = (int*)(smem + 65536 - 16);
  for (;;) {
    if (threadIdx.x == 0) *slot = (int)atomicAdd(q, 1u);
    __syncthreads();
    int u = *slot;
    __syncthreads();
    if (u >= PB_UNITS) break;
    int l = l_in; asm volatile("" : "+s"(l));
    if (u < PB_GQA) { attn_unit<0>(p, l, u, smem); continue; }
    u -= PB_GQA;
    if (u < PB_NAT) { attn_unit<1>(p, l, u, smem); continue; }
    u -= PB_NAT;
    if (u < PB_CONV) { conv_unit(p, l, u, smem); continue; }
    u -= PB_CONV;
    if (u < PB_PATT) { attn_unit<2>(p, l, u, smem); continue; }
    u -= PB_PATT;
    pool_unit(p, l, u, smem);
  }
}

__global__ void __launch_bounds__(256, 2) mega(Params p) {
  __shared__ __attribute__((aligned(16))) char smem[65536];
  cg::grid_group grid = cg::this_grid();
  const int ph0 = p.ph0, ph1 = p.ph1;
  if (ph0 <= 0 && 0 < ph1) { phase0(p, smem); if (1 < ph1) grid.sync(); }
  if (ph0 <= 1 && 1 < ph1) { for (int u = blockIdx.x; u < TT / 32; u += gridDim.x) h0_unit(p, u); if (2 < ph1) grid.sync(); }
  for (int li = 0; li < NLAYER; ++li) {
    int l = li; asm volatile("" : "+s"(l));
    const int pa = 2 + 3 * li;
    if (ph0 <= pa && pa < ph1) { for (int t = blockIdx.x; t < 320 * 24; t += gridDim.x) phaseA_tile(p, l, t, smem); if (pa + 1 < ph1) grid.sync(); }
    if (ph0 <= pa + 1 && pa + 1 < ph1) { phaseB(p, l, smem); if (pa + 2 < ph1) grid.sync(); }
    if (ph0 <= pa + 2 && pa + 2 < ph1) { for (int t = blockIdx.x; t < 320 * 8; t += gridDim.x) phaseC_tile(p, l, t, smem); if (pa + 3 < ph1) grid.sync(); }
  }
}

#ifndef ONE_LAUNCH
#define ONE_LAUNCH 1
#endif

extern "C" void kernel_launch(void* const* d_in, const int* in_sizes, int n_in, void* d_out, int out_size, void* d_ws, size_t ws_size,
                              hipStream_t stream) {
  static int grid_blocks = 0;
  if (!grid_blocks) {
    int dev = 0, cus = 0, per_cu = 0;
    hipGetDevice(&dev);
    hipDeviceGetAttribute(&cus, hipDeviceAttributeMultiprocessorCount, dev);
    hipOccupancyMaxActiveBlocksPerMultiprocessor(&per_cu, mega, 256, 0);
    if (per_cu > 2) per_cu = 2;
    if (per_cu < 1) per_cu = 1;
    grid_blocks = cus * per_cu;
  }
  Params p{};
  const float* const* in = (const float* const*)d_in;
  p.x_prompt = in[0]; p.x_sample = in[1]; p.c = in[2]; p.cnk = in[3]; p.cnv = in[4]; p.cgk = in[5]; p.cgv = in[6]; p.c_ctx = in[7];
  p.w_mod = in[8]; p.b_mod = in[9]; p.w_in = in[10]; p.b_in = in[11]; p.pool_w = in[12]; p.pool_scale = in[13]; p.nat_bias = in[14];
  p.q_norm = in[15]; p.k_norm = in[16]; p.conv_w = in[17]; p.conv_b = in[18]; p.conv_ln_g = in[19]; p.conv_ln_b = in[20]; p.conv_pw = in[21];
  p.w_out = in[22]; p.b_out = in[23]; p.ln_g = in[24]; p.ln_b = in[25];
  p.out = (float*)d_out;
  p.ws = (char*)d_ws;
#if ONE_LAUNCH
  p.ph0 = 0; p.ph1 = 14;
  void* args[] = {&p};
  hipError_t e = hipLaunchCooperativeKernel((void*)mega, dim3(grid_blocks), dim3(256), args, 0, stream);
  if (e != hipSuccess) fprintf(stderr, "cooperative launch failed: %s (grid %d)\n", hipGetErrorString(e), grid_blocks);
#else
  for (int ph = 0; ph < 14; ++ph) { p.ph0 = ph; p.ph1 = ph + 1; mega<<<grid_blocks, 256, 0, stream>>>(p); }
#endif
}
```

```cpp
#include <hip/hip_runtime.h>
#include <hip/hip_cooperative_groups.h>
#include <cstdio>
#include <cstdint>
namespace cg = cooperative_groups;

typedef unsigned short bf16_t;
typedef short bf16x8 __attribute__((ext_vector_type(8)));
typedef short s16x4 __attribute__((ext_vector_type(4)));
typedef float f32x4 __attribute__((ext_vector_type(4)));
typedef float f32x2 __attribute__((ext_vector_type(2)));
typedef __bf16 bf16x2_t __attribute__((ext_vector_type(2)));
typedef unsigned u32x4 __attribute__((ext_vector_type(4)));
typedef unsigned u32x2 __attribute__((ext_vector_type(2)));
#define DEV __device__ __forceinline__
__device__ const float ROPE_COS[1024] = {
1.f,1.f,1.f,1.f,1.f,1.f,1.f,1.f,
1.f,1.f,1.f,1.f,1.f,1.f,1.f,1.f,
0.540302277f,0.846009135f,0.950415254f,0.98423022f,0.995004177f,0.998419285f,0.999500036f,0.999841869f,
0.999949992f,0.999984205f,0.999994993f,0.999998391f,0.999999523f,0.999999821f,0.99999994f,1.f,
-0.416146845f,0.431462824f,0.806578398f,0.937418282f,0.980066597f,0.993682086f,0.998000681f,0.999367595f,
0.999800026f,0.999936759f,0.999979973f,0.999993682f,0.999997973f,0.999999344f,0.999999821f,0.99999994f,
-0.989992499f,-0.115966164f,0.582753658f,0.861040652f,0.955336511f,0.985803485f,0.995503366f,0.998577297f,
0.999550045f,0.999857724f,0.999954998f,0.999985754f,0.99999553f,0.999998569f,0.999999523f,0.999999881f,
-0.653643608f,-0.627679706f,0.301137477f,0.757506192f,0.921060979f,0.974808276f,0.992010653f,0.997471273f,
0.999200106f,0.999747038f,0.999920011f,0.999974728f,0.999992013f,0.999997497f,0.999999225f,0.999999762f,
0.2836622f,-0.946079254f,-0.0103423381f,0.630080283f,0.87758255f,0.960731268f,0.987526f,0.996049762f,
0.998750269f,0.999604762f,0.999875009f,0.999960482f,0.999987483f,0.999996066f,0.999998748f,0.999999583f,
0.960170269f,-0.973103702f,-0.3207964f,0.482782036f,0.825335622f,0.943616986f,0.982053936f,0.9943133f,
0.998200536f,0.999430835f,0.999819994f,0.999943078f,0.999981999f,0.999994338f,0.999998212f,0.999999404f,
0.753902256f,-0.700429797f,-0.599437475f,0.320257008f,0.764842212f,0.923519433f,0.975599885f,0.992262423f,
0.997551024f,0.999225318f,0.999755025f,0.999922514f,0.999975502f,0.999992251f,0.999997556f,0.999999225f,
-0.145500034f,-0.212036446f,-0.818632424f,0.147631213f,0.696706712f,0.900502324f,0.968170285f,0.989897788f,
0.996801734f,0.998988271f,0.999680042f,0.999898791f,0.999967992f,0.999989867f,0.999996781f,0.999998987f,
-0.91113025f,0.341660261f,-0.956644177f,-0.0296507962f,0.621609926f,0.874638259f,0.959772646f,0.987220109f,
0.995952725f,0.998719573f,0.999595046f,0.99987191f,0.999959528f,0.999987185f,0.999995947f,0.999998748f,
-0.839071512f,0.790131867f,-0.999786079f,-0.205997631f,0.540302277f,0.846009135f,0.950415313f,0.98423022f,
0.995004177f,0.998419285f,0.999500036f,0.999841869f,0.999949992f,0.999984205f,0.999994993f,0.999998391f,
0.00442569796f,0.995257378f,-0.943779767f,-0.375847399f,0.453596085f,0.814705312f,0.940107584f,0.980929136f,
0.993956089f,0.998087406f,0.999395072f,0.999808669f,0.999939501f,0.999980867f,0.99999392f,0.999998093f,
0.843853951f,0.893861592f,-0.79417938f,-0.53384304f,0.362357706f,0.780825913f,0.92885989f,0.97731787f,
0.99280864f,0.997723997f,0.999280095f,0.99977231f,0.999927998f,0.999977231f,0.999992788f,0.999997735f,
0.907446802f,0.517172873f,-0.565820515f,-0.675001681f,0.267498761f,0.744477987f,0.916683376f,0.973397553f,
0.99156189f,0.997329056f,0.999155104f,0.999732792f,0.999915481f,0.999973297f,0.999991536f,0.999997318f,
0.136737213f,-0.0187961515f,-0.28134948f,-0.794870913f,0.16996716f,0.705776393f,0.903590262f,0.969169438f,
0.990216017f,0.996902585f,0.999020159f,0.999690115f,0.99990201f,0.999969006f,0.999990225f,0.999996901f,
-0.759687901f,-0.548975468f,0.0310223512f,-0.889670432f,0.070737198f,0.6648435f,0.889593601f,0.964634836f,
0.988771081f,0.996444523f,0.998875201f,0.999644279f,0.999887526f,0.999964416f,0.999988735f,0.999996424f,
-0.957659483f,-0.910081089f,0.340318173f,-0.95641005f,-0.0291995462f,0.621808827f,0.87470746f,0.959795177f,
0.987227261f,0.99595499f,0.998720288f,0.999595284f,0.999872029f,0.999959528f,0.999987185f,0.999995947f,
-0.275163352f,-0.990897954f,0.615864813f,-0.99298501f,-0.128844544f,0.576808274f,0.858946681f,0.954652011f,
0.985584795f,0.995433986f,0.998555362f,0.999543071f,0.999855518f,0.999954283f,0.999985576f,0.99999541f,
0.660316706f,-0.766536534f,0.830336154f,-0.998241663f,-0.227202162f,0.529984176f,0.842327058f,0.949207008f,
0.983843684f,0.994881511f,0.998380423f,0.999487758f,0.999837995f,0.9999488f,0.999983788f,0.999994874f,
0.988704622f,-0.306095392f,0.962463796f,-0.972014248f,-0.323289543f,0.481484592f,0.824865162f,0.943461835f,
0.982004225f,0.994297504f,0.998195529f,0.999429286f,0.999819517f,0.999942899f,0.99998194f,0.999994278f,
0.408082068f,0.248616725f,0.999144375f,-0.91512996f,-0.416146845f,0.431462824f,0.806578457f,0.937418282f,
0.980066597f,0.993682086f,0.998000681f,0.999367595f,0.999800026f,0.999936759f,0.999979973f,0.999993682f,
-0.547729254f,0.726760268f,0.936740458f,-0.829382956f,-0.504846215f,0.380077004f,0.787485182f,0.931078374f,
0.97803092f,0.993035257f,0.99779582f,0.999302804f,0.999779522f,0.999930263f,0.999977946f,0.999993026f,
-0.99996084f,0.981074572f,0.781440377f,-0.717477441f,-0.588501155f,0.327489585f,0.767604589f,0.92444396f,
0.975897431f,0.992357016f,0.997581005f,0.999234855f,0.999758005f,0.999923468f,0.999975801f,0.999992371f,
-0.53283304f,0.933235765f,0.548645258f,-0.582943261f,-0.666275978f,0.273866832f,0.746956408f,0.917517304f,
0.97366637f,0.991647422f,0.997356176f,0.999163687f,0.999735534f,0.999916375f,0.999973536f,0.999991655f,
0.424179018f,0.597977161f,0.261441678f,-0.430023283f,-0.737393796f,0.219378278f,0.725561321f,0.910300434f,
0.971337974f,0.990906477f,0.997121394f,0.99908942f,0.99971199f,0.999908924f,0.999971211f,0.99999088f,
0.991202831f,0.078552261f,-0.0516893305f,-0.263540596f,-0.801143587f,0.164196163f,0.703440726f,0.902795732f,
0.968912423f,0.99013412f,0.996876657f,0.999011934f,0.999687493f,0.999901175f,0.999968767f,0.999990106f,
0.64691931f,-0.465064496f,-0.359694332f,-0.0887455046f,-0.856888831f,0.108494945f,0.680616796f,0.895005584f,
0.966389954f,0.98933053f,0.996621907f,0.998931348f,0.999662042f,0.999893129f,0.999966204f,0.999989331f,
-0.292138815f,-0.865450621f,-0.632028639f,0.088848114f,-0.904072165f,0.0524506159f,0.6571123f,0.886932373f,
0.963770926f,0.988495648f,0.996357203f,0.998847544f,0.999635518f,0.999884725f,0.999963522f,0.999988496f,
-0.962605894f,-0.999293387f,-0.841684937f,0.26363951f,-0.942222297f,-0.00375941908f,0.632950664f,0.878578722f,
0.961055458f,0.987629473f,0.996082544f,0.998760641f,0.99960804f,0.999876022f,0.99996078f,0.999987602f,
-0.748057544f,-0.825371623f,-0.967871487f,0.430115849f,-0.970958173f,-0.0599575676f,0.608156204f,0.869947195f,
0.958243906f,0.986732066f,0.995797932f,0.998670578f,0.999579549f,0.999867022f,0.999957979f,0.999986708f,
0.154251456f,-0.397251874f,-0.998075247f,0.583026946f,-0.989992499f,-0.115966164f,0.582753658f,0.861040652f,
0.955336511f,0.985803485f,0.995503366f,0.998577297f,0.999550045f,0.999857724f,0.999954998f,0.999985754f,
0.914742351f,0.153215483f,-0.929300308f,0.717549205f,-0.999135137f,-0.171608135f,0.556768358f,0.851861775f,
0.95233357f,0.984843671f,0.995198846f,0.998480916f,0.999519527f,0.999848068f,0.999951959f,0.999984801f,
0.83422339f,0.656495154f,-0.768367112f,0.829440355f,-0.998294771f,-0.226707578f,0.53022635f,0.842413545f,
0.949235439f,0.983852804f,0.994884372f,0.998381376f,0.999488056f,0.999838114f,0.9999488f,0.999983788f,
-0.0132767474f,0.95758605f,-0.531235278f,0.915171385f,-0.987479806f,-0.281090319f,0.503154159f,0.832698941f,
0.946042359f,0.982830763f,0.994559944f,0.998278618f,0.999455571f,0.999827802f,0.999945521f,0.999982774f,
-0.848570287f,0.963757515f,-0.241421118f,0.972038329f,-0.966798186f,-0.334584385f,0.475578904f,0.822721004f,
0.942754686f,0.981777668f,0.994225562f,0.99817276f,0.999422073f,0.999817252f,0.999942183f,0.999981701f,
-0.903692186f,0.673110247f,0.0723346695f,0.998247743f,-0.93645668f,-0.387020677f,0.447528064f,0.812482953f,
0.939372718f,0.980693519f,0.993881226f,0.998063743f,0.999387562f,0.999806345f,0.999938726f,0.999980628f,
-0.127963692f,0.175156534f,0.378916174f,0.992972851f,-0.896758378f,-0.438233554f,0.419029742f,0.801987886f,
0.935896814f,0.979578316f,0.993526995f,0.997951567f,0.999352098f,0.999795079f,0.99993521f,0.999979496f,
0.765414059f,-0.376742303f,0.647921681f,0.95638001f,-0.848100007f,-0.488060862f,0.39011243f,0.791239262f,
0.93232733f,0.978432178f,0.993162811f,0.997836173f,0.99931556f,0.999783576f,0.999931574f,0.999978364f,
0.955073655f,-0.812611222f,0.852673113f,0.889623463f,-0.790967762f,-0.536345184f,0.360805035f,0.780240417f,
0.928664625f,0.977255106f,0.992788672f,0.997717679f,0.999278069f,0.999771714f,0.999927819f,0.999977171f,
0.266642928f,-0.998210371f,0.972865343f,0.794808388f,-0.72593224f,-0.582933903f,0.331136853f,0.768994927f,
0.924909055f,0.976047099f,0.99240464f,0.997596025f,0.999239624f,0.999759495f,0.999923944f,0.999975979f,
-0.666938066f,-0.87637943f,0.996578991f,0.674925625f,-0.653643608f,-0.627679706f,0.301137596f,0.757506192f,
0.921060979f,0.974808276f,0.992010653f,0.997471273f,0.999200106f,0.999747038f,0.999920011f,0.999974728f,
-0.987339258f,-0.484639406f,0.921462357f,0.533756077f,-0.574824035f,-0.670441091f,0.270837069f,0.745777905f,
0.917120814f,0.973538578f,0.991606772f,0.997343302f,0.999159634f,0.999734223f,0.999915957f,0.999973416f,
-0.399985313f,0.0563609414f,0.754965365f,0.375752151f,-0.490260571f,-0.711082935f,0.240265876f,0.733813822f,
0.913088918f,0.972238123f,0.991192937f,0.997212172f,0.999118149f,0.99972111f,0.999911785f,0.999972105f,
0.555113316f,0.580003142f,0.513598442f,0.205897167f,-0.400799006f,-0.749476731f,0.209454417f,0.721617639f,
0.908965766f,0.970906913f,0.990769207f,0.997077882f,0.999075651f,0.999707639f,0.999907553f,0.999970794f,
0.999843299f,0.925014675f,0.221298173f,0.0295478199f,-0.307332784f,-0.785501122f,0.178433523f,0.709193349f,
0.904751658f,0.969545007f,0.990335584f,0.996940494f,0.99903214f,0.99969393f,0.999903202f,0.999969363f,
0.52532196f,0.985138178f,-0.0929481089f,-0.147732988f,-0.210795805f,-0.819042206f,0.147234216f,0.696544766f,
0.90044713f,0.968152404f,0.989892066f,0.996799886f,0.998987675f,0.999679863f,0.999898732f,0.999967992f,
-0.432177931f,0.741858006f,-0.397976756f,-0.320354372f,-0.112152621f,-0.849993885f,0.115887694f,0.683675885f,
0.89605248f,0.966729224f,0.989438653f,0.996656179f,0.998942196f,0.999665439f,0.999894202f,0.999966562f,
-0.992335498f,0.270098448f,-0.663538277f,-0.48287195f,-0.0123883775f,-0.878258407f,0.0844252855f,0.670590878f,
0.891568303f,0.965275466f,0.988975346f,0.996509314f,0.998895705f,0.999650776f,0.999889553f,0.999965072f,
-0.640144348f,-0.284846604f,-0.863296509f,-0.630159974f,0.0874991715f,-0.903746367f,0.0528784581f,0.657293737f,
0.886994898f,0.963791192f,0.988502085f,0.996359289f,0.9988482f,0.999635756f,0.999884784f,0.999963582f,
0.300592542f,-0.75206399f,-0.977442741f,-0.757573068f,0.18651247f,-0.926377118f,0.0212787576f,0.643788815f,
0.882332861f,0.962276459f,0.98801899f,0.996206105f,0.998799741f,0.999620378f,0.999879956f,0.999962032f,
0.964965999f,-0.987659097f,-0.994656444f,-0.861092687f,0.2836622f,-0.946079254f,-0.0103422189f,0.630080283f,
0.87758255f,0.960731268f,0.987526f,0.996049762f,0.998750269f,0.999604762f,0.999875009f,0.999960482f,
0.742154181f,-0.919073522f,-0.913230121f,-0.937454224f,0.377977669f,-0.96279037f,-0.0419528559f,0.616172493f,
0.872744501f,0.959155679f,0.987023175f,0.99589026f,0.998699784f,0.999588788f,0.999869943f,0.999958873f,
-0.162990779f,-0.567430019f,-0.741239965f,-0.984248459f,0.468516916f,-0.976457715f,-0.0735215396f,0.602069914f,
0.86781919f,0.95754981f,0.986510456f,0.995727658f,0.998648286f,0.999572515f,0.999864817f,0.999957263f,
-0.918282807f,-0.0410281904f,-0.495741814f,-1.f,0.554374516f,-0.987038016f,-0.105016708f,0.587776959f,
0.862807095f,0.955913603f,0.985987842f,0.995561838f,0.998595834f,0.999555886f,0.999859571f,0.999955595f,
-0.829309821f,0.498009592f,-0.201079622f,-0.984212041f,0.634692967f,-0.994497895f,-0.136406869f,0.573298037f,
0.857708693f,0.954247177f,0.985455394f,0.995392919f,0.998542368f,0.999538958f,0.999854207f,0.999953866f,
0.0221267566f,0.883669317f,0.113521777f,-0.937382519f,0.708669782f,-0.998813629f,-0.167660639f,0.558637917f,
0.852524519f,0.95255059f,0.984913111f,0.99522084f,0.99848789f,0.999521732f,0.999848783f,0.999952197f,
0.853220105f,0.997174621f,0.416867077f,-0.860988438f,0.775565803f,-0.999971747f,-0.198746875f,0.543801069f,
0.847255111f,0.950823903f,0.984360933f,0.995045662f,0.998432398f,0.999504209f,0.99984318f,0.999950409f,
0.899866819f,0.803569078f,0.678870201f,-0.757439196f,0.834712923f,-0.997968495f,-0.22963427f,0.528792322f,
0.841901004f,0.949067116f,0.983798921f,0.994867265f,0.998375952f,0.999486327f,0.999837577f,0.999948621f,
0.119180135f,0.362476677f,0.873550534f,-0.63000071f,0.885519624f,-0.99281019f,-0.260292053f,0.513616323f,
0.836462677f,0.947280347f,0.983227074f,0.994685769f,0.998318493f,0.999468148f,0.999831796f,0.999946833f,
-0.771080196f,-0.1902491f,0.981602073f,-0.482692331f,0.927478492f,-0.984513164f,-0.290689558f,0.498277903f,
0.830940723f,0.945463598f,0.982645452f,0.994501114f,0.998260021f,0.99944967f,0.999825954f,0.999944985f,
-0.952412963f,-0.684381902f,0.992308319f,-0.320159167f,0.960170269f,-0.973103702f,-0.3207964f,0.482782036f,
0.825335622f,0.943616986f,0.982053936f,0.9943133f,0.998200536f,0.999430835f,0.999819994f,0.999943078f,
-0.258101642f,-0.967739642f,0.904607594f,-0.1475292f,0.98326844f,-0.958617806f,-0.350582451f,0.467133403f,
0.819648027f,0.941740453f,0.981452644f,0.994122326f,0.998140097f,0.999411702f,0.999813974f,0.99994117f,
0.673507154f,-0.953050017f,0.727198064f,0.0297537707f,0.996542096f,-0.941101313f,-0.380017966f,0.451337039f,
0.813878477f,0.939834237f,0.980841517f,0.993928254f,0.998078644f,0.999392271f,0.999807835f,0.999939203f,
0.985896587f,-0.644837022f,0.477671444f,0.206098333f,0.999858618f,-0.920609534f,-0.409073502f,0.435397953f,
0.808027506f,0.937898219f,0.980220556f,0.993731022f,0.998016179f,0.999372482f,0.999801576f,0.999937236f,
};
__device__ const float ROPE_SIN[1024] = {
0.f,0.f,0.f,0.f,0.f,0.f,0.f,0.f,
0.f,0.f,0.f,0.f,0.f,0.f,0.f,0.f,
0.841470957f,0.533168435f,0.310983598f,0.176892191f,0.0998334214f,0.0562044978f,0.0316175036f,0.0177818574f,
0.00999983307f,0.00562338345f,0.00316227227f,0.0017782785f,0.000999999931f,0.000562341243f,0.000316227757f,0.00017782794f,
0.909297407f,0.902130723f,0.591127098f,0.348205268f,0.198669329f,0.112231314f,0.0632033944f,0.0355580896f,
0.0199986659f,0.011246589f,0.00632451288f,0.00355655141f,0.0019999987f,0.00112468237f,0.000632455456f,0.00035565588f,
0.141120002f,0.993253171f,0.812648892f,0.5085361f,0.295520216f,0.167903304f,0.0947260857f,0.0533230826f,
0.0299954992f,0.0168694388f,0.00948669016f,0.00533481315f,0.0029999956f,0.00168702309f,0.000948683126f,0.000533483806f,
-0.756802499f,0.778471708f,0.953580737f,0.652827978f,0.389418334f,0.223044485f,0.126154065f,0.0710712075f,
0.0399893336f,0.0224917568f,0.0126487734f,0.00711305765f,0.00399998948f,0.00224936334f,0.00126491068f,0.000711311703f,
-0.958924294f,0.32393527f,0.999946535f,0.776529968f,0.47942555f,0.277480543f,0.157455876f,0.0887968615f,
0.0499791652f,0.0281133614f,0.0158107281f,0.00889127981f,0.0049999794f,0.0028117029f,0.00158113812f,0.000889139599f,
-0.279415488f,-0.230367512f,0.947148204f,0.875740528f,0.564642489f,0.33103931f,0.188600272f,0.106494442f,
0.0599640049f,0.0337340795f,0.0189725272f,0.0106694745f,0.0059999642f,0.00337404152f,0.00189736532f,0.00106696738f,
0.656986594f,-0.713721275f,0.800421596f,0.947330713f,0.64421767f,0.383551568f,0.219556093f,0.124158338f,
0.0699428469f,0.0393537246f,0.0221341345f,0.0124476347f,0.00699994294f,0.00393637875f,0.00221359241f,0.00124479528f,
0.989358246f,-0.977261782f,0.574317753f,0.989042461f,0.717356086f,0.434851229f,0.250292331f,0.141782969f,
0.0799146891f,0.0449721329f,0.0252955221f,0.0142257558f,0.0079999147f,0.00449871505f,0.00252981926f,0.00142262306f,
0.412118495f,-0.939823508f,0.291259229f,0.999560297f,0.783326924f,0.484776139f,0.280778319f,0.159362778f,
0.0898785442f,0.0505891182f,0.0284566563f,0.0160038304f,0.00899987947f,0.00506105041f,0.00284604589f,0.00160045072f,
-0.54402113f,-0.612936914f,-0.0206835698f,0.978552461f,0.841470957f,0.533168435f,0.310983568f,0.176892191f,
0.099833414f,0.0562044978f,0.0316175036f,0.0177818574f,0.009999834f,0.00562338345f,0.00316227227f,0.0017782785f,
-0.999990225f,-0.0972764567f,-0.33057496f,0.926681578f,0.891207397f,0.579875171f,0.340877861f,0.19436565f,
0.1097783f,0.0618181042f,0.0347780399f,0.0195598267f,0.0109997792f,0.00618571462f,0.00347849843f,0.00195610616f,
-0.536572933f,0.448342979f,-0.60768342f,0.845583618f,0.932039082f,0.624748647f,0.370431304f,0.211777672f,
0.119712204f,0.0674297586f,0.0379382223f,0.0213377345f,0.0119997123f,0.0067480444f,0.00379472389f,0.00213393359f,
0.420167029f,0.855880976f,-0.824528456f,0.737816215f,0.963558197f,0.667647004f,0.399614304f,0.229122713f,
0.129634142f,0.0730392784f,0.0410980321f,0.0231155735f,0.0129996343f,0.00731037185f,0.00411094911f,0.00231176103f,
0.990607381f,0.999823332f,-0.959605396f,0.606778562f,0.985449731f,0.708434701f,0.428397775f,0.246395305f,
0.139543116f,0.078646481f,0.0442574248f,0.0248933397f,0.0139995432f,0.00787269697f,0.00442717411f,0.00248958869f,
0.650287867f,0.835838437f,-0.999518692f,0.456603259f,0.997494996f,0.746982634f,0.456752867f,0.263589978f,
0.149438128f,0.0842512026f,0.0474163815f,0.0266710296f,0.0149994381f,0.00843502022f,0.00474339863f,0.00266741589f,
-0.287903309f,0.414430231f,-0.940310359f,0.292027086f,0.999573588f,0.783169091f,0.484651238f,0.280701309f,
0.159318209f,0.0898532644f,0.0505748577f,0.028448632f,0.015999319f,0.00899733976f,0.00505962269f,0.00284524332f,
-0.961397469f,-0.134615138f,-0.78785187f,0.11824052f,0.991664827f,0.81687957f,0.512064993f,0.29772386f,
0.169182345f,0.09545248f,0.0537328273f,0.0302261449f,0.0169991814f,0.00955965649f,0.00537584582f,0.00302307028f,
-0.750987232f,-0.642200708f,-0.557262897f,-0.0592755191f,0.973847628f,0.84800756f,0.538966715f,0.314652264f,
0.179029569f,0.101048686f,0.0568902642f,0.0320035629f,0.0179990288f,0.0101219704f,0.00569206895f,0.00320089748f,
0.149877205f,-0.952000856f,-0.271410108f,-0.234921798f,0.946300089f,0.876454532f,0.565329552f,0.331481189f,
0.188858896f,0.10664168f,0.060047131f,0.0337808803f,0.0189988576f,0.0106842816f,0.00600829115f,0.00337872445f,
0.912945271f,-0.968601942f,0.0413582884f,-0.403158993f,0.909297407f,0.902130723f,0.591127038f,0.348205268f,
0.198669314f,0.112231314f,0.0632033944f,0.0355580896f,0.0199986678f,0.011246589f,0.00632451288f,0.00355655141f,
0.836655617f,-0.686891198f,0.35002476f,-0.558680534f,0.863209307f,0.924954832f,0.616333544f,0.364819258f,
0.208459899f,0.117817394f,0.0663590282f,0.0373351872f,0.0209984574f,0.0118088927f,0.00664073415f,0.00373437814f,
-0.00885130931f,-0.193630233f,0.623979926f,-0.696581721f,0.808496356f,0.944854796f,0.640923738f,0.381317884f,
0.218229622f,0.123399742f,0.0695140064f,0.0391121693f,0.0219982266f,0.0123711927f,0.00695695449f,0.00391220488f,
-0.846220434f,0.359264523f,0.836055279f,-0.812512875f,0.745705247f,0.961767614f,0.664873064f,0.397695929f,
0.227977514f,0.128978193f,0.0726682767f,0.0408890247f,0.0229979735f,0.0129334899f,0.00727317436f,0.00409003161f,
-0.905578375f,0.801513135f,0.965219259f,-0.902817786f,0.67546314f,0.97563988f,0.688157499f,0.413948208f,
0.237702623f,0.134552568f,0.0758218244f,0.0426657498f,0.0239976961f,0.0134957815f,0.0075893933f,0.00426785741f,
-0.132351756f,0.996909976f,0.998663187f,-0.964648306f,0.598472118f,0.986427724f,0.710753918f,0.430069596f,
0.247403964f,0.140122697f,0.0789746121f,0.0444423407f,0.0249973964f,0.0140580693f,0.00790561177f,0.00444568414f,
0.76255846f,0.885276794f,0.933070183f,-0.996054351f,0.515501261f,0.994096994f,0.732639611f,0.446054995f,
0.257080555f,0.145688385f,0.0821266174f,0.0462187938f,0.0259970706f,0.0146203535f,0.00822182931f,0.00462350994f,
0.956375957f,0.500994205f,0.774945021f,-0.996045172f,0.427379847f,0.99862349f,0.753792703f,0.46189931f,
0.266731411f,0.151249468f,0.0852777958f,0.0479951017f,0.0269967206f,0.015182632f,0.00853804592f,0.00480133574f,
0.270905793f,-0.0375856608f,0.539968967f,-0.964621305f,0.334988207f,0.999992907f,0.774192095f,0.477597594f,
0.276355654f,0.156805754f,0.0884281173f,0.049771253f,0.0279963426f,0.0157449059f,0.0088542616f,0.00497916201f,
-0.663633883f,-0.564589798f,0.251445323f,-0.902773678f,0.239249229f,0.998200953f,0.793817401f,0.49314484f,
0.28595221f,0.162357092f,0.0915775672f,0.0515472479f,0.0289959367f,0.0163071752f,0.00917047635f,0.00515698735f,
-0.988031626f,-0.917709649f,-0.0620148405f,-0.812452853f,0.141120002f,0.993253171f,0.812648892f,0.5085361f,
0.295520186f,0.167903304f,0.0947260931f,0.0533230826f,0.029995501f,0.0168694388f,0.00948669016f,0.00533481315f,
-0.404037654f,-0.988192797f,-0.369325012f,-0.696507812f,0.0415805206f,0.985165298f,0.830667794f,0.523766637f,
0.305058628f,0.173444211f,0.0978736654f,0.055098746f,0.0309950355f,0.0174316969f,0.00980290305f,0.00551263802f,
0.551426709f,-0.754330218f,-0.640009403f,-0.5585953f,-0.0583741926f,0.973962843f,0.847856104f,0.538831532f,
0.314566553f,0.17897962f,0.101020269f,0.0568742342f,0.0319945402f,0.0179939512f,0.0101191159f,0.00569046335f,
0.999911845f,-0.28814739f,-0.847224355f,-0.403064936f,-0.157745644f,0.959681332f,0.864196658f,0.553726017f,
0.324043006f,0.184509367f,0.10416586f,0.0586495437f,0.0329940096f,0.0185561981f,0.010435327f,0.00586828869f,
0.529082716f,0.266779721f,-0.97042042f,-0.234822124f,-0.255541205f,0.942365825f,0.879673064f,0.568445385f,
0.333487093f,0.190033287f,0.107310407f,0.0604246669f,0.0339934528f,0.0191184394f,0.010751537f,0.00604611309f,
-0.428182662f,0.739542127f,-0.997380435f,-0.0591726787f,-0.350783229f,0.92207104f,0.894269884f,0.582984984f,
0.342897803f,0.195551202f,0.110453881f,0.0621996038f,0.034992855f,0.0196806751f,0.0110677453f,0.00622393796f,
-0.991778851f,0.984540582f,-0.925431013f,0.118342586f,-0.442520559f,0.89886117f,0.907972515f,0.597340286f,
0.352274209f,0.201062918f,0.113596253f,0.0639743358f,0.0359922275f,0.0202429052f,0.0113839535f,0.0064017619f,
-0.643538117f,0.926318109f,-0.761706948f,0.292125374f,-0.529836178f,0.872809589f,0.920767248f,0.611506701f,
0.361615449f,0.206568271f,0.116737492f,0.0657488778f,0.036991559f,0.0208051261f,0.0117001599f,0.0065795863f,
0.296368569f,0.58280617f,-0.522444785f,0.456694692f,-0.611857831f,0.84399873f,0.932641268f,0.625479698f,
0.370920479f,0.212067112f,0.119877554f,0.0675232038f,0.0379908569f,0.0213673431f,0.0120163653f,0.00675741071f,
0.963795364f,0.0598003156f,-0.231372014f,0.606860459f,-0.687766254f,0.81251961f,0.943582714f,0.639254928f,
0.380188406f,0.217559248f,0.123016424f,0.0692973137f,0.0389901139f,0.0219295528f,0.0123325698f,0.00693523418f,
0.745113134f,-0.481621295f,0.0826458037f,0.737885714f,-0.756802499f,0.778471708f,0.953580678f,0.652827978f,
0.389418334f,0.223044485f,0.126154065f,0.0710712075f,0.0399893373f,0.0224917568f,0.0126487734f,0.00711305765f,
-0.158622667f,-0.874714017f,0.388467699f,0.845638454f,-0.818277061f,0.74196279f,0.962625206f,0.666194677f,
0.39860931f,0.228522688f,0.129290432f,0.0728448778f,0.0409885161f,0.0230539497f,0.0129649751f,0.00729088066f,
-0.916521549f,-0.998410463f,0.655764699f,0.926720202f,-0.871575892f,0.703108132f,0.970707119f,0.679350674f,
0.407760441f,0.233993664f,0.132425532f,0.0746183172f,0.0419876575f,0.0236161388f,0.0132811759f,0.00746870413f,
-0.831774771f,-0.814614236f,0.858030677f,0.97857362f,-0.916166008f,0.662030637f,0.977818429f,0.692291796f,
0.416870773f,0.23945722f,0.135559291f,0.0763915181f,0.0429867506f,0.0241783205f,0.0135973748f,0.00764652714f,
0.0177019257f,-0.37993139f,0.975206196f,0.999563396f,-0.951602101f,0.618860185f,0.983951986f,0.70501405f,
0.425939471f,0.244913206f,0.138691694f,0.0781644881f,0.0439858064f,0.0247404929f,0.0139135728f,0.00782434922f,
0.850903511f,0.171763569f,0.995670974f,0.989027262f,-0.977530122f,0.57373327f,0.989101648f,0.717513323f,
0.434965521f,0.250361472f,0.141822711f,0.0799371973f,0.0449848175f,0.0253026579f,0.0142297689f,0.00800217129f,
0.901788354f,0.670557022f,0.917395473f,0.947297752f,-0.993690968f,0.526792526f,0.993262351f,0.72978574f,
0.44394809f,0.255801797f,0.144952312f,0.0817096606f,0.0459837839f,0.0258648153f,0.0145459641f,0.0081799943f,
0.123573124f,0.962832689f,0.748142362f,0.875690997f,-0.999923289f,0.478186339f,0.996429801f,0.741827428f,
0.452886283f,0.261234075f,0.148080453f,0.0834818557f,0.0469827019f,0.0264269635f,0.0148621574f,0.00835781638f,
-0.768254638f,0.958573103f,0.504697084f,0.776465356f,-0.99616462f,0.428068399f,0.99860096f,0.753634512f,
0.461779177f,0.266658038f,0.151207119f,0.0852537975f,0.0479815714f,0.0269891042f,0.0151783489f,0.00853563752f,
-0.953752637f,0.659090102f,0.211200655f,0.652750373f,-0.982452571f,0.376597136f,0.999773562f,0.765203178f,
0.470625877f,0.272073567f,0.15433228f,0.087025471f,0.0489803962f,0.0275512375f,0.0154945394f,0.0087134596f,
-0.262374848f,0.156619072f,-0.10324046f,0.508447945f,-0.958924294f,0.32393527f,0.999946535f,0.776529968f,
0.47942555f,0.277480543f,0.157455891f,0.0887968615f,0.0499791689f,0.0281133596f,0.0158107281f,0.00889127981f,
0.670229197f,-0.394086063f,-0.407444149f,0.3481085f,-0.925814748f,0.270249337f,0.99911958f,0.787611187f,
0.48817724f,0.282878697f,0.160577938f,0.0905679762f,0.0509778969f,0.0286754742f,0.0161269177f,0.00906910095f,
0.986627579f,-0.823421597f,-0.671240151f,0.176790684f,-0.883454502f,0.215709001f,0.997293651f,0.798443377f,
0.496880114f,0.28826794f,0.163698375f,0.0923388004f,0.051976569f,0.0292375814f,0.0164431017f,0.00924692024f,
0.395925164f,-0.999157965f,-0.868469954f,-0.000103020677f,-0.832267344f,0.160486728f,0.994470477f,0.809023023f,
0.505533338f,0.293648034f,0.166817173f,0.0941093415f,0.0529751927f,0.0297996756f,0.0167592876f,0.00942474138f,
-0.558789074f,-0.867171526f,-0.979574919f,-0.176993474f,-0.772764444f,0.104756832f,0.990652919f,0.819346905f,
0.514135957f,0.29901889f,0.169934288f,0.0958795771f,0.0539737605f,0.0303617641f,0.0170754679f,0.00960256159f,
-0.999755144f,-0.468111664f,-0.993535519f,-0.348301649f,-0.705540299f,0.0486960001f,0.985844791f,0.829411685f,
0.522687256f,0.304380238f,0.173049718f,0.0976495072f,0.0549722798f,0.0309238415f,0.01739165f,0.00978038087f,
-0.521551013f,0.0751182064f,-0.908967435f,-0.508624554f,-0.631266713f,-0.00751878507f,0.980050862f,0.839214146f,
0.531186223f,0.30973196f,0.17616342f,0.0994191393f,0.0559707358f,0.0314859077f,0.0177078284f,0.00995820016f,
0.436164767f,0.595211506f,-0.734258294f,-0.652905703f,-0.550685287f,-0.0637097955f,0.973276973f,0.848751247f,
0.539632022f,0.315073937f,0.179275364f,0.101188451f,0.0569691435f,0.0320479684f,0.0180240069f,0.0101360194f,
0.992872655f,0.931992829f,-0.486733496f,-0.776594579f,-0.464602023f,-0.119699396f,0.965529919f,0.858020008f,
0.548023939f,0.3204059f,0.182385504f,0.102957435f,0.0579674877f,0.0326100141f,0.0183401816f,0.0103138378f,
0.636738002f,0.981735826f,-0.190938011f,-0.87579f,-0.373876572f,-0.175310582f,0.956817448f,0.867017388f,
0.55636102f,0.325727791f,0.185493827f,0.104726106f,0.0589657798f,0.0331720486f,0.0186563563f,0.0104916561f,
-0.304810613f,0.729123712f,0.12379095f,-0.947363734f,-0.279415488f,-0.230367512f,0.947148204f,0.875740528f,
0.564642429f,0.33103931f,0.188600287f,0.106494442f,0.0599640086f,0.0337340795f,0.0189725272f,0.0106694745f,
-0.966117799f,0.251952261f,0.426245421f,-0.98905772f,-0.182162598f,-0.284696162f,0.936531842f,0.884186864f,
0.572867453f,0.336340427f,0.191704854f,0.108262435f,0.0609621815f,0.0342960916f,0.0192886982f,0.0108472919f,
-0.739180684f,-0.302812874f,0.686427653f,-0.999557257f,-0.0830891207f,-0.338124752f,0.924979091f,0.892353535f,
0.581035137f,0.341630876f,0.194807529f,0.110030092f,0.0619602874f,0.0348580964f,0.0196048655f,0.0110251084f,
0.167355701f,-0.764320076f,0.878538549f,-0.978531301f,0.0168140903f,-0.390484393f,0.912501454f,0.900238097f,
0.589144766f,0.346910536f,0.197908238f,0.111797392f,0.0629583374f,0.0354200937f,0.0199210308f,0.0112029258f,
};
#ifndef PROBE_DUP
#define PROBE_DUP 0
#endif

constexpr int TP = 8192;
constexpr int TS = 32768;
constexpr int TT = TP + TS;
constexpr int DM = 1024;
constexpr int NIN = 3072;
constexpr int NLAYER = 4;
constexpr float ALPHA = 1.6817928305074292f;
constexpr float LOG2E = 1.4426950408889634f;
constexpr float C1 = 0.125f * LOG2E;
constexpr size_t OUT_NK = (size_t)TT * DM;
constexpr size_t OUT_NV = OUT_NK + (size_t)32 * 4 * 256 * 256;
constexpr size_t OUT_GK = OUT_NV + (size_t)32 * 4 * 256 * 256;
constexpr size_t OUT_GV = OUT_GK + (size_t)32 * 4 * 256 * 128;

struct Params {
  const float *x_prompt, *x_sample, *c, *cnk, *cnv, *cgk, *cgv, *c_ctx, *w_mod, *b_mod, *w_in, *b_in, *pool_w, *pool_scale,
      *nat_bias, *q_norm, *k_norm, *conv_w, *conv_b, *conv_ln_g, *conv_ln_b, *conv_pw, *w_out, *b_out, *ln_g, *ln_b;
  float* out;
  char* ws;
  int ph0, ph1;
};
constexpr size_t WS_WINT = 0;
constexpr size_t WS_WOUTT = WS_WINT + (size_t)4 * 3072 * 1024 * 2;
constexpr size_t WS_PWT = WS_WOUTT + (size_t)4 * 1024 * 1024 * 2;
constexpr size_t WS_POOLT = WS_PWT + (size_t)4 * 256 * 256 * 2;
constexpr size_t WS_CNK = WS_POOLT + (size_t)16 * 4096 * 2;
constexpr size_t WS_CNV = WS_CNK + (size_t)4194304 * 2;
constexpr size_t WS_CGK = WS_CNV + (size_t)4194304 * 2;
constexpr size_t WS_CGV = WS_CGK + (size_t)2097152 * 2;
constexpr size_t WS_U = WS_CGV + (size_t)2097152 * 2;
constexpr size_t WS_H = WS_U + (size_t)TT * NIN * 2;
constexpr size_t WS_MX = WS_H + (size_t)TT * DM * 2;
constexpr size_t WS_MOD = WS_MX + (size_t)TT * DM * 2;
constexpr size_t WS_STATS = WS_MOD + (size_t)4 * 9 * 3072 * 4;
constexpr size_t WS_CNT = WS_STATS + (size_t)TT * 2 * 4;
#define P_WinT ((bf16_t*)(p.ws + WS_WINT))
#define P_WoutT ((bf16_t*)(p.ws + WS_WOUTT))
#define P_pwT ((bf16_t*)(p.ws + WS_PWT))
#define P_poolT ((bf16_t*)(p.ws + WS_POOLT))
#define P_cnk_b ((bf16_t*)(p.ws + WS_CNK))
#define P_cnv_b ((bf16_t*)(p.ws + WS_CNV))
#define P_cgk_b ((bf16_t*)(p.ws + WS_CGK))
#define P_cgv_b ((bf16_t*)(p.ws + WS_CGV))
#define P_U ((bf16_t*)(p.ws + WS_U))
#define P_H ((bf16_t*)(p.ws + WS_H))
#define P_MX ((bf16_t*)(p.ws + WS_MX))
#define P_mod ((float*)(p.ws + WS_MOD))
#define P_stats ((float*)(p.ws + WS_STATS))
#define P_cnt ((unsigned*)(p.ws + WS_CNT))

DEV float bf2f(bf16_t h) { return __uint_as_float(((unsigned)h) << 16); }
DEV unsigned pk2(float lo, float hi) { f32x2 v = {lo, hi}; bf16x2_t b = __builtin_convertvector(v, bf16x2_t); return __builtin_bit_cast(unsigned, b); }
DEV bf16_t f2bf(float f) { return (bf16_t)(pk2(f, 0.f) & 0xffffu); }
DEV float bflo(unsigned w) { return __uint_as_float(w << 16); }
DEV float bfhi(unsigned w) { return __uint_as_float(w & 0xffff0000u); }
DEV float silu_f(float x) { return x / (1.f + __expf(-x)); }
DEV float sigm_f(float x) { return 1.f / (1.f + __expf(-x)); }
DEV f32x4 mfma16(bf16x8 a, bf16x8 b, f32x4 c) { return __builtin_amdgcn_mfma_f32_16x16x32_bf16(a, b, c, 0, 0, 0); }
typedef short v4i16_t __attribute__((ext_vector_type(4)));
DEV s16x4 tr16(const char* p) {
  return __builtin_bit_cast(s16x4, __builtin_amdgcn_ds_read_tr16_b64_v4i16((__attribute__((address_space(3))) v4i16_t*)p));
}
DEV float wave_sum(float v) {
  v += __shfl_xor(v, 1); v += __shfl_xor(v, 2); v += __shfl_xor(v, 4); v += __shfl_xor(v, 8); v += __shfl_xor(v, 16); v += __shfl_xor(v, 32);
  return v;
}
DEV int get_tid() { int t = threadIdx.x; asm volatile("" : "+v"(t)); return t; }
DEV int cond_of_row(int row) { return row < TP ? 0 : 1 + ((row - TP) >> 12); }

DEV void tconv_tile(const float* src, int sld, bf16_t* dst, int dld, char* smem) {
  float* t = (float*)smem;
  const int tid = get_tid();
#pragma unroll
  for (int i = 0; i < 16; ++i) { int idx = tid + i * 256; int r = idx >> 6, c = idx & 63; t[r * 65 + c] = src[(size_t)r * sld + c]; }
  __syncthreads();
#pragma unroll
  for (int i = 0; i < 16; ++i) { int idx = tid + i * 256; int n = idx >> 6, k = idx & 63; dst[(size_t)n * dld + k] = f2bf(t[k * 65 + n]); }
  __syncthreads();
}

DEV void cvt_unit(const float* src, bf16_t* dst, int u) {
  const size_t base = (size_t)u * 16384;
  const int tid = get_tid();
#pragma unroll
  for (int i = 0; i < 16; ++i) {
    size_t e = base + (size_t)(i * 256 + tid) * 4;
    f32x4 v = *(const f32x4*)(src + e);
    u32x2 w; w.x = pk2(v[0], v[1]); w.y = pk2(v[2], v[3]);
    *(u32x2*)(dst + e) = w;
  }
}

DEV void mod_unit(const Params& p, int u, char* smem) {
  const int l = u / 48, n0 = (u % 48) * 64, tid = get_tid();
  float* sc = (float*)smem;
  float* red = (float*)(smem + 36864);
  for (int i = tid; i < 9216; i += 256) { int c = i >> 10, k = i & 1023; float v = (c == 0) ? p.c_ctx[k] : p.c[(c - 1) * 1024 + k]; sc[i] = silu_f(v); }
  __syncthreads();
  const int kq = tid >> 6, col = n0 + (tid & 63);
  float acc[9];
#pragma unroll
  for (int c = 0; c < 9; ++c) acc[c] = 0.f;
  const float* wp = p.w_mod + ((size_t)l * 1024 + kq * 256) * 3072 + col;
#pragma unroll 8
  for (int k = 0; k < 256; ++k) {
    float w = wp[(size_t)k * 3072];
#pragma unroll
    for (int c = 0; c < 9; ++c) acc[c] += sc[c * 1024 + kq * 256 + k] * w;
  }
#pragma unroll
  for (int c = 0; c < 9; ++c) red[(kq * 9 + c) * 64 + (tid & 63)] = acc[c];
  __syncthreads();
  for (int i = tid; i < 576; i += 256) {
    int c = i >> 6, j = i & 63;
    float s = red[(0 * 9 + c) * 64 + j] + red[(1 * 9 + c) * 64 + j] + red[(2 * 9 + c) * 64 + j] + red[(3 * 9 + c) * 64 + j];
    P_mod[((size_t)l * 9 + c) * 3072 + n0 + j] = s + p.b_mod[l * 3072 + n0 + j];
  }
  __syncthreads();
}

DEV void h0_unit(const Params& p, int u) {
  const int tid = get_tid(), col = tid * 4;
  const int row0 = u * 32;
  const int cond = cond_of_row(row0);
  const float* md = P_mod + (size_t)cond * 3072;
  const f32x4 sh = *(const f32x4*)(md + col), sc = *(const f32x4*)(md + 1024 + col);
#pragma unroll 4
  for (int i = 0; i < 32; ++i) {
    const int row = row0 + i;
    const float* xr = (row < TP) ? p.x_prompt + (size_t)row * DM : p.x_sample + (size_t)(row - TP) * DM;
    f32x4 x = *(const f32x4*)(xr + col);
    u32x2 w; w.x = pk2(x[0] * (1.f + sc[0]) + sh[0], x[1] * (1.f + sc[1]) + sh[1]); w.y = pk2(x[2] * (1.f + sc[2]) + sh[2], x[3] * (1.f + sc[3]) + sh[3]);
    *(u32x2*)(P_H + (size_t)row * DM + col) = w;
  }
}

DEV void gemm_core(const bf16_t* Ag, const bf16_t* Bg, f32x4 (&acc)[4][4], char* smem) {
  const int tid = get_tid(), lane = tid & 63, wid = tid >> 6, wr = wid >> 1, wc = wid & 1, fr = lane & 15, fq = lane >> 4;
  u32x4 ra[4], rb[4];
#pragma unroll
  for (int m = 0; m < 4; ++m)
#pragma unroll
    for (int n = 0; n < 4; ++n) acc[m][n] = (f32x4){0.f, 0.f, 0.f, 0.f};
  const int lr = tid >> 3, lc = tid & 7;
  const bf16_t* ap = Ag + (size_t)lr * 1024 + lc * 8;
  const bf16_t* bp = Bg + (size_t)lr * 1024 + lc * 8;
#pragma unroll
  for (int i = 0; i < 4; ++i) { ra[i] = *(const u32x4*)(ap + (size_t)i * 32 * 1024); rb[i] = *(const u32x4*)(bp + (size_t)i * 32 * 1024); }
  char* sa = smem; char* sb = smem + 18432;
  for (int kt = 0; kt < 16; ++kt) {
    __syncthreads();
#pragma unroll
    for (int i = 0; i < 4; ++i) { *(u32x4*)(sa + (lr + i * 32) * 144 + lc * 16) = ra[i]; *(u32x4*)(sb + (lr + i * 32) * 144 + lc * 16) = rb[i]; }
    __syncthreads();
    if (kt + 1 < 16) {
#pragma unroll
      for (int i = 0; i < 4; ++i) { ra[i] = *(const u32x4*)(ap + (size_t)i * 32 * 1024 + (kt + 1) * 64); rb[i] = *(const u32x4*)(bp + (size_t)i * 32 * 1024 + (kt + 1) * 64); }
    }
#pragma unroll
    for (int ks = 0; ks < 2; ++ks) {
      bf16x8 af[4], bfr[4];
#pragma unroll
      for (int m = 0; m < 4; ++m) af[m] = *(const bf16x8*)(sa + (wr * 64 + m * 16 + fr) * 144 + ks * 64 + fq * 16);
#pragma unroll
      for (int n = 0; n < 4; ++n) bfr[n] = *(const bf16x8*)(sb + (wc * 64 + n * 16 + fr) * 144 + ks * 64 + fq * 16);
#pragma unroll
      for (int m = 0; m < 4; ++m)
#pragma unroll
        for (int n = 0; n < 4; ++n) acc[m][n] = mfma16(bfr[n], af[m], acc[m][n]);
    }
  }
}

DEV void phaseA_tile(const Params& p, int l, int tile, char* smem) {
  const int mt = tile / 24, nt = tile % 24;
  f32x4 acc[4][4];
  gemm_core(P_H + (size_t)mt * 128 * 1024, P_WinT + ((size_t)l * 3072 + nt * 128) * 1024, acc, smem);
  const int tid = get_tid(), lane = tid & 63, wid = tid >> 6, wr = wid >> 1, wc = wid & 1, fr = lane & 15, fq = lane >> 4;
  const int colb = nt * 128 + wc * 64;
  const int reg = colb >> 6;
  const bool prompt = (mt * 128) < TP;
  f32x4 bias[4];
#pragma unroll
  for (int n = 0; n < 4; ++n) bias[n] = *(const f32x4*)(p.b_in + l * 3072 + colb + n * 16 + 4 * fq);
#pragma unroll
  for (int m = 0; m < 4; ++m)
#pragma unroll
    for (int n = 0; n < 4; ++n) acc[m][n] += bias[n];
  if (reg >= 36 && reg < 42) {
    const float* gptr = (reg < 40 ? p.q_norm : p.k_norm) + l * 64;
    f32x4 gg[4];
#pragma unroll
    for (int n = 0; n < 4; ++n) gg[n] = *(const f32x4*)(gptr + n * 16 + 4 * fq);
#pragma unroll
    for (int m = 0; m < 4; ++m) {
      float ss = 0.f;
#pragma unroll
      for (int n = 0; n < 4; ++n)
#pragma unroll
        for (int j = 0; j < 4; ++j) ss += acc[m][n][j] * acc[m][n][j];
      ss += __shfl_xor(ss, 16); ss += __shfl_xor(ss, 32);
      const float r = rsqrtf(ss * (1.f / 64.f) + 1e-6f);
#pragma unroll
      for (int n = 0; n < 4; ++n) acc[m][n] = acc[m][n] * r * gg[n];
      if (!prompt) {
        const int row = mt * 128 + wr * 64 + m * 16 + fr;
        const int t = (row - TP) & 4095, pr = t >> 6, pc = t & 63;
        const f32x4 c0 = *(const f32x4*)(ROPE_COS + pr * 16 + 4 * fq), s0 = *(const f32x4*)(ROPE_SIN + pr * 16 + 4 * fq);
        const f32x4 c1 = *(const f32x4*)(ROPE_COS + pc * 16 + 4 * fq), s1 = *(const f32x4*)(ROPE_SIN + pc * 16 + 4 * fq);
        const f32x4 x1 = acc[m][0], x2 = acc[m][1], y1 = acc[m][2], y2 = acc[m][3];
        acc[m][0] = x1 * c0 - x2 * s0; acc[m][1] = x2 * c0 + x1 * s0;
        acc[m][2] = y1 * c1 - y2 * s1; acc[m][3] = y2 * c1 + y1 * s1;
      }
    }
  }
#pragma unroll
  for (int m = 0; m < 4; ++m) {
    const int row = mt * 128 + wr * 64 + m * 16 + fr;
    bf16_t* up = P_U + (size_t)row * NIN + colb + 4 * fq;
#pragma unroll
    for (int n = 0; n < 4; ++n) { u32x2 w; w.x = pk2(acc[m][n][0], acc[m][n][1]); w.y = pk2(acc[m][n][2], acc[m][n][3]); *(u32x2*)(up + n * 16) = w; }
  }
  if (prompt) {
    float* ob = nullptr; int hw = 0, cofs = 0;
    if (reg >= 12 && reg < 16) { ob = p.out + OUT_NK; hw = 256; cofs = colb - 768; }
    else if (reg >= 16 && reg < 20) { ob = p.out + OUT_NV; hw = 256; cofs = colb - 1024; }
    else if (reg >= 40 && reg < 42) { ob = p.out + OUT_GK; hw = 128; cofs = colb - 2560; }
    else if (reg >= 42 && reg < 44) { ob = p.out + OUT_GV; hw = 128; cofs = colb - 2688; }
    if (ob) {
#pragma unroll
      for (int m = 0; m < 4; ++m) {
        const int row = mt * 128 + wr * 64 + m * 16 + fr;
        const int b = row >> 8, s = row & 255;
        float* op = ob + ((size_t)(b * 4 + l) * 256 + s) * hw + cofs + 4 * fq;
#pragma unroll
        for (int n = 0; n < 4; ++n) *(f32x4*)(op + n * 16) = acc[m][n];
      }
    }
  }
}

DEV void ln_unit(const Params& p, int l, int u) {
  const int tid = get_tid(), lane = tid & 63, wid = tid >> 6;
  float* Y = p.out;
  {
    const int row = u * 4 + wid;
    float* yr = Y + (size_t)row * DM;
    f32x4 v[4];
#pragma unroll
    for (int q = 0; q < 4; ++q) v[q] = *(const f32x4*)(yr + q * 256 + lane * 4);
    float s = 0.f;
#pragma unroll
    for (int q = 0; q < 4; ++q) s += (v[q][0] + v[q][1]) + (v[q][2] + v[q][3]);
    const float mean = wave_sum(s) * (1.f / 1024.f);
    float s2 = 0.f;
#pragma unroll
    for (int q = 0; q < 4; ++q) { v[q] = v[q] - mean; s2 += (v[q][0] * v[q][0] + v[q][1] * v[q][1]) + (v[q][2] * v[q][2] + v[q][3] * v[q][3]); }
    const float rstd = rsqrtf(wave_sum(s2) * (1.f / 1024.f) + 1e-5f);
    const int cond = cond_of_row(row);
#pragma unroll
    for (int q = 0; q < 4; ++q) {
      const int col = q * 256 + lane * 4;
      const f32x4 g = *(const f32x4*)(p.ln_g + l * 1024 + col), b = *(const f32x4*)(p.ln_b + l * 1024 + col);
      f32x4 x = v[q] * rstd * g + b;
      if (l < NLAYER - 1) {
        const float* md = P_mod + ((size_t)(l + 1) * 9 + cond) * 3072;
        const f32x4 sh = *(const f32x4*)(md + col), sc = *(const f32x4*)(md + 1024 + col);
        f32x4 h = x * (sc + 1.f) + sh;
        u32x2 w; w.x = pk2(h[0], h[1]); w.y = pk2(h[2], h[3]);
        *(u32x2*)(P_H + (size_t)row * DM + col) = w;
      } else {
        *(f32x4*)(yr + col) = x;
      }
    }
    if (l < NLAYER - 1 && lane == 0) { P_stats[row * 2] = mean; P_stats[row * 2 + 1] = rstd; }
  }
}

DEV void phaseC_tile(const Params& p, int l, int tile, char* smem) {
  const int mt = tile >> 3, nt = tile & 7;
  f32x4 acc[4][4];
  gemm_core(P_MX + (size_t)mt * 128 * 1024, P_WoutT + ((size_t)l * 1024 + nt * 128) * 1024, acc, smem);
  const int tid = get_tid(), lane = tid & 63, wid = tid >> 6, wr = wid >> 1, wc = wid & 1, fr = lane & 15, fq = lane >> 4;
  const int colb = nt * 128 + wc * 64 + 4 * fq;
  const int cond = cond_of_row(mt * 128);
  const float* gatep = P_mod + ((size_t)l * 9 + cond) * 3072 + 2048;
  float* Y = p.out;
#pragma unroll
  for (int m = 0; m < 4; ++m) {
    const int row = mt * 128 + wr * 64 + m * 16 + fr;
    float mean = 0.f, rstd = 1.f;
    const float* xr;
    if (l == 0) xr = (row < TP) ? p.x_prompt + (size_t)row * DM : p.x_sample + (size_t)(row - TP) * DM;
    else { xr = Y + (size_t)row * DM; mean = P_stats[row * 2]; rstd = P_stats[row * 2 + 1]; }
#pragma unroll
    for (int n = 0; n < 4; ++n) {
      const int col = colb + n * 16;
      f32x4 xo = *(const f32x4*)(xr + col);
      if (l > 0) {
        const f32x4 g = *(const f32x4*)(p.ln_g + (l - 1) * 1024 + col), b = *(const f32x4*)(p.ln_b + (l - 1) * 1024 + col);
        xo = (xo - mean) * rstd * g + b;
      }
      const f32x4 gt = *(const f32x4*)(gatep + col), bo = *(const f32x4*)(p.b_out + l * 1024 + col);
      f32x4 y = xo * ALPHA + gt * (acc[m][n] + bo);
      *(f32x4*)(Y + (size_t)row * DM + col) = y;
    }
  }
}

template <int NQ, int NKT, bool NATL>
DEV void attn_tile(const char* ks, const char* vs, int koff, const bf16x8 (&qf)[NQ][2], f32x4 (&o)[NQ][4], float (&mrun)[NQ], float (&lrun)[NQ],
                   int fr, int fq, const float* biasrow, int qc) {
  f32x4 s[NQ][NKT];
#pragma unroll
  for (int t = 0; t < NKT; ++t) {
    const char* kp = ks + (koff + 16 * t + fr) * 144 + fq * 16;
    const bf16x8 k0 = *(const bf16x8*)kp, k1 = *(const bf16x8*)(kp + 64);
#pragma unroll
    for (int g = 0; g < NQ; ++g) { f32x4 z = {0.f, 0.f, 0.f, 0.f}; z = mfma16(k0, qf[g][0], z); z = mfma16(k1, qf[g][1], z); s[g][t] = z; }
  }
#pragma unroll
  for (int g = 0; g < NQ; ++g) {
    float mx = -1e30f;
#pragma unroll
    for (int t = 0; t < NKT; ++t)
#pragma unroll
      for (int j = 0; j < 4; ++j) {
        float x = s[g][t][j] * C1;
        if (NATL) {
          const int kc = koff + 16 * t + 4 * fq + j;
          const int cs = min(max(qc - 8, 0), 48);
          const bool valid = (kc >= cs) && (kc < cs + 16);
          const int dc = min(max(kc - qc + 15, 0), 30);
          x = valid ? x + biasrow[dc] : -1e30f;
        }
        s[g][t][j] = x; mx = fmaxf(mx, x);
      }
    mx = fmaxf(mx, __shfl_xor(mx, 16)); mx = fmaxf(mx, __shfl_xor(mx, 32));
    const float mn = fmaxf(mrun[g], mx);
    const float al = __builtin_amdgcn_exp2f(mrun[g] - mn);
    mrun[g] = mn;
    float ps = 0.f;
#pragma unroll
    for (int t = 0; t < NKT; ++t)
#pragma unroll
      for (int j = 0; j < 4; ++j) { const float pp = __builtin_amdgcn_exp2f(s[g][t][j] - mn); s[g][t][j] = pp; ps += pp; }
    lrun[g] = lrun[g] * al + ps;
#pragma unroll
    for (int dt = 0; dt < 4; ++dt) o[g][dt] = o[g][dt] * al;
  }
#pragma unroll
  for (int u = 0; u < NKT / 2; ++u) {
    bf16x8 pf[NQ];
#pragma unroll
    for (int g = 0; g < NQ; ++g) {
      u32x4 w;
      w.x = pk2(s[g][2 * u][0], s[g][2 * u][1]); w.y = pk2(s[g][2 * u][2], s[g][2 * u][3]);
      w.z = pk2(s[g][2 * u + 1][0], s[g][2 * u + 1][1]); w.w = pk2(s[g][2 * u + 1][2], s[g][2 * u + 1][3]);
      pf[g] = __builtin_bit_cast(bf16x8, w);
    }
#pragma unroll
    for (int dt = 0; dt < 4; ++dt) {
      const char* vp = vs + (koff + 32 * u + 4 * fq + (fr >> 2)) * 160 + dt * 32 + (fr & 3) * 8;
      const s16x4 lo = tr16(vp), hi = tr16(vp + 16 * 160);
      const bf16x8 vf = {lo[0], lo[1], lo[2], lo[3], hi[0], hi[1], hi[2], hi[3]};
#pragma unroll
      for (int g = 0; g < NQ; ++g) o[g][dt] = mfma16(vf, pf[g], o[g][dt]);
    }
  }
}

template <int MODE>
DEV void attn_unit(const Params& p, int l, int u, char* smem) {
  constexpr int NQ = (MODE == 1) ? 1 : 2;
  const int tid = get_tid(), lane = tid & 63, wid = tid >> 6, fr = lane & 15, fq = lane >> 4;
  int qrow0, qcol, gcol, ocol, NT, NLOC, cstride = 0;
  const bf16_t *kU, *vU, *kC = nullptr, *vC = nullptr;
  int nat_r = 0, nat_rs = 0;
  if (MODE == 0) {
    const int qb = u & 31, g = (u >> 5) & 1, kvh = (u >> 6) & 1, b = u >> 7, h = kvh * 2 + g;
    qrow0 = TP + b * 4096 + qb * 128 + wid * 32; qcol = 2304 + h * 64; gcol = 2816 + h * 64; ocol = 768 + h * 64;
    kU = P_U + (size_t)(TP + b * 4096) * NIN + 2560 + kvh * 64; vU = kU + 128; NLOC = 64; NT = 72;
    kC = P_cgk_b + ((size_t)(b * 4 + l) * 512 * 2 + kvh) * 64; vC = P_cgv_b + ((size_t)(b * 4 + l) * 512 * 2 + kvh) * 64; cstride = 128;
  } else if (MODE == 1) {
    const int r = u & 63, h = (u >> 6) & 3, b = u >> 8;
    nat_r = r; nat_rs = min(max(r - 4, 0), 56);
    qrow0 = TP + b * 4096 + r * 64 + wid * 16; qcol = 512 + h * 64; gcol = 1280 + h * 64; ocol = 256 + h * 64;
    kU = P_U + (size_t)(TP + b * 4096 + nat_rs * 64) * NIN + 768 + h * 64; vU = kU + 256; NLOC = 8; NT = 16;
    kC = P_cnk_b + ((size_t)(b * 4 + l) * 512 * 4 + h) * 64; vC = P_cnv_b + ((size_t)(b * 4 + l) * 512 * 4 + h) * 64; cstride = 256;
    float* bl = (float*)(smem + 38912);
    for (int i = tid; i < 465; i += 256) bl[i] = p.nat_bias[(size_t)(l * 4 + h) * 465 + i] * LOG2E;
  } else {
    const int qb = u & 1, hh = (u >> 1) & 7, b = u >> 4;
    qrow0 = b * 256 + qb * 128 + wid * 32; NLOC = 4; NT = 4;
    int kcol;
    if (hh < 4) { qcol = 512 + hh * 64; kcol = 768 + hh * 64; gcol = 1280 + hh * 64; ocol = 256 + hh * 64; kU = P_U + (size_t)(b * 256) * NIN + kcol; vU = kU + 256; }
    else { const int h = hh - 4; qcol = 2304 + h * 64; kcol = 2560 + (h >> 1) * 64; gcol = 2816 + h * 64; ocol = 768 + h * 64; kU = P_U + (size_t)(b * 256) * NIN + kcol; vU = kU + 128; }
  }
  bf16x8 qf[NQ][2];
#pragma unroll
  for (int g = 0; g < NQ; ++g)
#pragma unroll
    for (int ks = 0; ks < 2; ++ks) qf[g][ks] = *(const bf16x8*)(P_U + (size_t)(qrow0 + g * 16 + fr) * NIN + qcol + ks * 32 + fq * 8);
  f32x4 o[NQ][4]; float mrun[NQ], lrun[NQ];
#pragma unroll
  for (int g = 0; g < NQ; ++g) { mrun[g] = -1e30f; lrun[g] = 0.f;
#pragma unroll
    for (int dt = 0; dt < 4; ++dt) o[g][dt] = (f32x4){0.f, 0.f, 0.f, 0.f}; }
  u32x4 rk[2], rv[2];
  const int lrow = tid >> 3, lc = tid & 7;
  auto gl = [&](int t) {
    const bf16_t *kp, *vp; int st;
    if (t < NLOC) { kp = kU + (size_t)t * 64 * NIN; vp = vU + (size_t)t * 64 * NIN; st = NIN; }
    else { kp = kC + (size_t)(t - NLOC) * 64 * cstride; vp = vC + (size_t)(t - NLOC) * 64 * cstride; st = cstride; }
#pragma unroll
    for (int i = 0; i < 2; ++i) { const size_t off = (size_t)(lrow + i * 32) * st + lc * 8; rk[i] = *(const u32x4*)(kp + off); rv[i] = *(const u32x4*)(vp + off); }
  };
  auto stl = [&](int buf) {
#pragma unroll
    for (int i = 0; i < 2; ++i) {
      *(u32x4*)(smem + buf * 9216 + (lrow + i * 32) * 144 + lc * 16) = rk[i];
      *(u32x4*)(smem + 18432 + buf * 10240 + (lrow + i * 32) * 160 + lc * 16) = rv[i];
    }
  };
  gl(0); stl(0);
  __syncthreads();
  const float* bl = (const float*)(smem + 38912);
#pragma unroll 1
  for (int t = 0; t < NT; ++t) {
    if (t + 1 < NT) gl(t + 1);
    const char* ks = smem + (t & 1) * 9216; const char* vs = smem + 18432 + (t & 1) * 10240;
    if constexpr (MODE == 1) {
      if (t < 8) {
        const int kcw = (wid == 0) ? 0 : (wid == 1) ? 8 : (wid == 2) ? 24 : 32;
        attn_tile<1, 2, true>(ks, vs, kcw, qf, o, mrun, lrun, fr, fq, bl + (nat_rs + t - nat_r + 7) * 31, wid * 16 + fr);
      } else {
        attn_tile<1, 4, false>(ks, vs, 0, qf, o, mrun, lrun, fr, fq, nullptr, 0);
      }
    } else {
      attn_tile<NQ, 4, false>(ks, vs, 0, qf, o, mrun, lrun, fr, fq, nullptr, 0);
    }
    if (t + 1 < NT) stl((t + 1) & 1);
    __syncthreads();
  }
#pragma unroll
  for (int g = 0; g < NQ; ++g) {
    float lt = lrun[g]; lt += __shfl_xor(lt, 16); lt += __shfl_xor(lt, 32);
    const float inv = 1.f / lt;
    const int row = qrow0 + g * 16 + fr;
#pragma unroll
    for (int dt = 0; dt < 4; ++dt) {
      const int d0 = dt * 16 + 4 * fq;
      const u32x2 gw = *(const u32x2*)(P_U + (size_t)row * NIN + gcol + d0);
      u32x2 w;
      w.x = pk2(o[g][dt][0] * inv * silu_f(bflo(gw.x)), o[g][dt][1] * inv * silu_f(bfhi(gw.x)));
      w.y = pk2(o[g][dt][2] * inv * silu_f(bflo(gw.y)), o[g][dt][3] * inv * silu_f(bfhi(gw.y)));
      *(u32x2*)(P_MX + (size_t)row * DM + ocol + d0) = w;
    }
  }
}

DEV void pool_unit(const Params& p, int l, int u, char* smem) {
  const int tid = get_tid(), lane = tid & 63, wid = tid >> 6, fr = lane & 15, fq = lane >> 4;
  const int R0 = u * 32;
  int L, sb;
  if (R0 < TP) { L = 256; sb = R0 & ~255; } else { L = 4096; sb = TP + ((R0 - TP) & ~4095); }
  const int t0 = R0 - sb;
  bf16_t* ya = (bf16_t*)smem;
  {
    const int c = tid, g = c >> 6, win = 2 << g, half = win >> 1;
    const bf16_t* xc = P_U + (size_t)sb * NIN + c;
    float sum = 0.f;
    for (int i = t0 - half; i < t0 - half + win; ++i) if (i >= 0 && i < L) sum += bf2f(xc[(size_t)i * NIN]);
    for (int tt = 0; tt < 32; ++tt) {
      const int t = t0 + tt;
      const int lo = max(t - half, 0), hi = min(t - half + win, L);
      const float y = sum / (float)(hi - lo) - bf2f(xc[(size_t)t * NIN]);
      ya[tt * 264 + c] = f2bf(y);
      const int ia = t - half + win; if (ia < L) sum += bf2f(xc[(size_t)ia * NIN]);
      const int ir = t - half; if (ir >= 0) sum -= bf2f(xc[(size_t)ir * NIN]);
    }
  }
  __syncthreads();
  const int g = wid;
  f32x4 acc[2][4];
#pragma unroll
  for (int m = 0; m < 2; ++m)
#pragma unroll
    for (int n = 0; n < 4; ++n) acc[m][n] = (f32x4){0.f, 0.f, 0.f, 0.f};
  const bf16_t* wt = P_poolT + (size_t)(l * 4 + g) * 4096;
#pragma unroll
  for (int ks = 0; ks < 2; ++ks) {
    bf16x8 af[2], bfr[4];
#pragma unroll
    for (int m = 0; m < 2; ++m) af[m] = *(const bf16x8*)(smem + (m * 16 + fr) * 528 + (g * 64 + ks * 32 + fq * 8) * 2);
#pragma unroll
    for (int n = 0; n < 4; ++n) bfr[n] = *(const bf16x8*)(wt + (n * 16 + fr) * 64 + ks * 32 + fq * 8);
#pragma unroll
    for (int m = 0; m < 2; ++m)
#pragma unroll
      for (int n = 0; n < 4; ++n) acc[m][n] = mfma16(bfr[n], af[m], acc[m][n]);
  }
#pragma unroll
  for (int m = 0; m < 2; ++m) {
    const int row = R0 + m * 16 + fr;
#pragma unroll
    for (int n = 0; n < 4; ++n) {
      const int ch = g * 64 + n * 16 + 4 * fq;
      const f32x4 sc = *(const f32x4*)(p.pool_scale + l * 256 + ch);
      const u32x2 gw = *(const u32x2*)(P_U + (size_t)row * NIN + 256 + ch);
      u32x2 w;
      w.x = pk2(acc[m][n][0] * sc[0] * silu_f(bflo(gw.x)), acc[m][n][1] * sc[1] * silu_f(bfhi(gw.x)));
      w.y = pk2(acc[m][n][2] * sc[2] * silu_f(bflo(gw.y)), acc[m][n][3] * sc[3] * silu_f(bfhi(gw.y)));
      *(u32x2*)(P_MX + (size_t)row * DM + ch) = w;
    }
  }
  __syncthreads();
}

DEV void conv_unit(const Params& p, int l, int u, char* smem) {
  const int tid = get_tid(), lane = tid & 63, wid = tid >> 6, fr = lane & 15, fq = lane >> 4;
  const int R0 = u * 32;
  int L, sb;
  if (R0 < TP) { L = 256; sb = R0 & ~255; } else { L = 4096; sb = TP + ((R0 - TP) & ~4095); }
  const int t0 = R0 - sb;
  bf16_t* zs = (bf16_t*)smem;
  bf16_t* za = (bf16_t*)(smem + 31744);
  float* red = (float*)(smem + 48640);
  for (int idx = tid; idx < 62 * 64; idx += 256) {
    const int i = idx >> 6, cq = (idx & 63) * 4, t = t0 - 15 + i;
    u32x2 w = {0u, 0u};
    if (t >= 0 && t < L) {
      const bf16_t* ur = P_U + (size_t)(sb + t) * NIN;
      const u32x2 vv = *(const u32x2*)(ur + 1536 + cq), gg = *(const u32x2*)(ur + 1792 + cq);
      w.x = pk2(bflo(vv.x) * sigm_f(bflo(gg.x)), bfhi(vv.x) * sigm_f(bfhi(gg.x)));
      w.y = pk2(bflo(vv.y) * sigm_f(bflo(gg.y)), bfhi(vv.y) * sigm_f(bfhi(gg.y)));
    }
    *(u32x2*)(zs + i * 256 + cq) = w;
  }
  __syncthreads();
  const int c = tid;
  float wj[31];
#pragma unroll
  for (int j = 0; j < 31; ++j) wj[j] = p.conv_w[(size_t)(l * 31 + j) * 256 + c];
  const float cb = p.conv_b[l * 256 + c], lg = p.conv_ln_g[l * 256 + c], lb = p.conv_ln_b[l * 256 + c];
  float a[2][16];
#pragma unroll
  for (int ch = 0; ch < 2; ++ch) {
    float zr[46];
#pragma unroll
    for (int i = 0; i < 46; ++i) zr[i] = bf2f(zs[(ch * 16 + i) * 256 + c]);
#pragma unroll
    for (int i = 0; i < 16; ++i) {
      float s = cb;
#pragma unroll
      for (int j = 0; j < 31; ++j) s += zr[i + j] * wj[j];
      a[ch][i] = s;
      const float s1 = wave_sum(s), s2 = wave_sum(s * s);
      if (lane == 0) { red[((ch * 16 + i) * 4 + wid) * 2] = s1; red[((ch * 16 + i) * 4 + wid) * 2 + 1] = s2; }
    }
  }
  __syncthreads();
#pragma unroll
  for (int ch = 0; ch < 2; ++ch)
#pragma unroll
    for (int i = 0; i < 16; ++i) {
      const int tt = ch * 16 + i;
      const float s1 = red[(tt * 4 + 0) * 2] + red[(tt * 4 + 1) * 2] + red[(tt * 4 + 2) * 2] + red[(tt * 4 + 3) * 2];
      const float s2 = red[(tt * 4 + 0) * 2 + 1] + red[(tt * 4 + 1) * 2 + 1] + red[(tt * 4 + 2) * 2 + 1] + red[(tt * 4 + 3) * 2 + 1];
      const float mean = s1 * (1.f / 256.f);
      const float var = fmaxf(s2 * (1.f / 256.f) - mean * mean, 0.f);
      const float rstd = rsqrtf(var + 1e-5f);
      const float v = (a[ch][i] - mean) * rstd * lg + lb;
      za[tt * 264 + c] = f2bf(silu_f(v));
    }
  __syncthreads();
  f32x4 acc[2][4];
#pragma unroll
  for (int m = 0; m < 2; ++m)
#pragma unroll
    for (int n = 0; n < 4; ++n) acc[m][n] = (f32x4){0.f, 0.f, 0.f, 0.f};
  const bf16_t* wt = P_pwT + (size_t)l * 65536;
#pragma unroll
  for (int ks = 0; ks < 8; ++ks) {
    bf16x8 af[2], bfr[4];
#pragma unroll
    for (int m = 0; m < 2; ++m) af[m] = *(const bf16x8*)(smem + 31744 + (m * 16 + fr) * 528 + (ks * 32 + fq * 8) * 2);
#pragma unroll
    for (int n = 0; n < 4; ++n) bfr[n] = *(const bf16x8*)(wt + (size_t)(wid * 64 + n * 16 + fr) * 256 + ks * 32 + fq * 8);
#pragma unroll
    for (int m = 0; m < 2; ++m)
#pragma unroll
      for (int n = 0; n < 4; ++n) acc[m][n] = mfma16(bfr[n], af[m], acc[m][n]);
  }
#pragma unroll
  for (int m = 0; m < 2; ++m) {
    const int row = R0 + m * 16 + fr;
#pragma unroll
    for (int n = 0; n < 4; ++n) {
      const int ch = wid * 64 + n * 16 + 4 * fq;
      const u32x2 gw = *(const u32x2*)(P_U + (size_t)row * NIN + 2048 + ch);
      u32x2 w;
      w.x = pk2(acc[m][n][0] * silu_f(bflo(gw.x)), acc[m][n][1] * silu_f(bfhi(gw.x)));
      w.y = pk2(acc[m][n][2] * silu_f(bflo(gw.y)), acc[m][n][3] * silu_f(bfhi(gw.y)));
      *(u32x2*)(P_MX + (size_t)row * DM + 512 + ch) = w;
    }
  }
  __syncthreads();
}

constexpr int P0_WIN = 3072, P0_WOUT = 1024, P0_PW = 64, P0_POOL = 16, P0_CVT = 768, P0_MOD = 192;
constexpr int P0_UNITS = P0_WIN + P0_WOUT + P0_PW + P0_POOL + P0_CVT + P0_MOD;

DEV void phase0(const Params& p, char* smem) {
  if (blockIdx.x == 0) for (int i = threadIdx.x; i < 1280 + 8; i += 256) P_cnt[i] = 0u;
  for (int u = blockIdx.x; u < P0_UNITS; u += gridDim.x) {
    int v = u;
    if (v < P0_MOD) { mod_unit(p, v, smem); continue; }
    v -= P0_MOD;
    if (v < P0_WIN) { const int l = v / 768, r = v % 768, kt = r / 48, nt = r % 48;
      tconv_tile(p.w_in + ((size_t)l * 1024 + kt * 64) * 3072 + nt * 64, 3072, P_WinT + ((size_t)l * 3072 + nt * 64) * 1024 + kt * 64, 1024, smem); continue; }
    v -= P0_WIN;
    if (v < P0_WOUT) { const int l = v >> 8, r = v & 255, kt = r >> 4, nt = r & 15;
      tconv_tile(p.w_out + ((size_t)l * 1024 + kt * 64) * 1024 + nt * 64, 1024, P_WoutT + ((size_t)l * 1024 + nt * 64) * 1024 + kt * 64, 1024, smem); continue; }
    v -= P0_WOUT;
    if (v < P0_PW) { const int l = v >> 4, r = v & 15, kt = r >> 2, nt = r & 3;
      tconv_tile(p.conv_pw + ((size_t)l * 256 + kt * 64) * 256 + nt * 64, 256, P_pwT + ((size_t)l * 256 + nt * 64) * 256 + kt * 64, 256, smem); continue; }
    v -= P0_PW;
    if (v < P0_POOL) { tconv_tile(p.pool_w + (size_t)v * 4096, 64, P_poolT + (size_t)v * 4096, 64, smem); continue; }
    v -= P0_POOL;
    if (v < 256) { cvt_unit(p.cnk, P_cnk_b, v); continue; }
    v -= 256;
    if (v < 256) { cvt_unit(p.cnv, P_cnv_b, v); continue; }
    v -= 256;
    if (v < 128) { cvt_unit(p.cgk, P_cgk_b, v); continue; }
    v -= 128;
    cvt_unit(p.cgv, P_cgv_b, v);
  }
}

constexpr int PB_GQA = 1024, PB_NAT = 2048, PB_CONV = 1280, PB_PATT = 512, PB_POOL = 1280;
constexpr int PB_UNITS = PB_GQA + PB_NAT + PB_CONV + PB_PATT + PB_POOL;

DEV void phaseB(const Params& p, int l_in, char* smem, int qofs) {
  unsigned* q = P_cnt + 1280 + qofs + l_in;
  int* slot = (int*)(smem + 65536 - 16);
  for (;;) {
    if (threadIdx.x == 0) *slot = (int)atomicAdd(q, 1u);
    __syncthreads();
    int u = *slot;
    __syncthreads();
    if (u >= PB_UNITS) break;
    int l = l_in; asm volatile("" : "+s"(l));
    if (u < PB_GQA) { attn_unit<0>(p, l, u, smem); continue; }
    u -= PB_GQA;
    if (u < PB_NAT) { attn_unit<1>(p, l, u, smem); continue; }
    u -= PB_NAT;
    if (u < PB_CONV) { conv_unit(p, l, u, smem); continue; }
    u -= PB_CONV;
    if (u < PB_PATT) { attn_unit<2>(p, l, u, smem); continue; }
    u -= PB_PATT;
    pool_unit(p, l, u, smem);
  }
}

__global__ void __launch_bounds__(256, 2) mega(Params p) {
  __shared__ __attribute__((aligned(16))) char smem[65536];
  cg::grid_group grid = cg::this_grid();
  const int ph0 = p.ph0, ph1 = p.ph1;
  if (ph0 <= 0 && 0 < ph1) { phase0(p, smem); if (1 < ph1) grid.sync(); }
  if (ph0 <= 1 && 1 < ph1) { for (int u = blockIdx.x; u < TT / 32; u += gridDim.x) h0_unit(p, u); if (2 < ph1) grid.sync(); }
  for (int li = 0; li < NLAYER; ++li) {
    int l = li; asm volatile("" : "+s"(l));
    const int pa = 2 + 3 * li;
    if (ph0 <= pa && pa < ph1) { for (int t = blockIdx.x; t < 320 * 24; t += gridDim.x) phaseA_tile(p, l, t, smem); if (pa + 1 < ph1) grid.sync(); }
#if PROBE_DUP == 1
    { for (int t = blockIdx.x; t < 320 * 24; t += gridDim.x) phaseA_tile(p, l, t, smem); grid.sync(); }
#endif
    if (ph0 <= pa + 1 && pa + 1 < ph1) { phaseB(p, l, smem, 0); if (pa + 2 < ph1) grid.sync(); }
#if PROBE_DUP == 2
    { phaseB(p, l, smem, 4); grid.sync(); }
#endif
    if (ph0 <= pa + 2 && pa + 2 < ph1) {
      for (int t = blockIdx.x; t < 320 * 8; t += gridDim.x) phaseC_tile(p, l, t, smem);
      grid.sync();
      for (int u = blockIdx.x; u < TT / 4; u += gridDim.x) ln_unit(p, l, u);
      if (pa + 3 < ph1) grid.sync();
    }
  }
}

#ifndef PROBE_DUP
#define PROBE_DUP 0
#endif
#ifndef ONE_LAUNCH
#define ONE_LAUNCH 1
#endif

extern "C" void kernel_launch(void* const* d_in, const int* in_sizes, int n_in, void* d_out, int out_size, void* d_ws, size_t ws_size,
                              hipStream_t stream) {
  static int grid_blocks = 0;
  if (!grid_blocks) {
    int dev = 0, cus = 0, per_cu = 0;
    hipGetDevice(&dev);
    hipDeviceGetAttribute(&cus, hipDeviceAttributeMultiprocessorCount, dev);
    hipOccupancyMaxActiveBlocksPerMultiprocessor(&per_cu, mega, 256, 0);
    if (per_cu > 2) per_cu = 2;
    if (per_cu < 1) per_cu = 1;
    grid_blocks = cus * per_cu;
  }
  Params p{};
  const float* const* in = (const float* const*)d_in;
  p.x_prompt = in[0]; p.x_sample = in[1]; p.c = in[2]; p.cnk = in[3]; p.cnv = in[4]; p.cgk = in[5]; p.cgv = in[6]; p.c_ctx = in[7];
  p.w_mod = in[8]; p.b_mod = in[9]; p.w_in = in[10]; p.b_in = in[11]; p.pool_w = in[12]; p.pool_scale = in[13]; p.nat_bias = in[14];
  p.q_norm = in[15]; p.k_norm = in[16]; p.conv_w = in[17]; p.conv_b = in[18]; p.conv_ln_g = in[19]; p.conv_ln_b = in[20]; p.conv_pw = in[21];
  p.w_out = in[22]; p.b_out = in[23]; p.ln_g = in[24]; p.ln_b = in[25];
  p.out = (float*)d_out;
  p.ws = (char*)d_ws;
#if ONE_LAUNCH
  p.ph0 = 0; p.ph1 = 14;
  void* args[] = {&p};
  hipError_t e = hipLaunchCooperativeKernel((void*)mega, dim3(grid_blocks), dim3(256), args, 0, stream);
  if (e != hipSuccess) fprintf(stderr, "cooperative launch failed: %s (grid %d)\n", hipGetErrorString(e), grid_blocks);
#else
  for (int ph = 0; ph < 14; ++ph) { p.ph0 = ph; p.ph1 = ph + 1; mega<<<grid_blocks, 256, 0, stream>>>(p); }
#endif
}
```

```cpp
#include <hip/hip_runtime.h>
#include <hip/hip_cooperative_groups.h>
#include <cstdio>
#include <cstdint>
namespace cg = cooperative_groups;

typedef unsigned short bf16_t;
typedef short bf16x8 __attribute__((ext_vector_type(8)));
typedef short s16x4 __attribute__((ext_vector_type(4)));
typedef float f32x4 __attribute__((ext_vector_type(4)));
typedef float f32x2 __attribute__((ext_vector_type(2)));
typedef __bf16 bf16x2_t __attribute__((ext_vector_type(2)));
typedef unsigned u32x4 __attribute__((ext_vector_type(4)));
typedef unsigned u32x2 __attribute__((ext_vector_type(2)));
#define DEV __device__ __forceinline__
__device__ const float ROPE_COS[1024] = {
1.f,1.f,1.f,1.f,1.f,1.f,1.f,1.f,
1.f,1.f,1.f,1.f,1.f,1.f,1.f,1.f,
0.540302277f,0.846009135f,0.950415254f,0.98423022f,0.995004177f,0.998419285f,0.999500036f,0.999841869f,
0.999949992f,0.999984205f,0.999994993f,0.999998391f,0.999999523f,0.999999821f,0.99999994f,1.f,
-0.416146845f,0.431462824f,0.806578398f,0.937418282f,0.980066597f,0.993682086f,0.998000681f,0.999367595f,
0.999800026f,0.999936759f,0.999979973f,0.999993682f,0.999997973f,0.999999344f,0.999999821f,0.99999994f,
-0.989992499f,-0.115966164f,0.582753658f,0.861040652f,0.955336511f,0.985803485f,0.995503366f,0.998577297f,
0.999550045f,0.999857724f,0.999954998f,0.999985754f,0.99999553f,0.999998569f,0.999999523f,0.999999881f,
-0.653643608f,-0.627679706f,0.301137477f,0.757506192f,0.921060979f,0.974808276f,0.992010653f,0.997471273f,
0.999200106f,0.999747038f,0.999920011f,0.999974728f,0.999992013f,0.999997497f,0.999999225f,0.999999762f,
0.2836622f,-0.946079254f,-0.0103423381f,0.630080283f,0.87758255f,0.960731268f,0.987526f,0.996049762f,
0.998750269f,0.999604762f,0.999875009f,0.999960482f,0.999987483f,0.999996066f,0.999998748f,0.999999583f,
0.960170269f,-0.973103702f,-0.3207964f,0.482782036f,0.825335622f,0.943616986f,0.982053936f,0.9943133f,
0.998200536f,0.999430835f,0.999819994f,0.999943078f,0.999981999f,0.999994338f,0.999998212f,0.999999404f,
0.753902256f,-0.700429797f,-0.599437475f,0.320257008f,0.764842212f,0.923519433f,0.975599885f,0.992262423f,
0.997551024f,0.999225318f,0.999755025f,0.999922514f,0.999975502f,0.999992251f,0.999997556f,0.999999225f,
-0.145500034f,-0.212036446f,-0.818632424f,0.147631213f,0.696706712f,0.900502324f,0.968170285f,0.989897788f,
0.996801734f,0.998988271f,0.999680042f,0.999898791f,0.999967992f,0.999989867f,0.999996781f,0.999998987f,
-0.91113025f,0.341660261f,-0.956644177f,-0.0296507962f,0.621609926f,0.874638259f,0.959772646f,0.987220109f,
0.995952725f,0.998719573f,0.999595046f,0.99987191f,0.999959528f,0.999987185f,0.999995947f,0.999998748f,
-0.839071512f,0.790131867f,-0.999786079f,-0.205997631f,0.540302277f,0.846009135f,0.950415313f,0.98423022f,
0.995004177f,0.998419285f,0.999500036f,0.999841869f,0.999949992f,0.999984205f,0.999994993f,0.999998391f,
0.00442569796f,0.995257378f,-0.943779767f,-0.375847399f,0.453596085f,0.814705312f,0.940107584f,0.980929136f,
0.993956089f,0.998087406f,0.999395072f,0.999808669f,0.999939501f,0.999980867f,0.99999392f,0.999998093f,
0.843853951f,0.893861592f,-0.79417938f,-0.53384304f,0.362357706f,0.780825913f,0.92885989f,0.97731787f,
0.99280864f,0.997723997f,0.999280095f,0.99977231f,0.999927998f,0.999977231f,0.999992788f,0.999997735f,
0.907446802f,0.517172873f,-0.565820515f,-0.675001681f,0.267498761f,0.744477987f,0.916683376f,0.973397553f,
0.99156189f,0.997329056f,0.999155104f,0.999732792f,0.999915481f,0.999973297f,0.999991536f,0.999997318f,
0.136737213f,-0.0187961515f,-0.28134948f,-0.794870913f,0.16996716f,0.705776393f,0.903590262f,0.969169438f,
0.990216017f,0.996902585f,0.999020159f,0.999690115f,0.99990201f,0.999969006f,0.999990225f,0.999996901f,
-0.759687901f,-0.548975468f,0.0310223512f,-0.889670432f,0.070737198f,0.6648435f,0.889593601f,0.964634836f,
0.988771081f,0.996444523f,0.998875201f,0.999644279f,0.999887526f,0.999964416f,0.999988735f,0.999996424f,
-0.957659483f,-0.910081089f,0.340318173f,-0.95641005f,-0.0291995462f,0.621808827f,0.87470746f,0.959795177f,
0.987227261f,0.99595499f,0.998720288f,0.999595284f,0.999872029f,0.999959528f,0.999987185f,0.999995947f,
-0.275163352f,-0.990897954f,0.615864813f,-0.99298501f,-0.128844544f,0.576808274f,0.858946681f,0.954652011f,
0.985584795f,0.995433986f,0.998555362f,0.999543071f,0.999855518f,0.999954283f,0.999985576f,0.99999541f,
0.660316706f,-0.766536534f,0.830336154f,-0.998241663f,-0.227202162f,0.529984176f,0.842327058f,0.949207008f,
0.983843684f,0.994881511f,0.998380423f,0.999487758f,0.999837995f,0.9999488f,0.999983788f,0.999994874f,
0.988704622f,-0.306095392f,0.962463796f,-0.972014248f,-0.323289543f,0.481484592f,0.824865162f,0.943461835f,
0.982004225f,0.994297504f,0.998195529f,0.999429286f,0.999819517f,0.999942899f,0.99998194f,0.999994278f,
0.408082068f,0.248616725f,0.999144375f,-0.91512996f,-0.416146845f,0.431462824f,0.806578457f,0.937418282f,
0.980066597f,0.993682086f,0.998000681f,0.999367595f,0.999800026f,0.999936759f,0.999979973f,0.999993682f,
-0.547729254f,0.726760268f,0.936740458f,-0.829382956f,-0.504846215f,0.380077004f,0.787485182f,0.931078374f,
0.97803092f,0.993035257f,0.99779582f,0.999302804f,0.999779522f,0.999930263f,0.999977946f,0.999993026f,
-0.99996084f,0.981074572f,0.781440377f,-0.717477441f,-0.588501155f,0.327489585f,0.767604589f,0.92444396f,
0.975897431f,0.992357016f,0.997581005f,0.999234855f,0.999758005f,0.999923468f,0.999975801f,0.999992371f,
-0.53283304f,0.933235765f,0.548645258f,-0.582943261f,-0.666275978f,0.273866832f,0.746956408f,0.917517304f,
0.97366637f,0.991647422f,0.997356176f,0.999163687f,0.999735534f,0.999916375f,0.999973536f,0.999991655f,
0.424179018f,0.597977161f,0.261441678f,-0.430023283f,-0.737393796f,0.219378278f,0.725561321f,0.910300434f,
0.971337974f,0.990906477f,0.997121394f,0.99908942f,0.99971199f,0.999908924f,0.999971211f,0.99999088f,
0.991202831f,0.078552261f,-0.0516893305f,-0.263540596f,-0.801143587f,0.164196163f,0.703440726f,0.902795732f,
0.968912423f,0.99013412f,0.996876657f,0.999011934f,0.999687493f,0.999901175f,0.999968767f,0.999990106f,
0.64691931f,-0.465064496f,-0.359694332f,-0.0887455046f,-0.856888831f,0.108494945f,0.680616796f,0.895005584f,
0.966389954f,0.98933053f,0.996621907f,0.998931348f,0.999662042f,0.999893129f,0.999966204f,0.999989331f,
-0.292138815f,-0.865450621f,-0.632028639f,0.088848114f,-0.904072165f,0.0524506159f,0.6571123f,0.886932373f,
0.963770926f,0.988495648f,0.996357203f,0.998847544f,0.999635518f,0.999884725f,0.999963522f,0.999988496f,
-0.962605894f,-0.999293387f,-0.841684937f,0.26363951f,-0.942222297f,-0.00375941908f,0.632950664f,0.878578722f,
0.961055458f,0.987629473f,0.996082544f,0.998760641f,0.99960804f,0.999876022f,0.99996078f,0.999987602f,
-0.748057544f,-0.825371623f,-0.967871487f,0.430115849f,-0.970958173f,-0.0599575676f,0.608156204f,0.869947195f,
0.958243906f,0.986732066f,0.995797932f,0.998670578f,0.999579549f,0.999867022f,0.999957979f,0.999986708f,
0.154251456f,-0.397251874f,-0.998075247f,0.583026946f,-0.989992499f,-0.115966164f,0.582753658f,0.861040652f,
0.955336511f,0.985803485f,0.995503366f,0.998577297f,0.999550045f,0.999857724f,0.999954998f,0.999985754f,
0.914742351f,0.153215483f,-0.929300308f,0.717549205f,-0.999135137f,-0.171608135f,0.556768358f,0.851861775f,
0.95233357f,0.984843671f,0.995198846f,0.998480916f,0.999519527f,0.999848068f,0.999951959f,0.999984801f,
0.83422339f,0.656495154f,-0.768367112f,0.829440355f,-0.998294771f,-0.226707578f,0.53022635f,0.842413545f,
0.949235439f,0.983852804f,0.994884372f,0.998381376f,0.999488056f,0.999838114f,0.9999488f,0.999983788f,
-0.0132767474f,0.95758605f,-0.531235278f,0.915171385f,-0.987479806f,-0.281090319f,0.503154159f,0.832698941f,
0.946042359f,0.982830763f,0.994559944f,0.998278618f,0.999455571f,0.999827802f,0.999945521f,0.999982774f,
-0.848570287f,0.963757515f,-0.241421118f,0.972038329f,-0.966798186f,-0.334584385f,0.475578904f,0.822721004f,
0.942754686f,0.981777668f,0.994225562f,0.99817276f,0.999422073f,0.999817252f,0.999942183f,0.999981701f,
-0.903692186f,0.673110247f,0.0723346695f,0.998247743f,-0.93645668f,-0.387020677f,0.447528064f,0.812482953f,
0.939372718f,0.980693519f,0.993881226f,0.998063743f,0.999387562f,0.999806345f,0.999938726f,0.999980628f,
-0.127963692f,0.175156534f,0.378916174f,0.992972851f,-0.896758378f,-0.438233554f,0.419029742f,0.801987886f,
0.935896814f,0.979578316f,0.993526995f,0.997951567f,0.999352098f,0.999795079f,0.99993521f,0.999979496f,
0.765414059f,-0.376742303f,0.647921681f,0.95638001f,-0.848100007f,-0.488060862f,0.39011243f,0.791239262f,
0.93232733f,0.978432178f,0.993162811f,0.997836173f,0.99931556f,0.999783576f,0.999931574f,0.999978364f,
0.955073655f,-0.812611222f,0.852673113f,0.889623463f,-0.790967762f,-0.536345184f,0.360805035f,0.780240417f,
0.928664625f,0.977255106f,0.992788672f,0.997717679f,0.999278069f,0.999771714f,0.999927819f,0.999977171f,
0.266642928f,-0.998210371f,0.972865343f,0.794808388f,-0.72593224f,-0.582933903f,0.331136853f,0.768994927f,
0.924909055f,0.976047099f,0.99240464f,0.997596025f,0.999239624f,0.999759495f,0.999923944f,0.999975979f,
-0.666938066f,-0.87637943f,0.996578991f,0.674925625f,-0.653643608f,-0.627679706f,0.301137596f,0.757506192f,
0.921060979f,0.974808276f,0.992010653f,0.997471273f,0.999200106f,0.999747038f,0.999920011f,0.999974728f,
-0.987339258f,-0.484639406f,0.921462357f,0.533756077f,-0.574824035f,-0.670441091f,0.270837069f,0.745777905f,
0.917120814f,0.973538578f,0.991606772f,0.997343302f,0.999159634f,0.999734223f,0.999915957f,0.999973416f,
-0.399985313f,0.0563609414f,0.754965365f,0.375752151f,-0.490260571f,-0.711082935f,0.240265876f,0.733813822f,
0.913088918f,0.972238123f,0.991192937f,0.997212172f,0.999118149f,0.99972111f,0.999911785f,0.999972105f,
0.555113316f,0.580003142f,0.513598442f,0.205897167f,-0.400799006f,-0.749476731f,0.209454417f,0.721617639f,
0.908965766f,0.970906913f,0.990769207f,0.997077882f,0.999075651f,0.999707639f,0.999907553f,0.999970794f,
0.999843299f,0.925014675f,0.221298173f,0.0295478199f,-0.307332784f,-0.785501122f,0.178433523f,0.709193349f,
0.904751658f,0.969545007f,0.990335584f,0.996940494f,0.99903214f,0.99969393f,0.999903202f,0.999969363f,
0.52532196f,0.985138178f,-0.0929481089f,-0.147732988f,-0.210795805f,-0.819042206f,0.147234216f,0.696544766f,
0.90044713f,0.968152404f,0.989892066f,0.996799886f,0.998987675f,0.999679863f,0.999898732f,0.999967992f,
-0.432177931f,0.741858006f,-0.397976756f,-0.320354372f,-0.112152621f,-0.849993885f,0.115887694f,0.683675885f,
0.89605248f,0.966729224f,0.989438653f,0.996656179f,0.998942196f,0.999665439f,0.999894202f,0.999966562f,
-0.992335498f,0.270098448f,-0.663538277f,-0.48287195f,-0.0123883775f,-0.878258407f,0.0844252855f,0.670590878f,
0.891568303f,0.965275466f,0.988975346f,0.996509314f,0.998895705f,0.999650776f,0.999889553f,0.999965072f,
-0.640144348f,-0.284846604f,-0.863296509f,-0.630159974f,0.0874991715f,-0.903746367f,0.0528784581f,0.657293737f,
0.886994898f,0.963791192f,0.988502085f,0.996359289f,0.9988482f,0.999635756f,0.999884784f,0.999963582f,
0.300592542f,-0.75206399f,-0.977442741f,-0.757573068f,0.18651247f,-0.926377118f,0.0212787576f,0.643788815f,
0.882332861f,0.962276459f,0.98801899f,0.996206105f,0.998799741f,0.999620378f,0.999879956f,0.999962032f,
0.964965999f,-0.987659097f,-0.994656444f,-0.861092687f,0.2836622f,-0.946079254f,-0.0103422189f,0.630080283f,
0.87758255f,0.960731268f,0.987526f,0.996049762f,0.998750269f,0.999604762f,0.999875009f,0.999960482f,
0.742154181f,-0.919073522f,-0.913230121f,-0.937454224f,0.377977669f,-0.96279037f,-0.0419528559f,0.616172493f,
0.872744501f,0.959155679f,0.987023175f,0.99589026f,0.998699784f,0.999588788f,0.999869943f,0.999958873f,
-0.162990779f,-0.567430019f,-0.741239965f,-0.984248459f,0.468516916f,-0.976457715f,-0.0735215396f,0.602069914f,
0.86781919f,0.95754981f,0.986510456f,0.995727658f,0.998648286f,0.999572515f,0.999864817f,0.999957263f,
-0.918282807f,-0.0410281904f,-0.495741814f,-1.f,0.554374516f,-0.987038016f,-0.105016708f,0.587776959f,
0.862807095f,0.955913603f,0.985987842f,0.995561838f,0.998595834f,0.999555886f,0.999859571f,0.999955595f,
-0.829309821f,0.498009592f,-0.201079622f,-0.984212041f,0.634692967f,-0.994497895f,-0.136406869f,0.573298037f,
0.857708693f,0.954247177f,0.985455394f,0.995392919f,0.998542368f,0.999538958f,0.999854207f,0.999953866f,
0.0221267566f,0.883669317f,0.113521777f,-0.937382519f,0.708669782f,-0.998813629f,-0.167660639f,0.558637917f,
0.852524519f,0.95255059f,0.984913111f,0.99522084f,0.99848789f,0.999521732f,0.999848783f,0.999952197f,
0.853220105f,0.997174621f,0.416867077f,-0.860988438f,0.775565803f,-0.999971747f,-0.198746875f,0.543801069f,
0.847255111f,0.950823903f,0.984360933f,0.995045662f,0.998432398f,0.999504209f,0.99984318f,0.999950409f,
0.899866819f,0.803569078f,0.678870201f,-0.757439196f,0.834712923f,-0.997968495f,-0.22963427f,0.528792322f,
0.841901004f,0.949067116f,0.983798921f,0.994867265f,0.998375952f,0.999486327f,0.999837577f,0.999948621f,
0.119180135f,0.362476677f,0.873550534f,-0.63000071f,0.885519624f,-0.99281019f,-0.260292053f,0.513616323f,
0.836462677f,0.947280347f,0.983227074f,0.994685769f,0.998318493f,0.999468148f,0.999831796f,0.999946833f,
-0.771080196f,-0.1902491f,0.981602073f,-0.482692331f,0.927478492f,-0.984513164f,-0.290689558f,0.498277903f,
0.830940723f,0.945463598f,0.982645452f,0.994501114f,0.998260021f,0.99944967f,0.999825954f,0.999944985f,
-0.952412963f,-0.684381902f,0.992308319f,-0.320159167f,0.960170269f,-0.973103702f,-0.3207964f,0.482782036f,
0.825335622f,0.943616986f,0.982053936f,0.9943133f,0.998200536f,0.999430835f,0.999819994f,0.999943078f,
-0.258101642f,-0.967739642f,0.904607594f,-0.1475292f,0.98326844f,-0.958617806f,-0.350582451f,0.467133403f,
0.819648027f,0.941740453f,0.981452644f,0.994122326f,0.998140097f,0.999411702f,0.999813974f,0.99994117f,
0.673507154f,-0.953050017f,0.727198064f,0.0297537707f,0.996542096f,-0.941101313f,-0.380017966f,0.451337039f,
0.813878477f,0.939834237f,0.980841517f,0.993928254f,0.998078644f,0.999392271f,0.999807835f,0.999939203f,
0.985896587f,-0.644837022f,0.477671444f,0.206098333f,0.999858618f,-0.920609534f,-0.409073502f,0.435397953f,
0.808027506f,0.937898219f,0.980220556f,0.993731022f,0.998016179f,0.999372482f,0.999801576f,0.999937236f,
};
__device__ const float ROPE_SIN[1024] = {
0.f,0.f,0.f,0.f,0.f,0.f,0.f,0.f,
0.f,0.f,0.f,0.f,0.f,0.f,0.f,0.f,
0.841470957f,0.533168435f,0.310983598f,0.176892191f,0.0998334214f,0.0562044978f,0.0316175036f,0.0177818574f,
0.00999983307f,0.00562338345f,0.00316227227f,0.0017782785f,0.000999999931f,0.000562341243f,0.000316227757f,0.00017782794f,
0.909297407f,0.902130723f,0.591127098f,0.348205268f,0.198669329f,0.112231314f,0.0632033944f,0.0355580896f,
0.0199986659f,0.011246589f,0.00632451288f,0.00355655141f,0.0019999987f,0.00112468237f,0.000632455456f,0.00035565588f,
0.141120002f,0.993253171f,0.812648892f,0.5085361f,0.295520216f,0.167903304f,0.0947260857f,0.0533230826f,
0.0299954992f,0.0168694388f,0.00948669016f,0.00533481315f,0.0029999956f,0.00168702309f,0.000948683126f,0.000533483806f,
-0.756802499f,0.778471708f,0.953580737f,0.652827978f,0.389418334f,0.223044485f,0.126154065f,0.0710712075f,
0.0399893336f,0.0224917568f,0.0126487734f,0.00711305765f,0.00399998948f,0.00224936334f,0.00126491068f,0.000711311703f,
-0.958924294f,0.32393527f,0.999946535f,0.776529968f,0.47942555f,0.277480543f,0.157455876f,0.0887968615f,
0.0499791652f,0.0281133614f,0.0158107281f,0.00889127981f,0.0049999794f,0.0028117029f,0.00158113812f,0.000889139599f,
-0.279415488f,-0.230367512f,0.947148204f,0.875740528f,0.564642489f,0.33103931f,0.188600272f,0.106494442f,
0.0599640049f,0.0337340795f,0.0189725272f,0.0106694745f,0.0059999642f,0.00337404152f,0.00189736532f,0.00106696738f,
0.656986594f,-0.713721275f,0.800421596f,0.947330713f,0.64421767f,0.383551568f,0.219556093f,0.124158338f,
0.0699428469f,0.0393537246f,0.0221341345f,0.0124476347f,0.00699994294f,0.00393637875f,0.00221359241f,0.00124479528f,
0.989358246f,-0.977261782f,0.574317753f,0.989042461f,0.717356086f,0.434851229f,0.250292331f,0.141782969f,
0.0799146891f,0.0449721329f,0.0252955221f,0.0142257558f,0.0079999147f,0.00449871505f,0.00252981926f,0.00142262306f,
0.412118495f,-0.939823508f,0.291259229f,0.999560297f,0.783326924f,0.484776139f,0.280778319f,0.159362778f,
0.0898785442f,0.0505891182f,0.0284566563f,0.0160038304f,0.00899987947f,0.00506105041f,0.00284604589f,0.00160045072f,
-0.54402113f,-0.612936914f,-0.0206835698f,0.978552461f,0.841470957f,0.533168435f,0.310983568f,0.176892191f,
0.099833414f,0.0562044978f,0.0316175036f,0.0177818574f,0.009999834f,0.00562338345f,0.00316227227f,0.0017782785f,
-0.999990225f,-0.0972764567f,-0.33057496f,0.926681578f,0.891207397f,0.579875171f,0.340877861f,0.19436565f,
0.1097783f,0.0618181042f,0.0347780399f,0.0195598267f,0.0109997792f,0.00618571462f,0.00347849843f,0.00195610616f,
-0.536572933f,0.448342979f,-0.60768342f,0.845583618f,0.932039082f,0.624748647f,0.370431304f,0.211777672f,
0.119712204f,0.0674297586f,0.0379382223f,0.0213377345f,0.0119997123f,0.0067480444f,0.00379472389f,0.00213393359f,
0.420167029f,0.855880976f,-0.824528456f,0.737816215f,0.963558197f,0.667647004f,0.399614304f,0.229122713f,
0.129634142f,0.0730392784f,0.0410980321f,0.0231155735f,0.0129996343f,0.00731037185f,0.00411094911f,0.00231176103f,
0.990607381f,0.999823332f,-0.959605396f,0.606778562f,0.985449731f,0.708434701f,0.428397775f,0.246395305f,
0.139543116f,0.078646481f,0.0442574248f,0.0248933397f,0.0139995432f,0.00787269697f,0.00442717411f,0.00248958869f,
0.650287867f,0.835838437f,-0.999518692f,0.456603259f,0.997494996f,0.746982634f,0.456752867f,0.263589978f,
0.149438128f,0.0842512026f,0.0474163815f,0.0266710296f,0.0149994381f,0.00843502022f,0.00474339863f,0.00266741589f,
-0.287903309f,0.414430231f,-0.940310359f,0.292027086f,0.999573588f,0.783169091f,0.484651238f,0.280701309f,
0.159318209f,0.0898532644f,0.0505748577f,0.028448632f,0.015999319f,0.00899733976f,0.00505962269f,0.00284524332f,
-0.961397469f,-0.134615138f,-0.78785187f,0.11824052f,0.991664827f,0.81687957f,0.512064993f,0.29772386f,
0.169182345f,0.09545248f,0.0537328273f,0.0302261449f,0.0169991814f,0.00955965649f,0.00537584582f,0.00302307028f,
-0.750987232f,-0.642200708f,-0.557262897f,-0.0592755191f,0.973847628f,0.84800756f,0.538966715f,0.314652264f,
0.179029569f,0.101048686f,0.0568902642f,0.0320035629f,0.0179990288f,0.0101219704f,0.00569206895f,0.00320089748f,
0.149877205f,-0.952000856f,-0.271410108f,-0.234921798f,0.946300089f,0.876454532f,0.565329552f,0.331481189f,
0.188858896f,0.10664168f,0.060047131f,0.0337808803f,0.0189988576f,0.0106842816f,0.00600829115f,0.00337872445f,
0.912945271f,-0.968601942f,0.0413582884f,-0.403158993f,0.909297407f,0.902130723f,0.591127038f,0.348205268f,
0.198669314f,0.112231314f,0.0632033944f,0.0355580896f,0.0199986678f,0.011246589f,0.00632451288f,0.00355655141f,
0.836655617f,-0.686891198f,0.35002476f,-0.558680534f,0.863209307f,0.924954832f,0.616333544f,0.364819258f,
0.208459899f,0.117817394f,0.0663590282f,0.0373351872f,0.0209984574f,0.0118088927f,0.00664073415f,0.00373437814f,
-0.00885130931f,-0.193630233f,0.623979926f,-0.696581721f,0.808496356f,0.944854796f,0.640923738f,0.381317884f,
0.218229622f,0.123399742f,0.0695140064f,0.0391121693f,0.0219982266f,0.0123711927f,0.00695695449f,0.00391220488f,
-0.846220434f,0.359264523f,0.836055279f,-0.812512875f,0.745705247f,0.961767614f,0.664873064f,0.397695929f,
0.227977514f,0.128978193f,0.0726682767f,0.0408890247f,0.0229979735f,0.0129334899f,0.00727317436f,0.00409003161f,
-0.905578375f,0.801513135f,0.965219259f,-0.902817786f,0.67546314f,0.97563988f,0.688157499f,0.413948208f,
0.237702623f,0.134552568f,0.0758218244f,0.0426657498f,0.0239976961f,0.0134957815f,0.0075893933f,0.00426785741f,
-0.132351756f,0.996909976f,0.998663187f,-0.964648306f,0.598472118f,0.986427724f,0.710753918f,0.430069596f,
0.247403964f,0.140122697f,0.0789746121f,0.0444423407f,0.0249973964f,0.0140580693f,0.00790561177f,0.00444568414f,
0.76255846f,0.885276794f,0.933070183f,-0.996054351f,0.515501261f,0.994096994f,0.732639611f,0.446054995f,
0.257080555f,0.145688385f,0.0821266174f,0.0462187938f,0.0259970706f,0.0146203535f,0.00822182931f,0.00462350994f,
0.956375957f,0.500994205f,0.774945021f,-0.996045172f,0.427379847f,0.99862349f,0.753792703f,0.46189931f,
0.266731411f,0.151249468f,0.0852777958f,0.0479951017f,0.0269967206f,0.015182632f,0.00853804592f,0.00480133574f,
0.270905793f,-0.0375856608f,0.539968967f,-0.964621305f,0.334988207f,0.999992907f,0.774192095f,0.477597594f,
0.276355654f,0.156805754f,0.0884281173f,0.049771253f,0.0279963426f,0.0157449059f,0.0088542616f,0.00497916201f,
-0.663633883f,-0.564589798f,0.251445323f,-0.902773678f,0.239249229f,0.998200953f,0.793817401f,0.49314484f,
0.28595221f,0.162357092f,0.0915775672f,0.0515472479f,0.0289959367f,0.0163071752f,0.00917047635f,0.00515698735f,
-0.988031626f,-0.917709649f,-0.0620148405f,-0.812452853f,0.141120002f,0.993253171f,0.812648892f,0.5085361f,
0.295520186f,0.167903304f,0.0947260931f,0.0533230826f,0.029995501f,0.0168694388f,0.00948669016f,0.00533481315f,
-0.404037654f,-0.988192797f,-0.369325012f,-0.696507812f,0.0415805206f,0.985165298f,0.830667794f,0.523766637f,
0.305058628f,0.173444211f,0.0978736654f,0.055098746f,0.0309950355f,0.0174316969f,0.00980290305f,0.00551263802f,
0.551426709f,-0.754330218f,-0.640009403f,-0.5585953f,-0.0583741926f,0.973962843f,0.847856104f,0.538831532f,
0.314566553f,0.17897962f,0.101020269f,0.0568742342f,0.0319945402f,0.0179939512f,0.0101191159f,0.00569046335f,
0.999911845f,-0.28814739f,-0.847224355f,-0.403064936f,-0.157745644f,0.959681332f,0.864196658f,0.553726017f,
0.324043006f,0.184509367f,0.10416586f,0.0586495437f,0.0329940096f,0.0185561981f,0.010435327f,0.00586828869f,
0.529082716f,0.266779721f,-0.97042042f,-0.234822124f,-0.255541205f,0.942365825f,0.879673064f,0.568445385f,
0.333487093f,0.190033287f,0.107310407f,0.0604246669f,0.0339934528f,0.0191184394f,0.010751537f,0.00604611309f,
-0.428182662f,0.739542127f,-0.997380435f,-0.0591726787f,-0.350783229f,0.92207104f,0.894269884f,0.582984984f,
0.342897803f,0.195551202f,0.110453881f,0.0621996038f,0.034992855f,0.0196806751f,0.0110677453f,0.00622393796f,
-0.991778851f,0.984540582f,-0.925431013f,0.118342586f,-0.442520559f,0.89886117f,0.907972515f,0.597340286f,
0.352274209f,0.201062918f,0.113596253f,0.0639743358f,0.0359922275f,0.0202429052f,0.0113839535f,0.0064017619f,
-0.643538117f,0.926318109f,-0.761706948f,0.292125374f,-0.529836178f,0.872809589f,0.920767248f,0.611506701f,
0.361615449f,0.206568271f,0.116737492f,0.0657488778f,0.036991559f,0.0208051261f,0.0117001599f,0.0065795863f,
0.296368569f,0.58280617f,-0.522444785f,0.456694692f,-0.611857831f,0.84399873f,0.932641268f,0.625479698f,
0.370920479f,0.212067112f,0.119877554f,0.0675232038f,0.0379908569f,0.0213673431f,0.0120163653f,0.00675741071f,
0.963795364f,0.0598003156f,-0.231372014f,0.606860459f,-0.687766254f,0.81251961f,0.943582714f,0.639254928f,
0.380188406f,0.217559248f,0.123016424f,0.0692973137f,0.0389901139f,0.0219295528f,0.0123325698f,0.00693523418f,
0.745113134f,-0.481621295f,0.0826458037f,0.737885714f,-0.756802499f,0.778471708f,0.953580678f,0.652827978f,
0.389418334f,0.223044485f,0.126154065f,0.0710712075f,0.0399893373f,0.0224917568f,0.0126487734f,0.00711305765f,
-0.158622667f,-0.874714017f,0.388467699f,0.845638454f,-0.818277061f,0.74196279f,0.962625206f,0.666194677f,
0.39860931f,0.228522688f,0.129290432f,0.0728448778f,0.0409885161f,0.0230539497f,0.0129649751f,0.00729088066f,
-0.916521549f,-0.998410463f,0.655764699f,0.926720202f,-0.871575892f,0.703108132f,0.970707119f,0.679350674f,
0.407760441f,0.233993664f,0.132425532f,0.0746183172f,0.0419876575f,0.0236161388f,0.0132811759f,0.00746870413f,
-0.831774771f,-0.814614236f,0.858030677f,0.97857362f,-0.916166008f,0.662030637f,0.977818429f,0.692291796f,
0.416870773f,0.23945722f,0.135559291f,0.0763915181f,0.0429867506f,0.0241783205f,0.0135973748f,0.00764652714f,
0.0177019257f,-0.37993139f,0.975206196f,0.999563396f,-0.951602101f,0.618860185f,0.983951986f,0.70501405f,
0.425939471f,0.244913206f,0.138691694f,0.0781644881f,0.0439858064f,0.0247404929f,0.0139135728f,0.00782434922f,
0.850903511f,0.171763569f,0.995670974f,0.989027262f,-0.977530122f,0.57373327f,0.989101648f,0.717513323f,
0.434965521f,0.250361472f,0.141822711f,0.0799371973f,0.0449848175f,0.0253026579f,0.0142297689f,0.00800217129f,
0.901788354f,0.670557022f,0.917395473f,0.947297752f,-0.993690968f,0.526792526f,0.993262351f,0.72978574f,
0.44394809f,0.255801797f,0.144952312f,0.0817096606f,0.0459837839f,0.0258648153f,0.0145459641f,0.0081799943f,
0.123573124f,0.962832689f,0.748142362f,0.875690997f,-0.999923289f,0.478186339f,0.996429801f,0.741827428f,
0.452886283f,0.261234075f,0.148080453f,0.0834818557f,0.0469827019f,0.0264269635f,0.0148621574f,0.00835781638f,
-0.768254638f,0.958573103f,0.504697084f,0.776465356f,-0.99616462f,0.428068399f,0.99860096f,0.753634512f,
0.461779177f,0.266658038f,0.151207119f,0.0852537975f,0.0479815714f,0.0269891042f,0.0151783489f,0.00853563752f,
-0.953752637f,0.659090102f,0.211200655f,0.652750373f,-0.982452571f,0.376597136f,0.999773562f,0.765203178f,
0.470625877f,0.272073567f,0.15433228f,0.087025471f,0.0489803962f,0.0275512375f,0.0154945394f,0.0087134596f,
-0.262374848f,0.156619072f,-0.10324046f,0.508447945f,-0.958924294f,0.32393527f,0.999946535f,0.776529968f,
0.47942555f,0.277480543f,0.157455891f,0.0887968615f,0.0499791689f,0.0281133596f,0.0158107281f,0.00889127981f,
0.670229197f,-0.394086063f,-0.407444149f,0.3481085f,-0.925814748f,0.270249337f,0.99911958f,0.787611187f,
0.48817724f,0.282878697f,0.160577938f,0.0905679762f,0.0509778969f,0.0286754742f,0.0161269177f,0.00906910095f,
0.986627579f,-0.823421597f,-0.671240151f,0.176790684f,-0.883454502f,0.215709001f,0.997293651f,0.798443377f,
0.496880114f,0.28826794f,0.163698375f,0.0923388004f,0.051976569f,0.0292375814f,0.0164431017f,0.00924692024f,
0.395925164f,-0.999157965f,-0.868469954f,-0.000103020677f,-0.832267344f,0.160486728f,0.994470477f,0.809023023f,
0.505533338f,0.293648034f,0.166817173f,0.0941093415f,0.0529751927f,0.0297996756f,0.0167592876f,0.00942474138f,
-0.558789074f,-0.867171526f,-0.979574919f,-0.176993474f,-0.772764444f,0.104756832f,0.990652919f,0.819346905f,
0.514135957f,0.29901889f,0.169934288f,0.0958795771f,0.0539737605f,0.0303617641f,0.0170754679f,0.00960256159f,
-0.999755144f,-0.468111664f,-0.993535519f,-0.348301649f,-0.705540299f,0.0486960001f,0.985844791f,0.829411685f,
0.522687256f,0.304380238f,0.173049718f,0.0976495072f,0.0549722798f,0.0309238415f,0.01739165f,0.00978038087f,
-0.521551013f,0.0751182064f,-0.908967435f,-0.508624554f,-0.631266713f,-0.00751878507f,0.980050862f,0.839214146f,
0.531186223f,0.30973196f,0.17616342f,0.0994191393f,0.0559707358f,0.0314859077f,0.0177078284f,0.00995820016f,
0.436164767f,0.595211506f,-0.734258294f,-0.652905703f,-0.550685287f,-0.0637097955f,0.973276973f,0.848751247f,
0.539632022f,0.315073937f,0.179275364f,0.101188451f,0.0569691435f,0.0320479684f,0.0180240069f,0.0101360194f,
0.992872655f,0.931992829f,-0.486733496f,-0.776594579f,-0.464602023f,-0.119699396f,0.965529919f,0.858020008f,
0.548023939f,0.3204059f,0.182385504f,0.102957435f,0.0579674877f,0.0326100141f,0.0183401816f,0.0103138378f,
0.636738002f,0.981735826f,-0.190938011f,-0.87579f,-0.373876572f,-0.175310582f,0.956817448f,0.867017388f,
0.55636102f,0.325727791f,0.185493827f,0.104726106f,0.0589657798f,0.0331720486f,0.0186563563f,0.0104916561f,
-0.304810613f,0.729123712f,0.12379095f,-0.947363734f,-0.279415488f,-0.230367512f,0.947148204f,0.875740528f,
0.564642429f,0.33103931f,0.188600287f,0.106494442f,0.0599640086f,0.0337340795f,0.0189725272f,0.0106694745f,
-0.966117799f,0.251952261f,0.426245421f,-0.98905772f,-0.182162598f,-0.284696162f,0.936531842f,0.884186864f,
0.572867453f,0.336340427f,0.191704854f,0.108262435f,0.0609621815f,0.0342960916f,0.0192886982f,0.0108472919f,
-0.739180684f,-0.302812874f,0.686427653f,-0.999557257f,-0.0830891207f,-0.338124752f,0.924979091f,0.892353535f,
0.581035137f,0.341630876f,0.194807529f,0.110030092f,0.0619602874f,0.0348580964f,0.0196048655f,0.0110251084f,
0.167355701f,-0.764320076f,0.878538549f,-0.978531301f,0.0168140903f,-0.390484393f,0.912501454f,0.900238097f,
0.589144766f,0.346910536f,0.197908238f,0.111797392f,0.0629583374f,0.0354200937f,0.0199210308f,0.0112029258f,
};
namespace pg8 {
#define PG8_LAS __attribute__((address_space(3)))
typedef unsigned short bf16_t;
typedef short bf16x8 __attribute__((ext_vector_type(8)));
typedef float f32x4 __attribute__((ext_vector_type(4)));
typedef unsigned u32x4 __attribute__((ext_vector_type(4)));
constexpr int BM = 256, BK = 64, HALF = 128, HTB = HALF * BK * 2  , STAGE_BYTES = 8 * HTB, NXCD = 8, WGM = 8;

__host__ __device__ __forceinline__ int lds_byte(int r, int c) { const int st = (r >> 4) * 2 + (c >> 5), rr = r & 15, cc = c & 31, ob = rr * 64 + cc * 2; return st * 1024 + (ob ^ (((ob >> 9) & 1) << 5)); }
__host__ __device__ __forceinline__ void stage_rc(int b, int& R, int& C) { const int st = b / 1024, sb = b % 1024, swz = sb ^ (((sb >> 9) & 1) << 5); R = (st >> 1) * 16 + swz / 64; C = (st & 1) * 32 + (swz % 64) / 2; }
__host__ __device__ __forceinline__ int perm32(int rho) { const int n = rho >> 4, i = rho & 15; return 8 * (i >> 2) + 4 * n + (i & 3); }

struct Unit { int pm, pn; };
struct Gemm { const bf16_t* A; const bf16_t* Bt; int M, N, K; };

struct StaticOrder {
    int nM, nN, nwg, G, c;
    __host__ __device__ void init(int M, int N, int G_, int c_) { nM = M / BM; nN = N / BM; nwg = nM * nN; G = G_; c = c_; }
    __host__ __device__ bool next(int i, Unit& u) const {
        const long L = (long)i * G + c; if (L >= nwg) return false;
        int wgid = (int)L; { const int q = nwg / NXCD, r = nwg % NXCD, xcd = wgid % NXCD, off = wgid / NXCD; wgid = (xcd < r ? xcd * (q + 1) : r * (q + 1) + (xcd - r) * q) + off; }
        const int nig = WGM * nN, gid = wgid / nig, fm = gid * WGM, gsz = (nM - fm) < WGM ? (nM - fm) : WGM;
        u.pm = fm + ((wgid % nig) % gsz); u.pn = (wgid % nig) / gsz; return true;
    }
    __device__ __forceinline__ void a_ready(const Unit&) const {}
    __device__ __forceinline__ void done(const Unit&) const {}
};
template <class Epi, class Sched, bool ALIGN_EPI = false, bool SP2 = false>
__device__ __forceinline__ void gemm_phase(PG8_LAS unsigned char* lds, const Gemm g, const Sched& S, const Epi& E) {
    int tid = threadIdx.x; asm volatile("" : "+v"(tid)); const int wid = __builtin_amdgcn_readfirstlane(tid >> 6), lane = tid & 63, wr = wid >> 2, wc = wid & 3, fr = lane & 15, fq = lane >> 4;
    const int K = g.K, nt = K / BK;
    unsigned voffA[2], voffB[2];
#pragma unroll
    for (int i = 0; i < 2; ++i) { int R, C; stage_rc(tid * 16 + i * 8192, R, C); const int Rb = (R >> 5) * 64 + (R & 31);
        voffA[i] = (unsigned)(R * K + C) * 2u; voffB[i] = (unsigned)(Rb * K + C) * 2u; }
    const size_t kstep = (size_t)(BK * 2);
    const size_t hstep = (size_t)HALF * K * 2; const size_t bhstep = (size_t)32 * K * 2;
    const size_t tstep = 2 * hstep;
    const unsigned ldsw = (unsigned)wid * 1024u;
    const int aoff = lds_byte(wr * 64 + fr, fq * 8), boff = lds_byte(wc * 32 + fr, fq * 8);
#define PG8_SA(b, h) (((b) * 2 + (h)) * HTB)
#define PG8_SB(b, h) ((4 + (b) * 2 + (h)) * HTB)
#define PG8_STAGE(bufoff, gbase, voff) do { _Pragma("unroll") for (int _i = 0; _i < 2; ++_i) \
        __builtin_amdgcn_global_load_lds((const unsigned*)((const char*)(gbase) + (voff)[_i]), (PG8_LAS unsigned*)(lds + (bufoff) + ldsw + _i * 8192), 16, 0, 0); } while (0)
#define PG8_LDA(dst, b, h) do { _Pragma("unroll") for (int m = 0; m < 4; ++m) _Pragma("unroll") for (int k = 0; k < 2; ++k) dst[m][k] = *(const PG8_LAS bf16x8*)(lds + PG8_SA(b, h) + aoff + m * 2048 + k * 1024); } while (0)
#define PG8_LDB(dst, b, h) do { _Pragma("unroll") for (int n = 0; n < 2; ++n) _Pragma("unroll") for (int k = 0; k < 2; ++k) dst[n][k] = *(const PG8_LAS bf16x8*)(lds + PG8_SB(b, h) + boff + n * 2048 + k * 1024); } while (0)
#define PG8_MMA(ai, bj, At, Bt) do { __builtin_amdgcn_s_setprio(1); _Pragma("unroll") for (int m = 0; m < 4; ++m) _Pragma("unroll") for (int n = 0; n < 2; ++n) _Pragma("unroll") for (int k = 0; k < 2; ++k) \
        acc[ai][bj][m][n] = __builtin_amdgcn_mfma_f32_16x16x32_bf16(Bt[n][k], At[m][k], acc[ai][bj][m][n], 0, 0, 0); __builtin_amdgcn_s_setprio(0); } while (0)
#define PG8_WAIT_V(n) asm volatile("s_waitcnt vmcnt(" #n ")" ::: "memory")
#define PG8_WAIT_L(n) asm volatile("s_waitcnt lgkmcnt(" #n ")" ::: "memory")
#define PG8_BAR __builtin_amdgcn_s_barrier()
#define PG8_SCHED __builtin_amdgcn_sched_barrier(0)
    Unit cur, nxt; int ui = 0;
    if (!S.next(0, cur)) return;
    f32x4 acc[2][2][4][2];
#pragma unroll
    for (int a = 0; a < 2; ++a)
#pragma unroll
        for (int b = 0; b < 2; ++b)
#pragma unroll
            for (int m = 0; m < 4; ++m)
#pragma unroll
                for (int n = 0; n < 2; ++n) acc[a][b][m][n] = (f32x4){0.f, 0.f, 0.f, 0.f};
    bf16x8 At[4][2], B0[2][2], B1[2][2];
    const char* cA = (const char*)g.A + (size_t)cur.pm * tstep; const char* cB = (const char*)g.Bt + (size_t)cur.pn * tstep;
    S.a_ready(cur);
    if constexpr (SP2) {
        PG8_STAGE(PG8_SB(0, 0), cB, voffB); PG8_STAGE(PG8_SB(0, 1), cB + bhstep, voffB); PG8_STAGE(PG8_SA(0, 0), cA, voffA); PG8_STAGE(PG8_SA(0, 1), cA + hstep, voffA);
        if (wr == 1) PG8_BAR;
        PG8_WAIT_V(2); PG8_BAR;
        PG8_STAGE(PG8_SB(1, 0), cB + kstep, voffB); PG8_STAGE(PG8_SA(1, 0), cA + kstep, voffA); PG8_STAGE(PG8_SB(1, 1), cB + bhstep + kstep, voffB);
        PG8_WAIT_V(6); PG8_BAR;
    } else {
        PG8_STAGE(PG8_SB(0, 0), cB, voffB); PG8_STAGE(PG8_SA(0, 0), cA, voffA); PG8_STAGE(PG8_SB(0, 1), cB + bhstep, voffB); PG8_STAGE(PG8_SA(0, 1), cA + hstep, voffA);
        if (wr == 1) PG8_BAR;
        PG8_WAIT_V(4); PG8_BAR;
        PG8_STAGE(PG8_SB(1, 0), cB + kstep, voffB); PG8_STAGE(PG8_SA(1, 0), cA + kstep, voffA); PG8_STAGE(PG8_SB(1, 1), cB + bhstep + kstep, voffB);
        PG8_WAIT_V(6); PG8_BAR;
    }
    for (;;) {
        const bool has_next = S.next(ui + 1, nxt);
        const char* nA = has_next ? (const char*)g.A + (size_t)nxt.pm * tstep : cA; const char* nB = has_next ? (const char*)g.Bt + (size_t)nxt.pn * tstep : cB;
        for (int t = 0; t < nt; t += 2) {
            const bool last = (t == nt - 2);
            const char* a1 = cA + (size_t)(t + 1) * kstep;
            const char* a2 = last ? nA : cA + (size_t)(t + 2) * kstep; const char* b2 = last ? nB : cB + (size_t)(t + 2) * kstep;
            const char* a3 = a2 + kstep; const char* b3 = b2 + kstep;
            if (last && has_next) S.a_ready(nxt);
            if constexpr (SP2) {
            PG8_LDB(B0, 0, 0); PG8_LDB(B1, 0, 1); PG8_SCHED; PG8_LDA(At, 0, 0); PG8_STAGE(PG8_SA(1, 1), a1 + hstep, voffA);
            PG8_WAIT_V(8); PG8_WAIT_L(0); PG8_BAR; PG8_MMA(0, 0, At, B0); PG8_MMA(0, 1, At, B1); PG8_BAR; PG8_SCHED;
            PG8_LDA(At, 0, 1); PG8_STAGE(PG8_SB(0, 0), b2, voffB); PG8_STAGE(PG8_SB(0, 1), b2 + bhstep, voffB); PG8_STAGE(PG8_SA(0, 0), a2, voffA);
            PG8_WAIT_V(8); PG8_WAIT_L(0); PG8_BAR; PG8_MMA(1, 0, At, B0); PG8_MMA(1, 1, At, B1); PG8_BAR; PG8_SCHED;
            PG8_LDB(B0, 1, 0); PG8_LDB(B1, 1, 1); PG8_SCHED; PG8_LDA(At, 1, 0); PG8_STAGE(PG8_SA(0, 1), a2 + hstep, voffA);
            PG8_WAIT_V(8); PG8_WAIT_L(0); PG8_BAR; PG8_MMA(0, 0, At, B0); PG8_MMA(0, 1, At, B1); PG8_BAR; PG8_SCHED;
            PG8_LDA(At, 1, 1); PG8_STAGE(PG8_SB(1, 0), b3, voffB); PG8_STAGE(PG8_SB(1, 1), b3 + bhstep, voffB); PG8_STAGE(PG8_SA(1, 0), a3, voffA);
            PG8_WAIT_V(8); PG8_WAIT_L(0); PG8_BAR; PG8_MMA(1, 0, At, B0); PG8_MMA(1, 1, At, B1); PG8_BAR; PG8_SCHED;
            } else {
            PG8_LDB(B0, 0, 0); PG8_SCHED; PG8_LDA(At, 0, 0); PG8_STAGE(PG8_SA(1, 1), a1 + hstep, voffA);
            PG8_WAIT_L(8); PG8_BAR; PG8_WAIT_L(0); PG8_MMA(0, 0, At, B0); PG8_BAR; PG8_SCHED;
            PG8_LDB(B1, 0, 1); PG8_STAGE(PG8_SB(0, 0), b2, voffB);
            PG8_BAR; PG8_WAIT_L(0); PG8_MMA(0, 1, At, B1); PG8_BAR;
            PG8_LDA(At, 0, 1); PG8_STAGE(PG8_SA(0, 0), a2, voffA);
            PG8_BAR; PG8_WAIT_L(0); PG8_MMA(1, 0, At, B0); PG8_BAR; PG8_SCHED;
            PG8_STAGE(PG8_SB(0, 1), b2 + bhstep, voffB);
            PG8_WAIT_V(6); PG8_BAR; PG8_MMA(1, 1, At, B1); PG8_BAR;
            PG8_LDB(B0, 1, 0); PG8_SCHED; PG8_LDA(At, 1, 0); PG8_STAGE(PG8_SA(0, 1), a2 + hstep, voffA);
            PG8_WAIT_L(8); PG8_BAR; PG8_WAIT_L(0); PG8_MMA(0, 0, At, B0); PG8_BAR; PG8_SCHED;
            PG8_LDB(B1, 1, 1); PG8_STAGE(PG8_SB(1, 0), b3, voffB);
            PG8_BAR; PG8_WAIT_L(0); PG8_MMA(0, 1, At, B1); PG8_BAR;
            PG8_LDA(At, 1, 1); PG8_STAGE(PG8_SA(1, 0), a3, voffA);
            PG8_BAR; PG8_WAIT_L(0); PG8_MMA(1, 0, At, B0); PG8_BAR; PG8_SCHED;
            PG8_STAGE(PG8_SB(1, 1), b3 + bhstep, voffB);
            PG8_WAIT_V(6); PG8_BAR; PG8_MMA(1, 1, At, B1); PG8_BAR;
            }
        }
        if constexpr (ALIGN_EPI) { if (wr == 0) PG8_BAR; }
        if constexpr (!Epi::AFTER_DRAIN) { E(acc, cur, wr, wc, fr, fq); S.done(cur); }
        if (!has_next) break;
#pragma unroll
        for (int a = 0; a < 2; ++a)
#pragma unroll
            for (int b = 0; b < 2; ++b)
#pragma unroll
                for (int m = 0; m < 4; ++m)
#pragma unroll
                    for (int n = 0; n < 2; ++n) acc[a][b][m][n] = (f32x4){0.f, 0.f, 0.f, 0.f};
        cur = nxt; cA = nA; cB = nB; ++ui;
        if constexpr (ALIGN_EPI) { if (wr == 1) PG8_BAR; }
    }
    PG8_WAIT_V(0);
    if constexpr (!ALIGN_EPI) { if (wr == 0) PG8_BAR; }
    PG8_BAR;
    if constexpr (Epi::AFTER_DRAIN) { E.fused(acc, cur, wr, wc, fr, fq, lds, wid, lane); S.done(cur); }
#undef PG8_SA
#undef PG8_SB
#undef PG8_STAGE
#undef PG8_LDA
#undef PG8_LDB
#undef PG8_MMA
#undef PG8_WAIT_V
#undef PG8_WAIT_L
#undef PG8_BAR
#undef PG8_SCHED
}
}

#ifndef PG8_SP2
#define PG8_SP2 true
#endif
#ifndef PG8_ALIGN
#define PG8_ALIGN true
#endif
#ifndef PROBE_DUP
#define PROBE_DUP 0
#endif

constexpr int TP = 8192;
constexpr int TS = 32768;
constexpr int TT = TP + TS;
constexpr int DM = 1024;
constexpr int NIN = 3072;
constexpr int NLAYER = 4;
constexpr float ALPHA = 1.6817928305074292f;
constexpr float LOG2E = 1.4426950408889634f;
constexpr float C1 = 0.125f * LOG2E;
constexpr size_t OUT_NK = (size_t)TT * DM;
constexpr size_t OUT_NV = OUT_NK + (size_t)32 * 4 * 256 * 256;
constexpr size_t OUT_GK = OUT_NV + (size_t)32 * 4 * 256 * 256;
constexpr size_t OUT_GV = OUT_GK + (size_t)32 * 4 * 256 * 128;

struct Params {
  const float *x_prompt, *x_sample, *c, *cnk, *cnv, *cgk, *cgv, *c_ctx, *w_mod, *b_mod, *w_in, *b_in, *pool_w, *pool_scale,
      *nat_bias, *q_norm, *k_norm, *conv_w, *conv_b, *conv_ln_g, *conv_ln_b, *conv_pw, *w_out, *b_out, *ln_g, *ln_b;
  float* out;
  char* ws;
  int ph0, ph1;
};
constexpr size_t WS_WINT = 0;
constexpr size_t WS_WOUTT = WS_WINT + (size_t)4 * 3072 * 1024 * 2;
constexpr size_t WS_PWT = WS_WOUTT + (size_t)4 * 1024 * 1024 * 2;
constexpr size_t WS_POOLT = WS_PWT + (size_t)4 * 256 * 256 * 2;
constexpr size_t WS_CNK = WS_POOLT + (size_t)16 * 4096 * 2;
constexpr size_t WS_CNV = WS_CNK + (size_t)4194304 * 2;
constexpr size_t WS_CGK = WS_CNV + (size_t)4194304 * 2;
constexpr size_t WS_CGV = WS_CGK + (size_t)2097152 * 2;
constexpr size_t WS_U = WS_CGV + (size_t)2097152 * 2;
constexpr size_t WS_H = WS_U + (size_t)TT * NIN * 2;
constexpr size_t WS_MX = WS_H + (size_t)TT * DM * 2;
constexpr size_t WS_MOD = WS_MX + (size_t)TT * DM * 2;
constexpr size_t WS_STATS = WS_MOD + (size_t)4 * 9 * 3072 * 4;
constexpr size_t WS_CNT = WS_STATS + (size_t)TT * 2 * 4;
#define P_WinT ((bf16_t*)(p.ws + WS_WINT))
#define P_WoutT ((bf16_t*)(p.ws + WS_WOUTT))
#define P_pwT ((bf16_t*)(p.ws + WS_PWT))
#define P_poolT ((bf16_t*)(p.ws + WS_POOLT))
#define P_cnk_b ((bf16_t*)(p.ws + WS_CNK))
#define P_cnv_b ((bf16_t*)(p.ws + WS_CNV))
#define P_cgk_b ((bf16_t*)(p.ws + WS_CGK))
#define P_cgv_b ((bf16_t*)(p.ws + WS_CGV))
#define P_U ((bf16_t*)(p.ws + WS_U))
#define P_H ((bf16_t*)(p.ws + WS_H))
#define P_MX ((bf16_t*)(p.ws + WS_MX))
#define P_mod ((float*)(p.ws + WS_MOD))
#define P_stats ((float*)(p.ws + WS_STATS))
#define P_cnt ((unsigned*)(p.ws + WS_CNT))

DEV float bf2f(bf16_t h) { return __uint_as_float(((unsigned)h) << 16); }
DEV unsigned pk2(float lo, float hi) { f32x2 v = {lo, hi}; bf16x2_t b = __builtin_convertvector(v, bf16x2_t); return __builtin_bit_cast(unsigned, b); }
DEV bf16_t f2bf(float f) { return (bf16_t)(pk2(f, 0.f) & 0xffffu); }
DEV float bflo(unsigned w) { return __uint_as_float(w << 16); }
DEV float bfhi(unsigned w) { return __uint_as_float(w & 0xffff0000u); }
DEV float silu_f(float x) { return x / (1.f + __expf(-x)); }
DEV float sigm_f(float x) { return 1.f / (1.f + __expf(-x)); }
DEV f32x4 mfma16(bf16x8 a, bf16x8 b, f32x4 c) { return __builtin_amdgcn_mfma_f32_16x16x32_bf16(a, b, c, 0, 0, 0); }
typedef short v4i16_t __attribute__((ext_vector_type(4)));
DEV s16x4 tr16(const char* p) {
  return __builtin_bit_cast(s16x4, __builtin_amdgcn_ds_read_tr16_b64_v4i16((__attribute__((address_space(3))) v4i16_t*)p));
}
DEV float wave_sum(float v) {
  v += __shfl_xor(v, 1); v += __shfl_xor(v, 2); v += __shfl_xor(v, 4); v += __shfl_xor(v, 8); v += __shfl_xor(v, 16); v += __shfl_xor(v, 32);
  return v;
}
DEV int get_tid() { int t = threadIdx.x & 255; asm volatile("" : "+v"(t)); return t; }
DEV int get_half() { return __builtin_amdgcn_readfirstlane((int)(threadIdx.x >> 8)); }
DEV int cond_of_row(int row) { return row < TP ? 0 : 1 + ((row - TP) >> 12); }

DEV void tconv_tile(const float* src, int sld, bf16_t* dst, int dld, char* smem) {
  float* t = (float*)smem;
  const int tid = get_tid();
#pragma unroll
  for (int i = 0; i < 16; ++i) { int idx = tid + i * 256; int r = idx >> 6, c = idx & 63; t[r * 65 + c] = src[(size_t)r * sld + c]; }
  __syncthreads();
#pragma unroll
  for (int i = 0; i < 16; ++i) { int idx = tid + i * 256; int n = idx >> 6, k = idx & 63; dst[(size_t)n * dld + k] = f2bf(t[k * 65 + n]); }
  __syncthreads();
}

DEV void cvt_unit(const float* src, bf16_t* dst, int u) {
  const size_t base = (size_t)u * 16384;
  const int tid = get_tid();
#pragma unroll
  for (int i = 0; i < 16; ++i) {
    size_t e = base + (size_t)(i * 256 + tid) * 4;
    f32x4 v = *(const f32x4*)(src + e);
    u32x2 w; w.x = pk2(v[0], v[1]); w.y = pk2(v[2], v[3]);
    *(u32x2*)(dst + e) = w;
  }
}

DEV void mod_unit(const Params& p, int u, char* smem) {
  const int l = u / 48, n0 = (u % 48) * 64, tid = get_tid();
  float* sc = (float*)smem;
  float* red = (float*)(smem + 36864);
  for (int i = tid; i < 9216; i += 256) { int c = i >> 10, k = i & 1023; float v = (c == 0) ? p.c_ctx[k] : p.c[(c - 1) * 1024 + k]; sc[i] = silu_f(v); }
  __syncthreads();
  const int kq = tid >> 6, col = n0 + (tid & 63);
  float acc[9];
#pragma unroll
  for (int c = 0; c < 9; ++c) acc[c] = 0.f;
  const float* wp = p.w_mod + ((size_t)l * 1024 + kq * 256) * 3072 + col;
#pragma unroll 8
  for (int k = 0; k < 256; ++k) {
    float w = wp[(size_t)k * 3072];
#pragma unroll
    for (int c = 0; c < 9; ++c) acc[c] += sc[c * 1024 + kq * 256 + k] * w;
  }
#pragma unroll
  for (int c = 0; c < 9; ++c) red[(kq * 9 + c) * 64 + (tid & 63)] = acc[c];
  __syncthreads();
  for (int i = tid; i < 576; i += 256) {
    int c = i >> 6, j = i & 63;
    float s = red[(0 * 9 + c) * 64 + j] + red[(1 * 9 + c) * 64 + j] + red[(2 * 9 + c) * 64 + j] + red[(3 * 9 + c) * 64 + j];
    P_mod[((size_t)l * 9 + c) * 3072 + n0 + j] = s + p.b_mod[l * 3072 + n0 + j];
  }
  __syncthreads();
}

DEV void h0_unit(const Params& p, int u) {
  const int tid = get_tid(), col = tid * 4;
  const int row0 = u * 32;
  const int cond = cond_of_row(row0);
  const float* md = P_mod + (size_t)cond * 3072;
  const f32x4 sh = *(const f32x4*)(md + col), sc = *(const f32x4*)(md + 1024 + col);
#pragma unroll 4
  for (int i = 0; i < 32; ++i) {
    const int row = row0 + i;
    const float* xr = (row < TP) ? p.x_prompt + (size_t)row * DM : p.x_sample + (size_t)(row - TP) * DM;
    f32x4 x = *(const f32x4*)(xr + col);
    u32x2 w; w.x = pk2(x[0] * (1.f + sc[0]) + sh[0], x[1] * (1.f + sc[1]) + sh[1]); w.y = pk2(x[2] * (1.f + sc[2]) + sh[2], x[3] * (1.f + sc[3]) + sh[3]);
    *(u32x2*)(P_H + (size_t)row * DM + col) = w;
  }
}

struct EpiA {
  static constexpr bool PERM = false, AFTER_DRAIN = false;
  const Params& p; int l;
  DEV void operator()(f32x4 (&acc)[2][2][4][2], const pg8::Unit& u, int wr, int wc, int fr, int fq) const {
    const int colb = u.pn * 256 + wc * 64;
    const int reg = colb >> 6;
    const bool prompt = (u.pm * 256) < TP;
    f32x4 bias[2][2];
#pragma unroll
    for (int bj = 0; bj < 2; ++bj)
#pragma unroll
      for (int n = 0; n < 2; ++n) bias[bj][n] = *(const f32x4*)(p.b_in + l * 3072 + colb + bj * 32 + n * 16 + 4 * fq);
    const bool rms = (reg >= 36 && reg < 42);
    f32x4 gg[2][2];
    if (rms) {
      const float* gptr = (reg < 40 ? p.q_norm : p.k_norm) + l * 64;
#pragma unroll
      for (int bj = 0; bj < 2; ++bj)
#pragma unroll
        for (int n = 0; n < 2; ++n) gg[bj][n] = *(const f32x4*)(gptr + bj * 32 + n * 16 + 4 * fq);
    }
    float* ob = nullptr; int hw = 0, cofs = 0;
    if (prompt) {
      if (reg >= 12 && reg < 16) { ob = p.out + OUT_NK; hw = 256; cofs = colb - 768; }
      else if (reg >= 16 && reg < 20) { ob = p.out + OUT_NV; hw = 256; cofs = colb - 1024; }
      else if (reg >= 40 && reg < 42) { ob = p.out + OUT_GK; hw = 128; cofs = colb - 2560; }
      else if (reg >= 42 && reg < 44) { ob = p.out + OUT_GV; hw = 128; cofs = colb - 2688; }
    }
#pragma unroll
    for (int ai = 0; ai < 2; ++ai)
#pragma unroll
      for (int m = 0; m < 4; ++m) {
        const int row = u.pm * 256 + ai * 128 + wr * 64 + m * 16 + fr;
        f32x4 v[2][2];
#pragma unroll
        for (int bj = 0; bj < 2; ++bj)
#pragma unroll
          for (int n = 0; n < 2; ++n) v[bj][n] = acc[ai][bj][m][n] + bias[bj][n];
        if (rms) {
          float ss = 0.f;
#pragma unroll
          for (int bj = 0; bj < 2; ++bj)
#pragma unroll
            for (int n = 0; n < 2; ++n)
#pragma unroll
              for (int j = 0; j < 4; ++j) ss += v[bj][n][j] * v[bj][n][j];
          ss += __shfl_xor(ss, 16); ss += __shfl_xor(ss, 32);
          const float r = rsqrtf(ss * (1.f / 64.f) + 1e-6f);
#pragma unroll
          for (int bj = 0; bj < 2; ++bj)
#pragma unroll
            for (int n = 0; n < 2; ++n) v[bj][n] = v[bj][n] * r * gg[bj][n];
          if (!prompt) {
            const int t = (row - TP) & 4095, pr = t >> 6, pc = t & 63;
            const f32x4 c0 = *(const f32x4*)(ROPE_COS + pr * 16 + 4 * fq), s0 = *(const f32x4*)(ROPE_SIN + pr * 16 + 4 * fq);
            const f32x4 c1 = *(const f32x4*)(ROPE_COS + pc * 16 + 4 * fq), s1 = *(const f32x4*)(ROPE_SIN + pc * 16 + 4 * fq);
            const f32x4 x1 = v[0][0], x2 = v[0][1], y1 = v[1][0], y2 = v[1][1];
            v[0][0] = x1 * c0 - x2 * s0; v[0][1] = x2 * c0 + x1 * s0;
            v[1][0] = y1 * c1 - y2 * s1; v[1][1] = y2 * c1 + y1 * s1;
          }
        }
        bf16_t* up = P_U + (size_t)row * NIN + colb + 4 * fq;
#pragma unroll
        for (int bj = 0; bj < 2; ++bj)
#pragma unroll
          for (int n = 0; n < 2; ++n) { u32x2 w; w.x = pk2(v[bj][n][0], v[bj][n][1]); w.y = pk2(v[bj][n][2], v[bj][n][3]); *(u32x2*)(up + bj * 32 + n * 16) = w; }
        if (ob) {
          const int b = row >> 8, sq = row & 255;
          float* op = ob + ((size_t)(b * 4 + l) * 256 + sq) * hw + cofs + 4 * fq;
#pragma unroll
          for (int bj = 0; bj < 2; ++bj)
#pragma unroll
            for (int n = 0; n < 2; ++n) *(f32x4*)(op + bj * 32 + n * 16) = v[bj][n];
        }
      }
  }
};

struct EpiC {
  static constexpr bool PERM = false, AFTER_DRAIN = false;
  const Params& p; int l;
  DEV void operator()(f32x4 (&acc)[2][2][4][2], const pg8::Unit& u, int wr, int wc, int fr, int fq) const {
    const int colb = u.pn * 256 + wc * 64 + 4 * fq;
    const int cond = cond_of_row(u.pm * 256);
    const float* gatep = P_mod + ((size_t)l * 9 + cond) * 3072 + 2048;
    float* Y = p.out;
#pragma unroll
    for (int ai = 0; ai < 2; ++ai)
#pragma unroll
      for (int m = 0; m < 4; ++m) {
        const int row = u.pm * 256 + ai * 128 + wr * 64 + m * 16 + fr;
        float mean = 0.f, rstd = 1.f;
        const float* xr;
        if (l == 0) xr = (row < TP) ? p.x_prompt + (size_t)row * DM : p.x_sample + (size_t)(row - TP) * DM;
        else { xr = Y + (size_t)row * DM; mean = P_stats[row * 2]; rstd = P_stats[row * 2 + 1]; }
#pragma unroll
        for (int bj = 0; bj < 2; ++bj)
#pragma unroll
          for (int n = 0; n < 2; ++n) {
            const int col = colb + bj * 32 + n * 16;
            f32x4 xo = *(const f32x4*)(xr + col);
            if (l > 0) {
              const f32x4 g = *(const f32x4*)(p.ln_g + (l - 1) * 1024 + col), b = *(const f32x4*)(p.ln_b + (l - 1) * 1024 + col);
              xo = (xo - mean) * rstd * g + b;
            }
            const f32x4 gt = *(const f32x4*)(gatep + col), bo = *(const f32x4*)(p.b_out + l * 1024 + col);
            f32x4 y = xo * ALPHA + gt * (acc[ai][bj][m][n] + bo);
            *(f32x4*)(Y + (size_t)row * DM + col) = y;
          }
      }
  }
};

DEV void ln_unit(const Params& p, int l, int u) {
  const int tid = get_tid(), lane = tid & 63, wid = tid >> 6;
  float* Y = p.out;
  {
    const int row = u * 4 + wid;
    float* yr = Y + (size_t)row * DM;
    f32x4 v[4];
#pragma unroll
    for (int q = 0; q < 4; ++q) v[q] = *(const f32x4*)(yr + q * 256 + lane * 4);
    float s = 0.f;
#pragma unroll
    for (int q = 0; q < 4; ++q) s += (v[q][0] + v[q][1]) + (v[q][2] + v[q][3]);
    const float mean = wave_sum(s) * (1.f / 1024.f);
    float s2 = 0.f;
#pragma unroll
    for (int q = 0; q < 4; ++q) { v[q] = v[q] - mean; s2 += (v[q][0] * v[q][0] + v[q][1] * v[q][1]) + (v[q][2] * v[q][2] + v[q][3] * v[q][3]); }
    const float rstd = rsqrtf(wave_sum(s2) * (1.f / 1024.f) + 1e-5f);
    const int cond = cond_of_row(row);
#pragma unroll
    for (int q = 0; q < 4; ++q) {
      const int col = q * 256 + lane * 4;
      const f32x4 g = *(const f32x4*)(p.ln_g + l * 1024 + col), b = *(const f32x4*)(p.ln_b + l * 1024 + col);
      f32x4 x = v[q] * rstd * g + b;
      if (l < NLAYER - 1) {
        const float* md = P_mod + ((size_t)(l + 1) * 9 + cond) * 3072;
        const f32x4 sh = *(const f32x4*)(md + col), sc = *(const f32x4*)(md + 1024 + col);
        f32x4 h = x * (sc + 1.f) + sh;
        u32x2 w; w.x = pk2(h[0], h[1]); w.y = pk2(h[2], h[3]);
        *(u32x2*)(P_H + (size_t)row * DM + col) = w;
      } else {
        *(f32x4*)(yr + col) = x;
      }
    }
    if (l < NLAYER - 1 && lane == 0) { P_stats[row * 2] = mean; P_stats[row * 2 + 1] = rstd; }
  }
}

template <int NQ, int NKT, bool NATL>
DEV void attn_tile(const char* ks, const char* vs, int koff, const bf16x8 (&qf)[NQ][2], f32x4 (&o)[NQ][4], float (&mrun)[NQ], float (&lrun)[NQ],
                   int fr, int fq, const float* biasrow, int qc) {
  f32x4 s[NQ][NKT];
#pragma unroll
  for (int t = 0; t < NKT; ++t) {
    const char* kp = ks + (koff + 16 * t + fr) * 144 + fq * 16;
    const bf16x8 k0 = *(const bf16x8*)kp, k1 = *(const bf16x8*)(kp + 64);
#pragma unroll
    for (int g = 0; g < NQ; ++g) { f32x4 z = {0.f, 0.f, 0.f, 0.f}; z = mfma16(k0, qf[g][0], z); z = mfma16(k1, qf[g][1], z); s[g][t] = z; }
  }
#pragma unroll
  for (int g = 0; g < NQ; ++g) {
    float mx = -1e30f;
#pragma unroll
    for (int t = 0; t < NKT; ++t)
#pragma unroll
      for (int j = 0; j < 4; ++j) {
        float x = s[g][t][j] * C1;
        if (NATL) {
          const int kc = koff + 16 * t + 4 * fq + j;
          const int cs = min(max(qc - 8, 0), 48);
          const bool valid = (kc >= cs) && (kc < cs + 16);
          const int dc = min(max(kc - qc + 15, 0), 30);
          x = valid ? x + biasrow[dc] : -1e30f;
        }
        s[g][t][j] = x; mx = fmaxf(mx, x);
      }
    mx = fmaxf(mx, __shfl_xor(mx, 16)); mx = fmaxf(mx, __shfl_xor(mx, 32));
    const float mn = fmaxf(mrun[g], mx);
    const float al = __builtin_amdgcn_exp2f(mrun[g] - mn);
    mrun[g] = mn;
    float ps = 0.f;
#pragma unroll
    for (int t = 0; t < NKT; ++t)
#pragma unroll
      for (int j = 0; j < 4; ++j) { const float pp = __builtin_amdgcn_exp2f(s[g][t][j] - mn); s[g][t][j] = pp; ps += pp; }
    lrun[g] = lrun[g] * al + ps;
#pragma unroll
    for (int dt = 0; dt < 4; ++dt) o[g][dt] = o[g][dt] * al;
  }
#pragma unroll
  for (int u = 0; u < NKT / 2; ++u) {
    bf16x8 pf[NQ];
#pragma unroll
    for (int g = 0; g < NQ; ++g) {
      u32x4 w;
      w.x = pk2(s[g][2 * u][0], s[g][2 * u][1]); w.y = pk2(s[g][2 * u][2], s[g][2 * u][3]);
      w.z = pk2(s[g][2 * u + 1][0], s[g][2 * u + 1][1]); w.w = pk2(s[g][2 * u + 1][2], s[g][2 * u + 1][3]);
      pf[g] = __builtin_bit_cast(bf16x8, w);
    }
#pragma unroll
    for (int dt = 0; dt < 4; ++dt) {
      const char* vp = vs + (koff + 32 * u + 4 * fq + (fr >> 2)) * 160 + dt * 32 + (fr & 3) * 8;
      const s16x4 lo = tr16(vp), hi = tr16(vp + 16 * 160);
      const bf16x8 vf = {lo[0], lo[1], lo[2], lo[3], hi[0], hi[1], hi[2], hi[3]};
#pragma unroll
      for (int g = 0; g < NQ; ++g) o[g][dt] = mfma16(vf, pf[g], o[g][dt]);
    }
  }
}

template <int MODE>
DEV void attn_unit(const Params& p, int l, int u, char* smem) {
  constexpr int NQ = (MODE == 1) ? 1 : 2;
  const int tid = get_tid(), lane = tid & 63, wid = tid >> 6, fr = lane & 15, fq = lane >> 4;
  int qrow0, qcol, gcol, ocol, NT, NLOC, cstride = 0;
  const bf16_t *kU, *vU, *kC = nullptr, *vC = nullptr;
  int nat_r = 0, nat_rs = 0;
  if (MODE == 0) {
    const int qb = u & 31, g = (u >> 5) & 1, kvh = (u >> 6) & 1, b = u >> 7, h = kvh * 2 + g;
    qrow0 = TP + b * 4096 + qb * 128 + wid * 32; qcol = 2304 + h * 64; gcol = 2816 + h * 64; ocol = 768 + h * 64;
    kU = P_U + (size_t)(TP + b * 4096) * NIN + 2560 + kvh * 64; vU = kU + 128; NLOC = 64; NT = 72;
    kC = P_cgk_b + ((size_t)(b * 4 + l) * 512 * 2 + kvh) * 64; vC = P_cgv_b + ((size_t)(b * 4 + l) * 512 * 2 + kvh) * 64; cstride = 128;
  } else if (MODE == 1) {
    const int r = u & 63, h = (u >> 6) & 3, b = u >> 8;
    nat_r = r; nat_rs = min(max(r - 4, 0), 56);
    qrow0 = TP + b * 4096 + r * 64 + wid * 16; qcol = 512 + h * 64; gcol = 1280 + h * 64; ocol = 256 + h * 64;
    kU = P_U + (size_t)(TP + b * 4096 + nat_rs * 64) * NIN + 768 + h * 64; vU = kU + 256; NLOC = 8; NT = 16;
    kC = P_cnk_b + ((size_t)(b * 4 + l) * 512 * 4 + h) * 64; vC = P_cnv_b + ((size_t)(b * 4 + l) * 512 * 4 + h) * 64; cstride = 256;
    float* bl = (float*)(smem + 38912);
    for (int i = tid; i < 465; i += 256) bl[i] = p.nat_bias[(size_t)(l * 4 + h) * 465 + i] * LOG2E;
  } else {
    const int qb = u & 1, hh = (u >> 1) & 7, b = u >> 4;
    qrow0 = b * 256 + qb * 128 + wid * 32; NLOC = 4; NT = 4;
    int kcol;
    if (hh < 4) { qcol = 512 + hh * 64; kcol = 768 + hh * 64; gcol = 1280 + hh * 64; ocol = 256 + hh * 64; kU = P_U + (size_t)(b * 256) * NIN + kcol; vU = kU + 256; }
    else { const int h = hh - 4; qcol = 2304 + h * 64; kcol = 2560 + (h >> 1) * 64; gcol = 2816 + h * 64; ocol = 768 + h * 64; kU = P_U + (size_t)(b * 256) * NIN + kcol; vU = kU + 128; }
  }
  bf16x8 qf[NQ][2];
#pragma unroll
  for (int g = 0; g < NQ; ++g)
#pragma unroll
    for (int ks = 0; ks < 2; ++ks) qf[g][ks] = *(const bf16x8*)(P_U + (size_t)(qrow0 + g * 16 + fr) * NIN + qcol + ks * 32 + fq * 8);
  f32x4 o[NQ][4]; float mrun[NQ], lrun[NQ];
#pragma unroll
  for (int g = 0; g < NQ; ++g) { mrun[g] = -1e30f; lrun[g] = 0.f;
#pragma unroll
    for (int dt = 0; dt < 4; ++dt) o[g][dt] = (f32x4){0.f, 0.f, 0.f, 0.f}; }
  u32x4 rk[2], rv[2];
  const int lrow = tid >> 3, lc = tid & 7;
  auto gl = [&](int t) {
    const bf16_t *kp, *vp; int st;
    if (t < NLOC) { kp = kU + (size_t)t * 64 * NIN; vp = vU + (size_t)t * 64 * NIN; st = NIN; }
    else { kp = kC + (size_t)(t - NLOC) * 64 * cstride; vp = vC + (size_t)(t - NLOC) * 64 * cstride; st = cstride; }
#pragma unroll
    for (int i = 0; i < 2; ++i) { const size_t off = (size_t)(lrow + i * 32) * st + lc * 8; rk[i] = *(const u32x4*)(kp + off); rv[i] = *(const u32x4*)(vp + off); }
  };
  auto stl = [&](int buf) {
#pragma unroll
    for (int i = 0; i < 2; ++i) {
      *(u32x4*)(smem + buf * 9216 + (lrow + i * 32) * 144 + lc * 16) = rk[i];
      *(u32x4*)(smem + 18432 + buf * 10240 + (lrow + i * 32) * 160 + lc * 16) = rv[i];
    }
  };
  gl(0); stl(0);
  __syncthreads();
  const float* bl = (const float*)(smem + 38912);
#pragma unroll 1
  for (int t = 0; t < NT; ++t) {
    if (t + 1 < NT) gl(t + 1);
    const char* ks = smem + (t & 1) * 9216; const char* vs = smem + 18432 + (t & 1) * 10240;
    if constexpr (MODE == 1) {
      if (t < 8) {
        const int kcw = (wid == 0) ? 0 : (wid == 1) ? 8 : (wid == 2) ? 24 : 32;
        attn_tile<1, 2, true>(ks, vs, kcw, qf, o, mrun, lrun, fr, fq, bl + (nat_rs + t - nat_r + 7) * 31, wid * 16 + fr);
      } else {
        attn_tile<1, 4, false>(ks, vs, 0, qf, o, mrun, lrun, fr, fq, nullptr, 0);
      }
    } else {
      attn_tile<NQ, 4, false>(ks, vs, 0, qf, o, mrun, lrun, fr, fq, nullptr, 0);
    }
    if (t + 1 < NT) stl((t + 1) & 1);
    __syncthreads();
  }
#pragma unroll
  for (int g = 0; g < NQ; ++g) {
    float lt = lrun[g]; lt += __shfl_xor(lt, 16); lt += __shfl_xor(lt, 32);
    const float inv = 1.f / lt;
    const int row = qrow0 + g * 16 + fr;
#pragma unroll
    for (int dt = 0; dt < 4; ++dt) {
      const int d0 = dt * 16 + 4 * fq;
      const u32x2 gw = *(const u32x2*)(P_U + (size_t)row * NIN + gcol + d0);
      u32x2 w;
      w.x = pk2(o[g][dt][0] * inv * silu_f(bflo(gw.x)), o[g][dt][1] * inv * silu_f(bfhi(gw.x)));
      w.y = pk2(o[g][dt][2] * inv * silu_f(bflo(gw.y)), o[g][dt][3] * inv * silu_f(bfhi(gw.y)));
      *(u32x2*)(P_MX + (size_t)row * DM + ocol + d0) = w;
    }
  }
}

DEV void pool_unit(const Params& p, int l, int u, char* smem) {
  const int tid = get_tid(), lane = tid & 63, wid = tid >> 6, fr = lane & 15, fq = lane >> 4;
  const int R0 = u * 32;
  int L, sb;
  if (R0 < TP) { L = 256; sb = R0 & ~255; } else { L = 4096; sb = TP + ((R0 - TP) & ~4095); }
  const int t0 = R0 - sb;
  bf16_t* ya = (bf16_t*)smem;
  {
    const int c = tid, g = c >> 6, win = 2 << g, half = win >> 1;
    const bf16_t* xc = P_U + (size_t)sb * NIN + c;
    float sum = 0.f;
    for (int i = t0 - half; i < t0 - half + win; ++i) if (i >= 0 && i < L) sum += bf2f(xc[(size_t)i * NIN]);
    for (int tt = 0; tt < 32; ++tt) {
      const int t = t0 + tt;
      const int lo = max(t - half, 0), hi = min(t - half + win, L);
      const float y = sum / (float)(hi - lo) - bf2f(xc[(size_t)t * NIN]);
      ya[tt * 264 + c] = f2bf(y);
      const int ia = t - half + win; if (ia < L) sum += bf2f(xc[(size_t)ia * NIN]);
      const int ir = t - half; if (ir >= 0) sum -= bf2f(xc[(size_t)ir * NIN]);
    }
  }
  __syncthreads();
  const int g = wid;
  f32x4 acc[2][4];
#pragma unroll
  for (int m = 0; m < 2; ++m)
#pragma unroll
    for (int n = 0; n < 4; ++n) acc[m][n] = (f32x4){0.f, 0.f, 0.f, 0.f};
  const bf16_t* wt = P_poolT + (size_t)(l * 4 + g) * 4096;
#pragma unroll
  for (int ks = 0; ks < 2; ++ks) {
    bf16x8 af[2], bfr[4];
#pragma unroll
    for (int m = 0; m < 2; ++m) af[m] = *(const bf16x8*)(smem + (m * 16 + fr) * 528 + (g * 64 + ks * 32 + fq * 8) * 2);
#pragma unroll
    for (int n = 0; n < 4; ++n) bfr[n] = *(const bf16x8*)(wt + (n * 16 + fr) * 64 + ks * 32 + fq * 8);
#pragma unroll
    for (int m = 0; m < 2; ++m)
#pragma unroll
      for (int n = 0; n < 4; ++n) acc[m][n] = mfma16(bfr[n], af[m], acc[m][n]);
  }
#pragma unroll
  for (int m = 0; m < 2; ++m) {
    const int row = R0 + m * 16 + fr;
#pragma unroll
    for (int n = 0; n < 4; ++n) {
      const int ch = g * 64 + n * 16 + 4 * fq;
      const f32x4 sc = *(const f32x4*)(p.pool_scale + l * 256 + ch);
      const u32x2 gw = *(const u32x2*)(P_U + (size_t)row * NIN + 256 + ch);
      u32x2 w;
      w.x = pk2(acc[m][n][0] * sc[0] * silu_f(bflo(gw.x)), acc[m][n][1] * sc[1] * silu_f(bfhi(gw.x)));
      w.y = pk2(acc[m][n][2] * sc[2] * silu_f(bflo(gw.y)), acc[m][n][3] * sc[3] * silu_f(bfhi(gw.y)));
      *(u32x2*)(P_MX + (size_t)row * DM + ch) = w;
    }
  }
  __syncthreads();
}

DEV void conv_unit(const Params& p, int l, int u, char* smem) {
  const int tid = get_tid(), lane = tid & 63, wid = tid >> 6, fr = lane & 15, fq = lane >> 4;
  const int R0 = u * 32;
  int L, sb;
  if (R0 < TP) { L = 256; sb = R0 & ~255; } else { L = 4096; sb = TP + ((R0 - TP) & ~4095); }
  const int t0 = R0 - sb;
  bf16_t* zs = (bf16_t*)smem;
  bf16_t* za = (bf16_t*)(smem + 31744);
  float* red = (float*)(smem + 48640);
  for (int idx = tid; idx < 62 * 64; idx += 256) {
    const int i = idx >> 6, cq = (idx & 63) * 4, t = t0 - 15 + i;
    u32x2 w = {0u, 0u};
    if (t >= 0 && t < L) {
      const bf16_t* ur = P_U + (size_t)(sb + t) * NIN;
      const u32x2 vv = *(const u32x2*)(ur + 1536 + cq), gg = *(const u32x2*)(ur + 1792 + cq);
      w.x = pk2(bflo(vv.x) * sigm_f(bflo(gg.x)), bfhi(vv.x) * sigm_f(bfhi(gg.x)));
      w.y = pk2(bflo(vv.y) * sigm_f(bflo(gg.y)), bfhi(vv.y) * sigm_f(bfhi(gg.y)));
    }
    *(u32x2*)(zs + i * 256 + cq) = w;
  }
  __syncthreads();
  const int c = tid;
  float wj[31];
#pragma unroll
  for (int j = 0; j < 31; ++j) wj[j] = p.conv_w[(size_t)(l * 31 + j) * 256 + c];
  const float cb = p.conv_b[l * 256 + c], lg = p.conv_ln_g[l * 256 + c], lb = p.conv_ln_b[l * 256 + c];
  float a[2][16];
#pragma unroll
  for (int ch = 0; ch < 2; ++ch) {
    float zr[46];
#pragma unroll
    for (int i = 0; i < 46; ++i) zr[i] = bf2f(zs[(ch * 16 + i) * 256 + c]);
#pragma unroll
    for (int i = 0; i < 16; ++i) {
      float s = cb;
#pragma unroll
      for (int j = 0; j < 31; ++j) s += zr[i + j] * wj[j];
      a[ch][i] = s;
      const float s1 = wave_sum(s), s2 = wave_sum(s * s);
      if (lane == 0) { red[((ch * 16 + i) * 4 + wid) * 2] = s1; red[((ch * 16 + i) * 4 + wid) * 2 + 1] = s2; }
    }
  }
  __syncthreads();
#pragma unroll
  for (int ch = 0; ch < 2; ++ch)
#pragma unroll
    for (int i = 0; i < 16; ++i) {
      const int tt = ch * 16 + i;
      const float s1 = red[(tt * 4 + 0) * 2] + red[(tt * 4 + 1) * 2] + red[(tt * 4 + 2) * 2] + red[(tt * 4 + 3) * 2];
      const float s2 = red[(tt * 4 + 0) * 2 + 1] + red[(tt * 4 + 1) * 2 + 1] + red[(tt * 4 + 2) * 2 + 1] + red[(tt * 4 + 3) * 2 + 1];
      const float mean = s1 * (1.f / 256.f);
      const float var = fmaxf(s2 * (1.f / 256.f) - mean * mean, 0.f);
      const float rstd = rsqrtf(var + 1e-5f);
      const float v = (a[ch][i] - mean) * rstd * lg + lb;
      za[tt * 264 + c] = f2bf(silu_f(v));
    }
  __syncthreads();
  f32x4 acc[2][4];
#pragma unroll
  for (int m = 0; m < 2; ++m)
#pragma unroll
    for (int n = 0; n < 4; ++n) acc[m][n] = (f32x4){0.f, 0.f, 0.f, 0.f};
  const bf16_t* wt = P_pwT + (size_t)l * 65536;
#pragma unroll
  for (int ks = 0; ks < 8; ++ks) {
    bf16x8 af[2], bfr[4];
#pragma unroll
    for (int m = 0; m < 2; ++m) af[m] = *(const bf16x8*)(smem + 31744 + (m * 16 + fr) * 528 + (ks * 32 + fq * 8) * 2);
#pragma unroll
    for (int n = 0; n < 4; ++n) bfr[n] = *(const bf16x8*)(wt + (size_t)(wid * 64 + n * 16 + fr) * 256 + ks * 32 + fq * 8);
#pragma unroll
    for (int m = 0; m < 2; ++m)
#pragma unroll
      for (int n = 0; n < 4; ++n) acc[m][n] = mfma16(bfr[n], af[m], acc[m][n]);
  }
#pragma unroll
  for (int m = 0; m < 2; ++m) {
    const int row = R0 + m * 16 + fr;
#pragma unroll
    for (int n = 0; n < 4; ++n) {
      const int ch = wid * 64 + n * 16 + 4 * fq;
      const u32x2 gw = *(const u32x2*)(P_U + (size_t)row * NIN + 2048 + ch);
      u32x2 w;
      w.x = pk2(acc[m][n][0] * silu_f(bflo(gw.x)), acc[m][n][1] * silu_f(bfhi(gw.x)));
      w.y = pk2(acc[m][n][2] * silu_f(bflo(gw.y)), acc[m][n][3] * silu_f(bfhi(gw.y)));
      *(u32x2*)(P_MX + (size_t)row * DM + 512 + ch) = w;
    }
  }
  __syncthreads();
}

constexpr int P0_WIN = 3072, P0_WOUT = 1024, P0_PW = 64, P0_POOL = 16, P0_CVT = 768, P0_MOD = 192;
constexpr int P0_UNITS = P0_WIN + P0_WOUT + P0_PW + P0_POOL + P0_CVT + P0_MOD;

DEV void phase0(const Params& p, char* smem) {
  if (blockIdx.x == 0) for (int i = threadIdx.x; i < 1280 + 8; i += 512) P_cnt[i] = 0u;
  const int half = get_half();
  smem += half * 65536;
  for (int pr = blockIdx.x; pr < P0_UNITS / 2; pr += gridDim.x) {
    int v = pr * 2 + half;
    if (v < P0_MOD) { mod_unit(p, v, smem); continue; }
    v -= P0_MOD;
    if (v < P0_WIN) { const int l = v / 768, r = v % 768, kt = r / 48, nt = r % 48;
      tconv_tile(p.w_in + ((size_t)l * 1024 + kt * 64) * 3072 + nt * 64, 3072, P_WinT + ((size_t)l * 3072 + nt * 64) * 1024 + kt * 64, 1024, smem); continue; }
    v -= P0_WIN;
    if (v < P0_WOUT) { const int l = v >> 8, r = v & 255, kt = r >> 4, nt = r & 15;
      tconv_tile(p.w_out + ((size_t)l * 1024 + kt * 64) * 1024 + nt * 64, 1024, P_WoutT + ((size_t)l * 1024 + nt * 64) * 1024 + kt * 64, 1024, smem); continue; }
    v -= P0_WOUT;
    if (v < P0_PW) { const int l = v >> 4, r = v & 15, kt = r >> 2, nt = r & 3;
      tconv_tile(p.conv_pw + ((size_t)l * 256 + kt * 64) * 256 + nt * 64, 256, P_pwT + ((size_t)l * 256 + nt * 64) * 256 + kt * 64, 256, smem); continue; }
    v -= P0_PW;
    if (v < P0_POOL) { tconv_tile(p.pool_w + (size_t)v * 4096, 64, P_poolT + (size_t)v * 4096, 64, smem); continue; }
    v -= P0_POOL;
    if (v < 256) { cvt_unit(p.cnk, P_cnk_b, v); continue; }
    v -= 256;
    if (v < 256) { cvt_unit(p.cnv, P_cnv_b, v); continue; }
    v -= 256;
    if (v < 128) { cvt_unit(p.cgk, P_cgk_b, v); continue; }
    v -= 128;
    cvt_unit(p.cgv, P_cgv_b, v);
  }
}

constexpr int PB_GQA = 1024, PB_NAT = 2048, PB_CONV = 1280, PB_PATT = 512, PB_POOL = 1280;
constexpr int PB_UNITS = PB_GQA + PB_NAT + PB_CONV + PB_PATT + PB_POOL;

DEV void phaseB(const Params& p, int l_in, char* smem, int qofs) {
  unsigned* q = P_cnt + 1280 + qofs + l_in;
  int* slot = (int*)(smem + 131072);
  const int half = get_half();
  smem += half * 65536;
  for (;;) {
    if (threadIdx.x == 0) *slot = (int)atomicAdd(q, 1u);
    __syncthreads();
    int u = *slot * 2 + half;
    __syncthreads();
    if (u >= PB_UNITS) break;
    int l = l_in; asm volatile("" : "+s"(l));
    if (u < PB_GQA) { attn_unit<0>(p, l, u, smem); continue; }
    u -= PB_GQA;
    if (u < PB_NAT) { attn_unit<1>(p, l, u, smem); continue; }
    u -= PB_NAT;
    if (u < PB_CONV) { conv_unit(p, l, u, smem); continue; }
    u -= PB_CONV;
    if (u < PB_PATT) { attn_unit<2>(p, l, u, smem); continue; }
    u -= PB_PATT;
    pool_unit(p, l, u, smem);
  }
}

constexpr int LDS_BYTES = 131072 + 1024;
__global__ void __launch_bounds__(512, 2) mega(Params p) {
  extern __shared__ __attribute__((aligned(16))) char smem[];
  cg::grid_group grid = cg::this_grid();
  const int ph0 = p.ph0, ph1 = p.ph1;
  const int half = get_half();
  if (ph0 <= 0 && 0 < ph1) { phase0(p, smem); if (1 < ph1) grid.sync(); }
  if (ph0 <= 1 && 1 < ph1) { for (int u = blockIdx.x; u < TT / 64; u += gridDim.x) h0_unit(p, u * 2 + half); if (2 < ph1) grid.sync(); }
  for (int li = 0; li < NLAYER; ++li) {
    int l = li; asm volatile("" : "+s"(l));
    const int pa = 2 + 3 * li;
    if (ph0 <= pa && pa < ph1) {
      pg8::Gemm g; g.A = P_H; g.Bt = P_WinT + (size_t)l * 3072 * 1024; g.M = TT; g.N = NIN; g.K = DM;
      pg8::StaticOrder S; S.init(TT, NIN, (int)gridDim.x, (int)blockIdx.x);
      EpiA E{p, l};
      pg8::gemm_phase<EpiA, pg8::StaticOrder, true, true>((PG8_LAS unsigned char*)smem, g, S, E);
      if (pa + 1 < ph1) grid.sync();
    }
    if (ph0 <= pa + 1 && pa + 1 < ph1) { phaseB(p, l, smem, 0); if (pa + 2 < ph1) grid.sync(); }
    if (ph0 <= pa + 2 && pa + 2 < ph1) {
      pg8::Gemm g; g.A = P_MX; g.Bt = P_WoutT + (size_t)l * 1024 * 1024; g.M = TT; g.N = DM; g.K = DM;
      pg8::StaticOrder S; S.init(TT, DM, (int)gridDim.x, (int)blockIdx.x);
      EpiC E{p, l};
      pg8::gemm_phase<EpiC, pg8::StaticOrder, true, true>((PG8_LAS unsigned char*)smem, g, S, E);
      grid.sync();
      for (int u = blockIdx.x; u < TT / 8; u += gridDim.x) ln_unit(p, l, u * 2 + half);
      if (pa + 3 < ph1) grid.sync();
    }
  }
}

#ifndef ONE_LAUNCH
#define ONE_LAUNCH 1
#endif

extern "C" void kernel_launch(void* const* d_in, const int* in_sizes, int n_in, void* d_out, int out_size, void* d_ws, size_t ws_size,
                              hipStream_t stream) {
  static int grid_blocks = 0;
  if (!grid_blocks) {
    int dev = 0, cus = 0, per_cu = 0;
    hipGetDevice(&dev);
    hipDeviceGetAttribute(&cus, hipDeviceAttributeMultiprocessorCount, dev);
    hipFuncSetAttribute((const void*)mega, hipFuncAttributeMaxDynamicSharedMemorySize, LDS_BYTES);
    hipOccupancyMaxActiveBlocksPerMultiprocessor(&per_cu, mega, 512, LDS_BYTES);
    if (per_cu > 1) per_cu = 1;
    if (per_cu < 1) per_cu = 1;
    grid_blocks = cus * per_cu;
  }
  Params p{};
  const float* const* in = (const float* const*)d_in;
  p.x_prompt = in[0]; p.x_sample = in[1]; p.c = in[2]; p.cnk = in[3]; p.cnv = in[4]; p.cgk = in[5]; p.cgv = in[6]; p.c_ctx = in[7];
  p.w_mod = in[8]; p.b_mod = in[9]; p.w_in = in[10]; p.b_in = in[11]; p.pool_w = in[12]; p.pool_scale = in[13]; p.nat_bias = in[14];
  p.q_norm = in[15]; p.k_norm = in[16]; p.conv_w = in[17]; p.conv_b = in[18]; p.conv_ln_g = in[19]; p.conv_ln_b = in[20]; p.conv_pw = in[21];
  p.w_out = in[22]; p.b_out = in[23]; p.ln_g = in[24]; p.ln_b = in[25];
  p.out = (float*)d_out;
  p.ws = (char*)d_ws;
#if ONE_LAUNCH
  p.ph0 = 0; p.ph1 = 14;
  void* args[] = {&p};
  hipError_t e = hipLaunchCooperativeKernel((void*)mega, dim3(grid_blocks), dim3(512), args, LDS_BYTES, stream);
  if (e != hipSuccess) fprintf(stderr, "cooperative launch failed: %s (grid %d)\n", hipGetErrorString(e), grid_blocks);
#else
  for (int ph = 0; ph < 14; ++ph) { p.ph0 = ph; p.ph1 = ph + 1; mega<<<grid_blocks, 512, LDS_BYTES, stream>>>(p); }
#endif
}
```

```cpp
#define PROBE_B 0
#include <hip/hip_runtime.h>
#include <hip/hip_cooperative_groups.h>
#include <cstdio>
#include <cstdint>
namespace cg = cooperative_groups;

typedef unsigned short bf16_t;
typedef short bf16x8 __attribute__((ext_vector_type(8)));
typedef short s16x4 __attribute__((ext_vector_type(4)));
typedef float f32x4 __attribute__((ext_vector_type(4)));
typedef float f32x2 __attribute__((ext_vector_type(2)));
typedef __bf16 bf16x2_t __attribute__((ext_vector_type(2)));
typedef unsigned u32x4 __attribute__((ext_vector_type(4)));
typedef unsigned u32x2 __attribute__((ext_vector_type(2)));
#define DEV __device__ __forceinline__
__device__ const float ROPE_COS[1024] = {
1.f,1.f,1.f,1.f,1.f,1.f,1.f,1.f,
1.f,1.f,1.f,1.f,1.f,1.f,1.f,1.f,
0.540302277f,0.846009135f,0.950415254f,0.98423022f,0.995004177f,0.998419285f,0.999500036f,0.999841869f,
0.999949992f,0.999984205f,0.999994993f,0.999998391f,0.999999523f,0.999999821f,0.99999994f,1.f,
-0.416146845f,0.431462824f,0.806578398f,0.937418282f,0.980066597f,0.993682086f,0.998000681f,0.999367595f,
0.999800026f,0.999936759f,0.999979973f,0.999993682f,0.999997973f,0.999999344f,0.999999821f,0.99999994f,
-0.989992499f,-0.115966164f,0.582753658f,0.861040652f,0.955336511f,0.985803485f,0.995503366f,0.998577297f,
0.999550045f,0.999857724f,0.999954998f,0.999985754f,0.99999553f,0.999998569f,0.999999523f,0.999999881f,
-0.653643608f,-0.627679706f,0.301137477f,0.757506192f,0.921060979f,0.974808276f,0.992010653f,0.997471273f,
0.999200106f,0.999747038f,0.999920011f,0.999974728f,0.999992013f,0.999997497f,0.999999225f,0.999999762f,
0.2836622f,-0.946079254f,-0.0103423381f,0.630080283f,0.87758255f,0.960731268f,0.987526f,0.996049762f,
0.998750269f,0.999604762f,0.999875009f,0.999960482f,0.999987483f,0.999996066f,0.999998748f,0.999999583f,
0.960170269f,-0.973103702f,-0.3207964f,0.482782036f,0.825335622f,0.943616986f,0.982053936f,0.9943133f,
0.998200536f,0.999430835f,0.999819994f,0.999943078f,0.999981999f,0.999994338f,0.999998212f,0.999999404f,
0.753902256f,-0.700429797f,-0.599437475f,0.320257008f,0.764842212f,0.923519433f,0.975599885f,0.992262423f,
0.997551024f,0.999225318f,0.999755025f,0.999922514f,0.999975502f,0.999992251f,0.999997556f,0.999999225f,
-0.145500034f,-0.212036446f,-0.818632424f,0.147631213f,0.696706712f,0.900502324f,0.968170285f,0.989897788f,
0.996801734f,0.998988271f,0.999680042f,0.999898791f,0.999967992f,0.999989867f,0.999996781f,0.999998987f,
-0.91113025f,0.341660261f,-0.956644177f,-0.0296507962f,0.621609926f,0.874638259f,0.959772646f,0.987220109f,
0.995952725f,0.998719573f,0.999595046f,0.99987191f,0.999959528f,0.999987185f,0.999995947f,0.999998748f,
-0.839071512f,0.790131867f,-0.999786079f,-0.205997631f,0.540302277f,0.846009135f,0.950415313f,0.98423022f,
0.995004177f,0.998419285f,0.999500036f,0.999841869f,0.999949992f,0.999984205f,0.999994993f,0.999998391f,
0.00442569796f,0.995257378f,-0.943779767f,-0.375847399f,0.453596085f,0.814705312f,0.940107584f,0.980929136f,
0.993956089f,0.998087406f,0.999395072f,0.999808669f,0.999939501f,0.999980867f,0.99999392f,0.999998093f,
0.843853951f,0.893861592f,-0.79417938f,-0.53384304f,0.362357706f,0.780825913f,0.92885989f,0.97731787f,
0.99280864f,0.997723997f,0.999280095f,0.99977231f,0.999927998f,0.999977231f,0.999992788f,0.999997735f,
0.907446802f,0.517172873f,-0.565820515f,-0.675001681f,0.267498761f,0.744477987f,0.916683376f,0.973397553f,
0.99156189f,0.997329056f,0.999155104f,0.999732792f,0.999915481f,0.999973297f,0.999991536f,0.999997318f,
0.136737213f,-0.0187961515f,-0.28134948f,-0.794870913f,0.16996716f,0.705776393f,0.903590262f,0.969169438f,
0.990216017f,0.996902585f,0.999020159f,0.999690115f,0.99990201f,0.999969006f,0.999990225f,0.999996901f,
-0.759687901f,-0.548975468f,0.0310223512f,-0.889670432f,0.070737198f,0.6648435f,0.889593601f,0.964634836f,
0.988771081f,0.996444523f,0.998875201f,0.999644279f,0.999887526f,0.999964416f,0.999988735f,0.999996424f,
-0.957659483f,-0.910081089f,0.340318173f,-0.95641005f,-0.0291995462f,0.621808827f,0.87470746f,0.959795177f,
0.987227261f,0.99595499f,0.998720288f,0.999595284f,0.999872029f,0.999959528f,0.999987185f,0.999995947f,
-0.275163352f,-0.990897954f,0.615864813f,-0.99298501f,-0.128844544f,0.576808274f,0.858946681f,0.954652011f,
0.985584795f,0.995433986f,0.998555362f,0.999543071f,0.999855518f,0.999954283f,0.999985576f,0.99999541f,
0.660316706f,-0.766536534f,0.830336154f,-0.998241663f,-0.227202162f,0.529984176f,0.842327058f,0.949207008f,
0.983843684f,0.994881511f,0.998380423f,0.999487758f,0.999837995f,0.9999488f,0.999983788f,0.999994874f,
0.988704622f,-0.306095392f,0.962463796f,-0.972014248f,-0.323289543f,0.481484592f,0.824865162f,0.943461835f,
0.982004225f,0.994297504f,0.998195529f,0.999429286f,0.999819517f,0.999942899f,0.99998194f,0.999994278f,
0.408082068f,0.248616725f,0.999144375f,-0.91512996f,-0.416146845f,0.431462824f,0.806578457f,0.937418282f,
0.980066597f,0.993682086f,0.998000681f,0.999367595f,0.999800026f,0.999936759f,0.999979973f,0.999993682f,
-0.547729254f,0.726760268f,0.936740458f,-0.829382956f,-0.504846215f,0.380077004f,0.787485182f,0.931078374f,
0.97803092f,0.993035257f,0.99779582f,0.999302804f,0.999779522f,0.999930263f,0.999977946f,0.999993026f,
-0.99996084f,0.981074572f,0.781440377f,-0.717477441f,-0.588501155f,0.327489585f,0.767604589f,0.92444396f,
0.975897431f,0.992357016f,0.997581005f,0.999234855f,0.999758005f,0.999923468f,0.999975801f,0.999992371f,
-0.53283304f,0.933235765f,0.548645258f,-0.582943261f,-0.666275978f,0.273866832f,0.746956408f,0.917517304f,
0.97366637f,0.991647422f,0.997356176f,0.999163687f,0.999735534f,0.999916375f,0.999973536f,0.999991655f,
0.424179018f,0.597977161f,0.261441678f,-0.430023283f,-0.737393796f,0.219378278f,0.725561321f,0.910300434f,
0.971337974f,0.990906477f,0.997121394f,0.99908942f,0.99971199f,0.999908924f,0.999971211f,0.99999088f,
0.991202831f,0.078552261f,-0.0516893305f,-0.263540596f,-0.801143587f,0.164196163f,0.703440726f,0.902795732f,
0.968912423f,0.99013412f,0.996876657f,0.999011934f,0.999687493f,0.999901175f,0.999968767f,0.999990106f,
0.64691931f,-0.465064496f,-0.359694332f,-0.0887455046f,-0.856888831f,0.108494945f,0.680616796f,0.895005584f,
0.966389954f,0.98933053f,0.996621907f,0.998931348f,0.999662042f,0.999893129f,0.999966204f,0.999989331f,
-0.292138815f,-0.865450621f,-0.632028639f,0.088848114f,-0.904072165f,0.0524506159f,0.6571123f,0.886932373f,
0.963770926f,0.988495648f,0.996357203f,0.998847544f,0.999635518f,0.999884725f,0.999963522f,0.999988496f,
-0.962605894f,-0.999293387f,-0.841684937f,0.26363951f,-0.942222297f,-0.00375941908f,0.632950664f,0.878578722f,
0.961055458f,0.987629473f,0.996082544f,0.998760641f,0.99960804f,0.999876022f,0.99996078f,0.999987602f,
-0.748057544f,-0.825371623f,-0.967871487f,0.430115849f,-0.970958173f,-0.0599575676f,0.608156204f,0.869947195f,
0.958243906f,0.986732066f,0.995797932f,0.998670578f,0.999579549f,0.999867022f,0.999957979f,0.999986708f,
0.154251456f,-0.397251874f,-0.998075247f,0.583026946f,-0.989992499f,-0.115966164f,0.582753658f,0.861040652f,
0.955336511f,0.985803485f,0.995503366f,0.998577297f,0.999550045f,0.999857724f,0.999954998f,0.999985754f,
0.914742351f,0.153215483f,-0.929300308f,0.717549205f,-0.999135137f,-0.171608135f,0.556768358f,0.851861775f,
0.95233357f,0.984843671f,0.995198846f,0.998480916f,0.999519527f,0.999848068f,0.999951959f,0.999984801f,
0.83422339f,0.656495154f,-0.768367112f,0.829440355f,-0.998294771f,-0.226707578f,0.53022635f,0.842413545f,
0.949235439f,0.983852804f,0.994884372f,0.998381376f,0.999488056f,0.999838114f,0.9999488f,0.999983788f,
-0.0132767474f,0.95758605f,-0.531235278f,0.915171385f,-0.987479806f,-0.281090319f,0.503154159f,0.832698941f,
0.946042359f,0.982830763f,0.994559944f,0.998278618f,0.999455571f,0.999827802f,0.999945521f,0.999982774f,
-0.848570287f,0.963757515f,-0.241421118f,0.972038329f,-0.966798186f,-0.334584385f,0.475578904f,0.822721004f,
0.942754686f,0.981777668f,0.994225562f,0.99817276f,0.999422073f,0.999817252f,0.999942183f,0.999981701f,
-0.903692186f,0.673110247f,0.0723346695f,0.998247743f,-0.93645668f,-0.387020677f,0.447528064f,0.812482953f,
0.939372718f,0.980693519f,0.993881226f,0.998063743f,0.999387562f,0.999806345f,0.999938726f,0.999980628f,
-0.127963692f,0.175156534f,0.378916174f,0.992972851f,-0.896758378f,-0.438233554f,0.419029742f,0.801987886f,
0.935896814f,0.979578316f,0.993526995f,0.997951567f,0.999352098f,0.999795079f,0.99993521f,0.999979496f,
0.765414059f,-0.376742303f,0.647921681f,0.95638001f,-0.848100007f,-0.488060862f,0.39011243f,0.791239262f,
0.93232733f,0.978432178f,0.993162811f,0.997836173f,0.99931556f,0.999783576f,0.999931574f,0.999978364f,
0.955073655f,-0.812611222f,0.852673113f,0.889623463f,-0.790967762f,-0.536345184f,0.360805035f,0.780240417f,
0.928664625f,0.977255106f,0.992788672f,0.997717679f,0.999278069f,0.999771714f,0.999927819f,0.999977171f,
0.266642928f,-0.998210371f,0.972865343f,0.794808388f,-0.72593224f,-0.582933903f,0.331136853f,0.768994927f,
0.924909055f,0.976047099f,0.99240464f,0.997596025f,0.999239624f,0.999759495f,0.999923944f,0.999975979f,
-0.666938066f,-0.87637943f,0.996578991f,0.674925625f,-0.653643608f,-0.627679706f,0.301137596f,0.757506192f,
0.921060979f,0.974808276f,0.992010653f,0.997471273f,0.999200106f,0.999747038f,0.999920011f,0.999974728f,
-0.987339258f,-0.484639406f,0.921462357f,0.533756077f,-0.574824035f,-0.670441091f,0.270837069f,0.745777905f,
0.917120814f,0.973538578f,0.991606772f,0.997343302f,0.999159634f,0.999734223f,0.999915957f,0.999973416f,
-0.399985313f,0.0563609414f,0.754965365f,0.375752151f,-0.490260571f,-0.711082935f,0.240265876f,0.733813822f,
0.913088918f,0.972238123f,0.991192937f,0.997212172f,0.999118149f,0.99972111f,0.999911785f,0.999972105f,
0.555113316f,0.580003142f,0.513598442f,0.205897167f,-0.400799006f,-0.749476731f,0.209454417f,0.721617639f,
0.908965766f,0.970906913f,0.990769207f,0.997077882f,0.999075651f,0.999707639f,0.999907553f,0.999970794f,
0.999843299f,0.925014675f,0.221298173f,0.0295478199f,-0.307332784f,-0.785501122f,0.178433523f,0.709193349f,
0.904751658f,0.969545007f,0.990335584f,0.996940494f,0.99903214f,0.99969393f,0.999903202f,0.999969363f,
0.52532196f,0.985138178f,-0.0929481089f,-0.147732988f,-0.210795805f,-0.819042206f,0.147234216f,0.696544766f,
0.90044713f,0.968152404f,0.989892066f,0.996799886f,0.998987675f,0.999679863f,0.999898732f,0.999967992f,
-0.432177931f,0.741858006f,-0.397976756f,-0.320354372f,-0.112152621f,-0.849993885f,0.115887694f,0.683675885f,
0.89605248f,0.966729224f,0.989438653f,0.996656179f,0.998942196f,0.999665439f,0.999894202f,0.999966562f,
-0.992335498f,0.270098448f,-0.663538277f,-0.48287195f,-0.0123883775f,-0.878258407f,0.0844252855f,0.670590878f,
0.891568303f,0.965275466f,0.988975346f,0.996509314f,0.998895705f,0.999650776f,0.999889553f,0.999965072f,
-0.640144348f,-0.284846604f,-0.863296509f,-0.630159974f,0.0874991715f,-0.903746367f,0.0528784581f,0.657293737f,
0.886994898f,0.963791192f,0.988502085f,0.996359289f,0.9988482f,0.999635756f,0.999884784f,0.999963582f,
0.300592542f,-0.75206399f,-0.977442741f,-0.757573068f,0.18651247f,-0.926377118f,0.0212787576f,0.643788815f,
0.882332861f,0.962276459f,0.98801899f,0.996206105f,0.998799741f,0.999620378f,0.999879956f,0.999962032f,
0.964965999f,-0.987659097f,-0.994656444f,-0.861092687f,0.2836622f,-0.946079254f,-0.0103422189f,0.630080283f,
0.87758255f,0.960731268f,0.987526f,0.996049762f,0.998750269f,0.999604762f,0.999875009f,0.999960482f,
0.742154181f,-0.919073522f,-0.913230121f,-0.937454224f,0.377977669f,-0.96279037f,-0.0419528559f,0.616172493f,
0.872744501f,0.959155679f,0.987023175f,0.99589026f,0.998699784f,0.999588788f,0.999869943f,0.999958873f,
-0.162990779f,-0.567430019f,-0.741239965f,-0.984248459f,0.468516916f,-0.976457715f,-0.0735215396f,0.602069914f,
0.86781919f,0.95754981f,0.986510456f,0.995727658f,0.998648286f,0.999572515f,0.999864817f,0.999957263f,
-0.918282807f,-0.0410281904f,-0.495741814f,-1.f,0.554374516f,-0.987038016f,-0.105016708f,0.587776959f,
0.862807095f,0.955913603f,0.985987842f,0.995561838f,0.998595834f,0.999555886f,0.999859571f,0.999955595f,
-0.829309821f,0.498009592f,-0.201079622f,-0.984212041f,0.634692967f,-0.994497895f,-0.136406869f,0.573298037f,
0.857708693f,0.954247177f,0.985455394f,0.995392919f,0.998542368f,0.999538958f,0.999854207f,0.999953866f,
0.0221267566f,0.883669317f,0.113521777f,-0.937382519f,0.708669782f,-0.998813629f,-0.167660639f,0.558637917f,
0.852524519f,0.95255059f,0.984913111f,0.99522084f,0.99848789f,0.999521732f,0.999848783f,0.999952197f,
0.853220105f,0.997174621f,0.416867077f,-0.860988438f,0.775565803f,-0.999971747f,-0.198746875f,0.543801069f,
0.847255111f,0.950823903f,0.984360933f,0.995045662f,0.998432398f,0.999504209f,0.99984318f,0.999950409f,
0.899866819f,0.803569078f,0.678870201f,-0.757439196f,0.834712923f,-0.997968495f,-0.22963427f,0.528792322f,
0.841901004f,0.949067116f,0.983798921f,0.994867265f,0.998375952f,0.999486327f,0.999837577f,0.999948621f,
0.119180135f,0.362476677f,0.873550534f,-0.63000071f,0.885519624f,-0.99281019f,-0.260292053f,0.513616323f,
0.836462677f,0.947280347f,0.983227074f,0.994685769f,0.998318493f,0.999468148f,0.999831796f,0.999946833f,
-0.771080196f,-0.1902491f,0.981602073f,-0.482692331f,0.927478492f,-0.984513164f,-0.290689558f,0.498277903f,
0.830940723f,0.945463598f,0.982645452f,0.994501114f,0.998260021f,0.99944967f,0.999825954f,0.999944985f,
-0.952412963f,-0.684381902f,0.992308319f,-0.320159167f,0.960170269f,-0.973103702f,-0.3207964f,0.482782036f,
0.825335622f,0.943616986f,0.982053936f,0.9943133f,0.998200536f,0.999430835f,0.999819994f,0.999943078f,
-0.258101642f,-0.967739642f,0.904607594f,-0.1475292f,0.98326844f,-0.958617806f,-0.350582451f,0.467133403f,
0.819648027f,0.941740453f,0.981452644f,0.994122326f,0.998140097f,0.999411702f,0.999813974f,0.99994117f,
0.673507154f,-0.953050017f,0.727198064f,0.0297537707f,0.996542096f,-0.941101313f,-0.380017966f,0.451337039f,
0.813878477f,0.939834237f,0.980841517f,0.993928254f,0.998078644f,0.999392271f,0.999807835f,0.999939203f,
0.985896587f,-0.644837022f,0.477671444f,0.206098333f,0.999858618f,-0.920609534f,-0.409073502f,0.435397953f,
0.808027506f,0.937898219f,0.980220556f,0.993731022f,0.998016179f,0.999372482f,0.999801576f,0.999937236f,
};
__device__ const float ROPE_SIN[1024] = {
0.f,0.f,0.f,0.f,0.f,0.f,0.f,0.f,
0.f,0.f,0.f,0.f,0.f,0.f,0.f,0.f,
0.841470957f,0.533168435f,0.310983598f,0.176892191f,0.0998334214f,0.0562044978f,0.0316175036f,0.0177818574f,
0.00999983307f,0.00562338345f,0.00316227227f,0.0017782785f,0.000999999931f,0.000562341243f,0.000316227757f,0.00017782794f,
0.909297407f,0.902130723f,0.591127098f,0.348205268f,0.198669329f,0.112231314f,0.0632033944f,0.0355580896f,
0.0199986659f,0.011246589f,0.00632451288f,0.00355655141f,0.0019999987f,0.00112468237f,0.000632455456f,0.00035565588f,
0.141120002f,0.993253171f,0.812648892f,0.5085361f,0.295520216f,0.167903304f,0.0947260857f,0.0533230826f,
0.0299954992f,0.0168694388f,0.00948669016f,0.00533481315f,0.0029999956f,0.00168702309f,0.000948683126f,0.000533483806f,
-0.756802499f,0.778471708f,0.953580737f,0.652827978f,0.389418334f,0.223044485f,0.126154065f,0.0710712075f,
0.0399893336f,0.0224917568f,0.0126487734f,0.00711305765f,0.00399998948f,0.00224936334f,0.00126491068f,0.000711311703f,
-0.958924294f,0.32393527f,0.999946535f,0.776529968f,0.47942555f,0.277480543f,0.157455876f,0.0887968615f,
0.0499791652f,0.0281133614f,0.0158107281f,0.00889127981f,0.0049999794f,0.0028117029f,0.00158113812f,0.000889139599f,
-0.279415488f,-0.230367512f,0.947148204f,0.875740528f,0.564642489f,0.33103931f,0.188600272f,0.106494442f,
0.0599640049f,0.0337340795f,0.0189725272f,0.0106694745f,0.0059999642f,0.00337404152f,0.00189736532f,0.00106696738f,
0.656986594f,-0.713721275f,0.800421596f,0.947330713f,0.64421767f,0.383551568f,0.219556093f,0.124158338f,
0.0699428469f,0.0393537246f,0.0221341345f,0.0124476347f,0.00699994294f,0.00393637875f,0.00221359241f,0.00124479528f,
0.989358246f,-0.977261782f,0.574317753f,0.989042461f,0.717356086f,0.434851229f,0.250292331f,0.141782969f,
0.0799146891f,0.0449721329f,0.0252955221f,0.0142257558f,0.0079999147f,0.00449871505f,0.00252981926f,0.00142262306f,
0.412118495f,-0.939823508f,0.291259229f,0.999560297f,0.783326924f,0.484776139f,0.280778319f,0.159362778f,
0.0898785442f,0.0505891182f,0.0284566563f,0.0160038304f,0.00899987947f,0.00506105041f,0.00284604589f,0.00160045072f,
-0.54402113f,-0.612936914f,-0.0206835698f,0.978552461f,0.841470957f,0.533168435f,0.310983568f,0.176892191f,
0.099833414f,0.0562044978f,0.0316175036f,0.0177818574f,0.009999834f,0.00562338345f,0.00316227227f,0.0017782785f,
-0.999990225f,-0.0972764567f,-0.33057496f,0.926681578f,0.891207397f,0.579875171f,0.340877861f,0.19436565f,
0.1097783f,0.0618181042f,0.0347780399f,0.0195598267f,0.0109997792f,0.00618571462f,0.00347849843f,0.00195610616f,
-0.536572933f,0.448342979f,-0.60768342f,0.845583618f,0.932039082f,0.624748647f,0.370431304f,0.211777672f,
0.119712204f,0.0674297586f,0.0379382223f,0.0213377345f,0.0119997123f,0.0067480444f,0.00379472389f,0.00213393359f,
0.420167029f,0.855880976f,-0.824528456f,0.737816215f,0.963558197f,0.667647004f,0.399614304f,0.229122713f,
0.129634142f,0.0730392784f,0.0410980321f,0.0231155735f,0.0129996343f,0.00731037185f,0.00411094911f,0.00231176103f,
0.990607381f,0.999823332f,-0.959605396f,0.606778562f,0.985449731f,0.708434701f,0.428397775f,0.246395305f,
0.139543116f,0.078646481f,0.0442574248f,0.0248933397f,0.0139995432f,0.00787269697f,0.00442717411f,0.00248958869f,
0.650287867f,0.835838437f,-0.999518692f,0.456603259f,0.997494996f,0.746982634f,0.456752867f,0.263589978f,
0.149438128f,0.0842512026f,0.0474163815f,0.0266710296f,0.0149994381f,0.00843502022f,0.00474339863f,0.00266741589f,
-0.287903309f,0.414430231f,-0.940310359f,0.292027086f,0.999573588f,0.783169091f,0.484651238f,0.280701309f,
0.159318209f,0.0898532644f,0.0505748577f,0.028448632f,0.015999319f,0.00899733976f,0.00505962269f,0.00284524332f,
-0.961397469f,-0.134615138f,-0.78785187f,0.11824052f,0.991664827f,0.81687957f,0.512064993f,0.29772386f,
0.169182345f,0.09545248f,0.0537328273f,0.0302261449f,0.0169991814f,0.00955965649f,0.00537584582f,0.00302307028f,
-0.750987232f,-0.642200708f,-0.557262897f,-0.0592755191f,0.973847628f,0.84800756f,0.538966715f,0.314652264f,
0.179029569f,0.101048686f,0.0568902642f,0.0320035629f,0.0179990288f,0.0101219704f,0.00569206895f,0.00320089748f,
0.149877205f,-0.952000856f,-0.271410108f,-0.234921798f,0.946300089f,0.876454532f,0.565329552f,0.331481189f,
0.188858896f,0.10664168f,0.060047131f,0.0337808803f,0.0189988576f,0.0106842816f,0.00600829115f,0.00337872445f,
0.912945271f,-0.968601942f,0.0413582884f,-0.403158993f,0.909297407f,0.902130723f,0.591127038f,0.348205268f,
0.198669314f,0.112231314f,0.0632033944f,0.0355580896f,0.0199986678f,0.011246589f,0.00632451288f,0.00355655141f,
0.836655617f,-0.686891198f,0.35002476f,-0.558680534f,0.863209307f,0.924954832f,0.616333544f,0.364819258f,
0.208459899f,0.117817394f,0.0663590282f,0.0373351872f,0.0209984574f,0.0118088927f,0.00664073415f,0.00373437814f,
-0.00885130931f,-0.193630233f,0.623979926f,-0.696581721f,0.808496356f,0.944854796f,0.640923738f,0.381317884f,
0.218229622f,0.123399742f,0.0695140064f,0.0391121693f,0.0219982266f,0.0123711927f,0.00695695449f,0.00391220488f,
-0.846220434f,0.359264523f,0.836055279f,-0.812512875f,0.745705247f,0.961767614f,0.664873064f,0.397695929f,
0.227977514f,0.128978193f,0.0726682767f,0.0408890247f,0.0229979735f,0.0129334899f,0.00727317436f,0.00409003161f,
-0.905578375f,0.801513135f,0.965219259f,-0.902817786f,0.67546314f,0.97563988f,0.688157499f,0.413948208f,
0.237702623f,0.134552568f,0.0758218244f,0.0426657498f,0.0239976961f,0.0134957815f,0.0075893933f,0.00426785741f,
-0.132351756f,0.996909976f,0.998663187f,-0.964648306f,0.598472118f,0.986427724f,0.710753918f,0.430069596f,
0.247403964f,0.140122697f,0.0789746121f,0.0444423407f,0.0249973964f,0.0140580693f,0.00790561177f,0.00444568414f,
0.76255846f,0.885276794f,0.933070183f,-0.996054351f,0.515501261f,0.994096994f,0.732639611f,0.446054995f,
0.257080555f,0.145688385f,0.0821266174f,0.0462187938f,0.0259970706f,0.0146203535f,0.00822182931f,0.00462350994f,
0.956375957f,0.500994205f,0.774945021f,-0.996045172f,0.427379847f,0.99862349f,0.753792703f,0.46189931f,
0.266731411f,0.151249468f,0.0852777958f,0.0479951017f,0.0269967206f,0.015182632f,0.00853804592f,0.00480133574f,
0.270905793f,-0.0375856608f,0.539968967f,-0.964621305f,0.334988207f,0.999992907f,0.774192095f,0.477597594f,
0.276355654f,0.156805754f,0.0884281173f,0.049771253f,0.0279963426f,0.0157449059f,0.0088542616f,0.00497916201f,
-0.663633883f,-0.564589798f,0.251445323f,-0.902773678f,0.239249229f,0.998200953f,0.793817401f,0.49314484f,
0.28595221f,0.162357092f,0.0915775672f,0.0515472479f,0.0289959367f,0.0163071752f,0.00917047635f,0.00515698735f,
-0.988031626f,-0.917709649f,-0.0620148405f,-0.812452853f,0.141120002f,0.993253171f,0.812648892f,0.5085361f,
0.295520186f,0.167903304f,0.0947260931f,0.0533230826f,0.029995501f,0.0168694388f,0.00948669016f,0.00533481315f,
-0.404037654f,-0.988192797f,-0.369325012f,-0.696507812f,0.0415805206f,0.985165298f,0.830667794f,0.523766637f,
0.305058628f,0.173444211f,0.0978736654f,0.055098746f,0.0309950355f,0.0174316969f,0.00980290305f,0.00551263802f,
0.551426709f,-0.754330218f,-0.640009403f,-0.5585953f,-0.0583741926f,0.973962843f,0.847856104f,0.538831532f,
0.314566553f,0.17897962f,0.101020269f,0.0568742342f,0.0319945402f,0.0179939512f,0.0101191159f,0.00569046335f,
0.999911845f,-0.28814739f,-0.847224355f,-0.403064936f,-0.157745644f,0.959681332f,0.864196658f,0.553726017f,
0.324043006f,0.184509367f,0.10416586f,0.0586495437f,0.0329940096f,0.0185561981f,0.010435327f,0.00586828869f,
0.529082716f,0.266779721f,-0.97042042f,-0.234822124f,-0.255541205f,0.942365825f,0.879673064f,0.568445385f,
0.333487093f,0.190033287f,0.107310407f,0.0604246669f,0.0339934528f,0.0191184394f,0.010751537f,0.00604611309f,
-0.428182662f,0.739542127f,-0.997380435f,-0.0591726787f,-0.350783229f,0.92207104f,0.894269884f,0.582984984f,
0.342897803f,0.195551202f,0.110453881f,0.0621996038f,0.034992855f,0.0196806751f,0.0110677453f,0.00622393796f,
-0.991778851f,0.984540582f,-0.925431013f,0.118342586f,-0.442520559f,0.89886117f,0.907972515f,0.597340286f,
0.352274209f,0.201062918f,0.113596253f,0.0639743358f,0.0359922275f,0.0202429052f,0.0113839535f,0.0064017619f,
-0.643538117f,0.926318109f,-0.761706948f,0.292125374f,-0.529836178f,0.872809589f,0.920767248f,0.611506701f,
0.361615449f,0.206568271f,0.116737492f,0.0657488778f,0.036991559f,0.0208051261f,0.0117001599f,0.0065795863f,
0.296368569f,0.58280617f,-0.522444785f,0.456694692f,-0.611857831f,0.84399873f,0.932641268f,0.625479698f,
0.370920479f,0.212067112f,0.119877554f,0.0675232038f,0.0379908569f,0.0213673431f,0.0120163653f,0.00675741071f,
0.963795364f,0.0598003156f,-0.231372014f,0.606860459f,-0.687766254f,0.81251961f,0.943582714f,0.639254928f,
0.380188406f,0.217559248f,0.123016424f,0.0692973137f,0.0389901139f,0.0219295528f,0.0123325698f,0.00693523418f,
0.745113134f,-0.481621295f,0.0826458037f,0.737885714f,-0.756802499f,0.778471708f,0.953580678f,0.652827978f,
0.389418334f,0.223044485f,0.126154065f,0.0710712075f,0.0399893373f,0.0224917568f,0.0126487734f,0.00711305765f,
-0.158622667f,-0.874714017f,0.388467699f,0.845638454f,-0.818277061f,0.74196279f,0.962625206f,0.666194677f,
0.39860931f,0.228522688f,0.129290432f,0.0728448778f,0.0409885161f,0.0230539497f,0.0129649751f,0.00729088066f,
-0.916521549f,-0.998410463f,0.655764699f,0.926720202f,-0.871575892f,0.703108132f,0.970707119f,0.679350674f,
0.407760441f,0.233993664f,0.132425532f,0.0746183172f,0.0419876575f,0.0236161388f,0.0132811759f,0.00746870413f,
-0.831774771f,-0.814614236f,0.858030677f,0.97857362f,-0.916166008f,0.662030637f,0.977818429f,0.692291796f,
0.416870773f,0.23945722f,0.135559291f,0.0763915181f,0.0429867506f,0.0241783205f,0.0135973748f,0.00764652714f,
0.0177019257f,-0.37993139f,0.975206196f,0.999563396f,-0.951602101f,0.618860185f,0.983951986f,0.70501405f,
0.425939471f,0.244913206f,0.138691694f,0.0781644881f,0.0439858064f,0.0247404929f,0.0139135728f,0.00782434922f,
0.850903511f,0.171763569f,0.995670974f,0.989027262f,-0.977530122f,0.57373327f,0.989101648f,0.717513323f,
0.434965521f,0.250361472f,0.141822711f,0.0799371973f,0.0449848175f,0.0253026579f,0.0142297689f,0.00800217129f,
0.901788354f,0.670557022f,0.917395473f,0.947297752f,-0.993690968f,0.526792526f,0.993262351f,0.72978574f,
0.44394809f,0.255801797f,0.144952312f,0.0817096606f,0.0459837839f,0.0258648153f,0.0145459641f,0.0081799943f,
0.123573124f,0.962832689f,0.748142362f,0.875690997f,-0.999923289f,0.478186339f,0.996429801f,0.741827428f,
0.452886283f,0.261234075f,0.148080453f,0.0834818557f,0.0469827019f,0.0264269635f,0.0148621574f,0.00835781638f,
-0.768254638f,0.958573103f,0.504697084f,0.776465356f,-0.99616462f,0.428068399f,0.99860096f,0.753634512f,
0.461779177f,0.266658038f,0.151207119f,0.0852537975f,0.0479815714f,0.0269891042f,0.0151783489f,0.00853563752f,
-0.953752637f,0.659090102f,0.211200655f,0.652750373f,-0.982452571f,0.376597136f,0.999773562f,0.765203178f,
0.470625877f,0.272073567f,0.15433228f,0.087025471f,0.0489803962f,0.0275512375f,0.0154945394f,0.0087134596f,
-0.262374848f,0.156619072f,-0.10324046f,0.508447945f,-0.958924294f,0.32393527f,0.999946535f,0.776529968f,
0.47942555f,0.277480543f,0.157455891f,0.0887968615f,0.0499791689f,0.0281133596f,0.0158107281f,0.00889127981f,
0.670229197f,-0.394086063f,-0.407444149f,0.3481085f,-0.925814748f,0.270249337f,0.99911958f,0.787611187f,
0.48817724f,0.282878697f,0.160577938f,0.0905679762f,0.0509778969f,0.0286754742f,0.0161269177f,0.00906910095f,
0.986627579f,-0.823421597f,-0.671240151f,0.176790684f,-0.883454502f,0.215709001f,0.997293651f,0.798443377f,
0.496880114f,0.28826794f,0.163698375f,0.0923388004f,0.051976569f,0.0292375814f,0.0164431017f,0.00924692024f,
0.395925164f,-0.999157965f,-0.868469954f,-0.000103020677f,-0.832267344f,0.160486728f,0.994470477f,0.809023023f,
0.505533338f,0.293648034f,0.166817173f,0.0941093415f,0.0529751927f,0.0297996756f,0.0167592876f,0.00942474138f,
-0.558789074f,-0.867171526f,-0.979574919f,-0.176993474f,-0.772764444f,0.104756832f,0.990652919f,0.819346905f,
0.514135957f,0.29901889f,0.169934288f,0.0958795771f,0.0539737605f,0.0303617641f,0.0170754679f,0.00960256159f,
-0.999755144f,-0.468111664f,-0.993535519f,-0.348301649f,-0.705540299f,0.0486960001f,0.985844791f,0.829411685f,
0.522687256f,0.304380238f,0.173049718f,0.0976495072f,0.0549722798f,0.0309238415f,0.01739165f,0.00978038087f,
-0.521551013f,0.0751182064f,-0.908967435f,-0.508624554f,-0.631266713f,-0.00751878507f,0.980050862f,0.839214146f,
0.531186223f,0.30973196f,0.17616342f,0.0994191393f,0.0559707358f,0.0314859077f,0.0177078284f,0.00995820016f,
0.436164767f,0.595211506f,-0.734258294f,-0.652905703f,-0.550685287f,-0.0637097955f,0.973276973f,0.848751247f,
0.539632022f,0.315073937f,0.179275364f,0.101188451f,0.0569691435f,0.0320479684f,0.0180240069f,0.0101360194f,
0.992872655f,0.931992829f,-0.486733496f,-0.776594579f,-0.464602023f,-0.119699396f,0.965529919f,0.858020008f,
0.548023939f,0.3204059f,0.182385504f,0.102957435f,0.0579674877f,0.0326100141f,0.0183401816f,0.0103138378f,
0.636738002f,0.981735826f,-0.190938011f,-0.87579f,-0.373876572f,-0.175310582f,0.956817448f,0.867017388f,
0.55636102f,0.325727791f,0.185493827f,0.104726106f,0.0589657798f,0.0331720486f,0.0186563563f,0.0104916561f,
-0.304810613f,0.729123712f,0.12379095f,-0.947363734f,-0.279415488f,-0.230367512f,0.947148204f,0.875740528f,
0.564642429f,0.33103931f,0.188600287f,0.106494442f,0.0599640086f,0.0337340795f,0.0189725272f,0.0106694745f,
-0.966117799f,0.251952261f,0.426245421f,-0.98905772f,-0.182162598f,-0.284696162f,0.936531842f,0.884186864f,
0.572867453f,0.336340427f,0.191704854f,0.108262435f,0.0609621815f,0.0342960916f,0.0192886982f,0.0108472919f,
-0.739180684f,-0.302812874f,0.686427653f,-0.999557257f,-0.0830891207f,-0.338124752f,0.924979091f,0.892353535f,
0.581035137f,0.341630876f,0.194807529f,0.110030092f,0.0619602874f,0.0348580964f,0.0196048655f,0.0110251084f,
0.167355701f,-0.764320076f,0.878538549f,-0.978531301f,0.0168140903f,-0.390484393f,0.912501454f,0.900238097f,
0.589144766f,0.346910536f,0.197908238f,0.111797392f,0.0629583374f,0.0354200937f,0.0199210308f,0.0112029258f,
};
#define XB_TMO      128
#define XB_XCNT(j)  (256  + 64 * (j))
#define XB_XSUB(j)  (1280 + 64 * (j))
#define XB_XGEN(j)  (2304 + 64 * (j))
#define XB_TOP      3328
#define XB_TOPGEN   3392
#define XCD_BAR_WORDS 3456
#define XB_SPIN_CAP (1u << 18)
#define LAS __attribute__((address_space(3)))

__device__ __forceinline__ unsigned xb_ld(unsigned* p)              { return __hip_atomic_load(p, __ATOMIC_RELAXED, __HIP_MEMORY_SCOPE_AGENT); }
__device__ __forceinline__ unsigned xb_add(unsigned* p, unsigned v) { return __hip_atomic_fetch_add(p, v, __ATOMIC_RELAXED, __HIP_MEMORY_SCOPE_AGENT); }
__device__ __forceinline__ unsigned xb_xcc_id() { return (unsigned)__builtin_amdgcn_s_getreg((3 << 11) | 20) & 0xFu; }
#define XB_SPIN(cond, bar) do { unsigned _sp = 0; while (cond) { __builtin_amdgcn_s_sleep(1); \
    if ((++_sp & 255u) == 0u) { if (xb_ld(&(bar)[XB_TMO])) break; if (_sp > XB_SPIN_CAP) { atomicAdd(&(bar)[XB_TMO], 1u); break; } } } } while (0)

struct XcdBarrier {
    unsigned* bar; unsigned x;
    volatile LAS unsigned* st;
};

__device__ __forceinline__ XcdBarrier xcd_barrier_post(unsigned* bar, volatile LAS unsigned* st) {
    XcdBarrier b; b.bar = bar; b.x = xb_xcc_id(); b.st = st;
    if (threadIdx.x == 0) (void)xb_add(&bar[XB_XCNT(b.x)], 1u);
    return b;
}
__device__ __forceinline__ void xcd_barrier_complete(unsigned* bar, unsigned x, unsigned& nloc, unsigned& nx) {
    const unsigned G = gridDim.x * gridDim.y * gridDim.z;
    unsigned sum, cnt, mine, sp = 0u;
    for (;;) {
        sum = 0u; cnt = 0u; mine = 0u;
#pragma unroll
        for (unsigned j = 0; j < 16; ++j) { const unsigned c = xb_ld(&bar[XB_XCNT(j)]); sum += c; cnt += (c > 0u) ? 1u : 0u; mine = (j == x) ? c : mine; }
        if (sum == G) break;
        __builtin_amdgcn_s_sleep(1);
        if ((++sp & 255u) == 0u) { if (xb_ld(&bar[XB_TMO])) break; if (sp > XB_SPIN_CAP) { atomicAdd(&bar[XB_TMO], 1u); break; } }
    }
    nloc = mine > 0u ? mine : 1u; nx = cnt > 0u ? cnt : 1u;
}

__device__ __forceinline__ void xcd_barrier(const XcdBarrier& b) {
    asm volatile("s_waitcnt vmcnt(0)" ::: "memory");
    __syncthreads();
    if (threadIdx.x == 0) {
        unsigned* bar = b.bar;
        __builtin_amdgcn_s_waitcnt(0);
        unsigned nloc = b.st[0], nx = b.st[1];
        if (nloc == 0u) { xcd_barrier_complete(bar, b.x, nloc, nx); b.st[0] = nloc; b.st[1] = nx; }
        const unsigned old = xb_add(&bar[XB_XSUB(b.x)], 1u);
        const unsigned gen = old / nloc;
        if (old + 1u == (gen + 1u) * nloc) {
            __builtin_amdgcn_fence(__ATOMIC_RELEASE, "agent");
            asm volatile("s_waitcnt vmcnt(0)" ::: "memory");
            const unsigned og = xb_add(&bar[XB_TOP], 1u);
            const unsigned tg = og / nx;
            if (og + 1u == (tg + 1u) * nx) xb_add(&bar[XB_TOPGEN], 1u);
            else XB_SPIN(xb_ld(&bar[XB_TOPGEN]) == tg, bar);
            __builtin_amdgcn_fence(__ATOMIC_ACQUIRE, "agent");
            xb_add(&bar[XB_XGEN(b.x)], 1u);
            asm volatile("s_waitcnt vmcnt(0)" ::: "memory");
        } else {
            XB_SPIN(xb_ld(&bar[XB_XGEN(b.x)]) == gen, bar);
            __builtin_amdgcn_fence(__ATOMIC_ACQUIRE, "agent");
            asm volatile("s_waitcnt vmcnt(0)" ::: "memory");
        }
    }
    __syncthreads();
}

namespace pg8 {
#define PG8_LAS __attribute__((address_space(3)))
typedef unsigned short bf16_t;
typedef short bf16x8 __attribute__((ext_vector_type(8)));
typedef float f32x4 __attribute__((ext_vector_type(4)));
typedef unsigned u32x4 __attribute__((ext_vector_type(4)));
constexpr int BM = 256, BK = 64, HALF = 128, HTB = HALF * BK * 2  , STAGE_BYTES = 8 * HTB, NXCD = 8, WGM = 8;

__host__ __device__ __forceinline__ int lds_byte(int r, int c) { const int st = (r >> 4) * 2 + (c >> 5), rr = r & 15, cc = c & 31, ob = rr * 64 + cc * 2; return st * 1024 + (ob ^ (((ob >> 9) & 1) << 5)); }
__host__ __device__ __forceinline__ void stage_rc(int b, int& R, int& C) { const int st = b / 1024, sb = b % 1024, swz = sb ^ (((sb >> 9) & 1) << 5); R = (st >> 1) * 16 + swz / 64; C = (st & 1) * 32 + (swz % 64) / 2; }
__host__ __device__ __forceinline__ int perm32(int rho) { const int n = rho >> 4, i = rho & 15; return 8 * (i >> 2) + 4 * n + (i & 3); }

struct Unit { int pm, pn; };
struct Gemm { const bf16_t* A; const bf16_t* Bt; int M, N, K; };

struct StaticOrder {
    int nM, nN, nwg, G, c;
    __host__ __device__ void init(int M, int N, int G_, int c_) { nM = M / BM; nN = N / BM; nwg = nM * nN; G = G_; c = c_; }
    __host__ __device__ bool next(int i, Unit& u) const {
        const long L = (long)i * G + c; if (L >= nwg) return false;
        int wgid = (int)L; { const int q = nwg / NXCD, r = nwg % NXCD, xcd = wgid % NXCD, off = wgid / NXCD; wgid = (xcd < r ? xcd * (q + 1) : r * (q + 1) + (xcd - r) * q) + off; }
        const int nig = WGM * nN, gid = wgid / nig, fm = gid * WGM, gsz = (nM - fm) < WGM ? (nM - fm) : WGM;
        u.pm = fm + ((wgid % nig) % gsz); u.pn = (wgid % nig) / gsz; return true;
    }
    __device__ __forceinline__ void a_ready(const Unit&) const {}
    __device__ __forceinline__ void done(const Unit&) const {}
};
template <class Epi, class Sched, bool ALIGN_EPI = false, bool SP2 = false>
__device__ __forceinline__ void gemm_phase(PG8_LAS unsigned char* lds, const Gemm g, const Sched& S, const Epi& E) {
    int tid = threadIdx.x; asm volatile("" : "+v"(tid)); const int wid = __builtin_amdgcn_readfirstlane(tid >> 6), lane = tid & 63, wr = wid >> 2, wc = wid & 3, fr = lane & 15, fq = lane >> 4;
    const int K = g.K, nt = K / BK;
    unsigned voffA[2], voffB[2];
#pragma unroll
    for (int i = 0; i < 2; ++i) { int R, C; stage_rc(tid * 16 + i * 8192, R, C); const int Rb = (R >> 5) * 64 + (R & 31);
        voffA[i] = (unsigned)(R * K + C) * 2u; voffB[i] = (unsigned)(Rb * K + C) * 2u; }
    const size_t kstep = (size_t)(BK * 2);
    const size_t hstep = (size_t)HALF * K * 2; const size_t bhstep = (size_t)32 * K * 2;
    const size_t tstep = 2 * hstep;
    const unsigned ldsw = (unsigned)wid * 1024u;
    const int aoff = lds_byte(wr * 64 + fr, fq * 8), boff = lds_byte(wc * 32 + fr, fq * 8);
#define PG8_SA(b, h) (((b) * 2 + (h)) * HTB)
#define PG8_SB(b, h) ((4 + (b) * 2 + (h)) * HTB)
#define PG8_STAGE(bufoff, gbase, voff) do { _Pragma("unroll") for (int _i = 0; _i < 2; ++_i) \
        __builtin_amdgcn_global_load_lds((const unsigned*)((const char*)(gbase) + (voff)[_i]), (PG8_LAS unsigned*)(lds + (bufoff) + ldsw + _i * 8192), 16, 0, 0); } while (0)
#define PG8_LDA(dst, b, h) do { _Pragma("unroll") for (int m = 0; m < 4; ++m) _Pragma("unroll") for (int k = 0; k < 2; ++k) dst[m][k] = *(const PG8_LAS bf16x8*)(lds + PG8_SA(b, h) + aoff + m * 2048 + k * 1024); } while (0)
#define PG8_LDB(dst, b, h) do { _Pragma("unroll") for (int n = 0; n < 2; ++n) _Pragma("unroll") for (int k = 0; k < 2; ++k) dst[n][k] = *(const PG8_LAS bf16x8*)(lds + PG8_SB(b, h) + boff + n * 2048 + k * 1024); } while (0)
#define PG8_MMA(ai, bj, At, Bt) do { __builtin_amdgcn_s_setprio(1); _Pragma("unroll") for (int m = 0; m < 4; ++m) _Pragma("unroll") for (int n = 0; n < 2; ++n) _Pragma("unroll") for (int k = 0; k < 2; ++k) \
        acc[ai][bj][m][n] = __builtin_amdgcn_mfma_f32_16x16x32_bf16(Bt[n][k], At[m][k], acc[ai][bj][m][n], 0, 0, 0); __builtin_amdgcn_s_setprio(0); } while (0)
#define PG8_WAIT_V(n) asm volatile("s_waitcnt vmcnt(" #n ")" ::: "memory")
#define PG8_WAIT_L(n) asm volatile("s_waitcnt lgkmcnt(" #n ")" ::: "memory")
#define PG8_BAR __builtin_amdgcn_s_barrier()
#define PG8_SCHED __builtin_amdgcn_sched_barrier(0)
    Unit cur, nxt; int ui = 0;
    if (!S.next(0, cur)) return;
    f32x4 acc[2][2][4][2];
#pragma unroll
    for (int a = 0; a < 2; ++a)
#pragma unroll
        for (int b = 0; b < 2; ++b)
#pragma unroll
            for (int m = 0; m < 4; ++m)
#pragma unroll
                for (int n = 0; n < 2; ++n) acc[a][b][m][n] = (f32x4){0.f, 0.f, 0.f, 0.f};
    bf16x8 At[4][2], B0[2][2], B1[2][2];
    const char* cA = (const char*)g.A + (size_t)cur.pm * tstep; const char* cB = (const char*)g.Bt + (size_t)cur.pn * tstep;
    S.a_ready(cur);
    if constexpr (SP2) {
        PG8_STAGE(PG8_SB(0, 0), cB, voffB); PG8_STAGE(PG8_SB(0, 1), cB + bhstep, voffB); PG8_STAGE(PG8_SA(0, 0), cA, voffA); PG8_STAGE(PG8_SA(0, 1), cA + hstep, voffA);
        if (wr == 1) PG8_BAR;
        PG8_WAIT_V(2); PG8_BAR;
        PG8_STAGE(PG8_SB(1, 0), cB + kstep, voffB); PG8_STAGE(PG8_SA(1, 0), cA + kstep, voffA); PG8_STAGE(PG8_SB(1, 1), cB + bhstep + kstep, voffB);
        PG8_WAIT_V(6); PG8_BAR;
    } else {
        PG8_STAGE(PG8_SB(0, 0), cB, voffB); PG8_STAGE(PG8_SA(0, 0), cA, voffA); PG8_STAGE(PG8_SB(0, 1), cB + bhstep, voffB); PG8_STAGE(PG8_SA(0, 1), cA + hstep, voffA);
        if (wr == 1) PG8_BAR;
        PG8_WAIT_V(4); PG8_BAR;
        PG8_STAGE(PG8_SB(1, 0), cB + kstep, voffB); PG8_STAGE(PG8_SA(1, 0), cA + kstep, voffA); PG8_STAGE(PG8_SB(1, 1), cB + bhstep + kstep, voffB);
        PG8_WAIT_V(6); PG8_BAR;
    }
    for (;;) {
        const bool has_next = S.next(ui + 1, nxt);
        const char* nA = has_next ? (const char*)g.A + (size_t)nxt.pm * tstep : cA; const char* nB = has_next ? (const char*)g.Bt + (size_t)nxt.pn * tstep : cB;
        for (int t = 0; t < nt; t += 2) {
            const bool last = (t == nt - 2);
            const char* a1 = cA + (size_t)(t + 1) * kstep;
            const char* a2 = last ? nA : cA + (size_t)(t + 2) * kstep; const char* b2 = last ? nB : cB + (size_t)(t + 2) * kstep;
            const char* a3 = a2 + kstep; const char* b3 = b2 + kstep;
            if (last && has_next) S.a_ready(nxt);
            if constexpr (SP2) {
            PG8_LDB(B0, 0, 0); PG8_LDB(B1, 0, 1); PG8_SCHED; PG8_LDA(At, 0, 0); PG8_STAGE(PG8_SA(1, 1), a1 + hstep, voffA);
            PG8_WAIT_V(8); PG8_WAIT_L(0); PG8_BAR; PG8_MMA(0, 0, At, B0); PG8_MMA(0, 1, At, B1); PG8_BAR; PG8_SCHED;
            PG8_LDA(At, 0, 1); PG8_STAGE(PG8_SB(0, 0), b2, voffB); PG8_STAGE(PG8_SB(0, 1), b2 + bhstep, voffB); PG8_STAGE(PG8_SA(0, 0), a2, voffA);
            PG8_WAIT_V(8); PG8_WAIT_L(0); PG8_BAR; PG8_MMA(1, 0, At, B0); PG8_MMA(1, 1, At, B1); PG8_BAR; PG8_SCHED;
            PG8_LDB(B0, 1, 0); PG8_LDB(B1, 1, 1); PG8_SCHED; PG8_LDA(At, 1, 0); PG8_STAGE(PG8_SA(0, 1), a2 + hstep, voffA);
            PG8_WAIT_V(8); PG8_WAIT_L(0); PG8_BAR; PG8_MMA(0, 0, At, B0); PG8_MMA(0, 1, At, B1); PG8_BAR; PG8_SCHED;
            PG8_LDA(At, 1, 1); PG8_STAGE(PG8_SB(1, 0), b3, voffB); PG8_STAGE(PG8_SB(1, 1), b3 + bhstep, voffB); PG8_STAGE(PG8_SA(1, 0), a3, voffA);
            PG8_WAIT_V(8); PG8_WAIT_L(0); PG8_BAR; PG8_MMA(1, 0, At, B0); PG8_MMA(1, 1, At, B1); PG8_BAR; PG8_SCHED;
            } else {
            PG8_LDB(B0, 0, 0); PG8_SCHED; PG8_LDA(At, 0, 0); PG8_STAGE(PG8_SA(1, 1), a1 + hstep, voffA);
            PG8_WAIT_L(8); PG8_BAR; PG8_WAIT_L(0); PG8_MMA(0, 0, At, B0); PG8_BAR; PG8_SCHED;
            PG8_LDB(B1, 0, 1); PG8_STAGE(PG8_SB(0, 0), b2, voffB);
            PG8_BAR; PG8_WAIT_L(0); PG8_MMA(0, 1, At, B1); PG8_BAR;
            PG8_LDA(At, 0, 1); PG8_STAGE(PG8_SA(0, 0), a2, voffA);
            PG8_BAR; PG8_WAIT_L(0); PG8_MMA(1, 0, At, B0); PG8_BAR; PG8_SCHED;
            PG8_STAGE(PG8_SB(0, 1), b2 + bhstep, voffB);
            PG8_WAIT_V(6); PG8_BAR; PG8_MMA(1, 1, At, B1); PG8_BAR;
            PG8_LDB(B0, 1, 0); PG8_SCHED; PG8_LDA(At, 1, 0); PG8_STAGE(PG8_SA(0, 1), a2 + hstep, voffA);
            PG8_WAIT_L(8); PG8_BAR; PG8_WAIT_L(0); PG8_MMA(0, 0, At, B0); PG8_BAR; PG8_SCHED;
            PG8_LDB(B1, 1, 1); PG8_STAGE(PG8_SB(1, 0), b3, voffB);
            PG8_BAR; PG8_WAIT_L(0); PG8_MMA(0, 1, At, B1); PG8_BAR;
            PG8_LDA(At, 1, 1); PG8_STAGE(PG8_SA(1, 0), a3, voffA);
            PG8_BAR; PG8_WAIT_L(0); PG8_MMA(1, 0, At, B0); PG8_BAR; PG8_SCHED;
            PG8_STAGE(PG8_SB(1, 1), b3 + bhstep, voffB);
            PG8_WAIT_V(6); PG8_BAR; PG8_MMA(1, 1, At, B1); PG8_BAR;
            }
        }
        if constexpr (ALIGN_EPI) { if (wr == 0) PG8_BAR; }
        if constexpr (!Epi::AFTER_DRAIN) { E(acc, cur, wr, wc, fr, fq); S.done(cur); }
        if (!has_next) break;
#pragma unroll
        for (int a = 0; a < 2; ++a)
#pragma unroll
            for (int b = 0; b < 2; ++b)
#pragma unroll
                for (int m = 0; m < 4; ++m)
#pragma unroll
                    for (int n = 0; n < 2; ++n) acc[a][b][m][n] = (f32x4){0.f, 0.f, 0.f, 0.f};
        cur = nxt; cA = nA; cB = nB; ++ui;
        if constexpr (ALIGN_EPI) { if (wr == 1) PG8_BAR; }
    }
    PG8_WAIT_V(0);
    if constexpr (!ALIGN_EPI) { if (wr == 0) PG8_BAR; }
    PG8_BAR;
    if constexpr (Epi::AFTER_DRAIN) { E.fused(acc, cur, wr, wc, fr, fq, lds, wid, lane); S.done(cur); }
#undef PG8_SA
#undef PG8_SB
#undef PG8_STAGE
#undef PG8_LDA
#undef PG8_LDB
#undef PG8_MMA
#undef PG8_WAIT_V
#undef PG8_WAIT_L
#undef PG8_BAR
#undef PG8_SCHED
}
}

#ifndef PG8_SP2
#define PG8_SP2 true
#endif
#ifndef PG8_ALIGN
#define PG8_ALIGN true
#endif
#ifndef PROBE_B
#define PROBE_B 0
#endif
#ifndef SGB_N
#define SGB_N 16
#endif
#ifndef SGB_V
#define SGB_V 14
#endif
#ifndef PROBE_X
#define PROBE_X 0
#endif
#ifndef PROBE_SYNC
#define PROBE_SYNC 0
#endif

constexpr int TP = 8192;
constexpr int TS = 32768;
constexpr int TT = TP + TS;
constexpr int DM = 1024;
constexpr int NIN = 3072;
constexpr int NLAYER = 4;
constexpr float ALPHA = 1.6817928305074292f;
constexpr float LOG2E = 1.4426950408889634f;
constexpr float C1 = 0.125f * LOG2E;
constexpr size_t OUT_NK = (size_t)TT * DM;
constexpr size_t OUT_NV = OUT_NK + (size_t)32 * 4 * 256 * 256;
constexpr size_t OUT_GK = OUT_NV + (size_t)32 * 4 * 256 * 256;
constexpr size_t OUT_GV = OUT_GK + (size_t)32 * 4 * 256 * 128;

struct Params {
  const float *x_prompt, *x_sample, *c, *cnk, *cnv, *cgk, *cgv, *c_ctx, *w_mod, *b_mod, *w_in, *b_in, *pool_w, *pool_scale,
      *nat_bias, *q_norm, *k_norm, *conv_w, *conv_b, *conv_ln_g, *conv_ln_b, *conv_pw, *w_out, *b_out, *ln_g, *ln_b;
  float* out;
  char* ws;
  int ph0, ph1;
};
constexpr size_t WS_WINT = 0;
constexpr size_t WS_WOUTT = WS_WINT + (size_t)4 * 3072 * 1024 * 2;
constexpr size_t WS_PWT = WS_WOUTT + (size_t)4 * 1024 * 1024 * 2;
constexpr size_t WS_POOLT = WS_PWT + (size_t)4 * 256 * 256 * 2;
constexpr size_t WS_CNK = WS_POOLT + (size_t)16 * 4096 * 2;
constexpr size_t WS_CNV = WS_CNK + (size_t)4194304 * 2;
constexpr size_t WS_CGK = WS_CNV + (size_t)4194304 * 2;
constexpr size_t WS_CGV = WS_CGK + (size_t)2097152 * 2;
constexpr size_t WS_U = WS_CGV + (size_t)2097152 * 2;
constexpr size_t WS_H = WS_U + (size_t)TT * NIN * 2;
constexpr size_t WS_MX = WS_H + (size_t)TT * DM * 2;
constexpr size_t WS_MOD = WS_MX + (size_t)TT * DM * 2;
constexpr size_t WS_STATS = WS_MOD + (size_t)4 * 9 * 3072 * 4;
constexpr size_t WS_CNT = WS_STATS + (size_t)TT * 2 * 4;
constexpr size_t WS_BAR = WS_CNT + 8192;
#define P_WinT ((bf16_t*)(p.ws + WS_WINT))
#define P_WoutT ((bf16_t*)(p.ws + WS_WOUTT))
#define P_pwT ((bf16_t*)(p.ws + WS_PWT))
#define P_poolT ((bf16_t*)(p.ws + WS_POOLT))
#define P_cnk_b ((bf16_t*)(p.ws + WS_CNK))
#define P_cnv_b ((bf16_t*)(p.ws + WS_CNV))
#define P_cgk_b ((bf16_t*)(p.ws + WS_CGK))
#define P_cgv_b ((bf16_t*)(p.ws + WS_CGV))
#define P_U ((bf16_t*)(p.ws + WS_U))
#define P_H ((bf16_t*)(p.ws + WS_H))
#define P_MX ((bf16_t*)(p.ws + WS_MX))
#define P_mod ((float*)(p.ws + WS_MOD))
#define P_stats ((float*)(p.ws + WS_STATS))
#define P_cnt ((unsigned*)(p.ws + WS_CNT))
#define P_bar ((unsigned*)(p.ws + WS_BAR))

DEV float bf2f(bf16_t h) { return __uint_as_float(((unsigned)h) << 16); }
DEV unsigned pk2(float lo, float hi) { f32x2 v = {lo, hi}; bf16x2_t b = __builtin_convertvector(v, bf16x2_t); return __builtin_bit_cast(unsigned, b); }
DEV bf16_t f2bf(float f) { return (bf16_t)(pk2(f, 0.f) & 0xffffu); }
DEV float bflo(unsigned w) { return __uint_as_float(w << 16); }
DEV float bfhi(unsigned w) { return __uint_as_float(w & 0xffff0000u); }
DEV float silu_f(float x) { return x * __builtin_amdgcn_rcpf(1.f + __expf(-x)); }
DEV float sigm_f(float x) { return __builtin_amdgcn_rcpf(1.f + __expf(-x)); }
DEV f32x4 mfma16(bf16x8 a, bf16x8 b, f32x4 c) { return __builtin_amdgcn_mfma_f32_16x16x32_bf16(a, b, c, 0, 0, 0); }
typedef short v4i16_t __attribute__((ext_vector_type(4)));
DEV s16x4 tr16(const char* p) {
  return __builtin_bit_cast(s16x4, __builtin_amdgcn_ds_read_tr16_b64_v4i16((__attribute__((address_space(3))) v4i16_t*)p));
}
DEV float xr16(float v, bool mx) {
  auto r = __builtin_amdgcn_permlane16_swap(__float_as_uint(v), __float_as_uint(v), false, false);
  const float a = __uint_as_float(r[0]), b = __uint_as_float(r[1]);
  return mx ? fmaxf(a, b) : a + b;
}
DEV float xr32(float v, bool mx) {
  auto r = __builtin_amdgcn_permlane32_swap(__float_as_uint(v), __float_as_uint(v), false, false);
  const float a = __uint_as_float(r[0]), b = __uint_as_float(r[1]);
  return mx ? fmaxf(a, b) : a + b;
}
DEV float wave_sum(float v) {
  v += __shfl_xor(v, 1); v += __shfl_xor(v, 2); v += __shfl_xor(v, 4); v += __shfl_xor(v, 8); v += __shfl_xor(v, 16); v += __shfl_xor(v, 32);
  return v;
}
DEV int get_tid() { int t = threadIdx.x & 255; asm volatile("" : "+v"(t)); return t; }
DEV int get_half() { return __builtin_amdgcn_readfirstlane((int)(threadIdx.x >> 8)); }
DEV int cond_of_row(int row) { return row < TP ? 0 : 1 + ((row - TP) >> 12); }

DEV void tconv_tile(const float* src, int sld, bf16_t* dst, int dld, char* smem) {
  float* t = (float*)smem;
  const int tid = get_tid();
#pragma unroll
  for (int i = 0; i < 16; ++i) { int idx = tid + i * 256; int r = idx >> 6, c = idx & 63; t[r * 65 + c] = src[(size_t)r * sld + c]; }
  __syncthreads();
#pragma unroll
  for (int i = 0; i < 16; ++i) { int idx = tid + i * 256; int n = idx >> 6, k = idx & 63; dst[(size_t)n * dld + k] = f2bf(t[k * 65 + n]); }
  __syncthreads();
}

DEV void cvt_unit(const float* src, bf16_t* dst, int u) {
  const size_t base = (size_t)u * 16384;
  const int tid = get_tid();
#pragma unroll
  for (int i = 0; i < 16; ++i) {
    size_t e = base + (size_t)(i * 256 + tid) * 4;
    f32x4 v = *(const f32x4*)(src + e);
    u32x2 w; w.x = pk2(v[0], v[1]); w.y = pk2(v[2], v[3]);
    *(u32x2*)(dst + e) = w;
  }
}

DEV void mod_unit(const Params& p, int u, char* smem) {
  const int l = u / 48, n0 = (u % 48) * 64, tid = get_tid();
  float* sc = (float*)smem;
  float* red = (float*)(smem + 36864);
  for (int i = tid; i < 9216; i += 256) { int c = i >> 10, k = i & 1023; float v = (c == 0) ? p.c_ctx[k] : p.c[(c - 1) * 1024 + k]; sc[i] = silu_f(v); }
  __syncthreads();
  const int kq = tid >> 6, col = n0 + (tid & 63);
  float acc[9];
#pragma unroll
  for (int c = 0; c < 9; ++c) acc[c] = 0.f;
  const float* wp = p.w_mod + ((size_t)l * 1024 + kq * 256) * 3072 + col;
#pragma unroll 8
  for (int k = 0; k < 256; ++k) {
    float w = wp[(size_t)k * 3072];
#pragma unroll
    for (int c = 0; c < 9; ++c) acc[c] += sc[c * 1024 + kq * 256 + k] * w;
  }
#pragma unroll
  for (int c = 0; c < 9; ++c) red[(kq * 9 + c) * 64 + (tid & 63)] = acc[c];
  __syncthreads();
  for (int i = tid; i < 576; i += 256) {
    int c = i >> 6, j = i & 63;
    float s = red[(0 * 9 + c) * 64 + j] + red[(1 * 9 + c) * 64 + j] + red[(2 * 9 + c) * 64 + j] + red[(3 * 9 + c) * 64 + j];
    P_mod[((size_t)l * 9 + c) * 3072 + n0 + j] = s + p.b_mod[l * 3072 + n0 + j];
  }
  __syncthreads();
}

DEV void h0_unit(const Params& p, int u) {
  const int tid = get_tid(), col = tid * 4;
  const int row0 = u * 32;
  const int cond = cond_of_row(row0);
  const float* md = P_mod + (size_t)cond * 3072;
  const f32x4 sh = *(const f32x4*)(md + col), sc = *(const f32x4*)(md + 1024 + col);
#pragma unroll 4
  for (int i = 0; i < 32; ++i) {
    const int row = row0 + i;
    const float* xr = (row < TP) ? p.x_prompt + (size_t)row * DM : p.x_sample + (size_t)(row - TP) * DM;
    f32x4 x = *(const f32x4*)(xr + col);
    u32x2 w; w.x = pk2(x[0] * (1.f + sc[0]) + sh[0], x[1] * (1.f + sc[1]) + sh[1]); w.y = pk2(x[2] * (1.f + sc[2]) + sh[2], x[3] * (1.f + sc[3]) + sh[3]);
    *(u32x2*)(P_H + (size_t)row * DM + col) = w;
  }
}

struct EpiA {
  static constexpr bool PERM = false, AFTER_DRAIN = false;
  const Params& p; int l;
  DEV void operator()(f32x4 (&acc)[2][2][4][2], const pg8::Unit& u, int wr, int wc, int fr, int fq) const {
    const int colb = u.pn * 256 + wc * 64;
    const int reg = colb >> 6;
    const bool prompt = (u.pm * 256) < TP;
    f32x4 bias[2][2];
#pragma unroll
    for (int bj = 0; bj < 2; ++bj)
#pragma unroll
      for (int n = 0; n < 2; ++n) bias[bj][n] = *(const f32x4*)(p.b_in + l * 3072 + colb + bj * 32 + n * 16 + 4 * fq);
    const bool rms = (reg >= 36 && reg < 42);
    f32x4 gg[2][2];
    if (rms) {
      const float* gptr = (reg < 40 ? p.q_norm : p.k_norm) + l * 64;
#pragma unroll
      for (int bj = 0; bj < 2; ++bj)
#pragma unroll
        for (int n = 0; n < 2; ++n) gg[bj][n] = *(const f32x4*)(gptr + bj * 32 + n * 16 + 4 * fq);
    }
    float* ob = nullptr; int hw = 0, cofs = 0;
    if (prompt) {
      if (reg >= 12 && reg < 16) { ob = p.out + OUT_NK; hw = 256; cofs = colb - 768; }
      else if (reg >= 16 && reg < 20) { ob = p.out + OUT_NV; hw = 256; cofs = colb - 1024; }
      else if (reg >= 40 && reg < 42) { ob = p.out + OUT_GK; hw = 128; cofs = colb - 2560; }
      else if (reg >= 42 && reg < 44) { ob = p.out + OUT_GV; hw = 128; cofs = colb - 2688; }
    }
#pragma unroll
    for (int ai = 0; ai < 2; ++ai)
#pragma unroll
      for (int m = 0; m < 4; ++m) {
        const int row = u.pm * 256 + ai * 128 + wr * 64 + m * 16 + fr;
        f32x4 v[2][2];
#pragma unroll
        for (int bj = 0; bj < 2; ++bj)
#pragma unroll
          for (int n = 0; n < 2; ++n) v[bj][n] = acc[ai][bj][m][n] + bias[bj][n];
        if (rms) {
          float ss = 0.f;
#pragma unroll
          for (int bj = 0; bj < 2; ++bj)
#pragma unroll
            for (int n = 0; n < 2; ++n)
#pragma unroll
              for (int j = 0; j < 4; ++j) ss += v[bj][n][j] * v[bj][n][j];
          ss += __shfl_xor(ss, 16); ss += __shfl_xor(ss, 32);
          const float r = rsqrtf(ss * (1.f / 64.f) + 1e-6f);
#pragma unroll
          for (int bj = 0; bj < 2; ++bj)
#pragma unroll
            for (int n = 0; n < 2; ++n) v[bj][n] = v[bj][n] * r * gg[bj][n];
          if (!prompt) {
            const int t = (row - TP) & 4095, pr = t >> 6, pc = t & 63;
            const f32x4 c0 = *(const f32x4*)(ROPE_COS + pr * 16 + 4 * fq), s0 = *(const f32x4*)(ROPE_SIN + pr * 16 + 4 * fq);
            const f32x4 c1 = *(const f32x4*)(ROPE_COS + pc * 16 + 4 * fq), s1 = *(const f32x4*)(ROPE_SIN + pc * 16 + 4 * fq);
            const f32x4 x1 = v[0][0], x2 = v[0][1], y1 = v[1][0], y2 = v[1][1];
            v[0][0] = x1 * c0 - x2 * s0; v[0][1] = x2 * c0 + x1 * s0;
            v[1][0] = y1 * c1 - y2 * s1; v[1][1] = y2 * c1 + y1 * s1;
          }
        }
        bf16_t* up = P_U + (size_t)row * NIN + colb + 4 * fq;
#pragma unroll
        for (int bj = 0; bj < 2; ++bj)
#pragma unroll
          for (int n = 0; n < 2; ++n) { u32x2 w; w.x = pk2(v[bj][n][0], v[bj][n][1]); w.y = pk2(v[bj][n][2], v[bj][n][3]); *(u32x2*)(up + bj * 32 + n * 16) = w; }
        if (ob) {
          const int b = row >> 8, sq = row & 255;
          float* op = ob + ((size_t)(b * 4 + l) * 256 + sq) * hw + cofs + 4 * fq;
#pragma unroll
          for (int bj = 0; bj < 2; ++bj)
#pragma unroll
            for (int n = 0; n < 2; ++n) *(f32x4*)(op + bj * 32 + n * 16) = v[bj][n];
        }
      }
  }
};

struct EpiC {
  static constexpr bool PERM = false, AFTER_DRAIN = false;
  const Params& p; int l;
  DEV void operator()(f32x4 (&acc)[2][2][4][2], const pg8::Unit& u, int wr, int wc, int fr, int fq) const {
    const int colb = u.pn * 256 + wc * 64 + 4 * fq;
    const int cond = cond_of_row(u.pm * 256);
    const float* gatep = P_mod + ((size_t)l * 9 + cond) * 3072 + 2048;
    float* Y = p.out;
#pragma unroll
    for (int ai = 0; ai < 2; ++ai)
#pragma unroll
      for (int m = 0; m < 4; ++m) {
        const int row = u.pm * 256 + ai * 128 + wr * 64 + m * 16 + fr;
        float mean = 0.f, rstd = 1.f;
        const float* xr;
        if (l == 0) xr = (row < TP) ? p.x_prompt + (size_t)row * DM : p.x_sample + (size_t)(row - TP) * DM;
        else { xr = Y + (size_t)row * DM; mean = P_stats[row * 2]; rstd = P_stats[row * 2 + 1]; }
#pragma unroll
        for (int bj = 0; bj < 2; ++bj)
#pragma unroll
          for (int n = 0; n < 2; ++n) {
            const int col = colb + bj * 32 + n * 16;
            f32x4 xo = *(const f32x4*)(xr + col);
            if (l > 0) {
              const f32x4 g = *(const f32x4*)(p.ln_g + (l - 1) * 1024 + col), b = *(const f32x4*)(p.ln_b + (l - 1) * 1024 + col);
              xo = (xo - mean) * rstd * g + b;
            }
            const f32x4 gt = *(const f32x4*)(gatep + col), bo = *(const f32x4*)(p.b_out + l * 1024 + col);
            f32x4 y = xo * ALPHA + gt * (acc[ai][bj][m][n] + bo);
            *(f32x4*)(Y + (size_t)row * DM + col) = y;
          }
      }
  }
};

DEV void ln_unit(const Params& p, int l, int u) {
  const int tid = get_tid(), lane = tid & 63, wid = tid >> 6;
  float* Y = p.out;
  {
    const int row = u * 4 + wid;
    float* yr = Y + (size_t)row * DM;
    f32x4 v[4];
#pragma unroll
    for (int q = 0; q < 4; ++q) v[q] = *(const f32x4*)(yr + q * 256 + lane * 4);
    float s = 0.f;
#pragma unroll
    for (int q = 0; q < 4; ++q) s += (v[q][0] + v[q][1]) + (v[q][2] + v[q][3]);
    const float mean = wave_sum(s) * (1.f / 1024.f);
    float s2 = 0.f;
#pragma unroll
    for (int q = 0; q < 4; ++q) { v[q] = v[q] - mean; s2 += (v[q][0] * v[q][0] + v[q][1] * v[q][1]) + (v[q][2] * v[q][2] + v[q][3] * v[q][3]); }
    const float rstd = rsqrtf(wave_sum(s2) * (1.f / 1024.f) + 1e-5f);
    const int cond = cond_of_row(row);
#pragma unroll
    for (int q = 0; q < 4; ++q) {
      const int col = q * 256 + lane * 4;
      const f32x4 g = *(const f32x4*)(p.ln_g + l * 1024 + col), b = *(const f32x4*)(p.ln_b + l * 1024 + col);
      f32x4 x = v[q] * rstd * g + b;
      if (l < NLAYER - 1) {
        const float* md = P_mod + ((size_t)(l + 1) * 9 + cond) * 3072;
        const f32x4 sh = *(const f32x4*)(md + col), sc = *(const f32x4*)(md + 1024 + col);
        f32x4 h = x * (sc + 1.f) + sh;
        u32x2 w; w.x = pk2(h[0], h[1]); w.y = pk2(h[2], h[3]);
        *(u32x2*)(P_H + (size_t)row * DM + col) = w;
      } else {
        *(f32x4*)(yr + col) = x;
      }
    }
    if (l < NLAYER - 1 && lane == 0) { P_stats[row * 2] = mean; P_stats[row * 2 + 1] = rstd; }
  }
}

DEV int kswz(int key, int ch) {
  const int ob = (key & 15) * 64 + (ch & 3) * 16;
  return ((key >> 4) * 2 + (ch >> 2)) * 1024 + (ob ^ (((ob >> 9) & 1) << 5));
}
template <int NQ, int NKT>
DEV void qk_tile(const char* kb, int koff, const bf16x8 (&qf)[NQ][2], f32x4 (&s)[NQ][4], int fr, int fq) {
#pragma unroll
  for (int t = 0; t < NKT; ++t) {
    const int key = koff + 16 * t + fr;
    const bf16x8 k0 = *(const bf16x8*)(kb + kswz(key, fq)), k1 = *(const bf16x8*)(kb + kswz(key, 4 + fq));
#pragma unroll
    for (int g = 0; g < NQ; ++g) { f32x4 z = {0.f, 0.f, 0.f, 0.f}; z = mfma16(k0, qf[g][0], z); z = mfma16(k1, qf[g][1], z); s[g][t] = z; }
  }
}
template <int NQ, int NKT, bool NATL>
DEV void softmax_pv(const char* vs, int koff, f32x4 (&s)[NQ][4], f32x4 (&o)[NQ][4], float (&mrun)[NQ], float (&lrun)[NQ],
                    int fr, int fq, const float* biasrow, int qc) {
#pragma unroll
  for (int g = 0; g < NQ; ++g) {
    float mx = -1e30f;
    if (NATL) {
      const int cs = min(max(qc - 8, 0), 48);
#pragma unroll
      for (int t = 0; t < NKT; ++t)
#pragma unroll
        for (int j = 0; j < 4; ++j) {
          const int kc = koff + 16 * t + 4 * fq + j;
          const bool valid = (kc >= cs) && (kc < cs + 16);
          const int dc = min(max(kc - qc + 15, 0), 30);
          const float bv = biasrow[dc];
          const float x = valid ? s[g][t][j] * C1 + bv : -1e30f;
          s[g][t][j] = x; mx = fmaxf(mx, x);
        }
    } else {
#pragma unroll
      for (int t = 0; t < NKT; ++t)
#pragma unroll
        for (int j = 0; j < 4; ++j) mx = fmaxf(mx, s[g][t][j]);
      mx *= C1;
    }
    mx = xr16(mx, true); mx = xr32(mx, true);
    if (__builtin_amdgcn_ballot_w64(mx > mrun[g] + 8.0f) != 0ull) {
      const float mn = fmaxf(mrun[g], mx);
      const float al = __builtin_amdgcn_exp2f(mrun[g] - mn);
      mrun[g] = mn; lrun[g] *= al;
#pragma unroll
      for (int dt = 0; dt < 4; ++dt) o[g][dt] = o[g][dt] * al;
    }
    const float mn = mrun[g];
    float ps = 0.f;
#pragma unroll
    for (int t = 0; t < NKT; ++t)
#pragma unroll
      for (int j = 0; j < 4; ++j) {
        const float pp = NATL ? __builtin_amdgcn_exp2f(s[g][t][j] - mn) : __builtin_amdgcn_exp2f(__builtin_fmaf(s[g][t][j], C1, -mn));
        s[g][t][j] = pp; ps += pp;
      }
    lrun[g] += ps;
  }
#pragma unroll
  for (int u = 0; u < NKT / 2; ++u) {
    bf16x8 pf[NQ];
#pragma unroll
    for (int g = 0; g < NQ; ++g) {
      u32x4 w;
      w.x = pk2(s[g][2 * u][0], s[g][2 * u][1]); w.y = pk2(s[g][2 * u][2], s[g][2 * u][3]);
      w.z = pk2(s[g][2 * u + 1][0], s[g][2 * u + 1][1]); w.w = pk2(s[g][2 * u + 1][2], s[g][2 * u + 1][3]);
      pf[g] = __builtin_bit_cast(bf16x8, w);
    }
#pragma unroll
    for (int dt = 0; dt < 4; ++dt) {
      const char* vp = vs + (koff + 32 * u + 4 * fq + (fr >> 2)) * 160 + dt * 32 + (fr & 3) * 8;
      const s16x4 lo = tr16(vp), hi = tr16(vp + 16 * 160);
      const bf16x8 vf = {lo[0], lo[1], lo[2], lo[3], hi[0], hi[1], hi[2], hi[3]};
#pragma unroll
      for (int g = 0; g < NQ; ++g) o[g][dt] = mfma16(vf, pf[g], o[g][dt]);
    }
  }
}

template <int MODE>
DEV void attn_unit(const Params& p, int l, int u, char* smem, char* smem0, int half) {
  constexpr int NQ = (MODE == 1) ? 1 : 2;
  constexpr int NLD = (MODE == 0) ? 1 : 2;
  if constexpr (MODE == 0) smem = smem0;
  const int tid = get_tid(), lane = tid & 63, wid = tid >> 6, fr = lane & 15, fq = lane >> 4;
  int qrow0, qcol, gcol, ocol, NT, NLOC, cstride = 0;
  const bf16_t *kU, *vU, *kC = nullptr, *vC = nullptr;
  int nat_r = 0, nat_rs = 0;
  if (MODE == 0) {
    const int g = u & 1, qb = (u >> 1) & 31, kvh = (u >> 6) & 1, b = u >> 7, h = kvh * 2 + g;
    qrow0 = TP + b * 4096 + qb * 128 + wid * 32; qcol = 2304 + h * 64; gcol = 2816 + h * 64; ocol = 768 + h * 64;
    kU = P_U + (size_t)(TP + b * 4096) * NIN + 2560 + kvh * 64; vU = kU + 128; NLOC = 64; NT = 72;
    kC = P_cgk_b + ((size_t)(b * 4 + l) * 512 * 2 + kvh) * 64; vC = P_cgv_b + ((size_t)(b * 4 + l) * 512 * 2 + kvh) * 64; cstride = 128;
  } else if (MODE == 1) {
    const int r = u & 63, h = (u >> 6) & 3, b = u >> 8;
    nat_r = r; nat_rs = min(max(r - 4, 0), 56);
    qrow0 = TP + b * 4096 + r * 64 + wid * 16; qcol = 512 + h * 64; gcol = 1280 + h * 64; ocol = 256 + h * 64;
    kU = P_U + (size_t)(TP + b * 4096 + nat_rs * 64) * NIN + 768 + h * 64; vU = kU + 256; NLOC = 8; NT = 16;
    kC = P_cnk_b + ((size_t)(b * 4 + l) * 512 * 4 + h) * 64; vC = P_cnv_b + ((size_t)(b * 4 + l) * 512 * 4 + h) * 64; cstride = 256;
    float* blw = (float*)(smem + 36864);
    for (int i = tid; i < 465; i += 256) blw[i] = p.nat_bias[(size_t)(l * 4 + h) * 465 + i] * LOG2E;
  } else {
    const int qb = u & 1, hh = (u >> 1) & 7, b = u >> 4;
    qrow0 = b * 256 + qb * 128 + wid * 32; NLOC = 4; NT = 4;
    int kcol;
    if (hh < 4) { qcol = 512 + hh * 64; kcol = 768 + hh * 64; gcol = 1280 + hh * 64; ocol = 256 + hh * 64; kU = P_U + (size_t)(b * 256) * NIN + kcol; vU = kU + 256; }
    else { const int h = hh - 4; qcol = 2304 + h * 64; kcol = 2560 + (h >> 1) * 64; gcol = 2816 + h * 64; ocol = 768 + h * 64; kU = P_U + (size_t)(b * 256) * NIN + kcol; vU = kU + 128; }
  }
  bf16x8 qf[NQ][2];
#pragma unroll
  for (int g = 0; g < NQ; ++g)
#pragma unroll
    for (int ks = 0; ks < 2; ++ks) qf[g][ks] = *(const bf16x8*)(P_U + (size_t)(qrow0 + g * 16 + fr) * NIN + qcol + ks * 32 + fq * 8);
#pragma unroll
  for (int g = 0; g < NQ; ++g)
#pragma unroll
    for (int ks = 0; ks < 2; ++ks) asm volatile("" : "+v"(qf[g][ks]));
  f32x4 o[NQ][4]; float mrun[NQ], lrun[NQ];
#pragma unroll
  for (int g = 0; g < NQ; ++g) { mrun[g] = -1e30f; lrun[g] = 0.f;
#pragma unroll
    for (int dt = 0; dt < 4; ++dt) o[g][dt] = (f32x4){0.f, 0.f, 0.f, 0.f}; }
  u32x4 rkA[NLD], rvA[NLD], rkB[NLD], rvB[NLD];
  const int ltid = (MODE == 0) ? half * 256 + tid : tid;
  const int lrow = ltid >> 3, lc = ltid & 7;
  auto glK = [&](int t, u32x4 (&rk)[NLD]) {
    const bf16_t* kp; int st;
    if (t < NLOC) { kp = kU + (size_t)t * 64 * NIN; st = NIN; } else { kp = kC + (size_t)(t - NLOC) * 64 * cstride; st = cstride; }
#pragma unroll
    for (int i = 0; i < NLD; ++i) rk[i] = *(const u32x4*)(kp + (size_t)(lrow + i * 32) * st + lc * 8);
  };
  auto glV = [&](int t, u32x4 (&rv)[NLD]) {
    const bf16_t* vp; int st;
    if (t < NLOC) { vp = vU + (size_t)t * 64 * NIN; st = NIN; } else { vp = vC + (size_t)(t - NLOC) * 64 * cstride; st = cstride; }
#pragma unroll
    for (int i = 0; i < NLD; ++i) rv[i] = *(const u32x4*)(vp + (size_t)(lrow + i * 32) * st + lc * 8);
  };
  auto stK = [&](int buf, const u32x4 (&rk)[NLD]) {
#pragma unroll
    for (int i = 0; i < NLD; ++i) *(u32x4*)(smem + buf * 8192 + kswz(lrow + i * 32, lc)) = rk[i];
  };
  auto stV = [&](int buf, const u32x4 (&rv)[NLD]) {
#pragma unroll
    for (int i = 0; i < NLD; ++i) *(u32x4*)(smem + 16384 + buf * 10240 + (lrow + i * 32) * 160 + lc * 16) = rv[i];
  };
  const float* bl = (const float*)(smem + 36864);
  const int kcw = (wid == 0) ? 0 : (wid == 1) ? 8 : (wid == 2) ? 24 : 32;
  auto qk = [&](int t, f32x4 (&sd)[NQ][4]) {
    const char* kb = smem + (t & 1) * 8192;
    if constexpr (MODE == 1) { if (t < 8) qk_tile<1, 2>(kb, kcw, qf, sd, fr, fq); else qk_tile<1, 4>(kb, 0, qf, sd, fr, fq); }
    else qk_tile<NQ, 4>(kb, 0, qf, sd, fr, fq);
  };
  auto sp = [&](int t, f32x4 (&sd)[NQ][4]) {
    const char* vs = smem + 16384 + (t & 1) * 10240;
    if constexpr (MODE == 1) {
      if (t < 8) softmax_pv<1, 2, true>(vs, kcw, sd, o, mrun, lrun, fr, fq, bl + (nat_rs + t - nat_r + 7) * 31, wid * 16 + fr);
      else softmax_pv<1, 4, false>(vs, 0, sd, o, mrun, lrun, fr, fq, nullptr, 0);
    } else softmax_pv<NQ, 4, false>(vs, 0, sd, o, mrun, lrun, fr, fq, nullptr, 0);
  };
  auto iter = [&](int t, f32x4 (&sc)[NQ][4], f32x4 (&sn)[NQ][4], u32x4 (&rkX)[NLD], u32x4 (&rvX)[NLD], u32x4 (&rkY)[NLD], u32x4 (&rvY)[NLD]) {
    glK(min(t + 3, NT - 1), rkX);
    glV(min(t + 2, NT - 1), rvX);
    qk(t + 1, sn);
    sp(t, sc);
    stK(t & 1, rkY);
    stV((t + 1) & 1, rvY);
    __syncthreads();
  };
  glK(0, rkA); glV(0, rvA); stK(0, rkA); stV(0, rvA);
  glK(1, rkA); stK(1, rkA);
  glK(2, rkB); glV(1, rvB);
  __syncthreads();
  f32x4 sA[NQ][4], sB[NQ][4];
  qk(0, sA);
#pragma unroll 1
  for (int t = 0; t < NT; t += 2) { iter(t, sA, sB, rkA, rvA, rkB, rvB); iter(t + 1, sB, sA, rkB, rvB, rkA, rvA); }
#pragma unroll
  for (int g = 0; g < NQ; ++g) {
    float lt = lrun[g]; lt = xr16(lt, false); lt = xr32(lt, false);
    const float inv = __builtin_amdgcn_rcpf(lt);
    const int row = qrow0 + g * 16 + fr;
#pragma unroll
    for (int dt = 0; dt < 4; ++dt) {
      const int d0 = dt * 16 + 4 * fq;
      const u32x2 gw = *(const u32x2*)(P_U + (size_t)row * NIN + gcol + d0);
      u32x2 w;
      w.x = pk2(o[g][dt][0] * inv * silu_f(bflo(gw.x)), o[g][dt][1] * inv * silu_f(bfhi(gw.x)));
      w.y = pk2(o[g][dt][2] * inv * silu_f(bflo(gw.y)), o[g][dt][3] * inv * silu_f(bfhi(gw.y)));
      *(u32x2*)(P_MX + (size_t)row * DM + ocol + d0) = w;
    }
  }
}

DEV void pool_unit(const Params& p, int l, int u, char* smem) {
  const int tid = get_tid(), lane = tid & 63, wid = tid >> 6, fr = lane & 15, fq = lane >> 4;
  const int R0 = u * 32;
  int L, sb;
  if (R0 < TP) { L = 256; sb = R0 & ~255; } else { L = 4096; sb = TP + ((R0 - TP) & ~4095); }
  const int t0 = R0 - sb;
  bf16_t* xs = (bf16_t*)smem;
  bf16_t* ya = (bf16_t*)(smem + 24576);
#pragma unroll
  for (int k = 0; k < 6; ++k) {
    const int idx = tid + k * 256, i = idx >> 5, c8 = (idx & 31) * 8, t = t0 - 8 + i;
    u32x4 w = {0u, 0u, 0u, 0u};
    if (t >= 0 && t < L) w = *(const u32x4*)(P_U + (size_t)(sb + t) * NIN + c8);
    *(u32x4*)(xs + i * 256 + c8) = w;
  }
  __syncthreads();
  {
    const int c = tid, g = c >> 6, win = 2 << g, half = win >> 1;
    float sum = 0.f;
    for (int i = 0; i < win; ++i) sum += bf2f(xs[(8 - half + i) * 256 + c]);
#pragma unroll 8
    for (int tt = 0; tt < 32; ++tt) {
      const int t = t0 + tt;
      const int lo = max(t - half, 0), hi = min(t - half + win, L);
      const float y = sum / (float)(hi - lo) - bf2f(xs[(tt + 8) * 256 + c]);
      ya[tt * 264 + c] = f2bf(y);
      sum += bf2f(xs[(tt + 8 - half + win) * 256 + c]) - bf2f(xs[(tt + 8 - half) * 256 + c]);
    }
  }
  __syncthreads();
  const int g = wid;
  f32x4 acc[2][4];
#pragma unroll
  for (int m = 0; m < 2; ++m)
#pragma unroll
    for (int n = 0; n < 4; ++n) acc[m][n] = (f32x4){0.f, 0.f, 0.f, 0.f};
  const bf16_t* wt = P_poolT + (size_t)(l * 4 + g) * 4096;
#pragma unroll
  for (int ks = 0; ks < 2; ++ks) {
    bf16x8 af[2], bfr[4];
#pragma unroll
    for (int m = 0; m < 2; ++m) af[m] = *(const bf16x8*)(smem + 24576 + (m * 16 + fr) * 528 + (g * 64 + ks * 32 + fq * 8) * 2);
#pragma unroll
    for (int n = 0; n < 4; ++n) bfr[n] = *(const bf16x8*)(wt + (n * 16 + fr) * 64 + ks * 32 + fq * 8);
#pragma unroll
    for (int m = 0; m < 2; ++m)
#pragma unroll
      for (int n = 0; n < 4; ++n) acc[m][n] = mfma16(bfr[n], af[m], acc[m][n]);
  }
#pragma unroll
  for (int m = 0; m < 2; ++m) {
    const int row = R0 + m * 16 + fr;
#pragma unroll
    for (int n = 0; n < 4; ++n) {
      const int ch = g * 64 + n * 16 + 4 * fq;
      const f32x4 sc = *(const f32x4*)(p.pool_scale + l * 256 + ch);
      const u32x2 gw = *(const u32x2*)(P_U + (size_t)row * NIN + 256 + ch);
      u32x2 w;
      w.x = pk2(acc[m][n][0] * sc[0] * silu_f(bflo(gw.x)), acc[m][n][1] * sc[1] * silu_f(bfhi(gw.x)));
      w.y = pk2(acc[m][n][2] * sc[2] * silu_f(bflo(gw.y)), acc[m][n][3] * sc[3] * silu_f(bfhi(gw.y)));
      *(u32x2*)(P_MX + (size_t)row * DM + ch) = w;
    }
  }
  __syncthreads();
}

DEV void conv_unit(const Params& p, int l, int u, char* smem) {
  const int tid = get_tid(), lane = tid & 63, wid = tid >> 6, fr = lane & 15, fq = lane >> 4;
  const int R0 = u * 64;
  int L, sb;
  if (R0 < TP) { L = 256; sb = R0 & ~255; } else { L = 4096; sb = TP + ((R0 - TP) & ~4095); }
  const int t0 = R0 - sb;
  bf16_t* zs = (bf16_t*)smem;
  bf16_t* za = (bf16_t*)smem;
  float* cs = (float*)(smem + 48128);
  float* red = (float*)(smem + 64768);
#pragma unroll 8
  for (int it = 0; it < 24; ++it) {
    const int idx = tid + it * 256;
    if (idx >= 94 * 64) break;
    const int i = idx >> 6, cq = (idx & 63) * 4, t = t0 - 15 + i;
    u32x2 w = {0u, 0u};
    if (t >= 0 && t < L) {
      const bf16_t* ur = P_U + (size_t)(sb + t) * NIN;
      const u32x2 vv = *(const u32x2*)(ur + 1536 + cq), gg = *(const u32x2*)(ur + 1792 + cq);
      w.x = pk2(bflo(vv.x) * sigm_f(bflo(gg.x)), bfhi(vv.x) * sigm_f(bfhi(gg.x)));
      w.y = pk2(bflo(vv.y) * sigm_f(bflo(gg.y)), bfhi(vv.y) * sigm_f(bfhi(gg.y)));
    }
    *(u32x2*)(zs + i * 256 + cq) = w;
  }
  __syncthreads();
  const int c = tid;
  float wj[31];
#pragma unroll
  for (int j = 0; j < 31; ++j) wj[j] = p.conv_w[(size_t)(l * 31 + j) * 256 + c];
  const float cb = p.conv_b[l * 256 + c], lg = p.conv_ln_g[l * 256 + c], lb = p.conv_ln_b[l * 256 + c];
  float a[4][16];
#pragma unroll
  for (int ch = 0; ch < 4; ++ch) {
    float zr[46];
#pragma unroll
    for (int i = 0; i < 46; ++i) zr[i] = bf2f(zs[(ch * 16 + i) * 256 + c]);
#pragma unroll
    for (int i = 0; i < 16; ++i) {
      float s = cb;
#pragma unroll
      for (int j = 0; j < 31; ++j) s += zr[i + j] * wj[j];
      a[ch][i] = s;
      cs[i * 260 + c] = s;
    }
    __syncthreads();
    {
      const int i2 = tid >> 4, sl = tid & 15;
      float s1 = 0.f, s2 = 0.f;
#pragma unroll
      for (int q = 0; q < 4; ++q) {
        const f32x4 v = *(const f32x4*)(cs + i2 * 260 + sl * 16 + q * 4);
        s1 += (v[0] + v[1]) + (v[2] + v[3]);
        s2 += (v[0] * v[0] + v[1] * v[1]) + (v[2] * v[2] + v[3] * v[3]);
      }
      s1 += __shfl_xor(s1, 1); s2 += __shfl_xor(s2, 1);
      s1 += __shfl_xor(s1, 2); s2 += __shfl_xor(s2, 2);
      s1 += __shfl_xor(s1, 4); s2 += __shfl_xor(s2, 4);
      s1 += __shfl_xor(s1, 8); s2 += __shfl_xor(s2, 8);
      if (sl == 0) { red[(ch * 16 + i2) * 2] = s1; red[(ch * 16 + i2) * 2 + 1] = s2; }
    }
    __syncthreads();
  }
#pragma unroll
  for (int ch = 0; ch < 4; ++ch)
#pragma unroll
    for (int i = 0; i < 16; ++i) {
      const int tt = ch * 16 + i;
      const float mean = red[tt * 2] * (1.f / 256.f);
      const float var = fmaxf(red[tt * 2 + 1] * (1.f / 256.f) - mean * mean, 0.f);
      const float rstd = rsqrtf(var + 1e-5f);
      const float v = (a[ch][i] - mean) * rstd * lg + lb;
      za[tt * 264 + c] = f2bf(silu_f(v));
    }
  __syncthreads();
  f32x4 acc[4][4];
#pragma unroll
  for (int m = 0; m < 4; ++m)
#pragma unroll
    for (int n = 0; n < 4; ++n) acc[m][n] = (f32x4){0.f, 0.f, 0.f, 0.f};
  const bf16_t* wt = P_pwT + (size_t)l * 65536;
#pragma unroll
  for (int ks = 0; ks < 8; ++ks) {
    bf16x8 af[4], bfr[4];
#pragma unroll
    for (int m = 0; m < 4; ++m) af[m] = *(const bf16x8*)(smem + (m * 16 + fr) * 528 + (ks * 32 + fq * 8) * 2);
#pragma unroll
    for (int n = 0; n < 4; ++n) bfr[n] = *(const bf16x8*)(wt + (size_t)(wid * 64 + n * 16 + fr) * 256 + ks * 32 + fq * 8);
#pragma unroll
    for (int m = 0; m < 4; ++m)
#pragma unroll
      for (int n = 0; n < 4; ++n) acc[m][n] = mfma16(bfr[n], af[m], acc[m][n]);
  }
#pragma unroll
  for (int m = 0; m < 4; ++m) {
    const int row = R0 + m * 16 + fr;
#pragma unroll
    for (int n = 0; n < 4; ++n) {
      const int ch = wid * 64 + n * 16 + 4 * fq;
      const u32x2 gw = *(const u32x2*)(P_U + (size_t)row * NIN + 2048 + ch);
      u32x2 w;
      w.x = pk2(acc[m][n][0] * silu_f(bflo(gw.x)), acc[m][n][1] * silu_f(bfhi(gw.x)));
      w.y = pk2(acc[m][n][2] * silu_f(bflo(gw.y)), acc[m][n][3] * silu_f(bfhi(gw.y)));
      *(u32x2*)(P_MX + (size_t)row * DM + 512 + ch) = w;
    }
  }
  __syncthreads();
}

constexpr int P0_WIN = 3072, P0_WOUT = 1024, P0_PW = 64, P0_POOL = 16, P0_CVT = 768, P0_MOD = 192;
constexpr int P0_UNITS = P0_WIN + P0_WOUT + P0_PW + P0_POOL + P0_CVT + P0_MOD;

DEV void phase0(const Params& p, char* smem) {
  if (blockIdx.x == 0) for (int i = threadIdx.x; i < 1280 + 64; i += 512) P_cnt[i] = 0u;
  const int half = get_half();
  smem += half * 65536;
  for (int pr = blockIdx.x; pr < P0_UNITS / 2; pr += gridDim.x) {
    int v = pr * 2 + half;
    if (v < P0_MOD) { mod_unit(p, v, smem); continue; }
    v -= P0_MOD;
    if (v < P0_WIN) { const int l = v / 768, r = v % 768, kt = r / 48, nt = r % 48;
      tconv_tile(p.w_in + ((size_t)l * 1024 + kt * 64) * 3072 + nt * 64, 3072, P_WinT + ((size_t)l * 3072 + nt * 64) * 1024 + kt * 64, 1024, smem); continue; }
    v -= P0_WIN;
    if (v < P0_WOUT) { const int l = v >> 8, r = v & 255, kt = r >> 4, nt = r & 15;
      tconv_tile(p.w_out + ((size_t)l * 1024 + kt * 64) * 1024 + nt * 64, 1024, P_WoutT + ((size_t)l * 1024 + nt * 64) * 1024 + kt * 64, 1024, smem); continue; }
    v -= P0_WOUT;
    if (v < P0_PW) { const int l = v >> 4, r = v & 15, kt = r >> 2, nt = r & 3;
      tconv_tile(p.conv_pw + ((size_t)l * 256 + kt * 64) * 256 + nt * 64, 256, P_pwT + ((size_t)l * 256 + nt * 64) * 256 + kt * 64, 256, smem); continue; }
    v -= P0_PW;
    if (v < P0_POOL) { tconv_tile(p.pool_w + (size_t)v * 4096, 64, P_poolT + (size_t)v * 4096, 64, smem); continue; }
    v -= P0_POOL;
    if (v < 256) { cvt_unit(p.cnk, P_cnk_b, v); continue; }
    v -= 256;
    if (v < 256) { cvt_unit(p.cnv, P_cnv_b, v); continue; }
    v -= 256;
    if (v < 128) { cvt_unit(p.cgk, P_cgk_b, v); continue; }
    v -= 128;
    cvt_unit(p.cgv, P_cgv_b, v);
  }
}

constexpr int XB_GQA = 128, XB_NAT = 256, XB_CONV = 80, XB_PATT = 64, XB_POOL = 160;
constexpr int XB_UNITS = XB_GQA + XB_NAT + XB_CONV + XB_PATT + XB_POOL;

DEV void phaseB(const Params& p, int l_in, char* smem, int qofs, int ubeg = 0, int uend = XB_UNITS) {
  const int xcd = blockIdx.x & 7;
  unsigned* q = P_cnt + 1280 + qofs + l_in * 8 + xcd;
  int* slot = (int*)(smem + 131072);
  const int half = get_half();
  char* smem0 = smem;
  smem += half * 65536;
  for (;;) {
    if (threadIdx.x == 0) *slot = (int)atomicAdd(q, 1u);
    __syncthreads();
    int u = ubeg + *slot * 2 + half;
    __syncthreads();
    if (u >= uend) break;
    int l = l_in; asm volatile("" : "+s"(l));
    if (u < XB_GQA) { attn_unit<0>(p, l, xcd * XB_GQA + u, smem, smem0, half); continue; }
    u -= XB_GQA;
    if (u < XB_NAT) { attn_unit<1>(p, l, xcd * XB_NAT + u, smem, smem0, half); continue; }
    u -= XB_NAT;
    if (u < XB_CONV) { conv_unit(p, l, xcd * XB_CONV + u, smem); continue; }
    u -= XB_CONV;
    if (u < XB_PATT) { attn_unit<2>(p, l, xcd * XB_PATT + u, smem, smem0, half); continue; }
    u -= XB_PATT;
    pool_unit(p, l, xcd * XB_POOL + u, smem);
  }
}

constexpr int LDS_BYTES = 131072 + 1024;
__global__ void __launch_bounds__(512, 2) mega(Params p) {
  extern __shared__ __attribute__((aligned(16))) char smem[];
  cg::grid_group grid = cg::this_grid();
  const int ph0 = p.ph0, ph1 = p.ph1;
  const int half = get_half();
  volatile LAS unsigned* xst = (volatile LAS unsigned*)(smem + 131072 + 64);
  if (threadIdx.x == 0) { xst[0] = 0u; xst[1] = 0u; }
  __syncthreads();
  const XcdBarrier xb = xcd_barrier_post(P_bar, xst);
  if (ph0 <= 0 && 0 < ph1) { for (int rep = 0; rep < (PROBE_X == 4 ? 2 : 1); ++rep) { phase0(p, smem); if (1 < ph1) grid.sync(); } }
  if (ph0 <= 1 && 1 < ph1) { for (int u = blockIdx.x; u < TT / 64; u += gridDim.x) h0_unit(p, u * 2 + half); if (2 < ph1) xcd_barrier(xb); }
  for (int li = 0; li < NLAYER; ++li) {
    int l = li; asm volatile("" : "+s"(l));
    const int pa = 2 + 3 * li;
    if (ph0 <= pa && pa < ph1) {
      pg8::Gemm g; g.A = P_H; g.Bt = P_WinT + (size_t)l * 3072 * 1024; g.M = TT; g.N = NIN; g.K = DM;
      pg8::StaticOrder S; S.init(TT, NIN, (int)gridDim.x, (int)blockIdx.x);
      EpiA E{p, l};
      for (int rep = 0; rep < (PROBE_X == 1 ? 2 : 1); ++rep) {
        pg8::gemm_phase<EpiA, pg8::StaticOrder, true, true>((PG8_LAS unsigned char*)smem, g, S, E);
        if (pa + 1 < ph1) xcd_barrier(xb);
      }
    }
    if (ph0 <= pa + 1 && pa + 1 < ph1) { phaseB(p, l, smem, 0); if (pa + 2 < ph1) xcd_barrier(xb); }
#if PROBE_SYNC
    for (int i = 0; i < 8; ++i) xcd_barrier(xb);
#endif
#if PROBE_B
    { constexpr int lo[7] = {0, 0, 128, 384, 464, 528, 0}, hi[7] = {0, 128, 384, 464, 528, 688, 688}; phaseB(p, l, smem, 32, lo[PROBE_B], hi[PROBE_B]); xcd_barrier(xb); }
#endif
    if (ph0 <= pa + 2 && pa + 2 < ph1) {
      pg8::Gemm g; g.A = P_MX; g.Bt = P_WoutT + (size_t)l * 1024 * 1024; g.M = TT; g.N = DM; g.K = DM;
      pg8::StaticOrder S; S.init(TT, DM, (int)gridDim.x, (int)blockIdx.x);
      EpiC E{p, l};
      for (int rep = 0; rep < ((PROBE_X == 2 && li == 0) ? 2 : 1); ++rep) {
        pg8::gemm_phase<EpiC, pg8::StaticOrder, true, true>((PG8_LAS unsigned char*)smem, g, S, E);
        xcd_barrier(xb);
      }
      for (int rep = 0; rep < ((PROBE_X == 3 && li < 3) ? 2 : 1); ++rep) {
        for (int u = blockIdx.x; u < TT / 8; u += gridDim.x) ln_unit(p, l, u * 2 + half);
        if (pa + 3 < ph1) xcd_barrier(xb);
      }
    }
  }
}

#ifndef ONE_LAUNCH
#define ONE_LAUNCH 1
#endif

extern "C" void kernel_launch(void* const* d_in, const int* in_sizes, int n_in, void* d_out, int out_size, void* d_ws, size_t ws_size,
                              hipStream_t stream) {
  static int grid_blocks = 0;
  if (!grid_blocks) {
    int dev = 0, cus = 0, per_cu = 0;
    hipGetDevice(&dev);
    hipDeviceGetAttribute(&cus, hipDeviceAttributeMultiprocessorCount, dev);
    hipFuncSetAttribute((const void*)mega, hipFuncAttributeMaxDynamicSharedMemorySize, LDS_BYTES);
    hipOccupancyMaxActiveBlocksPerMultiprocessor(&per_cu, mega, 512, LDS_BYTES);
    if (per_cu > 1) per_cu = 1;
    if (per_cu < 1) per_cu = 1;
    grid_blocks = cus * per_cu;
  }
  Params p{};
  const float* const* in = (const float* const*)d_in;
  p.x_prompt = in[0]; p.x_sample = in[1]; p.c = in[2]; p.cnk = in[3]; p.cnv = in[4]; p.cgk = in[5]; p.cgv = in[6]; p.c_ctx = in[7];
  p.w_mod = in[8]; p.b_mod = in[9]; p.w_in = in[10]; p.b_in = in[11]; p.pool_w = in[12]; p.pool_scale = in[13]; p.nat_bias = in[14];
  p.q_norm = in[15]; p.k_norm = in[16]; p.conv_w = in[17]; p.conv_b = in[18]; p.conv_ln_g = in[19]; p.conv_ln_b = in[20]; p.conv_pw = in[21];
  p.w_out = in[22]; p.b_out = in[23]; p.ln_g = in[24]; p.ln_b = in[25];
  p.out = (float*)d_out;
  p.ws = (char*)d_ws;
  hipMemsetAsync((char*)d_ws + WS_BAR, 0, XCD_BAR_WORDS * sizeof(unsigned), stream);
#if ONE_LAUNCH
  p.ph0 = 0; p.ph1 = 14;
  void* args[] = {&p};
  hipError_t e = hipLaunchCooperativeKernel((void*)mega, dim3(grid_blocks), dim3(512), args, LDS_BYTES, stream);
  if (e != hipSuccess) fprintf(stderr, "cooperative launch failed: %s (grid %d)\n", hipGetErrorString(e), grid_blocks);
#else
  for (int ph = 0; ph < 14; ++ph) { p.ph0 = ph; p.ph1 = ph + 1; mega<<<grid_blocks, 512, LDS_BYTES, stream>>>(p); }
#endif
}
```

```cpp
#define SGB_N 16
#define SGB_V 6
#define LN_UR 2
#include <hip/hip_runtime.h>
#include <hip/hip_cooperative_groups.h>
#include <cstdio>
#include <cstdint>
namespace cg = cooperative_groups;

typedef unsigned short bf16_t;
typedef short bf16x8 __attribute__((ext_vector_type(8)));
typedef short s16x4 __attribute__((ext_vector_type(4)));
typedef float f32x4 __attribute__((ext_vector_type(4)));
typedef float f32x2 __attribute__((ext_vector_type(2)));
typedef __bf16 bf16x2_t __attribute__((ext_vector_type(2)));
typedef unsigned u32x4 __attribute__((ext_vector_type(4)));
typedef unsigned u32x2 __attribute__((ext_vector_type(2)));
#define DEV __device__ __forceinline__
__device__ const float ROPE_COS[1024] = {
1.f,1.f,1.f,1.f,1.f,1.f,1.f,1.f,
1.f,1.f,1.f,1.f,1.f,1.f,1.f,1.f,
0.540302277f,0.846009135f,0.950415254f,0.98423022f,0.995004177f,0.998419285f,0.999500036f,0.999841869f,
0.999949992f,0.999984205f,0.999994993f,0.999998391f,0.999999523f,0.999999821f,0.99999994f,1.f,
-0.416146845f,0.431462824f,0.806578398f,0.937418282f,0.980066597f,0.993682086f,0.998000681f,0.999367595f,
0.999800026f,0.999936759f,0.999979973f,0.999993682f,0.999997973f,0.999999344f,0.999999821f,0.99999994f,
-0.989992499f,-0.115966164f,0.582753658f,0.861040652f,0.955336511f,0.985803485f,0.995503366f,0.998577297f,
0.999550045f,0.999857724f,0.999954998f,0.999985754f,0.99999553f,0.999998569f,0.999999523f,0.999999881f,
-0.653643608f,-0.627679706f,0.301137477f,0.757506192f,0.921060979f,0.974808276f,0.992010653f,0.997471273f,
0.999200106f,0.999747038f,0.999920011f,0.999974728f,0.999992013f,0.999997497f,0.999999225f,0.999999762f,
0.2836622f,-0.946079254f,-0.0103423381f,0.630080283f,0.87758255f,0.960731268f,0.987526f,0.996049762f,
0.998750269f,0.999604762f,0.999875009f,0.999960482f,0.999987483f,0.999996066f,0.999998748f,0.999999583f,
0.960170269f,-0.973103702f,-0.3207964f,0.482782036f,0.825335622f,0.943616986f,0.982053936f,0.9943133f,
0.998200536f,0.999430835f,0.999819994f,0.999943078f,0.999981999f,0.999994338f,0.999998212f,0.999999404f,
0.753902256f,-0.700429797f,-0.599437475f,0.320257008f,0.764842212f,0.923519433f,0.975599885f,0.992262423f,
0.997551024f,0.999225318f,0.999755025f,0.999922514f,0.999975502f,0.999992251f,0.999997556f,0.999999225f,
-0.145500034f,-0.212036446f,-0.818632424f,0.147631213f,0.696706712f,0.900502324f,0.968170285f,0.989897788f,
0.996801734f,0.998988271f,0.999680042f,0.999898791f,0.999967992f,0.999989867f,0.999996781f,0.999998987f,
-0.91113025f,0.341660261f,-0.956644177f,-0.0296507962f,0.621609926f,0.874638259f,0.959772646f,0.987220109f,
0.995952725f,0.998719573f,0.999595046f,0.99987191f,0.999959528f,0.999987185f,0.999995947f,0.999998748f,
-0.839071512f,0.790131867f,-0.999786079f,-0.205997631f,0.540302277f,0.846009135f,0.950415313f,0.98423022f,
0.995004177f,0.998419285f,0.999500036f,0.999841869f,0.999949992f,0.999984205f,0.999994993f,0.999998391f,
0.00442569796f,0.995257378f,-0.943779767f,-0.375847399f,0.453596085f,0.814705312f,0.940107584f,0.980929136f,
0.993956089f,0.998087406f,0.999395072f,0.999808669f,0.999939501f,0.999980867f,0.99999392f,0.999998093f,
0.843853951f,0.893861592f,-0.79417938f,-0.53384304f,0.362357706f,0.780825913f,0.92885989f,0.97731787f,
0.99280864f,0.997723997f,0.999280095f,0.99977231f,0.999927998f,0.999977231f,0.999992788f,0.999997735f,
0.907446802f,0.517172873f,-0.565820515f,-0.675001681f,0.267498761f,0.744477987f,0.916683376f,0.973397553f,
0.99156189f,0.997329056f,0.999155104f,0.999732792f,0.999915481f,0.999973297f,0.999991536f,0.999997318f,
0.136737213f,-0.0187961515f,-0.28134948f,-0.794870913f,0.16996716f,0.705776393f,0.903590262f,0.969169438f,
0.990216017f,0.996902585f,0.999020159f,0.999690115f,0.99990201f,0.999969006f,0.999990225f,0.999996901f,
-0.759687901f,-0.548975468f,0.0310223512f,-0.889670432f,0.070737198f,0.6648435f,0.889593601f,0.964634836f,
0.988771081f,0.996444523f,0.998875201f,0.999644279f,0.999887526f,0.999964416f,0.999988735f,0.999996424f,
-0.957659483f,-0.910081089f,0.340318173f,-0.95641005f,-0.0291995462f,0.621808827f,0.87470746f,0.959795177f,
0.987227261f,0.99595499f,0.998720288f,0.999595284f,0.999872029f,0.999959528f,0.999987185f,0.999995947f,
-0.275163352f,-0.990897954f,0.615864813f,-0.99298501f,-0.128844544f,0.576808274f,0.858946681f,0.954652011f,
0.985584795f,0.995433986f,0.998555362f,0.999543071f,0.999855518f,0.999954283f,0.999985576f,0.99999541f,
0.660316706f,-0.766536534f,0.830336154f,-0.998241663f,-0.227202162f,0.529984176f,0.842327058f,0.949207008f,
0.983843684f,0.994881511f,0.998380423f,0.999487758f,0.999837995f,0.9999488f,0.999983788f,0.999994874f,
0.988704622f,-0.306095392f,0.962463796f,-0.972014248f,-0.323289543f,0.481484592f,0.824865162f,0.943461835f,
0.982004225f,0.994297504f,0.998195529f,0.999429286f,0.999819517f,0.999942899f,0.99998194f,0.999994278f,
0.408082068f,0.248616725f,0.999144375f,-0.91512996f,-0.416146845f,0.431462824f,0.806578457f,0.937418282f,
0.980066597f,0.993682086f,0.998000681f,0.999367595f,0.999800026f,0.999936759f,0.999979973f,0.999993682f,
-0.547729254f,0.726760268f,0.936740458f,-0.829382956f,-0.504846215f,0.380077004f,0.787485182f,0.931078374f,
0.97803092f,0.993035257f,0.99779582f,0.999302804f,0.999779522f,0.999930263f,0.999977946f,0.999993026f,
-0.99996084f,0.981074572f,0.781440377f,-0.717477441f,-0.588501155f,0.327489585f,0.767604589f,0.92444396f,
0.975897431f,0.992357016f,0.997581005f,0.999234855f,0.999758005f,0.999923468f,0.999975801f,0.999992371f,
-0.53283304f,0.933235765f,0.548645258f,-0.582943261f,-0.666275978f,0.273866832f,0.746956408f,0.917517304f,
0.97366637f,0.991647422f,0.997356176f,0.999163687f,0.999735534f,0.999916375f,0.999973536f,0.999991655f,
0.424179018f,0.597977161f,0.261441678f,-0.430023283f,-0.737393796f,0.219378278f,0.725561321f,0.910300434f,
0.971337974f,0.990906477f,0.997121394f,0.99908942f,0.99971199f,0.999908924f,0.999971211f,0.99999088f,
0.991202831f,0.078552261f,-0.0516893305f,-0.263540596f,-0.801143587f,0.164196163f,0.703440726f,0.902795732f,
0.968912423f,0.99013412f,0.996876657f,0.999011934f,0.999687493f,0.999901175f,0.999968767f,0.999990106f,
0.64691931f,-0.465064496f,-0.359694332f,-0.0887455046f,-0.856888831f,0.108494945f,0.680616796f,0.895005584f,
0.966389954f,0.98933053f,0.996621907f,0.998931348f,0.999662042f,0.999893129f,0.999966204f,0.999989331f,
-0.292138815f,-0.865450621f,-0.632028639f,0.088848114f,-0.904072165f,0.0524506159f,0.6571123f,0.886932373f,
0.963770926f,0.988495648f,0.996357203f,0.998847544f,0.999635518f,0.999884725f,0.999963522f,0.999988496f,
-0.962605894f,-0.999293387f,-0.841684937f,0.26363951f,-0.942222297f,-0.00375941908f,0.632950664f,0.878578722f,
0.961055458f,0.987629473f,0.996082544f,0.998760641f,0.99960804f,0.999876022f,0.99996078f,0.999987602f,
-0.748057544f,-0.825371623f,-0.967871487f,0.430115849f,-0.970958173f,-0.0599575676f,0.608156204f,0.869947195f,
0.958243906f,0.986732066f,0.995797932f,0.998670578f,0.999579549f,0.999867022f,0.999957979f,0.999986708f,
0.154251456f,-0.397251874f,-0.998075247f,0.583026946f,-0.989992499f,-0.115966164f,0.582753658f,0.861040652f,
0.955336511f,0.985803485f,0.995503366f,0.998577297f,0.999550045f,0.999857724f,0.999954998f,0.999985754f,
0.914742351f,0.153215483f,-0.929300308f,0.717549205f,-0.999135137f,-0.171608135f,0.556768358f,0.851861775f,
0.95233357f,0.984843671f,0.995198846f,0.998480916f,0.999519527f,0.999848068f,0.999951959f,0.999984801f,
0.83422339f,0.656495154f,-0.768367112f,0.829440355f,-0.998294771f,-0.226707578f,0.53022635f,0.842413545f,
0.949235439f,0.983852804f,0.994884372f,0.998381376f,0.999488056f,0.999838114f,0.9999488f,0.999983788f,
-0.0132767474f,0.95758605f,-0.531235278f,0.915171385f,-0.987479806f,-0.281090319f,0.503154159f,0.832698941f,
0.946042359f,0.982830763f,0.994559944f,0.998278618f,0.999455571f,0.999827802f,0.999945521f,0.999982774f,
-0.848570287f,0.963757515f,-0.241421118f,0.972038329f,-0.966798186f,-0.334584385f,0.475578904f,0.822721004f,
0.942754686f,0.981777668f,0.994225562f,0.99817276f,0.999422073f,0.999817252f,0.999942183f,0.999981701f,
-0.903692186f,0.673110247f,0.0723346695f,0.998247743f,-0.93645668f,-0.387020677f,0.447528064f,0.812482953f,
0.939372718f,0.980693519f,0.993881226f,0.998063743f,0.999387562f,0.999806345f,0.999938726f,0.999980628f,
-0.127963692f,0.175156534f,0.378916174f,0.992972851f,-0.896758378f,-0.438233554f,0.419029742f,0.801987886f,
0.935896814f,0.979578316f,0.993526995f,0.997951567f,0.999352098f,0.999795079f,0.99993521f,0.999979496f,
0.765414059f,-0.376742303f,0.647921681f,0.95638001f,-0.848100007f,-0.488060862f,0.39011243f,0.791239262f,
0.93232733f,0.978432178f,0.993162811f,0.997836173f,0.99931556f,0.999783576f,0.999931574f,0.999978364f,
0.955073655f,-0.812611222f,0.852673113f,0.889623463f,-0.790967762f,-0.536345184f,0.360805035f,0.780240417f,
0.928664625f,0.977255106f,0.992788672f,0.997717679f,0.999278069f,0.999771714f,0.999927819f,0.999977171f,
0.266642928f,-0.998210371f,0.972865343f,0.794808388f,-0.72593224f,-0.582933903f,0.331136853f,0.768994927f,
0.924909055f,0.976047099f,0.99240464f,0.997596025f,0.999239624f,0.999759495f,0.999923944f,0.999975979f,
-0.666938066f,-0.87637943f,0.996578991f,0.674925625f,-0.653643608f,-0.627679706f,0.301137596f,0.757506192f,
0.921060979f,0.974808276f,0.992010653f,0.997471273f,0.999200106f,0.999747038f,0.999920011f,0.999974728f,
-0.987339258f,-0.484639406f,0.921462357f,0.533756077f,-0.574824035f,-0.670441091f,0.270837069f,0.745777905f,
0.917120814f,0.973538578f,0.991606772f,0.997343302f,0.999159634f,0.999734223f,0.999915957f,0.999973416f,
-0.399985313f,0.0563609414f,0.754965365f,0.375752151f,-0.490260571f,-0.711082935f,0.240265876f,0.733813822f,
0.913088918f,0.972238123f,0.991192937f,0.997212172f,0.999118149f,0.99972111f,0.999911785f,0.999972105f,
0.555113316f,0.580003142f,0.513598442f,0.205897167f,-0.400799006f,-0.749476731f,0.209454417f,0.721617639f,
0.908965766f,0.970906913f,0.990769207f,0.997077882f,0.999075651f,0.999707639f,0.999907553f,0.999970794f,
0.999843299f,0.925014675f,0.221298173f,0.0295478199f,-0.307332784f,-0.785501122f,0.178433523f,0.709193349f,
0.904751658f,0.969545007f,0.990335584f,0.996940494f,0.99903214f,0.99969393f,0.999903202f,0.999969363f,
0.52532196f,0.985138178f,-0.0929481089f,-0.147732988f,-0.210795805f,-0.819042206f,0.147234216f,0.696544766f,
0.90044713f,0.968152404f,0.989892066f,0.996799886f,0.998987675f,0.999679863f,0.999898732f,0.999967992f,
-0.432177931f,0.741858006f,-0.397976756f,-0.320354372f,-0.112152621f,-0.849993885f,0.115887694f,0.683675885f,
0.89605248f,0.966729224f,0.989438653f,0.996656179f,0.998942196f,0.999665439f,0.999894202f,0.999966562f,
-0.992335498f,0.270098448f,-0.663538277f,-0.48287195f,-0.0123883775f,-0.878258407f,0.0844252855f,0.670590878f,
0.891568303f,0.965275466f,0.988975346f,0.996509314f,0.998895705f,0.999650776f,0.999889553f,0.999965072f,
-0.640144348f,-0.284846604f,-0.863296509f,-0.630159974f,0.0874991715f,-0.903746367f,0.0528784581f,0.657293737f,
0.886994898f,0.963791192f,0.988502085f,0.996359289f,0.9988482f,0.999635756f,0.999884784f,0.999963582f,
0.300592542f,-0.75206399f,-0.977442741f,-0.757573068f,0.18651247f,-0.926377118f,0.0212787576f,0.643788815f,
0.882332861f,0.962276459f,0.98801899f,0.996206105f,0.998799741f,0.999620378f,0.999879956f,0.999962032f,
0.964965999f,-0.987659097f,-0.994656444f,-0.861092687f,0.2836622f,-0.946079254f,-0.0103422189f,0.630080283f,
0.87758255f,0.960731268f,0.987526f,0.996049762f,0.998750269f,0.999604762f,0.999875009f,0.999960482f,
0.742154181f,-0.919073522f,-0.913230121f,-0.937454224f,0.377977669f,-0.96279037f,-0.0419528559f,0.616172493f,
0.872744501f,0.959155679f,0.987023175f,0.99589026f,0.998699784f,0.999588788f,0.999869943f,0.999958873f,
-0.162990779f,-0.567430019f,-0.741239965f,-0.984248459f,0.468516916f,-0.976457715f,-0.0735215396f,0.602069914f,
0.86781919f,0.95754981f,0.986510456f,0.995727658f,0.998648286f,0.999572515f,0.999864817f,0.999957263f,
-0.918282807f,-0.0410281904f,-0.495741814f,-1.f,0.554374516f,-0.987038016f,-0.105016708f,0.587776959f,
0.862807095f,0.955913603f,0.985987842f,0.995561838f,0.998595834f,0.999555886f,0.999859571f,0.999955595f,
-0.829309821f,0.498009592f,-0.201079622f,-0.984212041f,0.634692967f,-0.994497895f,-0.136406869f,0.573298037f,
0.857708693f,0.954247177f,0.985455394f,0.995392919f,0.998542368f,0.999538958f,0.999854207f,0.999953866f,
0.0221267566f,0.883669317f,0.113521777f,-0.937382519f,0.708669782f,-0.998813629f,-0.167660639f,0.558637917f,
0.852524519f,0.95255059f,0.984913111f,0.99522084f,0.99848789f,0.999521732f,0.999848783f,0.999952197f,
0.853220105f,0.997174621f,0.416867077f,-0.860988438f,0.775565803f,-0.999971747f,-0.198746875f,0.543801069f,
0.847255111f,0.950823903f,0.984360933f,0.995045662f,0.998432398f,0.999504209f,0.99984318f,0.999950409f,
0.899866819f,0.803569078f,0.678870201f,-0.757439196f,0.834712923f,-0.997968495f,-0.22963427f,0.528792322f,
0.841901004f,0.949067116f,0.983798921f,0.994867265f,0.998375952f,0.999486327f,0.999837577f,0.999948621f,
0.119180135f,0.362476677f,0.873550534f,-0.63000071f,0.885519624f,-0.99281019f,-0.260292053f,0.513616323f,
0.836462677f,0.947280347f,0.983227074f,0.994685769f,0.998318493f,0.999468148f,0.999831796f,0.999946833f,
-0.771080196f,-0.1902491f,0.981602073f,-0.482692331f,0.927478492f,-0.984513164f,-0.290689558f,0.498277903f,
0.830940723f,0.945463598f,0.982645452f,0.994501114f,0.998260021f,0.99944967f,0.999825954f,0.999944985f,
-0.952412963f,-0.684381902f,0.992308319f,-0.320159167f,0.960170269f,-0.973103702f,-0.3207964f,0.482782036f,
0.825335622f,0.943616986f,0.982053936f,0.9943133f,0.998200536f,0.999430835f,0.999819994f,0.999943078f,
-0.258101642f,-0.967739642f,0.904607594f,-0.1475292f,0.98326844f,-0.958617806f,-0.350582451f,0.467133403f,
0.819648027f,0.941740453f,0.981452644f,0.994122326f,0.998140097f,0.999411702f,0.999813974f,0.99994117f,
0.673507154f,-0.953050017f,0.727198064f,0.0297537707f,0.996542096f,-0.941101313f,-0.380017966f,0.451337039f,
0.813878477f,0.939834237f,0.980841517f,0.993928254f,0.998078644f,0.999392271f,0.999807835f,0.999939203f,
0.985896587f,-0.644837022f,0.477671444f,0.206098333f,0.999858618f,-0.920609534f,-0.409073502f,0.435397953f,
0.808027506f,0.937898219f,0.980220556f,0.993731022f,0.998016179f,0.999372482f,0.999801576f,0.999937236f,
};
__device__ const float ROPE_SIN[1024] = {
0.f,0.f,0.f,0.f,0.f,0.f,0.f,0.f,
0.f,0.f,0.f,0.f,0.f,0.f,0.f,0.f,
0.841470957f,0.533168435f,0.310983598f,0.176892191f,0.0998334214f,0.0562044978f,0.0316175036f,0.0177818574f,
0.00999983307f,0.00562338345f,0.00316227227f,0.0017782785f,0.000999999931f,0.000562341243f,0.000316227757f,0.00017782794f,
0.909297407f,0.902130723f,0.591127098f,0.348205268f,0.198669329f,0.112231314f,0.0632033944f,0.0355580896f,
0.0199986659f,0.011246589f,0.00632451288f,0.00355655141f,0.0019999987f,0.00112468237f,0.000632455456f,0.00035565588f,
0.141120002f,0.993253171f,0.812648892f,0.5085361f,0.295520216f,0.167903304f,0.0947260857f,0.0533230826f,
0.0299954992f,0.0168694388f,0.00948669016f,0.00533481315f,0.0029999956f,0.00168702309f,0.000948683126f,0.000533483806f,
-0.756802499f,0.778471708f,0.953580737f,0.652827978f,0.389418334f,0.223044485f,0.126154065f,0.0710712075f,
0.0399893336f,0.0224917568f,0.0126487734f,0.00711305765f,0.00399998948f,0.00224936334f,0.00126491068f,0.000711311703f,
-0.958924294f,0.32393527f,0.999946535f,0.776529968f,0.47942555f,0.277480543f,0.157455876f,0.0887968615f,
0.0499791652f,0.0281133614f,0.0158107281f,0.00889127981f,0.0049999794f,0.0028117029f,0.00158113812f,0.000889139599f,
-0.279415488f,-0.230367512f,0.947148204f,0.875740528f,0.564642489f,0.33103931f,0.188600272f,0.106494442f,
0.0599640049f,0.0337340795f,0.0189725272f,0.0106694745f,0.0059999642f,0.00337404152f,0.00189736532f,0.00106696738f,
0.656986594f,-0.713721275f,0.800421596f,0.947330713f,0.64421767f,0.383551568f,0.219556093f,0.124158338f,
0.0699428469f,0.0393537246f,0.0221341345f,0.0124476347f,0.00699994294f,0.00393637875f,0.00221359241f,0.00124479528f,
0.989358246f,-0.977261782f,0.574317753f,0.989042461f,0.717356086f,0.434851229f,0.250292331f,0.141782969f,
0.0799146891f,0.0449721329f,0.0252955221f,0.0142257558f,0.0079999147f,0.00449871505f,0.00252981926f,0.00142262306f,
0.412118495f,-0.939823508f,0.291259229f,0.999560297f,0.783326924f,0.484776139f,0.280778319f,0.159362778f,
0.0898785442f,0.0505891182f,0.0284566563f,0.0160038304f,0.00899987947f,0.00506105041f,0.00284604589f,0.00160045072f,
-0.54402113f,-0.612936914f,-0.0206835698f,0.978552461f,0.841470957f,0.533168435f,0.310983568f,0.176892191f,
0.099833414f,0.0562044978f,0.0316175036f,0.0177818574f,0.009999834f,0.00562338345f,0.00316227227f,0.0017782785f,
-0.999990225f,-0.0972764567f,-0.33057496f,0.926681578f,0.891207397f,0.579875171f,0.340877861f,0.19436565f,
0.1097783f,0.0618181042f,0.0347780399f,0.0195598267f,0.0109997792f,0.00618571462f,0.00347849843f,0.00195610616f,
-0.536572933f,0.448342979f,-0.60768342f,0.845583618f,0.932039082f,0.624748647f,0.370431304f,0.211777672f,
0.119712204f,0.0674297586f,0.0379382223f,0.0213377345f,0.0119997123f,0.0067480444f,0.00379472389f,0.00213393359f,
0.420167029f,0.855880976f,-0.824528456f,0.737816215f,0.963558197f,0.667647004f,0.399614304f,0.229122713f,
0.129634142f,0.0730392784f,0.0410980321f,0.0231155735f,0.0129996343f,0.00731037185f,0.00411094911f,0.00231176103f,
0.990607381f,0.999823332f,-0.959605396f,0.606778562f,0.985449731f,0.708434701f,0.428397775f,0.246395305f,
0.139543116f,0.078646481f,0.0442574248f,0.0248933397f,0.0139995432f,0.00787269697f,0.00442717411f,0.00248958869f,
0.650287867f,0.835838437f,-0.999518692f,0.456603259f,0.997494996f,0.746982634f,0.456752867f,0.263589978f,
0.149438128f,0.0842512026f,0.0474163815f,0.0266710296f,0.0149994381f,0.00843502022f,0.00474339863f,0.00266741589f,
-0.287903309f,0.414430231f,-0.940310359f,0.292027086f,0.999573588f,0.783169091f,0.484651238f,0.280701309f,
0.159318209f,0.0898532644f,0.0505748577f,0.028448632f,0.015999319f,0.00899733976f,0.00505962269f,0.00284524332f,
-0.961397469f,-0.134615138f,-0.78785187f,0.11824052f,0.991664827f,0.81687957f,0.512064993f,0.29772386f,
0.169182345f,0.09545248f,0.0537328273f,0.0302261449f,0.0169991814f,0.00955965649f,0.00537584582f,0.00302307028f,
-0.750987232f,-0.642200708f,-0.557262897f,-0.0592755191f,0.973847628f,0.84800756f,0.538966715f,0.314652264f,
0.179029569f,0.101048686f,0.0568902642f,0.0320035629f,0.0179990288f,0.0101219704f,0.00569206895f,0.00320089748f,
0.149877205f,-0.952000856f,-0.271410108f,-0.234921798f,0.946300089f,0.876454532f,0.565329552f,0.331481189f,
0.188858896f,0.10664168f,0.060047131f,0.0337808803f,0.0189988576f,0.0106842816f,0.00600829115f,0.00337872445f,
0.912945271f,-0.968601942f,0.0413582884f,-0.403158993f,0.909297407f,0.902130723f,0.591127038f,0.348205268f,
0.198669314f,0.112231314f,0.0632033944f,0.0355580896f,0.0199986678f,0.011246589f,0.00632451288f,0.00355655141f,
0.836655617f,-0.686891198f,0.35002476f,-0.558680534f,0.863209307f,0.924954832f,0.616333544f,0.364819258f,
0.208459899f,0.117817394f,0.0663590282f,0.0373351872f,0.0209984574f,0.0118088927f,0.00664073415f,0.00373437814f,
-0.00885130931f,-0.193630233f,0.623979926f,-0.696581721f,0.808496356f,0.944854796f,0.640923738f,0.381317884f,
0.218229622f,0.123399742f,0.0695140064f,0.0391121693f,0.0219982266f,0.0123711927f,0.00695695449f,0.00391220488f,
-0.846220434f,0.359264523f,0.836055279f,-0.812512875f,0.745705247f,0.961767614f,0.664873064f,0.397695929f,
0.227977514f,0.128978193f,0.0726682767f,0.0408890247f,0.0229979735f,0.0129334899f,0.00727317436f,0.00409003161f,
-0.905578375f,0.801513135f,0.965219259f,-0.902817786f,0.67546314f,0.97563988f,0.688157499f,0.413948208f,
0.237702623f,0.134552568f,0.0758218244f,0.0426657498f,0.0239976961f,0.0134957815f,0.0075893933f,0.00426785741f,
-0.132351756f,0.996909976f,0.998663187f,-0.964648306f,0.598472118f,0.986427724f,0.710753918f,0.430069596f,
0.247403964f,0.140122697f,0.0789746121f,0.0444423407f,0.0249973964f,0.0140580693f,0.00790561177f,0.00444568414f,
0.76255846f,0.885276794f,0.933070183f,-0.996054351f,0.515501261f,0.994096994f,0.732639611f,0.446054995f,
0.257080555f,0.145688385f,0.0821266174f,0.0462187938f,0.0259970706f,0.0146203535f,0.00822182931f,0.00462350994f,
0.956375957f,0.500994205f,0.774945021f,-0.996045172f,0.427379847f,0.99862349f,0.753792703f,0.46189931f,
0.266731411f,0.151249468f,0.0852777958f,0.0479951017f,0.0269967206f,0.015182632f,0.00853804592f,0.00480133574f,
0.270905793f,-0.0375856608f,0.539968967f,-0.964621305f,0.334988207f,0.999992907f,0.774192095f,0.477597594f,
0.276355654f,0.156805754f,0.0884281173f,0.049771253f,0.0279963426f,0.0157449059f,0.0088542616f,0.00497916201f,
-0.663633883f,-0.564589798f,0.251445323f,-0.902773678f,0.239249229f,0.998200953f,0.793817401f,0.49314484f,
0.28595221f,0.162357092f,0.0915775672f,0.0515472479f,0.0289959367f,0.0163071752f,0.00917047635f,0.00515698735f,
-0.988031626f,-0.917709649f,-0.0620148405f,-0.812452853f,0.141120002f,0.993253171f,0.812648892f,0.5085361f,
0.295520186f,0.167903304f,0.0947260931f,0.0533230826f,0.029995501f,0.0168694388f,0.00948669016f,0.00533481315f,
-0.404037654f,-0.988192797f,-0.369325012f,-0.696507812f,0.0415805206f,0.985165298f,0.830667794f,0.523766637f,
0.305058628f,0.173444211f,0.0978736654f,0.055098746f,0.0309950355f,0.0174316969f,0.00980290305f,0.00551263802f,
0.551426709f,-0.754330218f,-0.640009403f,-0.5585953f,-0.0583741926f,0.973962843f,0.847856104f,0.538831532f,
0.314566553f,0.17897962f,0.101020269f,0.0568742342f,0.0319945402f,0.0179939512f,0.0101191159f,0.00569046335f,
0.999911845f,-0.28814739f,-0.847224355f,-0.403064936f,-0.157745644f,0.959681332f,0.864196658f,0.553726017f,
0.324043006f,0.184509367f,0.10416586f,0.0586495437f,0.0329940096f,0.0185561981f,0.010435327f,0.00586828869f,
0.529082716f,0.266779721f,-0.97042042f,-0.234822124f,-0.255541205f,0.942365825f,0.879673064f,0.568445385f,
0.333487093f,0.190033287f,0.107310407f,0.0604246669f,0.0339934528f,0.0191184394f,0.010751537f,0.00604611309f,
-0.428182662f,0.739542127f,-0.997380435f,-0.0591726787f,-0.350783229f,0.92207104f,0.894269884f,0.582984984f,
0.342897803f,0.195551202f,0.110453881f,0.0621996038f,0.034992855f,0.0196806751f,0.0110677453f,0.00622393796f,
-0.991778851f,0.984540582f,-0.925431013f,0.118342586f,-0.442520559f,0.89886117f,0.907972515f,0.597340286f,
0.352274209f,0.201062918f,0.113596253f,0.0639743358f,0.0359922275f,0.0202429052f,0.0113839535f,0.0064017619f,
-0.643538117f,0.926318109f,-0.761706948f,0.292125374f,-0.529836178f,0.872809589f,0.920767248f,0.611506701f,
0.361615449f,0.206568271f,0.116737492f,0.0657488778f,0.036991559f,0.0208051261f,0.0117001599f,0.0065795863f,
0.296368569f,0.58280617f,-0.522444785f,0.456694692f,-0.611857831f,0.84399873f,0.932641268f,0.625479698f,
0.370920479f,0.212067112f,0.119877554f,0.0675232038f,0.0379908569f,0.0213673431f,0.0120163653f,0.00675741071f,
0.963795364f,0.0598003156f,-0.231372014f,0.606860459f,-0.687766254f,0.81251961f,0.943582714f,0.639254928f,
0.380188406f,0.217559248f,0.123016424f,0.0692973137f,0.0389901139f,0.0219295528f,0.0123325698f,0.00693523418f,
0.745113134f,-0.481621295f,0.0826458037f,0.737885714f,-0.756802499f,0.778471708f,0.953580678f,0.652827978f,
0.389418334f,0.223044485f,0.126154065f,0.0710712075f,0.0399893373f,0.0224917568f,0.0126487734f,0.00711305765f,
-0.158622667f,-0.874714017f,0.388467699f,0.845638454f,-0.818277061f,0.74196279f,0.962625206f,0.666194677f,
0.39860931f,0.228522688f,0.129290432f,0.0728448778f,0.0409885161f,0.0230539497f,0.0129649751f,0.00729088066f,
-0.916521549f,-0.998410463f,0.655764699f,0.926720202f,-0.871575892f,0.703108132f,0.970707119f,0.679350674f,
0.407760441f,0.233993664f,0.132425532f,0.0746183172f,0.0419876575f,0.0236161388f,0.0132811759f,0.00746870413f,
-0.831774771f,-0.814614236f,0.858030677f,0.97857362f,-0.916166008f,0.662030637f,0.977818429f,0.692291796f,
0.416870773f,0.23945722f,0.135559291f,0.0763915181f,0.0429867506f,0.0241783205f,0.0135973748f,0.00764652714f,
0.0177019257f,-0.37993139f,0.975206196f,0.999563396f,-0.951602101f,0.618860185f,0.983951986f,0.70501405f,
0.425939471f,0.244913206f,0.138691694f,0.0781644881f,0.0439858064f,0.0247404929f,0.0139135728f,0.00782434922f,
0.850903511f,0.171763569f,0.995670974f,0.989027262f,-0.977530122f,0.57373327f,0.989101648f,0.717513323f,
0.434965521f,0.250361472f,0.141822711f,0.0799371973f,0.0449848175f,0.0253026579f,0.0142297689f,0.00800217129f,
0.901788354f,0.670557022f,0.917395473f,0.947297752f,-0.993690968f,0.526792526f,0.993262351f,0.72978574f,
0.44394809f,0.255801797f,0.144952312f,0.0817096606f,0.0459837839f,0.0258648153f,0.0145459641f,0.0081799943f,
0.123573124f,0.962832689f,0.748142362f,0.875690997f,-0.999923289f,0.478186339f,0.996429801f,0.741827428f,
0.452886283f,0.261234075f,0.148080453f,0.0834818557f,0.0469827019f,0.0264269635f,0.0148621574f,0.00835781638f,
-0.768254638f,0.958573103f,0.504697084f,0.776465356f,-0.99616462f,0.428068399f,0.99860096f,0.753634512f,
0.461779177f,0.266658038f,0.151207119f,0.0852537975f,0.0479815714f,0.0269891042f,0.0151783489f,0.00853563752f,
-0.953752637f,0.659090102f,0.211200655f,0.652750373f,-0.982452571f,0.376597136f,0.999773562f,0.765203178f,
0.470625877f,0.272073567f,0.15433228f,0.087025471f,0.0489803962f,0.0275512375f,0.0154945394f,0.0087134596f,
-0.262374848f,0.156619072f,-0.10324046f,0.508447945f,-0.958924294f,0.32393527f,0.999946535f,0.776529968f,
0.47942555f,0.277480543f,0.157455891f,0.0887968615f,0.0499791689f,0.0281133596f,0.0158107281f,0.00889127981f,
0.670229197f,-0.394086063f,-0.407444149f,0.3481085f,-0.925814748f,0.270249337f,0.99911958f,0.787611187f,
0.48817724f,0.282878697f,0.160577938f,0.0905679762f,0.0509778969f,0.0286754742f,0.0161269177f,0.00906910095f,
0.986627579f,-0.823421597f,-0.671240151f,0.176790684f,-0.883454502f,0.215709001f,0.997293651f,0.798443377f,
0.496880114f,0.28826794f,0.163698375f,0.0923388004f,0.051976569f,0.0292375814f,0.0164431017f,0.00924692024f,
0.395925164f,-0.999157965f,-0.868469954f,-0.000103020677f,-0.832267344f,0.160486728f,0.994470477f,0.809023023f,
0.505533338f,0.293648034f,0.166817173f,0.0941093415f,0.0529751927f,0.0297996756f,0.0167592876f,0.00942474138f,
-0.558789074f,-0.867171526f,-0.979574919f,-0.176993474f,-0.772764444f,0.104756832f,0.990652919f,0.819346905f,
0.514135957f,0.29901889f,0.169934288f,0.0958795771f,0.0539737605f,0.0303617641f,0.0170754679f,0.00960256159f,
-0.999755144f,-0.468111664f,-0.993535519f,-0.348301649f,-0.705540299f,0.0486960001f,0.985844791f,0.829411685f,
0.522687256f,0.304380238f,0.173049718f,0.0976495072f,0.0549722798f,0.0309238415f,0.01739165f,0.00978038087f,
-0.521551013f,0.0751182064f,-0.908967435f,-0.508624554f,-0.631266713f,-0.00751878507f,0.980050862f,0.839214146f,
0.531186223f,0.30973196f,0.17616342f,0.0994191393f,0.0559707358f,0.0314859077f,0.0177078284f,0.00995820016f,
0.436164767f,0.595211506f,-0.734258294f,-0.652905703f,-0.550685287f,-0.0637097955f,0.973276973f,0.848751247f,
0.539632022f,0.315073937f,0.179275364f,0.101188451f,0.0569691435f,0.0320479684f,0.0180240069f,0.0101360194f,
0.992872655f,0.931992829f,-0.486733496f,-0.776594579f,-0.464602023f,-0.119699396f,0.965529919f,0.858020008f,
0.548023939f,0.3204059f,0.182385504f,0.102957435f,0.0579674877f,0.0326100141f,0.0183401816f,0.0103138378f,
0.636738002f,0.981735826f,-0.190938011f,-0.87579f,-0.373876572f,-0.175310582f,0.956817448f,0.867017388f,
0.55636102f,0.325727791f,0.185493827f,0.104726106f,0.0589657798f,0.0331720486f,0.0186563563f,0.0104916561f,
-0.304810613f,0.729123712f,0.12379095f,-0.947363734f,-0.279415488f,-0.230367512f,0.947148204f,0.875740528f,
0.564642429f,0.33103931f,0.188600287f,0.106494442f,0.0599640086f,0.0337340795f,0.0189725272f,0.0106694745f,
-0.966117799f,0.251952261f,0.426245421f,-0.98905772f,-0.182162598f,-0.284696162f,0.936531842f,0.884186864f,
0.572867453f,0.336340427f,0.191704854f,0.108262435f,0.0609621815f,0.0342960916f,0.0192886982f,0.0108472919f,
-0.739180684f,-0.302812874f,0.686427653f,-0.999557257f,-0.0830891207f,-0.338124752f,0.924979091f,0.892353535f,
0.581035137f,0.341630876f,0.194807529f,0.110030092f,0.0619602874f,0.0348580964f,0.0196048655f,0.0110251084f,
0.167355701f,-0.764320076f,0.878538549f,-0.978531301f,0.0168140903f,-0.390484393f,0.912501454f,0.900238097f,
0.589144766f,0.346910536f,0.197908238f,0.111797392f,0.0629583374f,0.0354200937f,0.0199210308f,0.0112029258f,
};
#define XB_TMO      128
#define XB_XCNT(j)  (256  + 64 * (j))
#define XB_XSUB(j)  (1280 + 64 * (j))
#define XB_XGEN(j)  (2304 + 64 * (j))
#define XB_TOP      3328
#define XB_TOPGEN   3392
#define XCD_BAR_WORDS 3456
#define XB_SPIN_CAP (1u << 18)
#define LAS __attribute__((address_space(3)))

__device__ __forceinline__ unsigned xb_ld(unsigned* p)              { return __hip_atomic_load(p, __ATOMIC_RELAXED, __HIP_MEMORY_SCOPE_AGENT); }
__device__ __forceinline__ unsigned xb_add(unsigned* p, unsigned v) { return __hip_atomic_fetch_add(p, v, __ATOMIC_RELAXED, __HIP_MEMORY_SCOPE_AGENT); }
__device__ __forceinline__ unsigned xb_xcc_id() { return (unsigned)__builtin_amdgcn_s_getreg((3 << 11) | 20) & 0xFu; }
#define XB_SPIN(cond, bar) do { unsigned _sp = 0; while (cond) { __builtin_amdgcn_s_sleep(1); \
    if ((++_sp & 255u) == 0u) { if (xb_ld(&(bar)[XB_TMO])) break; if (_sp > XB_SPIN_CAP) { atomicAdd(&(bar)[XB_TMO], 1u); break; } } } } while (0)

struct XcdBarrier {
    unsigned* bar; unsigned x;
    volatile LAS unsigned* st;
};

__device__ __forceinline__ XcdBarrier xcd_barrier_post(unsigned* bar, volatile LAS unsigned* st) {
    XcdBarrier b; b.bar = bar; b.x = xb_xcc_id(); b.st = st;
    if (threadIdx.x == 0) (void)xb_add(&bar[XB_XCNT(b.x)], 1u);
    return b;
}
__device__ __forceinline__ void xcd_barrier_complete(unsigned* bar, unsigned x, unsigned& nloc, unsigned& nx) {
    const unsigned G = gridDim.x * gridDim.y * gridDim.z;
    unsigned sum, cnt, mine, sp = 0u;
    for (;;) {
        sum = 0u; cnt = 0u; mine = 0u;
#pragma unroll
        for (unsigned j = 0; j < 16; ++j) { const unsigned c = xb_ld(&bar[XB_XCNT(j)]); sum += c; cnt += (c > 0u) ? 1u : 0u; mine = (j == x) ? c : mine; }
        if (sum == G) break;
        __builtin_amdgcn_s_sleep(1);
        if ((++sp & 255u) == 0u) { if (xb_ld(&bar[XB_TMO])) break; if (sp > XB_SPIN_CAP) { atomicAdd(&bar[XB_TMO], 1u); break; } }
    }
    nloc = mine > 0u ? mine : 1u; nx = cnt > 0u ? cnt : 1u;
}

__device__ __forceinline__ void xcd_barrier(const XcdBarrier& b) {
    asm volatile("s_waitcnt vmcnt(0)" ::: "memory");
    __syncthreads();
    if (threadIdx.x == 0) {
        unsigned* bar = b.bar;
        __builtin_amdgcn_s_waitcnt(0);
        unsigned nloc = b.st[0], nx = b.st[1];
        if (nloc == 0u) { xcd_barrier_complete(bar, b.x, nloc, nx); b.st[0] = nloc; b.st[1] = nx; }
        const unsigned old = xb_add(&bar[XB_XSUB(b.x)], 1u);
        const unsigned gen = old / nloc;
        if (old + 1u == (gen + 1u) * nloc) {
            __builtin_amdgcn_fence(__ATOMIC_RELEASE, "agent");
            asm volatile("s_waitcnt vmcnt(0)" ::: "memory");
            const unsigned og = xb_add(&bar[XB_TOP], 1u);
            const unsigned tg = og / nx;
            if (og + 1u == (tg + 1u) * nx) xb_add(&bar[XB_TOPGEN], 1u);
            else XB_SPIN(xb_ld(&bar[XB_TOPGEN]) == tg, bar);
            __builtin_amdgcn_fence(__ATOMIC_ACQUIRE, "agent");
            xb_add(&bar[XB_XGEN(b.x)], 1u);
            asm volatile("s_waitcnt vmcnt(0)" ::: "memory");
        } else {
            XB_SPIN(xb_ld(&bar[XB_XGEN(b.x)]) == gen, bar);
            __builtin_amdgcn_fence(__ATOMIC_ACQUIRE, "agent");
            asm volatile("s_waitcnt vmcnt(0)" ::: "memory");
        }
    }
    __syncthreads();
}

namespace pg8 {
#define PG8_LAS __attribute__((address_space(3)))
typedef unsigned short bf16_t;
typedef short bf16x8 __attribute__((ext_vector_type(8)));
typedef float f32x4 __attribute__((ext_vector_type(4)));
typedef unsigned u32x4 __attribute__((ext_vector_type(4)));
constexpr int BM = 256, BK = 64, HALF = 128, HTB = HALF * BK * 2  , STAGE_BYTES = 8 * HTB, NXCD = 8, WGM = 8;

__host__ __device__ __forceinline__ int lds_byte(int r, int c) { const int st = (r >> 4) * 2 + (c >> 5), rr = r & 15, cc = c & 31, ob = rr * 64 + cc * 2; return st * 1024 + (ob ^ (((ob >> 9) & 1) << 5)); }
__host__ __device__ __forceinline__ void stage_rc(int b, int& R, int& C) { const int st = b / 1024, sb = b % 1024, swz = sb ^ (((sb >> 9) & 1) << 5); R = (st >> 1) * 16 + swz / 64; C = (st & 1) * 32 + (swz % 64) / 2; }
__host__ __device__ __forceinline__ int perm32(int rho) { const int n = rho >> 4, i = rho & 15; return 8 * (i >> 2) + 4 * n + (i & 3); }

struct Unit { int pm, pn; };
struct Gemm { const bf16_t* A; const bf16_t* Bt; int M, N, K; };

struct StaticOrder {
    int nM, nN, nwg, G, c;
    __host__ __device__ void init(int M, int N, int G_, int c_) { nM = M / BM; nN = N / BM; nwg = nM * nN; G = G_; c = c_; }
    __host__ __device__ bool next(int i, Unit& u) const {
        const long L = (long)i * G + c; if (L >= nwg) return false;
        int wgid = (int)L; { const int q = nwg / NXCD, r = nwg % NXCD, xcd = wgid % NXCD, off = wgid / NXCD; wgid = (xcd < r ? xcd * (q + 1) : r * (q + 1) + (xcd - r) * q) + off; }
        const int nig = WGM * nN, gid = wgid / nig, fm = gid * WGM, gsz = (nM - fm) < WGM ? (nM - fm) : WGM;
        u.pm = fm + ((wgid % nig) % gsz); u.pn = (wgid % nig) / gsz; return true;
    }
    __device__ __forceinline__ void a_ready(const Unit&) const {}
    __device__ __forceinline__ void done(const Unit&) const {}
};
template <class Epi, class Sched, bool ALIGN_EPI = false, bool SP2 = false>
__device__ __forceinline__ void gemm_phase(PG8_LAS unsigned char* lds, const Gemm g, const Sched& S, const Epi& E) {
    int tid = threadIdx.x; asm volatile("" : "+v"(tid)); const int wid = __builtin_amdgcn_readfirstlane(tid >> 6), lane = tid & 63, wr = wid >> 2, wc = wid & 3, fr = lane & 15, fq = lane >> 4;
    const int K = g.K, nt = K / BK;
    unsigned voffA[2], voffB[2];
#pragma unroll
    for (int i = 0; i < 2; ++i) { int R, C; stage_rc(tid * 16 + i * 8192, R, C); const int Rb = (R >> 5) * 64 + perm32(R & 31);
        voffA[i] = (unsigned)(R * K + C) * 2u; voffB[i] = (unsigned)(Rb * K + C) * 2u; }
    const size_t kstep = (size_t)(BK * 2);
    const size_t hstep = (size_t)HALF * K * 2; const size_t bhstep = (size_t)32 * K * 2;
    const size_t tstep = 2 * hstep;
    const unsigned ldsw = (unsigned)wid * 1024u;
    const int aoff = lds_byte(wr * 64 + fr, fq * 8), boff = lds_byte(wc * 32 + fr, fq * 8);
#define PG8_SA(b, h) (((b) * 2 + (h)) * HTB)
#define PG8_SB(b, h) ((4 + (b) * 2 + (h)) * HTB)
#define PG8_STAGE(bufoff, gbase, voff) do { _Pragma("unroll") for (int _i = 0; _i < 2; ++_i) \
        __builtin_amdgcn_global_load_lds((const unsigned*)((const char*)(gbase) + (voff)[_i]), (PG8_LAS unsigned*)(lds + (bufoff) + ldsw + _i * 8192), 16, 0, 0); } while (0)
#define PG8_LDA(dst, b, h) do { _Pragma("unroll") for (int m = 0; m < 4; ++m) _Pragma("unroll") for (int k = 0; k < 2; ++k) dst[m][k] = *(const PG8_LAS bf16x8*)(lds + PG8_SA(b, h) + aoff + m * 2048 + k * 1024); } while (0)
#define PG8_LDB(dst, b, h) do { _Pragma("unroll") for (int n = 0; n < 2; ++n) _Pragma("unroll") for (int k = 0; k < 2; ++k) dst[n][k] = *(const PG8_LAS bf16x8*)(lds + PG8_SB(b, h) + boff + n * 2048 + k * 1024); } while (0)
#define PG8_MMA(ai, bj, At, Bt) do { __builtin_amdgcn_s_setprio(1); _Pragma("unroll") for (int m = 0; m < 4; ++m) _Pragma("unroll") for (int n = 0; n < 2; ++n) _Pragma("unroll") for (int k = 0; k < 2; ++k) \
        acc[ai][bj][m][n] = __builtin_amdgcn_mfma_f32_16x16x32_bf16(Bt[n][k], At[m][k], acc[ai][bj][m][n], 0, 0, 0); __builtin_amdgcn_s_setprio(0); } while (0)
#define PG8_WAIT_V(n) asm volatile("s_waitcnt vmcnt(" #n ")" ::: "memory")
#define PG8_WAIT_L(n) asm volatile("s_waitcnt lgkmcnt(" #n ")" ::: "memory")
#define PG8_BAR __builtin_amdgcn_s_barrier()
#define PG8_SCHED __builtin_amdgcn_sched_barrier(0)
    Unit cur, nxt; int ui = 0;
    if (!S.next(0, cur)) return;
    f32x4 acc[2][2][4][2];
#pragma unroll
    for (int a = 0; a < 2; ++a)
#pragma unroll
        for (int b = 0; b < 2; ++b)
#pragma unroll
            for (int m = 0; m < 4; ++m)
#pragma unroll
                for (int n = 0; n < 2; ++n) acc[a][b][m][n] = (f32x4){0.f, 0.f, 0.f, 0.f};
    bf16x8 At[4][2], B0[2][2], B1[2][2];
    const char* cA = (const char*)g.A + (size_t)cur.pm * tstep; const char* cB = (const char*)g.Bt + (size_t)cur.pn * tstep;
    S.a_ready(cur);
    if constexpr (SP2) {
        PG8_STAGE(PG8_SB(0, 0), cB, voffB); PG8_STAGE(PG8_SB(0, 1), cB + bhstep, voffB); PG8_STAGE(PG8_SA(0, 0), cA, voffA); PG8_STAGE(PG8_SA(0, 1), cA + hstep, voffA);
        if (wr == 1) PG8_BAR;
        PG8_WAIT_V(2); PG8_BAR;
        PG8_STAGE(PG8_SB(1, 0), cB + kstep, voffB); PG8_STAGE(PG8_SA(1, 0), cA + kstep, voffA); PG8_STAGE(PG8_SB(1, 1), cB + bhstep + kstep, voffB);
        PG8_WAIT_V(6); PG8_BAR;
    } else {
        PG8_STAGE(PG8_SB(0, 0), cB, voffB); PG8_STAGE(PG8_SA(0, 0), cA, voffA); PG8_STAGE(PG8_SB(0, 1), cB + bhstep, voffB); PG8_STAGE(PG8_SA(0, 1), cA + hstep, voffA);
        if (wr == 1) PG8_BAR;
        PG8_WAIT_V(4); PG8_BAR;
        PG8_STAGE(PG8_SB(1, 0), cB + kstep, voffB); PG8_STAGE(PG8_SA(1, 0), cA + kstep, voffA); PG8_STAGE(PG8_SB(1, 1), cB + bhstep + kstep, voffB);
        PG8_WAIT_V(6); PG8_BAR;
    }
    for (;;) {
        const bool has_next = S.next(ui + 1, nxt);
        const char* nA = has_next ? (const char*)g.A + (size_t)nxt.pm * tstep : cA; const char* nB = has_next ? (const char*)g.Bt + (size_t)nxt.pn * tstep : cB;
        for (int t = 0; t < nt; t += 2) {
            const bool last = (t == nt - 2);
            const char* a1 = cA + (size_t)(t + 1) * kstep;
            const char* a2 = last ? nA : cA + (size_t)(t + 2) * kstep; const char* b2 = last ? nB : cB + (size_t)(t + 2) * kstep;
            const char* a3 = a2 + kstep; const char* b3 = b2 + kstep;
            if (last && has_next) S.a_ready(nxt);
            if constexpr (SP2) {
            PG8_LDB(B0, 0, 0); PG8_LDB(B1, 0, 1); PG8_SCHED; PG8_LDA(At, 0, 0); PG8_STAGE(PG8_SA(1, 1), a1 + hstep, voffA);
            PG8_WAIT_V(8); PG8_WAIT_L(0); PG8_BAR; PG8_MMA(0, 0, At, B0); PG8_MMA(0, 1, At, B1); PG8_BAR; PG8_SCHED;
            PG8_LDA(At, 0, 1); PG8_STAGE(PG8_SB(0, 0), b2, voffB); PG8_STAGE(PG8_SB(0, 1), b2 + bhstep, voffB); PG8_STAGE(PG8_SA(0, 0), a2, voffA);
            PG8_WAIT_V(8); PG8_WAIT_L(0); PG8_BAR; PG8_MMA(1, 0, At, B0); PG8_MMA(1, 1, At, B1); PG8_BAR; PG8_SCHED;
            PG8_LDB(B0, 1, 0); PG8_LDB(B1, 1, 1); PG8_SCHED; PG8_LDA(At, 1, 0); PG8_STAGE(PG8_SA(0, 1), a2 + hstep, voffA);
            PG8_WAIT_V(8); PG8_WAIT_L(0); PG8_BAR; PG8_MMA(0, 0, At, B0); PG8_MMA(0, 1, At, B1); PG8_BAR; PG8_SCHED;
            PG8_LDA(At, 1, 1); PG8_STAGE(PG8_SB(1, 0), b3, voffB); PG8_STAGE(PG8_SB(1, 1), b3 + bhstep, voffB); PG8_STAGE(PG8_SA(1, 0), a3, voffA);
            PG8_WAIT_V(8); PG8_WAIT_L(0); PG8_BAR; PG8_MMA(1, 0, At, B0); PG8_MMA(1, 1, At, B1); PG8_BAR; PG8_SCHED;
            } else {
            PG8_LDB(B0, 0, 0); PG8_SCHED; PG8_LDA(At, 0, 0); PG8_STAGE(PG8_SA(1, 1), a1 + hstep, voffA);
            PG8_WAIT_L(8); PG8_BAR; PG8_WAIT_L(0); PG8_MMA(0, 0, At, B0); PG8_BAR; PG8_SCHED;
            PG8_LDB(B1, 0, 1); PG8_STAGE(PG8_SB(0, 0), b2, voffB);
            PG8_BAR; PG8_WAIT_L(0); PG8_MMA(0, 1, At, B1); PG8_BAR;
            PG8_LDA(At, 0, 1); PG8_STAGE(PG8_SA(0, 0), a2, voffA);
            PG8_BAR; PG8_WAIT_L(0); PG8_MMA(1, 0, At, B0); PG8_BAR; PG8_SCHED;
            PG8_STAGE(PG8_SB(0, 1), b2 + bhstep, voffB);
            PG8_WAIT_V(6); PG8_BAR; PG8_MMA(1, 1, At, B1); PG8_BAR;
            PG8_LDB(B0, 1, 0); PG8_SCHED; PG8_LDA(At, 1, 0); PG8_STAGE(PG8_SA(0, 1), a2 + hstep, voffA);
            PG8_WAIT_L(8); PG8_BAR; PG8_WAIT_L(0); PG8_MMA(0, 0, At, B0); PG8_BAR; PG8_SCHED;
            PG8_LDB(B1, 1, 1); PG8_STAGE(PG8_SB(1, 0), b3, voffB);
            PG8_BAR; PG8_WAIT_L(0); PG8_MMA(0, 1, At, B1); PG8_BAR;
            PG8_LDA(At, 1, 1); PG8_STAGE(PG8_SA(1, 0), a3, voffA);
            PG8_BAR; PG8_WAIT_L(0); PG8_MMA(1, 0, At, B0); PG8_BAR; PG8_SCHED;
            PG8_STAGE(PG8_SB(1, 1), b3 + bhstep, voffB);
            PG8_WAIT_V(6); PG8_BAR; PG8_MMA(1, 1, At, B1); PG8_BAR;
            }
        }
        if constexpr (ALIGN_EPI) { if (wr == 0) PG8_BAR; }
        if constexpr (!Epi::AFTER_DRAIN) { E(acc, cur, wr, wc, fr, fq); S.done(cur); }
        if (!has_next) break;
#pragma unroll
        for (int a = 0; a < 2; ++a)
#pragma unroll
            for (int b = 0; b < 2; ++b)
#pragma unroll
                for (int m = 0; m < 4; ++m)
#pragma unroll
                    for (int n = 0; n < 2; ++n) acc[a][b][m][n] = (f32x4){0.f, 0.f, 0.f, 0.f};
        cur = nxt; cA = nA; cB = nB; ++ui;
        if constexpr (ALIGN_EPI) { if (wr == 1) PG8_BAR; }
    }
    PG8_WAIT_V(0);
    if constexpr (!ALIGN_EPI) { if (wr == 0) PG8_BAR; }
    PG8_BAR;
    if constexpr (Epi::AFTER_DRAIN) { E.fused(acc, cur, wr, wc, fr, fq, lds, wid, lane); S.done(cur); }
#undef PG8_SA
#undef PG8_SB
#undef PG8_STAGE
#undef PG8_LDA
#undef PG8_LDB
#undef PG8_MMA
#undef PG8_WAIT_V
#undef PG8_WAIT_L
#undef PG8_BAR
#undef PG8_SCHED
}
}

#ifndef PG8_SP2
#define PG8_SP2 true
#endif
#ifndef PG8_ALIGN
#define PG8_ALIGN true
#endif
#ifndef PROBE_B
#define PROBE_B 0
#endif
#ifndef LN_UR
#define LN_UR 2
#endif
#ifndef LN_NR
#define LN_NR 2
#endif
#ifndef FUSE_LN
#define FUSE_LN 0
#endif
#ifndef NT_STORE
#define NT_STORE 0
#endif
#ifndef PROBE_T
#define PROBE_T 0
#endif
#ifndef PROBE_MUL
#define PROBE_MUL 1
#endif
#ifndef SGB_R
#define SGB_R 24
#endif
#ifndef SGB_N
#define SGB_N 16
#endif
#ifndef SGB_V
#define SGB_V 14
#endif
#ifndef PROBE_X
#define PROBE_X 0
#endif
#ifndef PROBE_SYNC
#define PROBE_SYNC 0
#endif

constexpr int TP = 8192;
constexpr int TS = 32768;
constexpr int TT = TP + TS;
constexpr int DM = 1024;
constexpr int NIN = 3072;
constexpr int NLAYER = 4;
constexpr float ALPHA = 1.6817928305074292f;
constexpr float LOG2E = 1.4426950408889634f;
constexpr float C1 = 0.125f * LOG2E;
constexpr size_t OUT_NK = (size_t)TT * DM;
constexpr size_t OUT_NV = OUT_NK + (size_t)32 * 4 * 256 * 256;
constexpr size_t OUT_GK = OUT_NV + (size_t)32 * 4 * 256 * 256;
constexpr size_t OUT_GV = OUT_GK + (size_t)32 * 4 * 256 * 128;

struct Params {
  const float *x_prompt, *x_sample, *c, *cnk, *cnv, *cgk, *cgv, *c_ctx, *w_mod, *b_mod, *w_in, *b_in, *pool_w, *pool_scale,
      *nat_bias, *q_norm, *k_norm, *conv_w, *conv_b, *conv_ln_g, *conv_ln_b, *conv_pw, *w_out, *b_out, *ln_g, *ln_b;
  float* out;
  char* ws;
  int ph0, ph1;
};
constexpr size_t WS_WINT = 0;
constexpr size_t WS_WOUTT = WS_WINT + (size_t)4 * 3072 * 1024 * 2;
constexpr size_t WS_PWT = WS_WOUTT + (size_t)4 * 1024 * 1024 * 2;
constexpr size_t WS_POOLT = WS_PWT + (size_t)4 * 256 * 256 * 2;
constexpr size_t WS_CNK = WS_POOLT + (size_t)16 * 4096 * 2;
constexpr size_t WS_CNV = WS_CNK + (size_t)4194304 * 2;
constexpr size_t WS_CGK = WS_CNV + (size_t)4194304 * 2;
constexpr size_t WS_CGV = WS_CGK + (size_t)2097152 * 2;
constexpr size_t WS_U = WS_CGV + (size_t)2097152 * 2;
constexpr size_t WS_H = WS_U + (size_t)TT * NIN * 2;
constexpr size_t WS_MX = WS_H;
constexpr size_t WS_MOD = WS_MX + (size_t)TT * DM * 2;
constexpr size_t WS_STATS = WS_MOD + (size_t)4 * 9 * 3072 * 4;
constexpr size_t WS_CNT = WS_STATS + (size_t)TT * 2 * 4;
constexpr size_t WS_BAR = WS_CNT + 8192;
constexpr size_t WS_KN = WS_BAR + 16384;
constexpr size_t WS_VN = WS_KN + (size_t)4 * TT * 64 * 2;
constexpr size_t WS_KG = WS_VN + (size_t)4 * TT * 64 * 2;
constexpr size_t WS_VG = WS_KG + (size_t)2 * TT * 64 * 2;
constexpr size_t WS_PARAMS = WS_VG + (size_t)2 * TT * 64 * 2;
constexpr size_t WS_END = WS_PARAMS + 4096;
#define P_WinT ((bf16_t*)(p.ws + WS_WINT))
#define P_WoutT ((bf16_t*)(p.ws + WS_WOUTT))
#define P_pwT ((bf16_t*)(p.ws + WS_PWT))
#define P_poolT ((bf16_t*)(p.ws + WS_POOLT))
#define P_cnk_b ((bf16_t*)(p.ws + WS_CNK))
#define P_cnv_b ((bf16_t*)(p.ws + WS_CNV))
#define P_cgk_b ((bf16_t*)(p.ws + WS_CGK))
#define P_cgv_b ((bf16_t*)(p.ws + WS_CGV))
#define P_U ((bf16_t*)(p.ws + WS_U))
#define P_H ((bf16_t*)(p.ws + WS_H))
#define P_MX ((bf16_t*)(p.ws + WS_MX))
#define P_mod ((float*)(p.ws + WS_MOD))
#define P_stats ((float*)(p.ws + WS_STATS))
#define P_cnt ((unsigned*)(p.ws + WS_CNT))
#define P_bar ((unsigned*)(p.ws + WS_BAR))
#define P_KN ((bf16_t*)(p.ws + WS_KN))
#define P_VN ((bf16_t*)(p.ws + WS_VN))
#define P_KG ((bf16_t*)(p.ws + WS_KG))
#define P_VG ((bf16_t*)(p.ws + WS_VG))

DEV Params load_params(char* ws0) {
#if defined(__HIP_DEVICE_COMPILE__)
  typedef const __attribute__((address_space(4))) unsigned long long cu64;
  cu64* q = (cu64*)(ws0 + WS_PARAMS);
  asm volatile("" : "+s"(q));
  Params r;
  unsigned long long* d = (unsigned long long*)&r;
  static_assert(sizeof(Params) % 8 == 0, "Params is a whole number of 8-byte words");
#pragma unroll
  for (int i = 0; i < (int)(sizeof(Params) / 8); ++i) d[i] = q[i];
  return r;
#else
  return *(const Params*)(ws0 + WS_PARAMS);
#endif
}
DEV float bf2f(bf16_t h) { return __uint_as_float(((unsigned)h) << 16); }
DEV unsigned pk2(float lo, float hi) { f32x2 v = {lo, hi}; bf16x2_t b = __builtin_convertvector(v, bf16x2_t); return __builtin_bit_cast(unsigned, b); }
DEV bf16_t f2bf(float f) { return (bf16_t)(pk2(f, 0.f) & 0xffffu); }
DEV float bflo(unsigned w) { return __uint_as_float(w << 16); }
DEV float bfhi(unsigned w) { return __uint_as_float(w & 0xffff0000u); }
DEV float silu_f(float x) { return x * __builtin_amdgcn_rcpf(1.f + __expf(-x)); }
DEV float sigm_f(float x) { return __builtin_amdgcn_rcpf(1.f + __expf(-x)); }
DEV f32x4 mfma16(bf16x8 a, bf16x8 b, f32x4 c) { return __builtin_amdgcn_mfma_f32_16x16x32_bf16(a, b, c, 0, 0, 0); }
typedef short v4i16_t __attribute__((ext_vector_type(4)));
DEV s16x4 tr16(const char* p) {
  return __builtin_bit_cast(s16x4, __builtin_amdgcn_ds_read_tr16_b64_v4i16((__attribute__((address_space(3))) v4i16_t*)p));
}
DEV float xr16(float v, bool mx) {
  auto r = __builtin_amdgcn_permlane16_swap(__float_as_uint(v), __float_as_uint(v), false, false);
  const float a = __uint_as_float(r[0]), b = __uint_as_float(r[1]);
  return mx ? fmaxf(a, b) : a + b;
}
DEV float xr32(float v, bool mx) {
  auto r = __builtin_amdgcn_permlane32_swap(__float_as_uint(v), __float_as_uint(v), false, false);
  const float a = __uint_as_float(r[0]), b = __uint_as_float(r[1]);
  return mx ? fmaxf(a, b) : a + b;
}
DEV float wave_sum(float v) {
  v += __shfl_xor(v, 1); v += __shfl_xor(v, 2); v += __shfl_xor(v, 4); v += __shfl_xor(v, 8); v += __shfl_xor(v, 16); v += __shfl_xor(v, 32);
  return v;
}
DEV int get_tid() { int t = threadIdx.x & 255; asm volatile("" : "+v"(t)); return t; }
DEV int get_half() { return __builtin_amdgcn_readfirstlane((int)(threadIdx.x >> 8)); }
DEV int cond_of_row(int row) { return row < TP ? 0 : 1 + ((row - TP) >> 12); }

DEV void tconv_tile(const float* src, int sld, bf16_t* dst, int dld, char* smem) {
  float* t = (float*)smem;
  const int tid = get_tid();
#pragma unroll
  for (int i = 0; i < 16; ++i) { int idx = tid + i * 256; int r = idx >> 6, c = idx & 63; t[r * 65 + c] = src[(size_t)r * sld + c]; }
  __syncthreads();
#pragma unroll
  for (int i = 0; i < 4; ++i) {
    const int idx = tid + i * 256, n = idx >> 4, k = (idx & 15) * 4;
    u32x2 w; w.x = pk2(t[k * 65 + n], t[(k + 1) * 65 + n]); w.y = pk2(t[(k + 2) * 65 + n], t[(k + 3) * 65 + n]);
    *(u32x2*)(dst + (size_t)n * dld + k) = w;
  }
  __syncthreads();
}

DEV void cvt_unit(const float* src, bf16_t* dst, int u, int nh) {
  const size_t base = (size_t)u * 16384;
  const int tid = get_tid();
#pragma unroll
  for (int i = 0; i < 16; ++i) {
    const size_t e = base + (size_t)(i * 256 + tid) * 4;
    f32x4 v = *(const f32x4*)(src + e);
    u32x2 w; w.x = pk2(v[0], v[1]); w.y = pk2(v[2], v[3]);
    const size_t d = e & 63, hh = (e >> 6) % nh, sidx = (e / (64 * nh)) & 511, bl = e / ((size_t)64 * nh * 512);
    *(u32x2*)(dst + ((bl * nh + hh) * 512 + sidx) * 64 + d) = w;
  }
}

DEV void mod_unit(const Params& p, int u, char* smem) {
  const int l = u / 48, n0 = (u % 48) * 64, tid = get_tid();
  float* sc = (float*)smem;
  float* red = (float*)(smem + 36864);
  for (int i = tid; i < 9216; i += 256) { int c = i >> 10, k = i & 1023; float v = (c == 0) ? p.c_ctx[k] : p.c[(c - 1) * 1024 + k]; sc[i] = silu_f(v); }
  __syncthreads();
  const int kq = tid >> 6, col = n0 + (tid & 63);
  float acc[9];
#pragma unroll
  for (int c = 0; c < 9; ++c) acc[c] = 0.f;
  const float* wp = p.w_mod + ((size_t)l * 1024 + kq * 256) * 3072 + col;
#pragma unroll 8
  for (int k = 0; k < 256; ++k) {
    float w = wp[(size_t)k * 3072];
#pragma unroll
    for (int c = 0; c < 9; ++c) acc[c] += sc[c * 1024 + kq * 256 + k] * w;
  }
#pragma unroll
  for (int c = 0; c < 9; ++c) red[(kq * 9 + c) * 64 + (tid & 63)] = acc[c];
  __syncthreads();
  for (int i = tid; i < 576; i += 256) {
    int c = i >> 6, j = i & 63;
    float s = red[(0 * 9 + c) * 64 + j] + red[(1 * 9 + c) * 64 + j] + red[(2 * 9 + c) * 64 + j] + red[(3 * 9 + c) * 64 + j];
    P_mod[((size_t)l * 9 + c) * 3072 + n0 + j] = s + p.b_mod[l * 3072 + n0 + j];
  }
  __syncthreads();
}

DEV void h0_unit(const Params& p, int u) {
  const int tid = get_tid(), col = (tid & 127) * 8, rpar = tid >> 7;
  const int row0 = u * 32;
  const int cond = cond_of_row(row0);
  const float* md = P_mod + (size_t)cond * 3072;
  const f32x4 sh0 = *(const f32x4*)(md + col), sh1 = *(const f32x4*)(md + col + 4), sc0 = *(const f32x4*)(md + 1024 + col), sc1 = *(const f32x4*)(md + 1024 + col + 4);
#pragma unroll 4
  for (int i = 0; i < 16; ++i) {
    const int row = row0 + i * 2 + rpar;
    const float* xr = (row < TP) ? p.x_prompt + (size_t)row * DM : p.x_sample + (size_t)(row - TP) * DM;
    const f32x4 x0 = *(const f32x4*)(xr + col), x1 = *(const f32x4*)(xr + col + 4);
    const f32x4 h0v = x0 * (sc0 + 1.f) + sh0, h1v = x1 * (sc1 + 1.f) + sh1;
    u32x4 w; w.x = pk2(h0v[0], h0v[1]); w.y = pk2(h0v[2], h0v[3]); w.z = pk2(h1v[0], h1v[1]); w.w = pk2(h1v[2], h1v[3]);
    *(u32x4*)(P_H + (size_t)row * DM + col) = w;
  }
}

template <int NR>
DEV void ln_rowsN(const Params& p, int l, int row0, int lane) {
  float* Y = p.out;
  f32x4 v[NR][4];
#pragma unroll
  for (int r = 0; r < NR; ++r)
#pragma unroll
    for (int q = 0; q < 4; ++q) v[r][q] = *(const f32x4*)(Y + (size_t)(row0 + r) * DM + q * 256 + lane * 4);
  const int cond = cond_of_row(row0);
#pragma unroll
  for (int r = 0; r < NR; ++r) {
    const int row = row0 + r;
    float sm = 0.f;
#pragma unroll
    for (int q = 0; q < 4; ++q) sm += (v[r][q][0] + v[r][q][1]) + (v[r][q][2] + v[r][q][3]);
    const float mean = wave_sum(sm) * (1.f / 1024.f);
    float s2 = 0.f;
#pragma unroll
    for (int q = 0; q < 4; ++q) { v[r][q] = v[r][q] - mean; s2 += (v[r][q][0] * v[r][q][0] + v[r][q][1] * v[r][q][1]) + (v[r][q][2] * v[r][q][2] + v[r][q][3] * v[r][q][3]); }
    const float rstd = rsqrtf(wave_sum(s2) * (1.f / 1024.f) + 1e-5f);
#pragma unroll
    for (int q = 0; q < 4; ++q) {
      const int col = q * 256 + lane * 4;
      const f32x4 g = *(const f32x4*)(p.ln_g + l * 1024 + col), b = *(const f32x4*)(p.ln_b + l * 1024 + col);
      f32x4 x = v[r][q] * rstd * g + b;
      if (l < NLAYER - 1) {
        const float* md = P_mod + ((size_t)(l + 1) * 9 + cond) * 3072;
        const f32x4 sh = *(const f32x4*)(md + col), sc = *(const f32x4*)(md + 1024 + col);
        f32x4 h = x * (sc + 1.f) + sh;
        u32x2 w; w.x = pk2(h[0], h[1]); w.y = pk2(h[2], h[3]);
        *(u32x2*)(P_H + (size_t)row * DM + col) = w;
      } else {
        *(f32x4*)(Y + (size_t)row * DM + col) = x;
      }
    }
    if (l < NLAYER - 1 && lane == 0) { P_stats[row * 2] = mean; P_stats[row * 2 + 1] = rstd; }
  }
}

struct EpiA {
  static constexpr bool PERM = false, AFTER_DRAIN = false;
  char* ws0; int l_in;
  DEV void operator()(f32x4 (&acc)[2][2][4][2], const pg8::Unit& u, int wr, int wc, int, int) const {
    const int lane_ = (int)__builtin_amdgcn_mbcnt_hi(~0u, __builtin_amdgcn_mbcnt_lo(~0u, 0u)), fr = lane_ & 15, fq = lane_ >> 4;
    const Params p = load_params(ws0);
    int l = l_in; asm volatile("" : "+s"(l));
    const int colb = u.pn * 256 + wc * 64;
    const int reg = colb >> 6;
    const bool prompt = (u.pm * 256) < TP;
    f32x4 bias[2][2];
#pragma unroll
    for (int bj = 0; bj < 2; ++bj)
#pragma unroll
      for (int n = 0; n < 2; ++n) bias[bj][n] = *(const f32x4*)(p.b_in + l * 3072 + colb + bj * 32 + 8 * fq + 4 * n);
    const bool rms = (reg >= 36 && reg < 42);
    const float* gptr = (reg < 40 ? p.q_norm : p.k_norm) + l * 64;
    bf16_t* kvb = nullptr;
    if (reg >= 12 && reg < 16) kvb = P_KN + (size_t)(reg - 12) * TT * 64;
    else if (reg >= 16 && reg < 20) kvb = P_VN + (size_t)(reg - 16) * TT * 64;
    else if (reg >= 40 && reg < 42) kvb = P_KG + (size_t)(reg - 40) * TT * 64;
    else if (reg >= 42 && reg < 44) kvb = P_VG + (size_t)(reg - 42) * TT * 64;
    float* ob = nullptr; int hw = 0, cofs = 0;
    if (prompt) {
      if (reg >= 12 && reg < 16) { ob = p.out + OUT_NK; hw = 256; cofs = colb - 768; }
      else if (reg >= 16 && reg < 20) { ob = p.out + OUT_NV; hw = 256; cofs = colb - 1024; }
      else if (reg >= 40 && reg < 42) { ob = p.out + OUT_GK; hw = 128; cofs = colb - 2560; }
      else if (reg >= 42 && reg < 44) { ob = p.out + OUT_GV; hw = 128; cofs = colb - 2688; }
    }
#pragma unroll
    for (int ai = 0; ai < 2; ++ai)
#pragma unroll
      for (int m = 0; m < 4; ++m) {
        const int row = u.pm * 256 + ai * 128 + wr * 64 + m * 16 + fr;
        f32x4 v[2][2];
#pragma unroll
        for (int bj = 0; bj < 2; ++bj)
#pragma unroll
          for (int n = 0; n < 2; ++n) v[bj][n] = acc[ai][bj][m][n] + bias[bj][n];
        if (rms) {
          float ss = 0.f;
#pragma unroll
          for (int bj = 0; bj < 2; ++bj)
#pragma unroll
            for (int n = 0; n < 2; ++n)
#pragma unroll
              for (int j = 0; j < 4; ++j) ss += v[bj][n][j] * v[bj][n][j];
          ss += __shfl_xor(ss, 16); ss += __shfl_xor(ss, 32);
          const float r = rsqrtf(ss * (1.f / 64.f) + 1e-6f);
#pragma unroll
          for (int bj = 0; bj < 2; ++bj)
#pragma unroll
            for (int n = 0; n < 2; ++n) v[bj][n] = v[bj][n] * r * *(const f32x4*)(gptr + bj * 32 + 8 * fq + 4 * n);
          if (!prompt) {
            const int t = (row - TP) & 4095, pr = t >> 6, pc = t & 63;
            const float sg = (fq < 2) ? -1.f : 1.f;
#pragma unroll
            for (int bj = 0; bj < 2; ++bj)
#pragma unroll
              for (int n = 0; n < 2; ++n) {
                const int pos = bj ? pc : pr;
                const f32x4 c = *(const f32x4*)(ROPE_COS + pos * 16 + 8 * (fq & 1) + 4 * n), sn = *(const f32x4*)(ROPE_SIN + pos * 16 + 8 * (fq & 1) + 4 * n);
                f32x4 other;
#pragma unroll
                for (int j = 0; j < 4; ++j) {
                  auto r = __builtin_amdgcn_permlane32_swap(__float_as_uint(v[bj][n][j]), __float_as_uint(v[bj][n][j]), false, false);
                  other[j] = __uint_as_float((fq < 2) ? r[1] : r[0]);
                }
                v[bj][n] = v[bj][n] * c + other * sn * sg;
              }
          }
        }
        bf16_t* up = kvb ? kvb + (size_t)row * 64 + 8 * fq : P_U + (size_t)row * NIN + colb + 8 * fq;
#pragma unroll
        for (int bj = 0; bj < 2; ++bj) {
          u32x4 w; w.x = pk2(v[bj][0][0], v[bj][0][1]); w.y = pk2(v[bj][0][2], v[bj][0][3]); w.z = pk2(v[bj][1][0], v[bj][1][1]); w.w = pk2(v[bj][1][2], v[bj][1][3]);
          *(u32x4*)(up + bj * 32) = w;
        }
        if (ob) {
          const int b = row >> 8, sq = row & 255;
          float* op = ob + ((size_t)(b * 4 + l) * 256 + sq) * hw + cofs + 8 * fq;
#pragma unroll
          for (int bj = 0; bj < 2; ++bj)
#pragma unroll
            for (int n = 0; n < 2; ++n) *(f32x4*)(op + bj * 32 + n * 4) = v[bj][n];
        }
      }
  }
};

struct EpiC {
  static constexpr bool PERM = false, AFTER_DRAIN = false;
  char* ws0; int l_in; char* lds_x;
  DEV void operator()(f32x4 (&acc)[2][2][4][2], const pg8::Unit& u, int wr, int wc, int, int) const {
    const int lane_ = (int)__builtin_amdgcn_mbcnt_hi(~0u, __builtin_amdgcn_mbcnt_lo(~0u, 0u)), fr = lane_ & 15, fq = lane_ >> 4;
    const Params p = load_params(ws0);
    int l = l_in; asm volatile("" : "+s"(l));
    const int colb = u.pn * 256 + wc * 64 + 8 * fq;
    const int cond = cond_of_row(u.pm * 256);
    const float* gatep = P_mod + ((size_t)l * 9 + cond) * 3072 + 2048;
    float* Y = p.out;
    auto xrow = [&](int it) -> const float* {
      const int row = u.pm * 256 + (it >> 2) * 128 + wr * 64 + (it & 3) * 16 + fr;
      if (l == 0) return (row < TP) ? p.x_prompt + (size_t)row * DM : p.x_sample + (size_t)(row - TP) * DM;
      return Y + (size_t)row * DM;
    };
    f32x4 xq[2][4]; f32x2 st[2];
    {
      const float* xr = xrow(0);
#pragma unroll
      for (int k = 0; k < 4; ++k) xq[0][k] = *(const f32x4*)(xr + colb + (k >> 1) * 32 + (k & 1) * 4);
      st[0] = (l > 0) ? *(const f32x2*)(P_stats + (size_t)(u.pm * 256 + wr * 64 + fr) * 2) : (f32x2){0.f, 1.f};
    }
#pragma unroll
    for (int it = 0; it < 8; ++it) {
      const int ai = it >> 2, m = it & 3;
      const int row = u.pm * 256 + ai * 128 + wr * 64 + m * 16 + fr;
      if (it + 1 < 8) {
        const float* xr = xrow(it + 1);
#pragma unroll
        for (int k = 0; k < 4; ++k) xq[(it + 1) & 1][k] = *(const f32x4*)(xr + colb + (k >> 1) * 32 + (k & 1) * 4);
        const int rown = u.pm * 256 + ((it + 1) >> 2) * 128 + wr * 64 + ((it + 1) & 3) * 16 + fr;
        st[(it + 1) & 1] = (l > 0) ? *(const f32x2*)(P_stats + (size_t)rown * 2) : (f32x2){0.f, 1.f};
      }
      const float mean = st[it & 1][0], rstd = st[it & 1][1];
#pragma unroll
      for (int bj = 0; bj < 2; ++bj)
#pragma unroll
        for (int n = 0; n < 2; ++n) {
          const int col = colb + bj * 32 + n * 4;
          f32x4 xo = xq[it & 1][bj * 2 + n];
          if (l > 0) {
            const f32x4 g = *(const f32x4*)(p.ln_g + (l - 1) * 1024 + col), b = *(const f32x4*)(p.ln_b + (l - 1) * 1024 + col);
            xo = (xo - mean) * rstd * g + b;
          }
          const f32x4 gt = *(const f32x4*)(gatep + col), bo = *(const f32x4*)(p.b_out + l * 1024 + col);
          const f32x4 y = xo * ALPHA + gt * (acc[ai][bj][m][n] + bo);
#if FUSE_LN
          asm volatile("global_store_dwordx4 %0, %1, off sc1\n\ts_nop 1" :: "v"(Y + (size_t)row * DM + col), "v"(y) : "memory");
#else
          *(f32x4*)(Y + (size_t)row * DM + col) = y;
#endif
        }
    }
#if FUSE_LN
    asm volatile("s_waitcnt vmcnt(0)" ::: "memory");
    __syncthreads();
    volatile LAS unsigned* fl = (volatile LAS unsigned*)(lds_x);
    const int wave = wr * 4 + wc, lane = fq * 16 + fr;
    if (wave == 0 && lane == 0) { const unsigned old = __hip_atomic_fetch_add(P_cnt + l * 160 + u.pm, 1u, __ATOMIC_RELAXED, __HIP_MEMORY_SCOPE_AGENT); *fl = (old == 3u) ? 1u : 0u; }
    __syncthreads();
    if (*fl != 0u) {
      __builtin_amdgcn_fence(__ATOMIC_ACQUIRE, "agent");
      asm volatile("s_waitcnt vmcnt(0)" ::: "memory");
      for (int i = 0; i < 32 / LN_NR; ++i) ln_rowsN<LN_NR>(p, l, u.pm * 256 + wave * 32 + i * LN_NR, lane);
    }
    __syncthreads();
#endif
  }
};

DEV void ln_unit(const Params& p, int l, int u) {
  const int tid = get_tid(), lane = tid & 63, wid = tid >> 6;
  ln_rowsN<LN_UR>(p, l, (u * 4 + wid) * LN_UR, lane);
}

DEV int kswz(int key, int ch) {
  const int ob = (key & 15) * 64 + (ch & 3) * 16;
  return ((key >> 4) * 2 + (ch >> 2)) * 1024 + (ob ^ (((ob >> 9) & 1) << 5));
}
template <int NQ, int NKT>
DEV void qk_tile(const char* kb, int koff, const bf16x8 (&qf)[NQ][2], f32x4 (&s)[NQ][4], int fr, int fq, const float (&mb)[NQ]) {
#pragma unroll
  for (int t = 0; t < NKT; ++t) {
    const int key = koff + 16 * t + fr;
    const bf16x8 k0 = *(const bf16x8*)(kb + kswz(key, fq)), k1 = *(const bf16x8*)(kb + kswz(key, 4 + fq));
#pragma unroll
    for (int g = 0; g < NQ; ++g) { const float nb = -mb[g]; f32x4 z = {nb, nb, nb, nb}; z = mfma16(k0, qf[g][0], z); z = mfma16(k1, qf[g][1], z); s[g][t] = z; }
  }
#pragma unroll
  for (int t = NKT; t < 4; ++t)
#pragma unroll
    for (int g = 0; g < NQ; ++g) s[g][t] = (f32x4){0.f, 0.f, 0.f, 0.f};
}
template <int NQ, int NKT, bool NATL>
DEV void sm_max(f32x4 (&s)[NQ][4], int koff, f32x4 (&o)[NQ][4], float (&mrun)[NQ], f32x4 (&osum)[NQ], int fq, const float* br0, const float* br1, bool gv0, bool gv1, int qc, bool first) {
#pragma unroll
  for (int g = 0; g < NQ; ++g) {
    float mx = -1e30f;
    if (NATL) {
      const int cs = min(max(qc - 8, 0), 48);
      const float* biasrow = g ? br1 : br0;
      const bool gv = g ? gv1 : gv0;
#pragma unroll
      for (int t = 0; t < NKT; ++t)
#pragma unroll
        for (int j = 0; j < 4; ++j) {
          const int kc = koff + 16 * t + 4 * fq + j;
          const bool valid = gv && (kc >= cs) && (kc < cs + 16);
          const int dc = min(max(kc - qc + 15, 0), 30);
          const float bv = biasrow[dc];
          const float x = valid ? s[g][t][j] + bv : -1e30f;
          s[g][t][j] = x; mx = fmaxf(mx, x);
        }
    } else {
#pragma unroll
      for (int t = 0; t < NKT; ++t)
#pragma unroll
        for (int j = 0; j < 4; ++j) mx = fmaxf(mx, s[g][t][j]);
    }
    mx = xr16(mx, true); mx = xr32(mx, true);
    if (__builtin_amdgcn_ballot_w64(first || mx > 8.0f) != 0ull) {
      const float d = first ? mx : fmaxf(mx, 0.f);
      const float al = first ? 1.f : __builtin_amdgcn_exp2f(-d);
      mrun[g] += d; osum[g] = osum[g] * al;
#pragma unroll
      for (int dt = 0; dt < 4; ++dt) o[g][dt] = o[g][dt] * al;
#pragma unroll
      for (int t = 0; t < NKT; ++t) s[g][t] = s[g][t] - d;
    }
  }
}
template <int NQ, int NKT, bool NATL>
DEV void sm_exp_pv(const char* vs, int koff, f32x4 (&s)[NQ][4], f32x4 (&o)[NQ][4], const float (&mrun)[NQ], f32x4 (&osum)[NQ], int fr, int fq) {
#pragma unroll
  for (int g = 0; g < NQ; ++g)
#pragma unroll
    for (int t = 0; t < NKT; ++t)
#pragma unroll
      for (int j = 0; j < 4; ++j) s[g][t][j] = __builtin_amdgcn_exp2f(s[g][t][j]);
  const short one = (short)0x3f80;
  const bf16x8 ones = {one, one, one, one, one, one, one, one};
#pragma unroll
  for (int u = 0; u < NKT / 2; ++u) {
    bf16x8 pf[NQ];
#pragma unroll
    for (int g = 0; g < NQ; ++g) {
      u32x4 w;
      w.x = pk2(s[g][2 * u][0], s[g][2 * u][1]); w.y = pk2(s[g][2 * u][2], s[g][2 * u][3]);
      w.z = pk2(s[g][2 * u + 1][0], s[g][2 * u + 1][1]); w.w = pk2(s[g][2 * u + 1][2], s[g][2 * u + 1][3]);
      pf[g] = __builtin_bit_cast(bf16x8, w);
      osum[g] = mfma16(ones, pf[g], osum[g]);
    }
#pragma unroll
    for (int dt = 0; dt < 4; ++dt) {
      const char* vp = vs + (koff + 32 * u + 4 * fq + (fr >> 2)) * 160 + dt * 32 + (fr & 3) * 8;
      const s16x4 lo = tr16(vp), hi = tr16(vp + 16 * 160);
      const bf16x8 vf = {lo[0], lo[1], lo[2], lo[3], hi[0], hi[1], hi[2], hi[3]};
#pragma unroll
      for (int g = 0; g < NQ; ++g) o[g][dt] = mfma16(vf, pf[g], o[g][dt]);
    }
  }
}

template <int MODE>
DEV void attn_unit(const Params& p, int l, int u, char* smem, char* smem0, int half) {
  constexpr int NQ = 2;
  constexpr int QGS = (MODE == 1) ? 64 : 16;
  constexpr int NLD = (MODE == 0) ? 1 : 2;
  if constexpr (MODE == 0) smem = smem0;
  const int tid = get_tid(), lane = tid & 63, wid = tid >> 6, fr = lane & 15, fq = lane >> 4;
  int qrow0, qcol, gcol, ocol, NT, NLOC, cstride = 0;
  const bf16_t *kU, *vU, *kC = nullptr, *vC = nullptr;
  int nat_r = 0, nat_rs = 0;
  if (MODE == 0) {
    const int g = u & 1, qb = (u >> 1) & 31, kvh = (u >> 6) & 1, b = u >> 7, h = kvh * 2 + g;
    qrow0 = TP + b * 4096 + qb * 128 + wid * 32; qcol = 2304 + h * 64; gcol = 2816 + h * 64; ocol = 768 + h * 64;
    kU = P_KG + ((size_t)kvh * TT + TP + b * 4096) * 64; vU = P_VG + ((size_t)kvh * TT + TP + b * 4096) * 64; NLOC = 64; NT = 72;
    kC = P_cgk_b + ((size_t)((b * 4 + l) * 2 + kvh) * 512) * 64; vC = P_cgv_b + ((size_t)((b * 4 + l) * 2 + kvh) * 512) * 64; cstride = 64;
  } else if (MODE == 1) {
    const int rp = u & 31, h = (u >> 5) & 3, b = u >> 7, r = 2 * rp;
    nat_r = r; nat_rs = min(max(r - 4, 0), 56);
    qrow0 = TP + b * 4096 + r * 64 + wid * 16; qcol = 512 + h * 64; gcol = 1280 + h * 64; ocol = 256 + h * 64;
    kU = P_KN + ((size_t)h * TT + TP + b * 4096) * 64; vU = P_VN + ((size_t)h * TT + TP + b * 4096) * 64; NLOC = 8; NT = 18;
    kC = P_cnk_b + ((size_t)((b * 4 + l) * 4 + h) * 512) * 64; vC = P_cnv_b + ((size_t)((b * 4 + l) * 4 + h) * 512) * 64; cstride = 64;
    float* blw = (float*)(smem + 36864);
    for (int i = tid; i < 465; i += 256) blw[i] = p.nat_bias[(size_t)(l * 4 + h) * 465 + i] * LOG2E;
  } else {
    const int qb = u & 1, hh = (u >> 1) & 7, b = u >> 4;
    qrow0 = b * 256 + qb * 128 + wid * 32; NLOC = 4; NT = 4;
    if (hh < 4) { qcol = 512 + hh * 64; gcol = 1280 + hh * 64; ocol = 256 + hh * 64; kU = P_KN + ((size_t)hh * TT + b * 256) * 64; vU = P_VN + ((size_t)hh * TT + b * 256) * 64; }
    else { const int h = hh - 4; qcol = 2304 + h * 64; gcol = 2816 + h * 64; ocol = 768 + h * 64; kU = P_KG + ((size_t)(h >> 1) * TT + b * 256) * 64; vU = P_VG + ((size_t)(h >> 1) * TT + b * 256) * 64; }
  }
  bf16x8 qf[NQ][2];
#pragma unroll
  for (int g = 0; g < NQ; ++g)
#pragma unroll
    for (int ks = 0; ks < 2; ++ks) qf[g][ks] = *(const bf16x8*)(P_U + (size_t)(qrow0 + g * QGS + fr) * NIN + qcol + ks * 32 + fq * 8);
#pragma unroll
  for (int g = 0; g < NQ; ++g)
#pragma unroll
    for (int ks = 0; ks < 2; ++ks) asm volatile("" : "+v"(qf[g][ks]));
#pragma unroll
  for (int g = 0; g < NQ; ++g)
#pragma unroll
    for (int ks = 0; ks < 2; ++ks) {
      u32x4 w = __builtin_bit_cast(u32x4, qf[g][ks]);
      w.x = pk2(bflo(w.x) * C1, bfhi(w.x) * C1); w.y = pk2(bflo(w.y) * C1, bfhi(w.y) * C1);
      w.z = pk2(bflo(w.z) * C1, bfhi(w.z) * C1); w.w = pk2(bflo(w.w) * C1, bfhi(w.w) * C1);
      qf[g][ks] = __builtin_bit_cast(bf16x8, w);
    }
  f32x4 o[NQ][4]; float mrun[NQ]; f32x4 lrun[NQ];
#pragma unroll
  for (int g = 0; g < NQ; ++g) { mrun[g] = 0.f; lrun[g] = (f32x4){0.f, 0.f, 0.f, 0.f};
#pragma unroll
    for (int dt = 0; dt < 4; ++dt) o[g][dt] = (f32x4){0.f, 0.f, 0.f, 0.f}; }
  u32x4 rkA[NLD], rvA[NLD], rkB[NLD], rvB[NLD];
  const int ltid = (MODE == 0) ? half * 256 + tid : tid;
  const int lrow = ltid >> 3, lc = ltid & 7;
  auto glK = [&](int t, u32x4 (&rk)[NLD]) {
    const bf16_t* kp; int st;
    if constexpr (MODE == 1) { if (t < 8) kp = kC + (size_t)t * 4096; else kp = kU + (size_t)min(nat_rs + t - 8, 63) * 4096; st = 64; }
    else { if (t < NLOC) { kp = kU + (size_t)t * 64 * 64; st = 64; } else { kp = kC + (size_t)(t - NLOC) * 64 * cstride; st = cstride; } }
#pragma unroll
    for (int i = 0; i < NLD; ++i) rk[i] = *(const u32x4*)(kp + (size_t)(lrow + i * 32) * st + lc * 8);
  };
  auto glV = [&](int t, u32x4 (&rv)[NLD]) {
    const bf16_t* vp; int st;
    if constexpr (MODE == 1) { if (t < 8) vp = vC + (size_t)t * 4096; else vp = vU + (size_t)min(nat_rs + t - 8, 63) * 4096; st = 64; }
    else { if (t < NLOC) { vp = vU + (size_t)t * 64 * 64; st = 64; } else { vp = vC + (size_t)(t - NLOC) * 64 * cstride; st = cstride; } }
#pragma unroll
    for (int i = 0; i < NLD; ++i) rv[i] = *(const u32x4*)(vp + (size_t)(lrow + i * 32) * st + lc * 8);
  };
  auto stK = [&](int buf, const u32x4 (&rk)[NLD]) {
#pragma unroll
    for (int i = 0; i < NLD; ++i) *(u32x4*)(smem + buf * 8192 + kswz(lrow + i * 32, lc)) = rk[i];
  };
  auto stV = [&](int buf, const u32x4 (&rv)[NLD]) {
#pragma unroll
    for (int i = 0; i < NLD; ++i) *(u32x4*)(smem + 16384 + buf * 10240 + (lrow + i * 32) * 160 + lc * 16) = rv[i];
  };
  const float* bl = (const float*)(smem + 36864);
  const int kcw = (wid == 0) ? 0 : (wid == 1) ? 8 : (wid == 2) ? 24 : 32;
  auto qk = [&](int t, f32x4 (&sd)[NQ][4]) {
    const char* kb = smem + (t & 1) * 8192;
    if constexpr (MODE == 1) { if (t < 8) qk_tile<2, 4>(kb, 0, qf, sd, fr, fq, mrun); else qk_tile<2, 2>(kb, kcw, qf, sd, fr, fq, mrun); }
    else qk_tile<NQ, 4>(kb, 0, qf, sd, fr, fq, mrun);
  };
  auto smx = [&](int t, f32x4 (&sd)[NQ][4]) {
    if constexpr (MODE == 1) {
      if (t < 8) sm_max<2, 4, false>(sd, 0, o, mrun, lrun, fq, nullptr, nullptr, true, true, 0, t == 0);
      else {
        const int kr = nat_rs + t - 8;
        const int rs1 = min(max(nat_r - 3, 0), 56);
        const bool gv0 = (kr < nat_rs + 8) && (kr < 64), gv1 = (kr >= rs1) && (kr < rs1 + 8) && (kr < 64);
        const int dr0 = min(max(kr - nat_r + 7, 0), 14), dr1 = min(max(kr - nat_r + 6, 0), 14);
        sm_max<2, 2, true>(sd, kcw, o, mrun, lrun, fq, bl + dr0 * 31, bl + dr1 * 31, gv0, gv1, wid * 16 + fr, false);
      }
    } else sm_max<NQ, 4, false>(sd, 0, o, mrun, lrun, fq, nullptr, nullptr, true, true, 0, t == 0);
  };
  auto spv = [&](int t, f32x4 (&sd)[NQ][4]) {
    const char* vs = smem + 16384 + (t & 1) * 10240;
    if constexpr (MODE == 1) {
      if (t < 8) sm_exp_pv<2, 4, false>(vs, 0, sd, o, mrun, lrun, fr, fq);
      else sm_exp_pv<2, 2, true>(vs, kcw, sd, o, mrun, lrun, fr, fq);
    } else sm_exp_pv<NQ, 4, false>(vs, 0, sd, o, mrun, lrun, fr, fq);
  };
  auto iter = [&](int t, f32x4 (&sc)[NQ][4], f32x4 (&sn)[NQ][4], u32x4 (&rkX)[NLD], u32x4 (&rvX)[NLD], u32x4 (&rkY)[NLD], u32x4 (&rvY)[NLD]) {
    glK(min(t + 3, NT - 1), rkX);
    glV(min(t + 2, NT - 1), rvX);
    smx(t, sc);
    qk(t + 1, sn);
    spv(t, sc);
#if SGB_N > 0
    if constexpr (MODE != 1) {
#pragma unroll
      for (int i = 0; i < SGB_N; ++i) { __builtin_amdgcn_sched_group_barrier(0x008, 1, 0); __builtin_amdgcn_sched_group_barrier(0x002, SGB_V, 0); }
    }
#endif
#if PROBE_T == 1
    if constexpr (MODE == 0) { const unsigned long long t0_ = __builtin_amdgcn_s_memrealtime(); asm volatile("s_waitcnt vmcnt(2)" ::: "memory"); const unsigned long long t1_ = __builtin_amdgcn_s_memrealtime(); if (threadIdx.x == 0) *(volatile unsigned long long*)(smem0 + 131072 + 256) += t1_ - t0_; }
#endif
    stK(t & 1, rkY);
    stV((t + 1) & 1, rvY);
#if PROBE_T == 2
    if constexpr (MODE == 0) { asm volatile("s_waitcnt lgkmcnt(0)" ::: "memory"); const unsigned long long t0_ = __builtin_amdgcn_s_memrealtime(); __syncthreads(); const unsigned long long t1_ = __builtin_amdgcn_s_memrealtime(); if (threadIdx.x == 0) *(volatile unsigned long long*)(smem0 + 131072 + 256) += t1_ - t0_; } else
#endif
    __syncthreads();
  };
#if PROBE_T == 3
  const unsigned long long tu0_ = __builtin_amdgcn_s_memrealtime();
#endif
  glK(0, rkA); glV(0, rvA); stK(0, rkA); stV(0, rvA);
  glK(1, rkA); stK(1, rkA);
  glK(2, rkB); glV(1, rvB);
  __syncthreads();
  f32x4 sA[NQ][4], sB[NQ][4];
  qk(0, sA);
#pragma unroll 1
  for (int t = 0; t < NT; t += 2) { iter(t, sA, sB, rkA, rvA, rkB, rvB); iter(t + 1, sB, sA, rkB, rvB, rkA, rvA); }
#if PROBE_T == 3
  if constexpr (MODE == 0) { if (threadIdx.x == 0) *(volatile unsigned long long*)(smem0 + 131072 + 256) += __builtin_amdgcn_s_memrealtime() - tu0_; }
#endif
#pragma unroll
  for (int g = 0; g < NQ; ++g) {
    const float inv = __builtin_amdgcn_rcpf(lrun[g][0]);
    const int row = qrow0 + g * QGS + fr;
#pragma unroll
    for (int dt = 0; dt < 4; ++dt) {
      const int d0 = dt * 16 + 4 * fq;
      const u32x2 gw = *(const u32x2*)(P_U + (size_t)row * NIN + gcol + d0);
      u32x2 w;
      w.x = pk2(o[g][dt][0] * inv * silu_f(bflo(gw.x)), o[g][dt][1] * inv * silu_f(bfhi(gw.x)));
      w.y = pk2(o[g][dt][2] * inv * silu_f(bflo(gw.y)), o[g][dt][3] * inv * silu_f(bfhi(gw.y)));
      *(u32x2*)(P_MX + (size_t)row * DM + ocol + d0) = w;
    }
  }
}

DEV void pool_unit(const Params& p, int l, int u, char* smem) {
  const int tid = get_tid(), lane = tid & 63, wid = tid >> 6, fr = lane & 15, fq = lane >> 4;
  const int R0 = u * 32;
  int L, sb;
  if (R0 < TP) { L = 256; sb = R0 & ~255; } else { L = 4096; sb = TP + ((R0 - TP) & ~4095); }
  const int t0 = R0 - sb;
  bf16_t* xs = (bf16_t*)smem;
  bf16_t* ya = (bf16_t*)(smem + 24576);
  const bf16_t* wt = P_poolT + (size_t)(l * 4 + wid) * 4096;
  bf16x8 bfr[2][4];
#pragma unroll
  for (int ks = 0; ks < 2; ++ks)
#pragma unroll
    for (int n = 0; n < 4; ++n) bfr[ks][n] = *(const bf16x8*)(wt + (n * 16 + fr) * 64 + ks * 32 + fq * 8);
  u32x2 gwv[2][4];
#pragma unroll
  for (int m = 0; m < 2; ++m)
#pragma unroll
    for (int n = 0; n < 4; ++n) gwv[m][n] = *(const u32x2*)(P_U + (size_t)(R0 + m * 16 + fr) * NIN + 256 + wid * 64 + n * 16 + 4 * fq);
#pragma unroll
  for (int k = 0; k < 6; ++k) {
    const int idx = tid + k * 256, i = idx >> 5, c8 = (idx & 31) * 8, t = t0 - 8 + i;
    u32x4 w = {0u, 0u, 0u, 0u};
    if (t >= 0 && t < L) w = *(const u32x4*)(P_U + (size_t)(sb + t) * NIN + c8);
    *(u32x4*)(xs + i * 256 + c8) = w;
  }
  __syncthreads();
  {
    const int c = tid, g = c >> 6, win = 2 << g, half = win >> 1;
    float sum = 0.f;
    for (int i = 0; i < win; ++i) sum += bf2f(xs[(8 - half + i) * 256 + c]);
#pragma unroll 8
    for (int tt = 0; tt < 32; ++tt) {
      const int t = t0 + tt;
      const int lo = max(t - half, 0), hi = min(t - half + win, L);
      const float y = sum / (float)(hi - lo) - bf2f(xs[(tt + 8) * 256 + c]);
      ya[tt * 264 + c] = f2bf(y);
      sum += bf2f(xs[(tt + 8 - half + win) * 256 + c]) - bf2f(xs[(tt + 8 - half) * 256 + c]);
    }
  }
  __syncthreads();
  const int g = wid;
  f32x4 acc[2][4];
#pragma unroll
  for (int m = 0; m < 2; ++m)
#pragma unroll
    for (int n = 0; n < 4; ++n) acc[m][n] = (f32x4){0.f, 0.f, 0.f, 0.f};
#pragma unroll
  for (int ks = 0; ks < 2; ++ks) {
    bf16x8 af[2];
#pragma unroll
    for (int m = 0; m < 2; ++m) af[m] = *(const bf16x8*)(smem + 24576 + (m * 16 + fr) * 528 + (g * 64 + ks * 32 + fq * 8) * 2);
#pragma unroll
    for (int m = 0; m < 2; ++m)
#pragma unroll
      for (int n = 0; n < 4; ++n) acc[m][n] = mfma16(bfr[ks][n], af[m], acc[m][n]);
  }
#pragma unroll
  for (int m = 0; m < 2; ++m) {
    const int row = R0 + m * 16 + fr;
#pragma unroll
    for (int n = 0; n < 4; ++n) {
      const int ch = g * 64 + n * 16 + 4 * fq;
      const f32x4 sc = *(const f32x4*)(p.pool_scale + l * 256 + ch);
      const u32x2 gw = gwv[m][n];
      u32x2 w;
      w.x = pk2(acc[m][n][0] * sc[0] * silu_f(bflo(gw.x)), acc[m][n][1] * sc[1] * silu_f(bfhi(gw.x)));
      w.y = pk2(acc[m][n][2] * sc[2] * silu_f(bflo(gw.y)), acc[m][n][3] * sc[3] * silu_f(bfhi(gw.y)));
      *(u32x2*)(P_MX + (size_t)row * DM + ch) = w;
    }
  }
  __syncthreads();
}

DEV void conv_unit(const Params& p, int l, int u, char* smem) {
  const int tid = get_tid(), lane = tid & 63, wid = tid >> 6, fr = lane & 15, fq = lane >> 4;
  const int R0 = u * 64;
  int L, sb;
  if (R0 < TP) { L = 256; sb = R0 & ~255; } else { L = 4096; sb = TP + ((R0 - TP) & ~4095); }
  const int t0 = R0 - sb;
  bf16_t* zs = (bf16_t*)smem;
  bf16_t* za = (bf16_t*)smem;
  float* cs = (float*)(smem + 48128);
  float* red = (float*)(smem + 64768);
#pragma unroll 6
  for (int it = 0; it < 12; ++it) {
    const int idx = min(tid + it * 256, 94 * 32 - 1);
    const int i = idx >> 5, c8 = (idx & 31) * 8, t = t0 - 15 + i;
    u32x4 w = {0u, 0u, 0u, 0u};
    if (t >= 0 && t < L) {
      const bf16_t* ur = P_U + (size_t)(sb + t) * NIN;
      const u32x4 vv = *(const u32x4*)(ur + 1536 + c8), gg = *(const u32x4*)(ur + 1792 + c8);
      w.x = pk2(bflo(vv.x) * sigm_f(bflo(gg.x)), bfhi(vv.x) * sigm_f(bfhi(gg.x)));
      w.y = pk2(bflo(vv.y) * sigm_f(bflo(gg.y)), bfhi(vv.y) * sigm_f(bfhi(gg.y)));
      w.z = pk2(bflo(vv.z) * sigm_f(bflo(gg.z)), bfhi(vv.z) * sigm_f(bfhi(gg.z)));
      w.w = pk2(bflo(vv.w) * sigm_f(bflo(gg.w)), bfhi(vv.w) * sigm_f(bfhi(gg.w)));
    }
    *(u32x4*)(zs + i * 256 + c8) = w;
  }
  __syncthreads();
  const int c = tid;
  float wj[31];
#pragma unroll
  for (int j = 0; j < 31; ++j) wj[j] = p.conv_w[(size_t)(l * 31 + j) * 256 + c];
  const float cb = p.conv_b[l * 256 + c], lg = p.conv_ln_g[l * 256 + c], lb = p.conv_ln_b[l * 256 + c];
  float a[4][16];
#pragma unroll
  for (int ch = 0; ch < 4; ++ch) {
    float zr[46];
#pragma unroll
    for (int i = 0; i < 46; ++i) zr[i] = bf2f(zs[(ch * 16 + i) * 256 + c]);
#pragma unroll
    for (int i = 0; i < 16; ++i) {
      float s = cb;
#pragma unroll
      for (int j = 0; j < 31; ++j) s += zr[i + j] * wj[j];
      a[ch][i] = s;
      cs[i * 260 + c] = s;
    }
    __syncthreads();
    {
      const int i2 = tid >> 4, sl = tid & 15;
      float s1 = 0.f, s2 = 0.f;
#pragma unroll
      for (int q = 0; q < 4; ++q) {
        const f32x4 v = *(const f32x4*)(cs + i2 * 260 + sl * 16 + q * 4);
        s1 += (v[0] + v[1]) + (v[2] + v[3]);
        s2 += (v[0] * v[0] + v[1] * v[1]) + (v[2] * v[2] + v[3] * v[3]);
      }
      s1 += __shfl_xor(s1, 1); s2 += __shfl_xor(s2, 1);
      s1 += __shfl_xor(s1, 2); s2 += __shfl_xor(s2, 2);
      s1 += __shfl_xor(s1, 4); s2 += __shfl_xor(s2, 4);
      s1 += __shfl_xor(s1, 8); s2 += __shfl_xor(s2, 8);
      if (sl == 0) { red[(ch * 16 + i2) * 2] = s1; red[(ch * 16 + i2) * 2 + 1] = s2; }
    }
    __syncthreads();
  }
#pragma unroll
  for (int ch = 0; ch < 4; ++ch)
#pragma unroll
    for (int i = 0; i < 16; ++i) {
      const int tt = ch * 16 + i;
      const float mean = red[tt * 2] * (1.f / 256.f);
      const float var = fmaxf(red[tt * 2 + 1] * (1.f / 256.f) - mean * mean, 0.f);
      const float rstd = rsqrtf(var + 1e-5f);
      const float v = (a[ch][i] - mean) * rstd * lg + lb;
      za[tt * 264 + c] = f2bf(silu_f(v));
    }
  __syncthreads();
  f32x4 acc[4][4];
#pragma unroll
  for (int m = 0; m < 4; ++m)
#pragma unroll
    for (int n = 0; n < 4; ++n) acc[m][n] = (f32x4){0.f, 0.f, 0.f, 0.f};
  const bf16_t* wt = P_pwT + (size_t)l * 65536 + (size_t)(wid * 64 + fr) * 256 + fq * 8;
  bf16x8 bq[3][4];
#pragma unroll
  for (int n = 0; n < 4; ++n) { bq[0][n] = *(const bf16x8*)(wt + (size_t)n * 16 * 256); bq[1][n] = *(const bf16x8*)(wt + (size_t)n * 16 * 256 + 32); }
  u32x2 gwv[4][4];
#pragma unroll
  for (int m = 0; m < 4; ++m)
#pragma unroll
    for (int n = 0; n < 4; ++n) gwv[m][n] = *(const u32x2*)(P_U + (size_t)(R0 + m * 16 + fr) * NIN + 2048 + wid * 64 + n * 16 + 4 * fq);
#pragma unroll
  for (int ks = 0; ks < 8; ++ks) {
    if (ks + 2 < 8) {
#pragma unroll
      for (int n = 0; n < 4; ++n) bq[(ks + 2) % 3][n] = *(const bf16x8*)(wt + (size_t)n * 16 * 256 + (ks + 2) * 32);
    }
    bf16x8 af[4];
#pragma unroll
    for (int m = 0; m < 4; ++m) af[m] = *(const bf16x8*)(smem + (m * 16 + fr) * 528 + (ks * 32 + fq * 8) * 2);
#pragma unroll
    for (int m = 0; m < 4; ++m)
#pragma unroll
      for (int n = 0; n < 4; ++n) acc[m][n] = mfma16(bq[ks % 3][n], af[m], acc[m][n]);
  }
#pragma unroll
  for (int m = 0; m < 4; ++m) {
    const int row = R0 + m * 16 + fr;
#pragma unroll
    for (int n = 0; n < 4; ++n) {
      const int ch = wid * 64 + n * 16 + 4 * fq;
      const u32x2 gw = gwv[m][n];
      u32x2 w;
      w.x = pk2(acc[m][n][0] * silu_f(bflo(gw.x)), acc[m][n][1] * silu_f(bfhi(gw.x)));
      w.y = pk2(acc[m][n][2] * silu_f(bflo(gw.y)), acc[m][n][3] * silu_f(bfhi(gw.y)));
      *(u32x2*)(P_MX + (size_t)row * DM + 512 + ch) = w;
    }
  }
  __syncthreads();
}

constexpr int P0_WIN = 3072, P0_WOUT = 1024, P0_PW = 64, P0_POOL = 16, P0_CVT = 768, P0_MOD = 192;
constexpr int P0_UNITS = P0_WIN + P0_WOUT + P0_PW + P0_POOL + P0_CVT + P0_MOD;

DEV void phase0(const Params& p, char* smem) {
  if (blockIdx.x == 0) for (int i = threadIdx.x; i < 1280 + 64; i += 512) P_cnt[i] = 0u;
  const int half = get_half();
  smem += half * 65536;
  for (int pr = blockIdx.x; pr < P0_UNITS / 2; pr += gridDim.x) {
    int v = pr * 2 + half;
    if (v < P0_MOD) { mod_unit(p, v, smem); continue; }
    v -= P0_MOD;
    if (v < P0_WIN) { const int l = v / 768, r = v % 768, kt = r / 48, nt = r % 48;
      tconv_tile(p.w_in + ((size_t)l * 1024 + kt * 64) * 3072 + nt * 64, 3072, P_WinT + ((size_t)l * 3072 + nt * 64) * 1024 + kt * 64, 1024, smem); continue; }
    v -= P0_WIN;
    if (v < P0_WOUT) { const int l = v >> 8, r = v & 255, kt = r >> 4, nt = r & 15;
      tconv_tile(p.w_out + ((size_t)l * 1024 + kt * 64) * 1024 + nt * 64, 1024, P_WoutT + ((size_t)l * 1024 + nt * 64) * 1024 + kt * 64, 1024, smem); continue; }
    v -= P0_WOUT;
    if (v < P0_PW) { const int l = v >> 4, r = v & 15, kt = r >> 2, nt = r & 3;
      tconv_tile(p.conv_pw + ((size_t)l * 256 + kt * 64) * 256 + nt * 64, 256, P_pwT + ((size_t)l * 256 + nt * 64) * 256 + kt * 64, 256, smem); continue; }
    v -= P0_PW;
    if (v < P0_POOL) { tconv_tile(p.pool_w + (size_t)v * 4096, 64, P_poolT + (size_t)v * 4096, 64, smem); continue; }
    v -= P0_POOL;
    if (v < 256) { cvt_unit(p.cnk, P_cnk_b, v, 4); continue; }
    v -= 256;
    if (v < 256) { cvt_unit(p.cnv, P_cnv_b, v, 4); continue; }
    v -= 256;
    if (v < 128) { cvt_unit(p.cgk, P_cgk_b, v, 2); continue; }
    v -= 128;
    cvt_unit(p.cgv, P_cgv_b, v, 2);
  }
}

constexpr int XB_GQA = 128, XB_NAT = 128, XB_CONV = 80, XB_PATT = 64, XB_POOL = 160;
constexpr int XB_UNITS = XB_GQA + XB_NAT + XB_CONV + XB_PATT + XB_POOL;

DEV void phaseB(char* ws0, int l_in, char* smem, int qofs, int ubeg = 0, int uend = XB_UNITS) {
  const int xcd = blockIdx.x & 7;
  unsigned* q = (unsigned*)(ws0 + WS_CNT) + 1280 + qofs + l_in * 8 + xcd;
  int* slot = (int*)(smem + 131072);
  const int half = get_half();
  char* smem0 = smem;
  smem += half * 65536;
  for (;;) {
    if (threadIdx.x == 0) *slot = (int)atomicAdd(q, 1u);
    __syncthreads();
    int u = ubeg + *slot * 2 + half;
    __syncthreads();
    if (u >= uend) break;
    int l = l_in; asm volatile("" : "+s"(l));
    const Params p = load_params(ws0);
    if (u < XB_GQA) { attn_unit<0>(p, l, xcd * XB_GQA + u, smem, smem0, half); continue; }
    u -= XB_GQA;
    if (u < XB_NAT) { attn_unit<1>(p, l, xcd * XB_NAT + u, smem, smem0, half); continue; }
    u -= XB_NAT;
    if (u < XB_CONV) { conv_unit(p, l, xcd * XB_CONV + u, smem); continue; }
    u -= XB_CONV;
    if (u < XB_PATT) { attn_unit<2>(p, l, xcd * XB_PATT + u, smem, smem0, half); continue; }
    u -= XB_PATT;
    pool_unit(p, l, xcd * XB_POOL + u, smem);
  }
}

constexpr int LDS_BYTES = 131072 + 1024;
__global__ void __launch_bounds__(512, 2) mega(Params p0) {
  extern __shared__ __attribute__((aligned(16))) char smem[];
  cg::grid_group grid = cg::this_grid();
  const int ph0 = p0.ph0, ph1 = p0.ph1;
  char* const ws0 = p0.ws;
  if (blockIdx.x == 0 && threadIdx.x == 0) *(Params*)(ws0 + WS_PARAMS) = p0;
#define PP() load_params(ws0)
  const int half = get_half();
  volatile LAS unsigned* xst = (volatile LAS unsigned*)(smem + 131072 + 64);
  if (threadIdx.x == 0) { xst[0] = 0u; xst[1] = 0u; *(volatile unsigned long long*)(smem + 131072 + 256) = 0ull; }
  __syncthreads();
  const XcdBarrier xb = xcd_barrier_post((unsigned*)(ws0 + WS_BAR), xst);
  if (ph0 <= 0 && 0 < ph1) { for (int rep = 0; rep < (PROBE_X == 4 ? 2 : 1); ++rep) { phase0(p0, smem); if (1 < ph1) grid.sync(); } }
  if (ph0 <= 1 && 1 < ph1) { for (int u = blockIdx.x; u < TT / 64; u += gridDim.x) { const Params pl = PP(); h0_unit(pl, u * 2 + half); } if (2 < ph1) xcd_barrier(xb); }
  for (int li = 0; li < NLAYER; ++li) {
    int l = li; asm volatile("" : "+s"(l));
    const int pa = 2 + 3 * li;
    if (ph0 <= pa && pa < ph1) {
      const Params p = PP();
      pg8::Gemm g; g.A = P_H; g.Bt = P_WinT + (size_t)l * 3072 * 1024; g.M = TT; g.N = NIN; g.K = DM;
      pg8::StaticOrder S; S.init(TT, NIN, (int)gridDim.x, (int)blockIdx.x);
      EpiA E{ws0, l};
      for (int rep = 0; rep < (PROBE_X == 1 ? 2 : 1); ++rep) {
        pg8::gemm_phase<EpiA, pg8::StaticOrder, true, true>((PG8_LAS unsigned char*)smem, g, S, E);
        if (pa + 1 < ph1) xcd_barrier(xb);
      }
    }
    if (ph0 <= pa + 1 && pa + 1 < ph1) { phaseB(ws0, l, smem, 0); if (pa + 2 < ph1) xcd_barrier(xb); }
#if PROBE_SYNC
    for (int i = 0; i < 8; ++i) xcd_barrier(xb);
#endif
#if PROBE_B
    { constexpr int lo[7] = {0, 0, 128, 256, 336, 400, 0}, hi[7] = {0, 128, 256, 336, 400, 560, 560}; phaseB(ws0, l, smem, 32, lo[PROBE_B], hi[PROBE_B]); xcd_barrier(xb); }
#endif
    if (ph0 <= pa + 2 && pa + 2 < ph1) {
      const Params p = PP();
      pg8::Gemm g; g.A = P_MX; g.Bt = P_WoutT + (size_t)l * 1024 * 1024; g.M = TT; g.N = DM; g.K = DM;
      pg8::StaticOrder S; S.init(TT, DM, (int)gridDim.x, (int)blockIdx.x);
      EpiC E{ws0, l, smem + 131072 + 128};
      for (int rep = 0; rep < ((PROBE_X == 2 && li == 0) ? 2 : 1); ++rep) {
        pg8::gemm_phase<EpiC, pg8::StaticOrder, true, true>((PG8_LAS unsigned char*)smem, g, S, E);
#if FUSE_LN
        if (pa + 3 < ph1) xcd_barrier(xb);
#else
        xcd_barrier(xb);
#endif
      }
#if !FUSE_LN
      for (int rep = 0; rep < ((PROBE_X == 3 && li < 3) ? 2 : 1); ++rep) {
        for (int u = blockIdx.x; u < TT / (8 * LN_UR); u += gridDim.x) { const Params pl = PP(); ln_unit(pl, l, u * 2 + half); }
        if (pa + 3 < ph1) xcd_barrier(xb);
      }
#endif
    }
  }
#if PROBE_T
  if (blockIdx.x == 0 && threadIdx.x == 0) { const unsigned long long acc_ = *(volatile unsigned long long*)(smem + 131072 + 256) * PROBE_MUL; const unsigned long long ts_ = __builtin_amdgcn_s_memrealtime(); while (__builtin_amdgcn_s_memrealtime() - ts_ < acc_) __builtin_amdgcn_s_sleep(8); }
#endif
}

#ifndef ONE_LAUNCH
#define ONE_LAUNCH 1
#endif

extern "C" void kernel_launch(void* const* d_in, const int* in_sizes, int n_in, void* d_out, int out_size, void* d_ws, size_t ws_size,
                              hipStream_t stream) {
  static int grid_blocks = 0;
  if (!grid_blocks) {
    int dev = 0, cus = 0, per_cu = 0;
    hipGetDevice(&dev);
    hipDeviceGetAttribute(&cus, hipDeviceAttributeMultiprocessorCount, dev);
    hipFuncSetAttribute((const void*)mega, hipFuncAttributeMaxDynamicSharedMemorySize, LDS_BYTES);
    hipOccupancyMaxActiveBlocksPerMultiprocessor(&per_cu, mega, 512, LDS_BYTES);
    if (per_cu > 1) per_cu = 1;
    if (per_cu < 1) per_cu = 1;
    grid_blocks = cus * per_cu;
  }
  if (ws_size < WS_END) { fprintf(stderr, "kernel_launch: workspace too small (%zu < %zu); nothing launched\n", ws_size, (size_t)WS_END); return; }
  Params p{};
  const float* const* in = (const float* const*)d_in;
  p.x_prompt = in[0]; p.x_sample = in[1]; p.c = in[2]; p.cnk = in[3]; p.cnv = in[4]; p.cgk = in[5]; p.cgv = in[6]; p.c_ctx = in[7];
  p.w_mod = in[8]; p.b_mod = in[9]; p.w_in = in[10]; p.b_in = in[11]; p.pool_w = in[12]; p.pool_scale = in[13]; p.nat_bias = in[14];
  p.q_norm = in[15]; p.k_norm = in[16]; p.conv_w = in[17]; p.conv_b = in[18]; p.conv_ln_g = in[19]; p.conv_ln_b = in[20]; p.conv_pw = in[21];
  p.w_out = in[22]; p.b_out = in[23]; p.ln_g = in[24]; p.ln_b = in[25];
  p.out = (float*)d_out;
  p.ws = (char*)d_ws;
  hipMemsetAsync((char*)d_ws + WS_BAR, 0, XCD_BAR_WORDS * sizeof(unsigned), stream);
#if ONE_LAUNCH
  p.ph0 = 0; p.ph1 = 14;
  void* args[] = {&p};
  hipError_t e = hipLaunchCooperativeKernel((void*)mega, dim3(grid_blocks), dim3(512), args, LDS_BYTES, stream);
  if (e != hipSuccess) fprintf(stderr, "cooperative launch failed: %s (grid %d)\n", hipGetErrorString(e), grid_blocks);
#else
  for (int ph = 0; ph < 14; ++ph) { p.ph0 = ph; p.ph1 = ph + 1; mega<<<grid_blocks, 512, LDS_BYTES, stream>>>(p); }
#endif
}
```

```cpp
#define SGB_N 0
#define SGB_V 6
#define LN_UR 2
#include <hip/hip_runtime.h>
#include <hip/hip_cooperative_groups.h>
#include <cstdio>
#include <cstdint>
namespace cg = cooperative_groups;

typedef unsigned short bf16_t;
typedef short bf16x8 __attribute__((ext_vector_type(8)));
typedef short s16x4 __attribute__((ext_vector_type(4)));
typedef float f32x4 __attribute__((ext_vector_type(4)));
typedef float f32x2 __attribute__((ext_vector_type(2)));
typedef __bf16 bf16x2_t __attribute__((ext_vector_type(2)));
typedef unsigned u32x4 __attribute__((ext_vector_type(4)));
typedef unsigned u32x2 __attribute__((ext_vector_type(2)));
#define DEV __device__ __forceinline__
__device__ const float ROPE_COS[1024] = {
1.f,1.f,1.f,1.f,1.f,1.f,1.f,1.f,
1.f,1.f,1.f,1.f,1.f,1.f,1.f,1.f,
0.540302277f,0.846009135f,0.950415254f,0.98423022f,0.995004177f,0.998419285f,0.999500036f,0.999841869f,
0.999949992f,0.999984205f,0.999994993f,0.999998391f,0.999999523f,0.999999821f,0.99999994f,1.f,
-0.416146845f,0.431462824f,0.806578398f,0.937418282f,0.980066597f,0.993682086f,0.998000681f,0.999367595f,
0.999800026f,0.999936759f,0.999979973f,0.999993682f,0.999997973f,0.999999344f,0.999999821f,0.99999994f,
-0.989992499f,-0.115966164f,0.582753658f,0.861040652f,0.955336511f,0.985803485f,0.995503366f,0.998577297f,
0.999550045f,0.999857724f,0.999954998f,0.999985754f,0.99999553f,0.999998569f,0.999999523f,0.999999881f,
-0.653643608f,-0.627679706f,0.301137477f,0.757506192f,0.921060979f,0.974808276f,0.992010653f,0.997471273f,
0.999200106f,0.999747038f,0.999920011f,0.999974728f,0.999992013f,0.999997497f,0.999999225f,0.999999762f,
0.2836622f,-0.946079254f,-0.0103423381f,0.630080283f,0.87758255f,0.960731268f,0.987526f,0.996049762f,
0.998750269f,0.999604762f,0.999875009f,0.999960482f,0.999987483f,0.999996066f,0.999998748f,0.999999583f,
0.960170269f,-0.973103702f,-0.3207964f,0.482782036f,0.825335622f,0.943616986f,0.982053936f,0.9943133f,
0.998200536f,0.999430835f,0.999819994f,0.999943078f,0.999981999f,0.999994338f,0.999998212f,0.999999404f,
0.753902256f,-0.700429797f,-0.599437475f,0.320257008f,0.764842212f,0.923519433f,0.975599885f,0.992262423f,
0.997551024f,0.999225318f,0.999755025f,0.999922514f,0.999975502f,0.999992251f,0.999997556f,0.999999225f,
-0.145500034f,-0.212036446f,-0.818632424f,0.147631213f,0.696706712f,0.900502324f,0.968170285f,0.989897788f,
0.996801734f,0.998988271f,0.999680042f,0.999898791f,0.999967992f,0.999989867f,0.999996781f,0.999998987f,
-0.91113025f,0.341660261f,-0.956644177f,-0.0296507962f,0.621609926f,0.874638259f,0.959772646f,0.987220109f,
0.995952725f,0.998719573f,0.999595046f,0.99987191f,0.999959528f,0.999987185f,0.999995947f,0.999998748f,
-0.839071512f,0.790131867f,-0.999786079f,-0.205997631f,0.540302277f,0.846009135f,0.950415313f,0.98423022f,
0.995004177f,0.998419285f,0.999500036f,0.999841869f,0.999949992f,0.999984205f,0.999994993f,0.999998391f,
0.00442569796f,0.995257378f,-0.943779767f,-0.375847399f,0.453596085f,0.814705312f,0.940107584f,0.980929136f,
0.993956089f,0.998087406f,0.999395072f,0.999808669f,0.999939501f,0.999980867f,0.99999392f,0.999998093f,
0.843853951f,0.893861592f,-0.79417938f,-0.53384304f,0.362357706f,0.780825913f,0.92885989f,0.97731787f,
0.99280864f,0.997723997f,0.999280095f,0.99977231f,0.999927998f,0.999977231f,0.999992788f,0.999997735f,
0.907446802f,0.517172873f,-0.565820515f,-0.675001681f,0.267498761f,0.744477987f,0.916683376f,0.973397553f,
0.99156189f,0.997329056f,0.999155104f,0.999732792f,0.999915481f,0.999973297f,0.999991536f,0.999997318f,
0.136737213f,-0.0187961515f,-0.28134948f,-0.794870913f,0.16996716f,0.705776393f,0.903590262f,0.969169438f,
0.990216017f,0.996902585f,0.999020159f,0.999690115f,0.99990201f,0.999969006f,0.999990225f,0.999996901f,
-0.759687901f,-0.548975468f,0.0310223512f,-0.889670432f,0.070737198f,0.6648435f,0.889593601f,0.964634836f,
0.988771081f,0.996444523f,0.998875201f,0.999644279f,0.999887526f,0.999964416f,0.999988735f,0.999996424f,
-0.957659483f,-0.910081089f,0.340318173f,-0.95641005f,-0.0291995462f,0.621808827f,0.87470746f,0.959795177f,
0.987227261f,0.99595499f,0.998720288f,0.999595284f,0.999872029f,0.999959528f,0.999987185f,0.999995947f,
-0.275163352f,-0.990897954f,0.615864813f,-0.99298501f,-0.128844544f,0.576808274f,0.858946681f,0.954652011f,
0.985584795f,0.995433986f,0.998555362f,0.999543071f,0.999855518f,0.999954283f,0.999985576f,0.99999541f,
0.660316706f,-0.766536534f,0.830336154f,-0.998241663f,-0.227202162f,0.529984176f,0.842327058f,0.949207008f,
0.983843684f,0.994881511f,0.998380423f,0.999487758f,0.999837995f,0.9999488f,0.999983788f,0.999994874f,
0.988704622f,-0.306095392f,0.962463796f,-0.972014248f,-0.323289543f,0.481484592f,0.824865162f,0.943461835f,
0.982004225f,0.994297504f,0.998195529f,0.999429286f,0.999819517f,0.999942899f,0.99998194f,0.999994278f,
0.408082068f,0.248616725f,0.999144375f,-0.91512996f,-0.416146845f,0.431462824f,0.806578457f,0.937418282f,
0.980066597f,0.993682086f,0.998000681f,0.999367595f,0.999800026f,0.999936759f,0.999979973f,0.999993682f,
-0.547729254f,0.726760268f,0.936740458f,-0.829382956f,-0.504846215f,0.380077004f,0.787485182f,0.931078374f,
0.97803092f,0.993035257f,0.99779582f,0.999302804f,0.999779522f,0.999930263f,0.999977946f,0.999993026f,
-0.99996084f,0.981074572f,0.781440377f,-0.717477441f,-0.588501155f,0.327489585f,0.767604589f,0.92444396f,
0.975897431f,0.992357016f,0.997581005f,0.999234855f,0.999758005f,0.999923468f,0.999975801f,0.999992371f,
-0.53283304f,0.933235765f,0.548645258f,-0.582943261f,-0.666275978f,0.273866832f,0.746956408f,0.917517304f,
0.97366637f,0.991647422f,0.997356176f,0.999163687f,0.999735534f,0.999916375f,0.999973536f,0.999991655f,
0.424179018f,0.597977161f,0.261441678f,-0.430023283f,-0.737393796f,0.219378278f,0.725561321f,0.910300434f,
0.971337974f,0.990906477f,0.997121394f,0.99908942f,0.99971199f,0.999908924f,0.999971211f,0.99999088f,
0.991202831f,0.078552261f,-0.0516893305f,-0.263540596f,-0.801143587f,0.164196163f,0.703440726f,0.902795732f,
0.968912423f,0.99013412f,0.996876657f,0.999011934f,0.999687493f,0.999901175f,0.999968767f,0.999990106f,
0.64691931f,-0.465064496f,-0.359694332f,-0.0887455046f,-0.856888831f,0.108494945f,0.680616796f,0.895005584f,
0.966389954f,0.98933053f,0.996621907f,0.998931348f,0.999662042f,0.999893129f,0.999966204f,0.999989331f,
-0.292138815f,-0.865450621f,-0.632028639f,0.088848114f,-0.904072165f,0.0524506159f,0.6571123f,0.886932373f,
0.963770926f,0.988495648f,0.996357203f,0.998847544f,0.999635518f,0.999884725f,0.999963522f,0.999988496f,
-0.962605894f,-0.999293387f,-0.841684937f,0.26363951f,-0.942222297f,-0.00375941908f,0.632950664f,0.878578722f,
0.961055458f,0.987629473f,0.996082544f,0.998760641f,0.99960804f,0.999876022f,0.99996078f,0.999987602f,
-0.748057544f,-0.825371623f,-0.967871487f,0.430115849f,-0.970958173f,-0.0599575676f,0.608156204f,0.869947195f,
0.958243906f,0.986732066f,0.995797932f,0.998670578f,0.999579549f,0.999867022f,0.999957979f,0.999986708f,
0.154251456f,-0.397251874f,-0.998075247f,0.583026946f,-0.989992499f,-0.115966164f,0.582753658f,0.861040652f,
0.955336511f,0.985803485f,0.995503366f,0.998577297f,0.999550045f,0.999857724f,0.999954998f,0.999985754f,
0.914742351f,0.153215483f,-0.929300308f,0.717549205f,-0.999135137f,-0.171608135f,0.556768358f,0.851861775f,
0.95233357f,0.984843671f,0.995198846f,0.998480916f,0.999519527f,0.999848068f,0.999951959f,0.999984801f,
0.83422339f,0.656495154f,-0.768367112f,0.829440355f,-0.998294771f,-0.226707578f,0.53022635f,0.842413545f,
0.949235439f,0.983852804f,0.994884372f,0.998381376f,0.999488056f,0.999838114f,0.9999488f,0.999983788f,
-0.0132767474f,0.95758605f,-0.531235278f,0.915171385f,-0.987479806f,-0.281090319f,0.503154159f,0.832698941f,
0.946042359f,0.982830763f,0.994559944f,0.998278618f,0.999455571f,0.999827802f,0.999945521f,0.999982774f,
-0.848570287f,0.963757515f,-0.241421118f,0.972038329f,-0.966798186f,-0.334584385f,0.475578904f,0.822721004f,
0.942754686f,0.981777668f,0.994225562f,0.99817276f,0.999422073f,0.999817252f,0.999942183f,0.999981701f,
-0.903692186f,0.673110247f,0.0723346695f,0.998247743f,-0.93645668f,-0.387020677f,0.447528064f,0.812482953f,
0.939372718f,0.980693519f,0.993881226f,0.998063743f,0.999387562f,0.999806345f,0.999938726f,0.999980628f,
-0.127963692f,0.175156534f,0.378916174f,0.992972851f,-0.896758378f,-0.438233554f,0.419029742f,0.801987886f,
0.935896814f,0.979578316f,0.993526995f,0.997951567f,0.999352098f,0.999795079f,0.99993521f,0.999979496f,
0.765414059f,-0.376742303f,0.647921681f,0.95638001f,-0.848100007f,-0.488060862f,0.39011243f,0.791239262f,
0.93232733f,0.978432178f,0.993162811f,0.997836173f,0.99931556f,0.999783576f,0.999931574f,0.999978364f,
0.955073655f,-0.812611222f,0.852673113f,0.889623463f,-0.790967762f,-0.536345184f,0.360805035f,0.780240417f,
0.928664625f,0.977255106f,0.992788672f,0.997717679f,0.999278069f,0.999771714f,0.999927819f,0.999977171f,
0.266642928f,-0.998210371f,0.972865343f,0.794808388f,-0.72593224f,-0.582933903f,0.331136853f,0.768994927f,
0.924909055f,0.976047099f,0.99240464f,0.997596025f,0.999239624f,0.999759495f,0.999923944f,0.999975979f,
-0.666938066f,-0.87637943f,0.996578991f,0.674925625f,-0.653643608f,-0.627679706f,0.301137596f,0.757506192f,
0.921060979f,0.974808276f,0.992010653f,0.997471273f,0.999200106f,0.999747038f,0.999920011f,0.999974728f,
-0.987339258f,-0.484639406f,0.921462357f,0.533756077f,-0.574824035f,-0.670441091f,0.270837069f,0.745777905f,
0.917120814f,0.973538578f,0.991606772f,0.997343302f,0.999159634f,0.999734223f,0.999915957f,0.999973416f,
-0.399985313f,0.0563609414f,0.754965365f,0.375752151f,-0.490260571f,-0.711082935f,0.240265876f,0.733813822f,
0.913088918f,0.972238123f,0.991192937f,0.997212172f,0.999118149f,0.99972111f,0.999911785f,0.999972105f,
0.555113316f,0.580003142f,0.513598442f,0.205897167f,-0.400799006f,-0.749476731f,0.209454417f,0.721617639f,
0.908965766f,0.970906913f,0.990769207f,0.997077882f,0.999075651f,0.999707639f,0.999907553f,0.999970794f,
0.999843299f,0.925014675f,0.221298173f,0.0295478199f,-0.307332784f,-0.785501122f,0.178433523f,0.709193349f,
0.904751658f,0.969545007f,0.990335584f,0.996940494f,0.99903214f,0.99969393f,0.999903202f,0.999969363f,
0.52532196f,0.985138178f,-0.0929481089f,-0.147732988f,-0.210795805f,-0.819042206f,0.147234216f,0.696544766f,
0.90044713f,0.968152404f,0.989892066f,0.996799886f,0.998987675f,0.999679863f,0.999898732f,0.999967992f,
-0.432177931f,0.741858006f,-0.397976756f,-0.320354372f,-0.112152621f,-0.849993885f,0.115887694f,0.683675885f,
0.89605248f,0.966729224f,0.989438653f,0.996656179f,0.998942196f,0.999665439f,0.999894202f,0.999966562f,
-0.992335498f,0.270098448f,-0.663538277f,-0.48287195f,-0.0123883775f,-0.878258407f,0.0844252855f,0.670590878f,
0.891568303f,0.965275466f,0.988975346f,0.996509314f,0.998895705f,0.999650776f,0.999889553f,0.999965072f,
-0.640144348f,-0.284846604f,-0.863296509f,-0.630159974f,0.0874991715f,-0.903746367f,0.0528784581f,0.657293737f,
0.886994898f,0.963791192f,0.988502085f,0.996359289f,0.9988482f,0.999635756f,0.999884784f,0.999963582f,
0.300592542f,-0.75206399f,-0.977442741f,-0.757573068f,0.18651247f,-0.926377118f,0.0212787576f,0.643788815f,
0.882332861f,0.962276459f,0.98801899f,0.996206105f,0.998799741f,0.999620378f,0.999879956f,0.999962032f,
0.964965999f,-0.987659097f,-0.994656444f,-0.861092687f,0.2836622f,-0.946079254f,-0.0103422189f,0.630080283f,
0.87758255f,0.960731268f,0.987526f,0.996049762f,0.998750269f,0.999604762f,0.999875009f,0.999960482f,
0.742154181f,-0.919073522f,-0.913230121f,-0.937454224f,0.377977669f,-0.96279037f,-0.0419528559f,0.616172493f,
0.872744501f,0.959155679f,0.987023175f,0.99589026f,0.998699784f,0.999588788f,0.999869943f,0.999958873f,
-0.162990779f,-0.567430019f,-0.741239965f,-0.984248459f,0.468516916f,-0.976457715f,-0.0735215396f,0.602069914f,
0.86781919f,0.95754981f,0.986510456f,0.995727658f,0.998648286f,0.999572515f,0.999864817f,0.999957263f,
-0.918282807f,-0.0410281904f,-0.495741814f,-1.f,0.554374516f,-0.987038016f,-0.105016708f,0.587776959f,
0.862807095f,0.955913603f,0.985987842f,0.995561838f,0.998595834f,0.999555886f,0.999859571f,0.999955595f,
-0.829309821f,0.498009592f,-0.201079622f,-0.984212041f,0.634692967f,-0.994497895f,-0.136406869f,0.573298037f,
0.857708693f,0.954247177f,0.985455394f,0.995392919f,0.998542368f,0.999538958f,0.999854207f,0.999953866f,
0.0221267566f,0.883669317f,0.113521777f,-0.937382519f,0.708669782f,-0.998813629f,-0.167660639f,0.558637917f,
0.852524519f,0.95255059f,0.984913111f,0.99522084f,0.99848789f,0.999521732f,0.999848783f,0.999952197f,
0.853220105f,0.997174621f,0.416867077f,-0.860988438f,0.775565803f,-0.999971747f,-0.198746875f,0.543801069f,
0.847255111f,0.950823903f,0.984360933f,0.995045662f,0.998432398f,0.999504209f,0.99984318f,0.999950409f,
0.899866819f,0.803569078f,0.678870201f,-0.757439196f,0.834712923f,-0.997968495f,-0.22963427f,0.528792322f,
0.841901004f,0.949067116f,0.983798921f,0.994867265f,0.998375952f,0.999486327f,0.999837577f,0.999948621f,
0.119180135f,0.362476677f,0.873550534f,-0.63000071f,0.885519624f,-0.99281019f,-0.260292053f,0.513616323f,
0.836462677f,0.947280347f,0.983227074f,0.994685769f,0.998318493f,0.999468148f,0.999831796f,0.999946833f,
-0.771080196f,-0.1902491f,0.981602073f,-0.482692331f,0.927478492f,-0.984513164f,-0.290689558f,0.498277903f,
0.830940723f,0.945463598f,0.982645452f,0.994501114f,0.998260021f,0.99944967f,0.999825954f,0.999944985f,
-0.952412963f,-0.684381902f,0.992308319f,-0.320159167f,0.960170269f,-0.973103702f,-0.3207964f,0.482782036f,
0.825335622f,0.943616986f,0.982053936f,0.9943133f,0.998200536f,0.999430835f,0.999819994f,0.999943078f,
-0.258101642f,-0.967739642f,0.904607594f,-0.1475292f,0.98326844f,-0.958617806f,-0.350582451f,0.467133403f,
0.819648027f,0.941740453f,0.981452644f,0.994122326f,0.998140097f,0.999411702f,0.999813974f,0.99994117f,
0.673507154f,-0.953050017f,0.727198064f,0.0297537707f,0.996542096f,-0.941101313f,-0.380017966f,0.451337039f,
0.813878477f,0.939834237f,0.980841517f,0.993928254f,0.998078644f,0.999392271f,0.999807835f,0.999939203f,
0.985896587f,-0.644837022f,0.477671444f,0.206098333f,0.999858618f,-0.920609534f,-0.409073502f,0.435397953f,
0.808027506f,0.937898219f,0.980220556f,0.993731022f,0.998016179f,0.999372482f,0.999801576f,0.999937236f,
};
__device__ const float ROPE_SIN[1024] = {
0.f,0.f,0.f,0.f,0.f,0.f,0.f,0.f,
0.f,0.f,0.f,0.f,0.f,0.f,0.f,0.f,
0.841470957f,0.533168435f,0.310983598f,0.176892191f,0.0998334214f,0.0562044978f,0.0316175036f,0.0177818574f,
0.00999983307f,0.00562338345f,0.00316227227f,0.0017782785f,0.000999999931f,0.000562341243f,0.000316227757f,0.00017782794f,
0.909297407f,0.902130723f,0.591127098f,0.348205268f,0.198669329f,0.112231314f,0.0632033944f,0.0355580896f,
0.0199986659f,0.011246589f,0.00632451288f,0.00355655141f,0.0019999987f,0.00112468237f,0.000632455456f,0.00035565588f,
0.141120002f,0.993253171f,0.812648892f,0.5085361f,0.295520216f,0.167903304f,0.0947260857f,0.0533230826f,
0.0299954992f,0.0168694388f,0.00948669016f,0.00533481315f,0.0029999956f,0.00168702309f,0.000948683126f,0.000533483806f,
-0.756802499f,0.778471708f,0.953580737f,0.652827978f,0.389418334f,0.223044485f,0.126154065f,0.0710712075f,
0.0399893336f,0.0224917568f,0.0126487734f,0.00711305765f,0.00399998948f,0.00224936334f,0.00126491068f,0.000711311703f,
-0.958924294f,0.32393527f,0.999946535f,0.776529968f,0.47942555f,0.277480543f,0.157455876f,0.0887968615f,
0.0499791652f,0.0281133614f,0.0158107281f,0.00889127981f,0.0049999794f,0.0028117029f,0.00158113812f,0.000889139599f,
-0.279415488f,-0.230367512f,0.947148204f,0.875740528f,0.564642489f,0.33103931f,0.188600272f,0.106494442f,
0.0599640049f,0.0337340795f,0.0189725272f,0.0106694745f,0.0059999642f,0.00337404152f,0.00189736532f,0.00106696738f,
0.656986594f,-0.713721275f,0.800421596f,0.947330713f,0.64421767f,0.383551568f,0.219556093f,0.124158338f,
0.0699428469f,0.0393537246f,0.0221341345f,0.0124476347f,0.00699994294f,0.00393637875f,0.00221359241f,0.00124479528f,
0.989358246f,-0.977261782f,0.574317753f,0.989042461f,0.717356086f,0.434851229f,0.250292331f,0.141782969f,
0.0799146891f,0.0449721329f,0.0252955221f,0.0142257558f,0.0079999147f,0.00449871505f,0.00252981926f,0.00142262306f,
0.412118495f,-0.939823508f,0.291259229f,0.999560297f,0.783326924f,0.484776139f,0.280778319f,0.159362778f,
0.0898785442f,0.0505891182f,0.0284566563f,0.0160038304f,0.00899987947f,0.00506105041f,0.00284604589f,0.00160045072f,
-0.54402113f,-0.612936914f,-0.0206835698f,0.978552461f,0.841470957f,0.533168435f,0.310983568f,0.176892191f,
0.099833414f,0.0562044978f,0.0316175036f,0.0177818574f,0.009999834f,0.00562338345f,0.00316227227f,0.0017782785f,
-0.999990225f,-0.0972764567f,-0.33057496f,0.926681578f,0.891207397f,0.579875171f,0.340877861f,0.19436565f,
0.1097783f,0.0618181042f,0.0347780399f,0.0195598267f,0.0109997792f,0.00618571462f,0.00347849843f,0.00195610616f,
-0.536572933f,0.448342979f,-0.60768342f,0.845583618f,0.932039082f,0.624748647f,0.370431304f,0.211777672f,
0.119712204f,0.0674297586f,0.0379382223f,0.0213377345f,0.0119997123f,0.0067480444f,0.00379472389f,0.00213393359f,
0.420167029f,0.855880976f,-0.824528456f,0.737816215f,0.963558197f,0.667647004f,0.399614304f,0.229122713f,
0.129634142f,0.0730392784f,0.0410980321f,0.0231155735f,0.0129996343f,0.00731037185f,0.00411094911f,0.00231176103f,
0.990607381f,0.999823332f,-0.959605396f,0.606778562f,0.985449731f,0.708434701f,0.428397775f,0.246395305f,
0.139543116f,0.078646481f,0.0442574248f,0.0248933397f,0.0139995432f,0.00787269697f,0.00442717411f,0.00248958869f,
0.650287867f,0.835838437f,-0.999518692f,0.456603259f,0.997494996f,0.746982634f,0.456752867f,0.263589978f,
0.149438128f,0.0842512026f,0.0474163815f,0.0266710296f,0.0149994381f,0.00843502022f,0.00474339863f,0.00266741589f,
-0.287903309f,0.414430231f,-0.940310359f,0.292027086f,0.999573588f,0.783169091f,0.484651238f,0.280701309f,
0.159318209f,0.0898532644f,0.0505748577f,0.028448632f,0.015999319f,0.00899733976f,0.00505962269f,0.00284524332f,
-0.961397469f,-0.134615138f,-0.78785187f,0.11824052f,0.991664827f,0.81687957f,0.512064993f,0.29772386f,
0.169182345f,0.09545248f,0.0537328273f,0.0302261449f,0.0169991814f,0.00955965649f,0.00537584582f,0.00302307028f,
-0.750987232f,-0.642200708f,-0.557262897f,-0.0592755191f,0.973847628f,0.84800756f,0.538966715f,0.314652264f,
0.179029569f,0.101048686f,0.0568902642f,0.0320035629f,0.0179990288f,0.0101219704f,0.00569206895f,0.00320089748f,
0.149877205f,-0.952000856f,-0.271410108f,-0.234921798f,0.946300089f,0.876454532f,0.565329552f,0.331481189f,
0.188858896f,0.10664168f,0.060047131f,0.0337808803f,0.0189988576f,0.0106842816f,0.00600829115f,0.00337872445f,
0.912945271f,-0.968601942f,0.0413582884f,-0.403158993f,0.909297407f,0.902130723f,0.591127038f,0.348205268f,
0.198669314f,0.112231314f,0.0632033944f,0.0355580896f,0.0199986678f,0.011246589f,0.00632451288f,0.00355655141f,
0.836655617f,-0.686891198f,0.35002476f,-0.558680534f,0.863209307f,0.924954832f,0.616333544f,0.364819258f,
0.208459899f,0.117817394f,0.0663590282f,0.0373351872f,0.0209984574f,0.0118088927f,0.00664073415f,0.00373437814f,
-0.00885130931f,-0.193630233f,0.623979926f,-0.696581721f,0.808496356f,0.944854796f,0.640923738f,0.381317884f,
0.218229622f,0.123399742f,0.0695140064f,0.0391121693f,0.0219982266f,0.0123711927f,0.00695695449f,0.00391220488f,
-0.846220434f,0.359264523f,0.836055279f,-0.812512875f,0.745705247f,0.961767614f,0.664873064f,0.397695929f,
0.227977514f,0.128978193f,0.0726682767f,0.0408890247f,0.0229979735f,0.0129334899f,0.00727317436f,0.00409003161f,
-0.905578375f,0.801513135f,0.965219259f,-0.902817786f,0.67546314f,0.97563988f,0.688157499f,0.413948208f,
0.237702623f,0.134552568f,0.0758218244f,0.0426657498f,0.0239976961f,0.0134957815f,0.0075893933f,0.00426785741f,
-0.132351756f,0.996909976f,0.998663187f,-0.964648306f,0.598472118f,0.986427724f,0.710753918f,0.430069596f,
0.247403964f,0.140122697f,0.0789746121f,0.0444423407f,0.0249973964f,0.0140580693f,0.00790561177f,0.00444568414f,
0.76255846f,0.885276794f,0.933070183f,-0.996054351f,0.515501261f,0.994096994f,0.732639611f,0.446054995f,
0.257080555f,0.145688385f,0.0821266174f,0.0462187938f,0.0259970706f,0.0146203535f,0.00822182931f,0.00462350994f,
0.956375957f,0.500994205f,0.774945021f,-0.996045172f,0.427379847f,0.99862349f,0.753792703f,0.46189931f,
0.266731411f,0.151249468f,0.0852777958f,0.0479951017f,0.0269967206f,0.015182632f,0.00853804592f,0.00480133574f,
0.270905793f,-0.0375856608f,0.539968967f,-0.964621305f,0.334988207f,0.999992907f,0.774192095f,0.477597594f,
0.276355654f,0.156805754f,0.0884281173f,0.049771253f,0.0279963426f,0.0157449059f,0.0088542616f,0.00497916201f,
-0.663633883f,-0.564589798f,0.251445323f,-0.902773678f,0.239249229f,0.998200953f,0.793817401f,0.49314484f,
0.28595221f,0.162357092f,0.0915775672f,0.0515472479f,0.0289959367f,0.0163071752f,0.00917047635f,0.00515698735f,
-0.988031626f,-0.917709649f,-0.0620148405f,-0.812452853f,0.141120002f,0.993253171f,0.812648892f,0.5085361f,
0.295520186f,0.167903304f,0.0947260931f,0.0533230826f,0.029995501f,0.0168694388f,0.00948669016f,0.00533481315f,
-0.404037654f,-0.988192797f,-0.369325012f,-0.696507812f,0.0415805206f,0.985165298f,0.830667794f,0.523766637f,
0.305058628f,0.173444211f,0.0978736654f,0.055098746f,0.0309950355f,0.0174316969f,0.00980290305f,0.00551263802f,
0.551426709f,-0.754330218f,-0.640009403f,-0.5585953f,-0.0583741926f,0.973962843f,0.847856104f,0.538831532f,
0.314566553f,0.17897962f,0.101020269f,0.0568742342f,0.0319945402f,0.0179939512f,0.0101191159f,0.00569046335f,
0.999911845f,-0.28814739f,-0.847224355f,-0.403064936f,-0.157745644f,0.959681332f,0.864196658f,0.553726017f,
0.324043006f,0.184509367f,0.10416586f,0.0586495437f,0.0329940096f,0.0185561981f,0.010435327f,0.00586828869f,
0.529082716f,0.266779721f,-0.97042042f,-0.234822124f,-0.255541205f,0.942365825f,0.879673064f,0.568445385f,
0.333487093f,0.190033287f,0.107310407f,0.0604246669f,0.0339934528f,0.0191184394f,0.010751537f,0.00604611309f,
-0.428182662f,0.739542127f,-0.997380435f,-0.0591726787f,-0.350783229f,0.92207104f,0.894269884f,0.582984984f,
0.342897803f,0.195551202f,0.110453881f,0.0621996038f,0.034992855f,0.0196806751f,0.0110677453f,0.00622393796f,
-0.991778851f,0.984540582f,-0.925431013f,0.118342586f,-0.442520559f,0.89886117f,0.907972515f,0.597340286f,
0.352274209f,0.201062918f,0.113596253f,0.0639743358f,0.0359922275f,0.0202429052f,0.0113839535f,0.0064017619f,
-0.643538117f,0.926318109f,-0.761706948f,0.292125374f,-0.529836178f,0.872809589f,0.920767248f,0.611506701f,
0.361615449f,0.206568271f,0.116737492f,0.0657488778f,0.036991559f,0.0208051261f,0.0117001599f,0.0065795863f,
0.296368569f,0.58280617f,-0.522444785f,0.456694692f,-0.611857831f,0.84399873f,0.932641268f,0.625479698f,
0.370920479f,0.212067112f,0.119877554f,0.0675232038f,0.0379908569f,0.0213673431f,0.0120163653f,0.00675741071f,
0.963795364f,0.0598003156f,-0.231372014f,0.606860459f,-0.687766254f,0.81251961f,0.943582714f,0.639254928f,
0.380188406f,0.217559248f,0.123016424f,0.0692973137f,0.0389901139f,0.0219295528f,0.0123325698f,0.00693523418f,
0.745113134f,-0.481621295f,0.0826458037f,0.737885714f,-0.756802499f,0.778471708f,0.953580678f,0.652827978f,
0.389418334f,0.223044485f,0.126154065f,0.0710712075f,0.0399893373f,0.0224917568f,0.0126487734f,0.00711305765f,
-0.158622667f,-0.874714017f,0.388467699f,0.845638454f,-0.818277061f,0.74196279f,0.962625206f,0.666194677f,
0.39860931f,0.228522688f,0.129290432f,0.0728448778f,0.0409885161f,0.0230539497f,0.0129649751f,0.00729088066f,
-0.916521549f,-0.998410463f,0.655764699f,0.926720202f,-0.871575892f,0.703108132f,0.970707119f,0.679350674f,
0.407760441f,0.233993664f,0.132425532f,0.0746183172f,0.0419876575f,0.0236161388f,0.0132811759f,0.00746870413f,
-0.831774771f,-0.814614236f,0.858030677f,0.97857362f,-0.916166008f,0.662030637f,0.977818429f,0.692291796f,
0.416870773f,0.23945722f,0.135559291f,0.0763915181f,0.0429867506f,0.0241783205f,0.0135973748f,0.00764652714f,
0.0177019257f,-0.37993139f,0.975206196f,0.999563396f,-0.951602101f,0.618860185f,0.983951986f,0.70501405f,
0.425939471f,0.244913206f,0.138691694f,0.0781644881f,0.0439858064f,0.0247404929f,0.0139135728f,0.00782434922f,
0.850903511f,0.171763569f,0.995670974f,0.989027262f,-0.977530122f,0.57373327f,0.989101648f,0.717513323f,
0.434965521f,0.250361472f,0.141822711f,0.0799371973f,0.0449848175f,0.0253026579f,0.0142297689f,0.00800217129f,
0.901788354f,0.670557022f,0.917395473f,0.947297752f,-0.993690968f,0.526792526f,0.993262351f,0.72978574f,
0.44394809f,0.255801797f,0.144952312f,0.0817096606f,0.0459837839f,0.0258648153f,0.0145459641f,0.0081799943f,
0.123573124f,0.962832689f,0.748142362f,0.875690997f,-0.999923289f,0.478186339f,0.996429801f,0.741827428f,
0.452886283f,0.261234075f,0.148080453f,0.0834818557f,0.0469827019f,0.0264269635f,0.0148621574f,0.00835781638f,
-0.768254638f,0.958573103f,0.504697084f,0.776465356f,-0.99616462f,0.428068399f,0.99860096f,0.753634512f,
0.461779177f,0.266658038f,0.151207119f,0.0852537975f,0.0479815714f,0.0269891042f,0.0151783489f,0.00853563752f,
-0.953752637f,0.659090102f,0.211200655f,0.652750373f,-0.982452571f,0.376597136f,0.999773562f,0.765203178f,
0.470625877f,0.272073567f,0.15433228f,0.087025471f,0.0489803962f,0.0275512375f,0.0154945394f,0.0087134596f,
-0.262374848f,0.156619072f,-0.10324046f,0.508447945f,-0.958924294f,0.32393527f,0.999946535f,0.776529968f,
0.47942555f,0.277480543f,0.157455891f,0.0887968615f,0.0499791689f,0.0281133596f,0.0158107281f,0.00889127981f,
0.670229197f,-0.394086063f,-0.407444149f,0.3481085f,-0.925814748f,0.270249337f,0.99911958f,0.787611187f,
0.48817724f,0.282878697f,0.160577938f,0.0905679762f,0.0509778969f,0.0286754742f,0.0161269177f,0.00906910095f,
0.986627579f,-0.823421597f,-0.671240151f,0.176790684f,-0.883454502f,0.215709001f,0.997293651f,0.798443377f,
0.496880114f,0.28826794f,0.163698375f,0.0923388004f,0.051976569f,0.0292375814f,0.0164431017f,0.00924692024f,
0.395925164f,-0.999157965f,-0.868469954f,-0.000103020677f,-0.832267344f,0.160486728f,0.994470477f,0.809023023f,
0.505533338f,0.293648034f,0.166817173f,0.0941093415f,0.0529751927f,0.0297996756f,0.0167592876f,0.00942474138f,
-0.558789074f,-0.867171526f,-0.979574919f,-0.176993474f,-0.772764444f,0.104756832f,0.990652919f,0.819346905f,
0.514135957f,0.29901889f,0.169934288f,0.0958795771f,0.0539737605f,0.0303617641f,0.0170754679f,0.00960256159f,
-0.999755144f,-0.468111664f,-0.993535519f,-0.348301649f,-0.705540299f,0.0486960001f,0.985844791f,0.829411685f,
0.522687256f,0.304380238f,0.173049718f,0.0976495072f,0.0549722798f,0.0309238415f,0.01739165f,0.00978038087f,
-0.521551013f,0.0751182064f,-0.908967435f,-0.508624554f,-0.631266713f,-0.00751878507f,0.980050862f,0.839214146f,
0.531186223f,0.30973196f,0.17616342f,0.0994191393f,0.0559707358f,0.0314859077f,0.0177078284f,0.00995820016f,
0.436164767f,0.595211506f,-0.734258294f,-0.652905703f,-0.550685287f,-0.0637097955f,0.973276973f,0.848751247f,
0.539632022f,0.315073937f,0.179275364f,0.101188451f,0.0569691435f,0.0320479684f,0.0180240069f,0.0101360194f,
0.992872655f,0.931992829f,-0.486733496f,-0.776594579f,-0.464602023f,-0.119699396f,0.965529919f,0.858020008f,
0.548023939f,0.3204059f,0.182385504f,0.102957435f,0.0579674877f,0.0326100141f,0.0183401816f,0.0103138378f,
0.636738002f,0.981735826f,-0.190938011f,-0.87579f,-0.373876572f,-0.175310582f,0.956817448f,0.867017388f,
0.55636102f,0.325727791f,0.185493827f,0.104726106f,0.0589657798f,0.0331720486f,0.0186563563f,0.0104916561f,
-0.304810613f,0.729123712f,0.12379095f,-0.947363734f,-0.279415488f,-0.230367512f,0.947148204f,0.875740528f,
0.564642429f,0.33103931f,0.188600287f,0.106494442f,0.0599640086f,0.0337340795f,0.0189725272f,0.0106694745f,
-0.966117799f,0.251952261f,0.426245421f,-0.98905772f,-0.182162598f,-0.284696162f,0.936531842f,0.884186864f,
0.572867453f,0.336340427f,0.191704854f,0.108262435f,0.0609621815f,0.0342960916f,0.0192886982f,0.0108472919f,
-0.739180684f,-0.302812874f,0.686427653f,-0.999557257f,-0.0830891207f,-0.338124752f,0.924979091f,0.892353535f,
0.581035137f,0.341630876f,0.194807529f,0.110030092f,0.0619602874f,0.0348580964f,0.0196048655f,0.0110251084f,
0.167355701f,-0.764320076f,0.878538549f,-0.978531301f,0.0168140903f,-0.390484393f,0.912501454f,0.900238097f,
0.589144766f,0.346910536f,0.197908238f,0.111797392f,0.0629583374f,0.0354200937f,0.0199210308f,0.0112029258f,
};
#define XB_TMO      128
#define XB_XCNT(j)  (256  + 64 * (j))
#define XB_XSUB(j)  (1280 + 64 * (j))
#define XB_XGEN(j)  (2304 + 64 * (j))
#define XB_TOP      3328
#define XB_TOPGEN   3392
#define XCD_BAR_WORDS 3456
#define XB_SPIN_CAP (1u << 18)
#define LAS __attribute__((address_space(3)))

__device__ __forceinline__ unsigned xb_ld(unsigned* p)              { return __hip_atomic_load(p, __ATOMIC_RELAXED, __HIP_MEMORY_SCOPE_AGENT); }
__device__ __forceinline__ unsigned xb_add(unsigned* p, unsigned v) { return __hip_atomic_fetch_add(p, v, __ATOMIC_RELAXED, __HIP_MEMORY_SCOPE_AGENT); }
__device__ __forceinline__ unsigned xb_xcc_id() { return (unsigned)__builtin_amdgcn_s_getreg((3 << 11) | 20) & 0xFu; }
#define XB_SPIN(cond, bar) do { unsigned _sp = 0; while (cond) { __builtin_amdgcn_s_sleep(1); \
    if ((++_sp & 255u) == 0u) { if (xb_ld(&(bar)[XB_TMO])) break; if (_sp > XB_SPIN_CAP) { atomicAdd(&(bar)[XB_TMO], 1u); break; } } } } while (0)

struct XcdBarrier {
    unsigned* bar; unsigned x;
    volatile LAS unsigned* st;
};

__device__ __forceinline__ XcdBarrier xcd_barrier_post(unsigned* bar, volatile LAS unsigned* st) {
    XcdBarrier b; b.bar = bar; b.x = xb_xcc_id(); b.st = st;
    if (threadIdx.x == 0) (void)xb_add(&bar[XB_XCNT(b.x)], 1u);
    return b;
}
__device__ __forceinline__ void xcd_barrier_complete(unsigned* bar, unsigned x, unsigned& nloc, unsigned& nx) {
    const unsigned G = gridDim.x * gridDim.y * gridDim.z;
    unsigned sum, cnt, mine, sp = 0u;
    for (;;) {
        sum = 0u; cnt = 0u; mine = 0u;
#pragma unroll
        for (unsigned j = 0; j < 16; ++j) { const unsigned c = xb_ld(&bar[XB_XCNT(j)]); sum += c; cnt += (c > 0u) ? 1u : 0u; mine = (j == x) ? c : mine; }
        if (sum == G) break;
        __builtin_amdgcn_s_sleep(1);
        if ((++sp & 255u) == 0u) { if (xb_ld(&bar[XB_TMO])) break; if (sp > XB_SPIN_CAP) { atomicAdd(&bar[XB_TMO], 1u); break; } }
    }
    nloc = mine > 0u ? mine : 1u; nx = cnt > 0u ? cnt : 1u;
}

__device__ __forceinline__ void xcd_barrier(const XcdBarrier& b) {
    asm volatile("s_waitcnt vmcnt(0)" ::: "memory");
    __syncthreads();
    if (threadIdx.x == 0) {
        unsigned* bar = b.bar;
        __builtin_amdgcn_s_waitcnt(0);
        unsigned nloc = b.st[0], nx = b.st[1];
        if (nloc == 0u) { xcd_barrier_complete(bar, b.x, nloc, nx); b.st[0] = nloc; b.st[1] = nx; }
        const unsigned old = xb_add(&bar[XB_XSUB(b.x)], 1u);
        const unsigned gen = old / nloc;
        if (old + 1u == (gen + 1u) * nloc) {
            __builtin_amdgcn_fence(__ATOMIC_RELEASE, "agent");
            asm volatile("s_waitcnt vmcnt(0)" ::: "memory");
            const unsigned og = xb_add(&bar[XB_TOP], 1u);
            const unsigned tg = og / nx;
            if (og + 1u == (tg + 1u) * nx) xb_add(&bar[XB_TOPGEN], 1u);
            else XB_SPIN(xb_ld(&bar[XB_TOPGEN]) == tg, bar);
            __builtin_amdgcn_fence(__ATOMIC_ACQUIRE, "agent");
            xb_add(&bar[XB_XGEN(b.x)], 1u);
            asm volatile("s_waitcnt vmcnt(0)" ::: "memory");
        } else {
            XB_SPIN(xb_ld(&bar[XB_XGEN(b.x)]) == gen, bar);
            __builtin_amdgcn_fence(__ATOMIC_ACQUIRE, "agent");
            asm volatile("s_waitcnt vmcnt(0)" ::: "memory");
        }
    }
    __syncthreads();
}

namespace pg8 {
#define PG8_LAS __attribute__((address_space(3)))
typedef unsigned short bf16_t;
typedef short bf16x8 __attribute__((ext_vector_type(8)));
typedef float f32x4 __attribute__((ext_vector_type(4)));
typedef unsigned u32x4 __attribute__((ext_vector_type(4)));
constexpr int BM = 256, BK = 64, HALF = 128, HTB = HALF * BK * 2  , STAGE_BYTES = 8 * HTB, NXCD = 8, WGM = 8;

__host__ __device__ __forceinline__ int lds_byte(int r, int c) { const int st = (r >> 4) * 2 + (c >> 5), rr = r & 15, cc = c & 31, ob = rr * 64 + cc * 2; return st * 1024 + (ob ^ (((ob >> 9) & 1) << 5)); }
__host__ __device__ __forceinline__ void stage_rc(int b, int& R, int& C) { const int st = b / 1024, sb = b % 1024, swz = sb ^ (((sb >> 9) & 1) << 5); R = (st >> 1) * 16 + swz / 64; C = (st & 1) * 32 + (swz % 64) / 2; }
__host__ __device__ __forceinline__ int perm32(int rho) { const int n = rho >> 4, i = rho & 15; return 8 * (i >> 2) + 4 * n + (i & 3); }

struct Unit { int pm, pn; };
struct Gemm { const bf16_t* A; const bf16_t* Bt; int M, N, K; };

struct StaticOrder {
    int nM, nN, nwg, G, c;
    __host__ __device__ void init(int M, int N, int G_, int c_) { nM = M / BM; nN = N / BM; nwg = nM * nN; G = G_; c = c_; }
    __host__ __device__ bool next(int i, Unit& u) const {
        const long L = (long)i * G + c; if (L >= nwg) return false;
        int wgid = (int)L; { const int q = nwg / NXCD, r = nwg % NXCD, xcd = wgid % NXCD, off = wgid / NXCD; wgid = (xcd < r ? xcd * (q + 1) : r * (q + 1) + (xcd - r) * q) + off; }
        const int nig = WGM * nN, gid = wgid / nig, fm = gid * WGM, gsz = (nM - fm) < WGM ? (nM - fm) : WGM;
        u.pm = fm + ((wgid % nig) % gsz); u.pn = (wgid % nig) / gsz; return true;
    }
    __device__ __forceinline__ void a_ready(const Unit&) const {}
    __device__ __forceinline__ void done(const Unit&) const {}
};
template <class Epi, class Sched, bool ALIGN_EPI = false, bool SP2 = false>
__device__ __forceinline__ void gemm_phase(PG8_LAS unsigned char* lds, const Gemm g, const Sched& S, const Epi& E) {
    int tid = threadIdx.x; asm volatile("" : "+v"(tid)); const int wid = __builtin_amdgcn_readfirstlane(tid >> 6), lane = tid & 63, wr = wid >> 2, wc = wid & 3, fr = lane & 15, fq = lane >> 4;
    const int K = g.K, nt = K / BK;
    unsigned voffA[2], voffB[2];
#pragma unroll
    for (int i = 0; i < 2; ++i) { int R, C; stage_rc(tid * 16 + i * 8192, R, C); const int Rb = (R >> 5) * 64 + perm32(R & 31);
        voffA[i] = (unsigned)(R * K + C) * 2u; voffB[i] = (unsigned)(Rb * K + C) * 2u; }
    const size_t kstep = (size_t)(BK * 2);
    const size_t hstep = (size_t)HALF * K * 2; const size_t bhstep = (size_t)32 * K * 2;
    const size_t tstep = 2 * hstep;
    const unsigned ldsw = (unsigned)wid * 1024u;
    const int aoff = lds_byte(wr * 64 + fr, fq * 8), boff = lds_byte(wc * 32 + fr, fq * 8);
#define PG8_SA(b, h) (((b) * 2 + (h)) * HTB)
#define PG8_SB(b, h) ((4 + (b) * 2 + (h)) * HTB)
#define PG8_STAGE(bufoff, gbase, voff) do { _Pragma("unroll") for (int _i = 0; _i < 2; ++_i) \
        __builtin_amdgcn_global_load_lds((const unsigned*)((const char*)(gbase) + (voff)[_i]), (PG8_LAS unsigned*)(lds + (bufoff) + ldsw + _i * 8192), 16, 0, 0); } while (0)
#define PG8_LDA(dst, b, h) do { _Pragma("unroll") for (int m = 0; m < 4; ++m) _Pragma("unroll") for (int k = 0; k < 2; ++k) dst[m][k] = *(const PG8_LAS bf16x8*)(lds + PG8_SA(b, h) + aoff + m * 2048 + k * 1024); } while (0)
#define PG8_LDB(dst, b, h) do { _Pragma("unroll") for (int n = 0; n < 2; ++n) _Pragma("unroll") for (int k = 0; k < 2; ++k) dst[n][k] = *(const PG8_LAS bf16x8*)(lds + PG8_SB(b, h) + boff + n * 2048 + k * 1024); } while (0)
#define PG8_MMA(ai, bj, At, Bt) do { __builtin_amdgcn_s_setprio(1); _Pragma("unroll") for (int m = 0; m < 4; ++m) _Pragma("unroll") for (int n = 0; n < 2; ++n) _Pragma("unroll") for (int k = 0; k < 2; ++k) \
        acc[ai][bj][m][n] = __builtin_amdgcn_mfma_f32_16x16x32_bf16(Bt[n][k], At[m][k], acc[ai][bj][m][n], 0, 0, 0); __builtin_amdgcn_s_setprio(0); } while (0)
#define PG8_WAIT_V(n) asm volatile("s_waitcnt vmcnt(" #n ")" ::: "memory")
#define PG8_WAIT_L(n) asm volatile("s_waitcnt lgkmcnt(" #n ")" ::: "memory")
#define PG8_BAR __builtin_amdgcn_s_barrier()
#define PG8_SCHED __builtin_amdgcn_sched_barrier(0)
    Unit cur, nxt; int ui = 0;
    if (!S.next(0, cur)) return;
    f32x4 acc[2][2][4][2];
#pragma unroll
    for (int a = 0; a < 2; ++a)
#pragma unroll
        for (int b = 0; b < 2; ++b)
#pragma unroll
            for (int m = 0; m < 4; ++m)
#pragma unroll
                for (int n = 0; n < 2; ++n) acc[a][b][m][n] = (f32x4){0.f, 0.f, 0.f, 0.f};
    bf16x8 At[4][2], B0[2][2], B1[2][2];
    const char* cA = (const char*)g.A + (size_t)cur.pm * tstep; const char* cB = (const char*)g.Bt + (size_t)cur.pn * tstep;
    S.a_ready(cur);
    if constexpr (SP2) {
        PG8_STAGE(PG8_SB(0, 0), cB, voffB); PG8_STAGE(PG8_SB(0, 1), cB + bhstep, voffB); PG8_STAGE(PG8_SA(0, 0), cA, voffA); PG8_STAGE(PG8_SA(0, 1), cA + hstep, voffA);
        if (wr == 1) PG8_BAR;
        PG8_WAIT_V(2); PG8_BAR;
        PG8_STAGE(PG8_SB(1, 0), cB + kstep, voffB); PG8_STAGE(PG8_SA(1, 0), cA + kstep, voffA); PG8_STAGE(PG8_SB(1, 1), cB + bhstep + kstep, voffB);
        PG8_WAIT_V(6); PG8_BAR;
    } else {
        PG8_STAGE(PG8_SB(0, 0), cB, voffB); PG8_STAGE(PG8_SA(0, 0), cA, voffA); PG8_STAGE(PG8_SB(0, 1), cB + bhstep, voffB); PG8_STAGE(PG8_SA(0, 1), cA + hstep, voffA);
        if (wr == 1) PG8_BAR;
        PG8_WAIT_V(4); PG8_BAR;
        PG8_STAGE(PG8_SB(1, 0), cB + kstep, voffB); PG8_STAGE(PG8_SA(1, 0), cA + kstep, voffA); PG8_STAGE(PG8_SB(1, 1), cB + bhstep + kstep, voffB);
        PG8_WAIT_V(6); PG8_BAR;
    }
    for (;;) {
        const bool has_next = S.next(ui + 1, nxt);
        const char* nA = has_next ? (const char*)g.A + (size_t)nxt.pm * tstep : cA; const char* nB = has_next ? (const char*)g.Bt + (size_t)nxt.pn * tstep : cB;
        for (int t = 0; t < nt; t += 2) {
            const bool last = (t == nt - 2);
            const char* a1 = cA + (size_t)(t + 1) * kstep;
            const char* a2 = last ? nA : cA + (size_t)(t + 2) * kstep; const char* b2 = last ? nB : cB + (size_t)(t + 2) * kstep;
            const char* a3 = a2 + kstep; const char* b3 = b2 + kstep;
            if (last && has_next) S.a_ready(nxt);
            if constexpr (SP2) {
            PG8_LDB(B0, 0, 0); PG8_LDB(B1, 0, 1); PG8_SCHED; PG8_LDA(At, 0, 0); PG8_STAGE(PG8_SA(1, 1), a1 + hstep, voffA);
            PG8_WAIT_V(8); PG8_WAIT_L(0); PG8_BAR; PG8_MMA(0, 0, At, B0); PG8_MMA(0, 1, At, B1); PG8_BAR; PG8_SCHED;
            PG8_LDA(At, 0, 1); PG8_STAGE(PG8_SB(0, 0), b2, voffB); PG8_STAGE(PG8_SB(0, 1), b2 + bhstep, voffB); PG8_STAGE(PG8_SA(0, 0), a2, voffA);
            PG8_WAIT_V(8); PG8_WAIT_L(0); PG8_BAR; PG8_MMA(1, 0, At, B0); PG8_MMA(1, 1, At, B1); PG8_BAR; PG8_SCHED;
            PG8_LDB(B0, 1, 0); PG8_LDB(B1, 1, 1); PG8_SCHED; PG8_LDA(At, 1, 0); PG8_STAGE(PG8_SA(0, 1), a2 + hstep, voffA);
            PG8_WAIT_V(8); PG8_WAIT_L(0); PG8_BAR; PG8_MMA(0, 0, At, B0); PG8_MMA(0, 1, At, B1); PG8_BAR; PG8_SCHED;
            PG8_LDA(At, 1, 1); PG8_STAGE(PG8_SB(1, 0), b3, voffB); PG8_STAGE(PG8_SB(1, 1), b3 + bhstep, voffB); PG8_STAGE(PG8_SA(1, 0), a3, voffA);
            PG8_WAIT_V(8); PG8_WAIT_L(0); PG8_BAR; PG8_MMA(1, 0, At, B0); PG8_MMA(1, 1, At, B1); PG8_BAR; PG8_SCHED;
            } else {
            PG8_LDB(B0, 0, 0); PG8_SCHED; PG8_LDA(At, 0, 0); PG8_STAGE(PG8_SA(1, 1), a1 + hstep, voffA);
            PG8_WAIT_L(8); PG8_BAR; PG8_WAIT_L(0); PG8_MMA(0, 0, At, B0); PG8_BAR; PG8_SCHED;
            PG8_LDB(B1, 0, 1); PG8_STAGE(PG8_SB(0, 0), b2, voffB);
            PG8_BAR; PG8_WAIT_L(0); PG8_MMA(0, 1, At, B1); PG8_BAR;
            PG8_LDA(At, 0, 1); PG8_STAGE(PG8_SA(0, 0), a2, voffA);
            PG8_BAR; PG8_WAIT_L(0); PG8_MMA(1, 0, At, B0); PG8_BAR; PG8_SCHED;
            PG8_STAGE(PG8_SB(0, 1), b2 + bhstep, voffB);
            PG8_WAIT_V(6); PG8_BAR; PG8_MMA(1, 1, At, B1); PG8_BAR;
            PG8_LDB(B0, 1, 0); PG8_SCHED; PG8_LDA(At, 1, 0); PG8_STAGE(PG8_SA(0, 1), a2 + hstep, voffA);
            PG8_WAIT_L(8); PG8_BAR; PG8_WAIT_L(0); PG8_MMA(0, 0, At, B0); PG8_BAR; PG8_SCHED;
            PG8_LDB(B1, 1, 1); PG8_STAGE(PG8_SB(1, 0), b3, voffB);
            PG8_BAR; PG8_WAIT_L(0); PG8_MMA(0, 1, At, B1); PG8_BAR;
            PG8_LDA(At, 1, 1); PG8_STAGE(PG8_SA(1, 0), a3, voffA);
            PG8_BAR; PG8_WAIT_L(0); PG8_MMA(1, 0, At, B0); PG8_BAR; PG8_SCHED;
            PG8_STAGE(PG8_SB(1, 1), b3 + bhstep, voffB);
            PG8_WAIT_V(6); PG8_BAR; PG8_MMA(1, 1, At, B1); PG8_BAR;
            }
        }
        if constexpr (ALIGN_EPI) { if (wr == 0) PG8_BAR; }
        if constexpr (!Epi::AFTER_DRAIN) { E(acc, cur, wr, wc, fr, fq); S.done(cur); }
        if (!has_next) break;
#pragma unroll
        for (int a = 0; a < 2; ++a)
#pragma unroll
            for (int b = 0; b < 2; ++b)
#pragma unroll
                for (int m = 0; m < 4; ++m)
#pragma unroll
                    for (int n = 0; n < 2; ++n) acc[a][b][m][n] = (f32x4){0.f, 0.f, 0.f, 0.f};
        cur = nxt; cA = nA; cB = nB; ++ui;
        if constexpr (ALIGN_EPI) { if (wr == 1) PG8_BAR; }
    }
    PG8_WAIT_V(0);
    if constexpr (!ALIGN_EPI) { if (wr == 0) PG8_BAR; }
    PG8_BAR;
    if constexpr (Epi::AFTER_DRAIN) { E.fused(acc, cur, wr, wc, fr, fq, lds, wid, lane); S.done(cur); }
#undef PG8_SA
#undef PG8_SB
#undef PG8_STAGE
#undef PG8_LDA
#undef PG8_LDB
#undef PG8_MMA
#undef PG8_WAIT_V
#undef PG8_WAIT_L
#undef PG8_BAR
#undef PG8_SCHED
}
}

#ifndef PG8_SP2
#define PG8_SP2 true
#endif
#ifndef PG8_ALIGN
#define PG8_ALIGN true
#endif
#ifndef PROBE_B
#define PROBE_B 0
#endif
#ifndef LN_UR
#define LN_UR 2
#endif
#ifndef LN_NR
#define LN_NR 2
#endif
#ifndef FUSE_LN
#define FUSE_LN 0
#endif
#ifndef NT_STORE
#define NT_STORE 0
#endif
#ifndef PROBE_T
#define PROBE_T 0
#endif
#ifndef PROBE_MUL
#define PROBE_MUL 1
#endif
#ifndef SGB_R
#define SGB_R 24
#endif
#ifndef SGB_N
#define SGB_N 0
#endif
#ifndef SGB_V
#define SGB_V 14
#endif
#ifndef PROBE_X
#define PROBE_X 0
#endif
#ifndef PROBE_SYNC
#define PROBE_SYNC 0
#endif

constexpr int TP = 8192;
constexpr int TS = 32768;
constexpr int TT = TP + TS;
constexpr int DM = 1024;
constexpr int NIN = 3072;
constexpr int NLAYER = 4;
constexpr float ALPHA = 1.6817928305074292f;
constexpr float LOG2E = 1.4426950408889634f;
constexpr float C1 = 0.125f * LOG2E;
constexpr size_t OUT_NK = (size_t)TT * DM;
constexpr size_t OUT_NV = OUT_NK + (size_t)32 * 4 * 256 * 256;
constexpr size_t OUT_GK = OUT_NV + (size_t)32 * 4 * 256 * 256;
constexpr size_t OUT_GV = OUT_GK + (size_t)32 * 4 * 256 * 128;

struct Params {
  const float *x_prompt, *x_sample, *c, *cnk, *cnv, *cgk, *cgv, *c_ctx, *w_mod, *b_mod, *w_in, *b_in, *pool_w, *pool_scale,
      *nat_bias, *q_norm, *k_norm, *conv_w, *conv_b, *conv_ln_g, *conv_ln_b, *conv_pw, *w_out, *b_out, *ln_g, *ln_b;
  float* out;
  char* ws;
  int ph0, ph1;
};
constexpr size_t WS_WINT = 0;
constexpr size_t WS_WOUTT = WS_WINT + (size_t)4 * 3072 * 1024 * 2;
constexpr size_t WS_PWT = WS_WOUTT + (size_t)4 * 1024 * 1024 * 2;
constexpr size_t WS_POOLT = WS_PWT + (size_t)4 * 256 * 256 * 2;
constexpr size_t WS_CNK = WS_POOLT + (size_t)16 * 4096 * 2;
constexpr size_t WS_CNV = WS_CNK + (size_t)4194304 * 2;
constexpr size_t WS_CGK = WS_CNV + (size_t)4194304 * 2;
constexpr size_t WS_CGV = WS_CGK + (size_t)2097152 * 2;
constexpr size_t WS_U = WS_CGV + (size_t)2097152 * 2;
constexpr size_t WS_H = WS_U + (size_t)TT * NIN * 2;
constexpr size_t WS_MX = WS_H;
constexpr size_t WS_MOD = WS_MX + (size_t)TT * DM * 2;
constexpr size_t WS_STATS = WS_MOD + (size_t)4 * 9 * 3072 * 4;
constexpr size_t WS_CNT = WS_STATS + (size_t)TT * 2 * 4;
constexpr size_t WS_BAR = WS_CNT + 8192;
constexpr size_t WS_KN = WS_BAR + 16384;
constexpr size_t WS_VN = WS_KN + (size_t)4 * TT * 64 * 2;
constexpr size_t WS_KG = WS_VN + (size_t)4 * TT * 64 * 2;
constexpr size_t WS_VG = WS_KG + (size_t)2 * TT * 64 * 2;
constexpr size_t WS_PARAMS = WS_VG + (size_t)2 * TT * 64 * 2;
constexpr size_t WS_END = WS_PARAMS + 4096;
#define P_WinT ((bf16_t*)(p.ws + WS_WINT))
#define P_WoutT ((bf16_t*)(p.ws + WS_WOUTT))
#define P_pwT ((bf16_t*)(p.ws + WS_PWT))
#define P_poolT ((bf16_t*)(p.ws + WS_POOLT))
#define P_cnk_b ((bf16_t*)(p.ws + WS_CNK))
#define P_cnv_b ((bf16_t*)(p.ws + WS_CNV))
#define P_cgk_b ((bf16_t*)(p.ws + WS_CGK))
#define P_cgv_b ((bf16_t*)(p.ws + WS_CGV))
#define P_U ((bf16_t*)(p.ws + WS_U))
#define P_H ((bf16_t*)(p.ws + WS_H))
#define P_MX ((bf16_t*)(p.ws + WS_MX))
#define P_mod ((float*)(p.ws + WS_MOD))
#define P_stats ((float*)(p.ws + WS_STATS))
#define P_cnt ((unsigned*)(p.ws + WS_CNT))
#define P_bar ((unsigned*)(p.ws + WS_BAR))
#define P_KN ((bf16_t*)(p.ws + WS_KN))
#define P_VN ((bf16_t*)(p.ws + WS_VN))
#define P_KG ((bf16_t*)(p.ws + WS_KG))
#define P_VG ((bf16_t*)(p.ws + WS_VG))

DEV Params load_params(char* ws0) {
#if defined(__HIP_DEVICE_COMPILE__)
  typedef const __attribute__((address_space(4))) unsigned long long cu64;
  cu64* q = (cu64*)(ws0 + WS_PARAMS);
  asm volatile("" : "+s"(q));
  Params r;
  unsigned long long* d = (unsigned long long*)&r;
  static_assert(sizeof(Params) % 8 == 0, "Params is a whole number of 8-byte words");
#pragma unroll
  for (int i = 0; i < (int)(sizeof(Params) / 8); ++i) d[i] = q[i];
  return r;
#else
  return *(const Params*)(ws0 + WS_PARAMS);
#endif
}
DEV float bf2f(bf16_t h) { return __uint_as_float(((unsigned)h) << 16); }
DEV unsigned pk2(float lo, float hi) { f32x2 v = {lo, hi}; bf16x2_t b = __builtin_convertvector(v, bf16x2_t); return __builtin_bit_cast(unsigned, b); }
DEV bf16_t f2bf(float f) { return (bf16_t)(pk2(f, 0.f) & 0xffffu); }
DEV float bflo(unsigned w) { return __uint_as_float(w << 16); }
DEV float bfhi(unsigned w) { return __uint_as_float(w & 0xffff0000u); }
DEV float silu_f(float x) { return x * __builtin_amdgcn_rcpf(1.f + __expf(-x)); }
DEV float sigm_f(float x) { return __builtin_amdgcn_rcpf(1.f + __expf(-x)); }
DEV f32x4 mfma16(bf16x8 a, bf16x8 b, f32x4 c) { return __builtin_amdgcn_mfma_f32_16x16x32_bf16(a, b, c, 0, 0, 0); }
typedef short v4i16_t __attribute__((ext_vector_type(4)));
DEV s16x4 tr16(const char* p) {
  return __builtin_bit_cast(s16x4, __builtin_amdgcn_ds_read_tr16_b64_v4i16((__attribute__((address_space(3))) v4i16_t*)p));
}
DEV float xr16(float v, bool mx) {
  auto r = __builtin_amdgcn_permlane16_swap(__float_as_uint(v), __float_as_uint(v), false, false);
  const float a = __uint_as_float(r[0]), b = __uint_as_float(r[1]);
  return mx ? fmaxf(a, b) : a + b;
}
DEV float xr32(float v, bool mx) {
  auto r = __builtin_amdgcn_permlane32_swap(__float_as_uint(v), __float_as_uint(v), false, false);
  const float a = __uint_as_float(r[0]), b = __uint_as_float(r[1]);
  return mx ? fmaxf(a, b) : a + b;
}
DEV float wave_sum(float v) {
  v += __shfl_xor(v, 1); v += __shfl_xor(v, 2); v += __shfl_xor(v, 4); v += __shfl_xor(v, 8); v += __shfl_xor(v, 16); v += __shfl_xor(v, 32);
  return v;
}
DEV int get_tid() { int t = threadIdx.x & 255; asm volatile("" : "+v"(t)); return t; }
DEV int get_half() { return __builtin_amdgcn_readfirstlane((int)(threadIdx.x >> 8)); }
DEV int cond_of_row(int row) { return row < TP ? 0 : 1 + ((row - TP) >> 12); }

DEV void tconv_tile(const float* src, int sld, bf16_t* dst, int dld, char* smem) {
  float* t = (float*)smem;
  const int tid = get_tid();
#pragma unroll
  for (int i = 0; i < 16; ++i) { int idx = tid + i * 256; int r = idx >> 6, c = idx & 63; t[r * 65 + c] = src[(size_t)r * sld + c]; }
  __syncthreads();
#pragma unroll
  for (int i = 0; i < 4; ++i) {
    const int idx = tid + i * 256, n = idx >> 4, k = (idx & 15) * 4;
    u32x2 w; w.x = pk2(t[k * 65 + n], t[(k + 1) * 65 + n]); w.y = pk2(t[(k + 2) * 65 + n], t[(k + 3) * 65 + n]);
    *(u32x2*)(dst + (size_t)n * dld + k) = w;
  }
  __syncthreads();
}

DEV void cvt_unit(const float* src, bf16_t* dst, int u, int nh) {
  const size_t base = (size_t)u * 16384;
  const int tid = get_tid();
#pragma unroll
  for (int i = 0; i < 16; ++i) {
    const size_t e = base + (size_t)(i * 256 + tid) * 4;
    f32x4 v = *(const f32x4*)(src + e);
    u32x2 w; w.x = pk2(v[0], v[1]); w.y = pk2(v[2], v[3]);
    const size_t d = e & 63, hh = (e >> 6) % nh, sidx = (e / (64 * nh)) & 511, bl = e / ((size_t)64 * nh * 512);
    *(u32x2*)(dst + ((bl * nh + hh) * 512 + sidx) * 64 + d) = w;
  }
}

DEV void mod_unit(const Params& p, int u, char* smem) {
  const int l = u / 48, n0 = (u % 48) * 64, tid = get_tid();
  float* sc = (float*)smem;
  float* red = (float*)(smem + 36864);
  for (int i = tid; i < 9216; i += 256) { int c = i >> 10, k = i & 1023; float v = (c == 0) ? p.c_ctx[k] : p.c[(c - 1) * 1024 + k]; sc[i] = silu_f(v); }
  __syncthreads();
  const int kq = tid >> 6, col = n0 + (tid & 63);
  float acc[9];
#pragma unroll
  for (int c = 0; c < 9; ++c) acc[c] = 0.f;
  const float* wp = p.w_mod + ((size_t)l * 1024 + kq * 256) * 3072 + col;
#pragma unroll 8
  for (int k = 0; k < 256; ++k) {
    float w = wp[(size_t)k * 3072];
#pragma unroll
    for (int c = 0; c < 9; ++c) acc[c] += sc[c * 1024 + kq * 256 + k] * w;
  }
#pragma unroll
  for (int c = 0; c < 9; ++c) red[(kq * 9 + c) * 64 + (tid & 63)] = acc[c];
  __syncthreads();
  for (int i = tid; i < 576; i += 256) {
    int c = i >> 6, j = i & 63;
    float s = red[(0 * 9 + c) * 64 + j] + red[(1 * 9 + c) * 64 + j] + red[(2 * 9 + c) * 64 + j] + red[(3 * 9 + c) * 64 + j];
    P_mod[((size_t)l * 9 + c) * 3072 + n0 + j] = s + p.b_mod[l * 3072 + n0 + j];
  }
  __syncthreads();
}

DEV void h0_unit(const Params& p, int u) {
  const int tid = get_tid(), col = (tid & 127) * 8, rpar = tid >> 7;
  const int row0 = u * 32;
  const int cond = cond_of_row(row0);
  const float* md = P_mod + (size_t)cond * 3072;
  const f32x4 sh0 = *(const f32x4*)(md + col), sh1 = *(const f32x4*)(md + col + 4), sc0 = *(const f32x4*)(md + 1024 + col), sc1 = *(const f32x4*)(md + 1024 + col + 4);
#pragma unroll 4
  for (int i = 0; i < 16; ++i) {
    const int row = row0 + i * 2 + rpar;
    const float* xr = (row < TP) ? p.x_prompt + (size_t)row * DM : p.x_sample + (size_t)(row - TP) * DM;
    const f32x4 x0 = *(const f32x4*)(xr + col), x1 = *(const f32x4*)(xr + col + 4);
    const f32x4 h0v = x0 * (sc0 + 1.f) + sh0, h1v = x1 * (sc1 + 1.f) + sh1;
    u32x4 w; w.x = pk2(h0v[0], h0v[1]); w.y = pk2(h0v[2], h0v[3]); w.z = pk2(h1v[0], h1v[1]); w.w = pk2(h1v[2], h1v[3]);
    *(u32x4*)(P_H + (size_t)row * DM + col) = w;
  }
}

template <int NR>
DEV void ln_rowsN(const Params& p, int l, int row0, int lane) {
  float* Y = p.out;
  f32x4 v[NR][4];
#pragma unroll
  for (int r = 0; r < NR; ++r)
#pragma unroll
    for (int q = 0; q < 4; ++q) v[r][q] = *(const f32x4*)(Y + (size_t)(row0 + r) * DM + q * 256 + lane * 4);
  const int cond = cond_of_row(row0);
#pragma unroll
  for (int r = 0; r < NR; ++r) {
    const int row = row0 + r;
    float sm = 0.f;
#pragma unroll
    for (int q = 0; q < 4; ++q) sm += (v[r][q][0] + v[r][q][1]) + (v[r][q][2] + v[r][q][3]);
    const float mean = wave_sum(sm) * (1.f / 1024.f);
    float s2 = 0.f;
#pragma unroll
    for (int q = 0; q < 4; ++q) { v[r][q] = v[r][q] - mean; s2 += (v[r][q][0] * v[r][q][0] + v[r][q][1] * v[r][q][1]) + (v[r][q][2] * v[r][q][2] + v[r][q][3] * v[r][q][3]); }
    const float rstd = rsqrtf(wave_sum(s2) * (1.f / 1024.f) + 1e-5f);
#pragma unroll
    for (int q = 0; q < 4; ++q) {
      const int col = q * 256 + lane * 4;
      const f32x4 g = *(const f32x4*)(p.ln_g + l * 1024 + col), b = *(const f32x4*)(p.ln_b + l * 1024 + col);
      f32x4 x = v[r][q] * rstd * g + b;
      if (l < NLAYER - 1) {
        const float* md = P_mod + ((size_t)(l + 1) * 9 + cond) * 3072;
        const f32x4 sh = *(const f32x4*)(md + col), sc = *(const f32x4*)(md + 1024 + col);
        f32x4 h = x * (sc + 1.f) + sh;
        u32x2 w; w.x = pk2(h[0], h[1]); w.y = pk2(h[2], h[3]);
        *(u32x2*)(P_H + (size_t)row * DM + col) = w;
      } else {
        *(f32x4*)(Y + (size_t)row * DM + col) = x;
      }
    }
    if (l < NLAYER - 1 && lane == 0) { P_stats[row * 2] = mean; P_stats[row * 2 + 1] = rstd; }
  }
}

struct EpiA {
  static constexpr bool PERM = false, AFTER_DRAIN = false;
  char* ws0; int l_in;
  DEV void operator()(f32x4 (&acc)[2][2][4][2], const pg8::Unit& u, int wr, int wc, int, int) const {
    const int lane_ = (int)__builtin_amdgcn_mbcnt_hi(~0u, __builtin_amdgcn_mbcnt_lo(~0u, 0u)), fr = lane_ & 15, fq = lane_ >> 4;
    const Params p = load_params(ws0);
    int l = l_in; asm volatile("" : "+s"(l));
    const int colb = u.pn * 256 + wc * 64;
    const int reg = colb >> 6;
    const bool prompt = (u.pm * 256) < TP;
    f32x4 bias[2][2];
#pragma unroll
    for (int bj = 0; bj < 2; ++bj)
#pragma unroll
      for (int n = 0; n < 2; ++n) bias[bj][n] = *(const f32x4*)(p.b_in + l * 3072 + colb + bj * 32 + 8 * fq + 4 * n);
    const bool rms = (reg >= 36 && reg < 42);
    const float* gptr = (reg < 40 ? p.q_norm : p.k_norm) + l * 64;
    bf16_t* kvb = nullptr;
    if (reg >= 12 && reg < 16) kvb = P_KN + (size_t)(reg - 12) * TT * 64;
    else if (reg >= 16 && reg < 20) kvb = P_VN + (size_t)(reg - 16) * TT * 64;
    else if (reg >= 40 && reg < 42) kvb = P_KG + (size_t)(reg - 40) * TT * 64;
    else if (reg >= 42 && reg < 44) kvb = P_VG + (size_t)(reg - 42) * TT * 64;
    float* ob = nullptr; int hw = 0, cofs = 0;
    if (prompt) {
      if (reg >= 12 && reg < 16) { ob = p.out + OUT_NK; hw = 256; cofs = colb - 768; }
      else if (reg >= 16 && reg < 20) { ob = p.out + OUT_NV; hw = 256; cofs = colb - 1024; }
      else if (reg >= 40 && reg < 42) { ob = p.out + OUT_GK; hw = 128; cofs = colb - 2560; }
      else if (reg >= 42 && reg < 44) { ob = p.out + OUT_GV; hw = 128; cofs = colb - 2688; }
    }
#pragma unroll
    for (int ai = 0; ai < 2; ++ai)
#pragma unroll
      for (int m = 0; m < 4; ++m) {
        const int row = u.pm * 256 + ai * 128 + wr * 64 + m * 16 + fr;
        f32x4 v[2][2];
#pragma unroll
        for (int bj = 0; bj < 2; ++bj)
#pragma unroll
          for (int n = 0; n < 2; ++n) v[bj][n] = acc[ai][bj][m][n] + bias[bj][n];
        if (rms) {
          float ss = 0.f;
#pragma unroll
          for (int bj = 0; bj < 2; ++bj)
#pragma unroll
            for (int n = 0; n < 2; ++n)
#pragma unroll
              for (int j = 0; j < 4; ++j) ss += v[bj][n][j] * v[bj][n][j];
          ss += __shfl_xor(ss, 16); ss += __shfl_xor(ss, 32);
          const float r = rsqrtf(ss * (1.f / 64.f) + 1e-6f);
#pragma unroll
          for (int bj = 0; bj < 2; ++bj)
#pragma unroll
            for (int n = 0; n < 2; ++n) v[bj][n] = v[bj][n] * r * *(const f32x4*)(gptr + bj * 32 + 8 * fq + 4 * n);
          if (!prompt) {
            const int t = (row - TP) & 4095, pr = t >> 6, pc = t & 63;
            const float sg = (fq < 2) ? -1.f : 1.f;
#pragma unroll
            for (int bj = 0; bj < 2; ++bj)
#pragma unroll
              for (int n = 0; n < 2; ++n) {
                const int pos = bj ? pc : pr;
                const f32x4 c = *(const f32x4*)(ROPE_COS + pos * 16 + 8 * (fq & 1) + 4 * n), sn = *(const f32x4*)(ROPE_SIN + pos * 16 + 8 * (fq & 1) + 4 * n);
                f32x4 other;
#pragma unroll
                for (int j = 0; j < 4; ++j) {
                  auto r = __builtin_amdgcn_permlane32_swap(__float_as_uint(v[bj][n][j]), __float_as_uint(v[bj][n][j]), false, false);
                  other[j] = __uint_as_float((fq < 2) ? r[1] : r[0]);
                }
                v[bj][n] = v[bj][n] * c + other * sn * sg;
              }
          }
        }
        bf16_t* up = kvb ? kvb + (size_t)row * 64 + 8 * fq : P_U + (size_t)row * NIN + colb + 8 * fq;
#pragma unroll
        for (int bj = 0; bj < 2; ++bj) {
          u32x4 w; w.x = pk2(v[bj][0][0], v[bj][0][1]); w.y = pk2(v[bj][0][2], v[bj][0][3]); w.z = pk2(v[bj][1][0], v[bj][1][1]); w.w = pk2(v[bj][1][2], v[bj][1][3]);
          *(u32x4*)(up + bj * 32) = w;
        }
        if (ob) {
          const int b = row >> 8, sq = row & 255;
          float* op = ob + ((size_t)(b * 4 + l) * 256 + sq) * hw + cofs + 8 * fq;
#pragma unroll
          for (int bj = 0; bj < 2; ++bj)
#pragma unroll
            for (int n = 0; n < 2; ++n) *(f32x4*)(op + bj * 32 + n * 4) = v[bj][n];
        }
      }
  }
};

struct EpiC {
  static constexpr bool PERM = false, AFTER_DRAIN = false;
  char* ws0; int l_in; char* lds_x;
  DEV void operator()(f32x4 (&acc)[2][2][4][2], const pg8::Unit& u, int wr, int wc, int, int) const {
    const int lane_ = (int)__builtin_amdgcn_mbcnt_hi(~0u, __builtin_amdgcn_mbcnt_lo(~0u, 0u)), fr = lane_ & 15, fq = lane_ >> 4;
    const Params p = load_params(ws0);
    int l = l_in; asm volatile("" : "+s"(l));
    const int colb = u.pn * 256 + wc * 64 + 8 * fq;
    const int cond = cond_of_row(u.pm * 256);
    const float* gatep = P_mod + ((size_t)l * 9 + cond) * 3072 + 2048;
    float* Y = p.out;
    auto xrow = [&](int it) -> const float* {
      const int row = u.pm * 256 + (it >> 2) * 128 + wr * 64 + (it & 3) * 16 + fr;
      if (l == 0) return (row < TP) ? p.x_prompt + (size_t)row * DM : p.x_sample + (size_t)(row - TP) * DM;
      return Y + (size_t)row * DM;
    };
    f32x4 xq[2][4]; f32x2 st[2];
    {
      const float* xr = xrow(0);
#pragma unroll
      for (int k = 0; k < 4; ++k) xq[0][k] = *(const f32x4*)(xr + colb + (k >> 1) * 32 + (k & 1) * 4);
      st[0] = (l > 0) ? *(const f32x2*)(P_stats + (size_t)(u.pm * 256 + wr * 64 + fr) * 2) : (f32x2){0.f, 1.f};
    }
#pragma unroll
    for (int it = 0; it < 8; ++it) {
      const int ai = it >> 2, m = it & 3;
      const int row = u.pm * 256 + ai * 128 + wr * 64 + m * 16 + fr;
      if (it + 1 < 8) {
        const float* xr = xrow(it + 1);
#pragma unroll
        for (int k = 0; k < 4; ++k) xq[(it + 1) & 1][k] = *(const f32x4*)(xr + colb + (k >> 1) * 32 + (k & 1) * 4);
        const int rown = u.pm * 256 + ((it + 1) >> 2) * 128 + wr * 64 + ((it + 1) & 3) * 16 + fr;
        st[(it + 1) & 1] = (l > 0) ? *(const f32x2*)(P_stats + (size_t)rown * 2) : (f32x2){0.f, 1.f};
      }
      const float mean = st[it & 1][0], rstd = st[it & 1][1];
#pragma unroll
      for (int bj = 0; bj < 2; ++bj)
#pragma unroll
        for (int n = 0; n < 2; ++n) {
          const int col = colb + bj * 32 + n * 4;
          f32x4 xo = xq[it & 1][bj * 2 + n];
          if (l > 0) {
            const f32x4 g = *(const f32x4*)(p.ln_g + (l - 1) * 1024 + col), b = *(const f32x4*)(p.ln_b + (l - 1) * 1024 + col);
            xo = (xo - mean) * rstd * g + b;
          }
          const f32x4 gt = *(const f32x4*)(gatep + col), bo = *(const f32x4*)(p.b_out + l * 1024 + col);
          const f32x4 y = xo * ALPHA + gt * (acc[ai][bj][m][n] + bo);
#if FUSE_LN
          asm volatile("global_store_dwordx4 %0, %1, off sc1\n\ts_nop 1" :: "v"(Y + (size_t)row * DM + col), "v"(y) : "memory");
#else
          *(f32x4*)(Y + (size_t)row * DM + col) = y;
#endif
        }
    }
#if FUSE_LN
    asm volatile("s_waitcnt vmcnt(0)" ::: "memory");
    __syncthreads();
    volatile LAS unsigned* fl = (volatile LAS unsigned*)(lds_x);
    const int wave = wr * 4 + wc, lane = fq * 16 + fr;
    if (wave == 0 && lane == 0) { const unsigned old = __hip_atomic_fetch_add(P_cnt + l * 160 + u.pm, 1u, __ATOMIC_RELAXED, __HIP_MEMORY_SCOPE_AGENT); *fl = (old == 3u) ? 1u : 0u; }
    __syncthreads();
    if (*fl != 0u) {
      __builtin_amdgcn_fence(__ATOMIC_ACQUIRE, "agent");
      asm volatile("s_waitcnt vmcnt(0)" ::: "memory");
      for (int i = 0; i < 32 / LN_NR; ++i) ln_rowsN<LN_NR>(p, l, u.pm * 256 + wave * 32 + i * LN_NR, lane);
    }
    __syncthreads();
#endif
  }
};

DEV void ln_unit(const Params& p, int l, int u) {
  const int tid = get_tid(), lane = tid & 63, wid = tid >> 6;
  ln_rowsN<LN_UR>(p, l, (u * 4 + wid) * LN_UR, lane);
}

DEV int kswz(int key, int ch) {
  const int ob = (key & 15) * 64 + (ch & 3) * 16;
  return ((key >> 4) * 2 + (ch >> 2)) * 1024 + (ob ^ (((ob >> 9) & 1) << 5));
}
template <int NQ, int NKT>
DEV void qk_tile(const char* kb, int koff, const bf16x8 (&qf)[NQ][2], f32x4 (&s)[NQ][4], int fr, int fq, const float (&mb)[NQ]) {
#pragma unroll
  for (int t = 0; t < NKT; ++t) {
    const int key = koff + 16 * t + fr;
    const bf16x8 k0 = *(const bf16x8*)(kb + kswz(key, fq)), k1 = *(const bf16x8*)(kb + kswz(key, 4 + fq));
#pragma unroll
    for (int g = 0; g < NQ; ++g) { const float nb = -mb[g]; f32x4 z = {nb, nb, nb, nb}; z = mfma16(k0, qf[g][0], z); z = mfma16(k1, qf[g][1], z); s[g][t] = z; }
  }
#pragma unroll
  for (int t = NKT; t < 4; ++t)
#pragma unroll
    for (int g = 0; g < NQ; ++g) s[g][t] = (f32x4){0.f, 0.f, 0.f, 0.f};
}
template <int NQ, int NKT, bool NATL>
DEV void sm_max(f32x4 (&s)[NQ][4], int koff, f32x4 (&o)[NQ][4], float (&mrun)[NQ], f32x4 (&osum)[NQ], int fq, const float* br0, const float* br1, bool gv0, bool gv1, int qc, bool first) {
#pragma unroll
  for (int g = 0; g < NQ; ++g) {
    float mx = -1e30f;
    if (NATL) {
      const int cs = min(max(qc - 8, 0), 48);
      const float* biasrow = g ? br1 : br0;
      const bool gv = g ? gv1 : gv0;
#pragma unroll
      for (int t = 0; t < NKT; ++t)
#pragma unroll
        for (int j = 0; j < 4; ++j) {
          const int kc = koff + 16 * t + 4 * fq + j;
          const bool valid = gv && (kc >= cs) && (kc < cs + 16);
          const int dc = min(max(kc - qc + 15, 0), 30);
          const float bv = biasrow[dc];
          const float x = valid ? s[g][t][j] + bv : -1e30f;
          s[g][t][j] = x; mx = fmaxf(mx, x);
        }
    } else {
#pragma unroll
      for (int t = 0; t < NKT; ++t)
#pragma unroll
        for (int j = 0; j < 4; ++j) mx = fmaxf(mx, s[g][t][j]);
    }
    mx = xr16(mx, true); mx = xr32(mx, true);
    if (__builtin_amdgcn_ballot_w64(first || mx > 8.0f) != 0ull) {
      const float d = first ? mx : fmaxf(mx, 0.f);
      const float al = first ? 1.f : __builtin_amdgcn_exp2f(-d);
      mrun[g] += d; osum[g] = osum[g] * al;
#pragma unroll
      for (int dt = 0; dt < 4; ++dt) o[g][dt] = o[g][dt] * al;
#pragma unroll
      for (int t = 0; t < NKT; ++t) s[g][t] = s[g][t] - d;
    }
  }
}
template <int NQ, int NKT, bool NATL>
DEV void sm_exp_pv(const char* vs, int koff, f32x4 (&s)[NQ][4], f32x4 (&o)[NQ][4], const float (&mrun)[NQ], f32x4 (&osum)[NQ], int fr, int fq) {
#pragma unroll
  for (int g = 0; g < NQ; ++g)
#pragma unroll
    for (int t = 0; t < NKT; ++t)
#pragma unroll
      for (int j = 0; j < 4; ++j) s[g][t][j] = __builtin_amdgcn_exp2f(s[g][t][j]);
  const short one = (short)0x3f80;
  const bf16x8 ones = {one, one, one, one, one, one, one, one};
#pragma unroll
  for (int u = 0; u < NKT / 2; ++u) {
    bf16x8 pf[NQ];
#pragma unroll
    for (int g = 0; g < NQ; ++g) {
      u32x4 w;
      w.x = pk2(s[g][2 * u][0], s[g][2 * u][1]); w.y = pk2(s[g][2 * u][2], s[g][2 * u][3]);
      w.z = pk2(s[g][2 * u + 1][0], s[g][2 * u + 1][1]); w.w = pk2(s[g][2 * u + 1][2], s[g][2 * u + 1][3]);
      pf[g] = __builtin_bit_cast(bf16x8, w);
      osum[g] = mfma16(ones, pf[g], osum[g]);
    }
#pragma unroll
    for (int dt = 0; dt < 4; ++dt) {
      const char* vp = vs + (koff + 32 * u + 4 * fq + (fr >> 2)) * 160 + dt * 32 + (fr & 3) * 8;
      const s16x4 lo = tr16(vp), hi = tr16(vp + 16 * 160);
      const bf16x8 vf = {lo[0], lo[1], lo[2], lo[3], hi[0], hi[1], hi[2], hi[3]};
#pragma unroll
      for (int g = 0; g < NQ; ++g) o[g][dt] = mfma16(vf, pf[g], o[g][dt]);
    }
  }
}

template <int MODE>
DEV void attn_unit(const Params& p, int l, int u, char* smem, char* smem0, int half) {
  constexpr int NQ = 2;
  constexpr int QGS = (MODE == 1) ? 64 : 16;
  constexpr int NLD = (MODE == 0) ? 1 : 2;
  if constexpr (MODE == 0) smem = smem0;
  const int tid = get_tid(), lane = tid & 63, wid = tid >> 6, fr = lane & 15, fq = lane >> 4;
  int qrow0, qcol, gcol, ocol, NT, NLOC, cstride = 0;
  const bf16_t *kU, *vU, *kC = nullptr, *vC = nullptr;
  int nat_r = 0, nat_rs = 0;
  if (MODE == 0) {
    const int g = u & 1, qb = (u >> 1) & 31, kvh = (u >> 6) & 1, b = u >> 7, h = kvh * 2 + g;
    qrow0 = TP + b * 4096 + qb * 128 + wid * 32; qcol = 2304 + h * 64; gcol = 2816 + h * 64; ocol = 768 + h * 64;
    kU = P_KG + ((size_t)kvh * TT + TP + b * 4096) * 64; vU = P_VG + ((size_t)kvh * TT + TP + b * 4096) * 64; NLOC = 64; NT = 72;
    kC = P_cgk_b + ((size_t)((b * 4 + l) * 2 + kvh) * 512) * 64; vC = P_cgv_b + ((size_t)((b * 4 + l) * 2 + kvh) * 512) * 64; cstride = 64;
  } else if (MODE == 1) {
    const int rp = u & 31, h = (u >> 5) & 3, b = u >> 7, r = 2 * rp;
    nat_r = r; nat_rs = min(max(r - 4, 0), 56);
    qrow0 = TP + b * 4096 + r * 64 + wid * 16; qcol = 512 + h * 64; gcol = 1280 + h * 64; ocol = 256 + h * 64;
    kU = P_KN + ((size_t)h * TT + TP + b * 4096) * 64; vU = P_VN + ((size_t)h * TT + TP + b * 4096) * 64; NLOC = 8; NT = 18;
    kC = P_cnk_b + ((size_t)((b * 4 + l) * 4 + h) * 512) * 64; vC = P_cnv_b + ((size_t)((b * 4 + l) * 4 + h) * 512) * 64; cstride = 64;
    float* blw = (float*)(smem + 36864);
    for (int i = tid; i < 465; i += 256) blw[i] = p.nat_bias[(size_t)(l * 4 + h) * 465 + i] * LOG2E;
  } else {
    const int qb = u & 1, hh = (u >> 1) & 7, b = u >> 4;
    qrow0 = b * 256 + qb * 128 + wid * 32; NLOC = 4; NT = 4;
    if (hh < 4) { qcol = 512 + hh * 64; gcol = 1280 + hh * 64; ocol = 256 + hh * 64; kU = P_KN + ((size_t)hh * TT + b * 256) * 64; vU = P_VN + ((size_t)hh * TT + b * 256) * 64; }
    else { const int h = hh - 4; qcol = 2304 + h * 64; gcol = 2816 + h * 64; ocol = 768 + h * 64; kU = P_KG + ((size_t)(h >> 1) * TT + b * 256) * 64; vU = P_VG + ((size_t)(h >> 1) * TT + b * 256) * 64; }
  }
  bf16x8 qf[NQ][2];
#pragma unroll
  for (int g = 0; g < NQ; ++g)
#pragma unroll
    for (int ks = 0; ks < 2; ++ks) qf[g][ks] = *(const bf16x8*)(P_U + (size_t)(qrow0 + g * QGS + fr) * NIN + qcol + ks * 32 + fq * 8);
#pragma unroll
  for (int g = 0; g < NQ; ++g)
#pragma unroll
    for (int ks = 0; ks < 2; ++ks) asm volatile("" : "+v"(qf[g][ks]));
#pragma unroll
  for (int g = 0; g < NQ; ++g)
#pragma unroll
    for (int ks = 0; ks < 2; ++ks) {
      u32x4 w = __builtin_bit_cast(u32x4, qf[g][ks]);
      w.x = pk2(bflo(w.x) * C1, bfhi(w.x) * C1); w.y = pk2(bflo(w.y) * C1, bfhi(w.y) * C1);
      w.z = pk2(bflo(w.z) * C1, bfhi(w.z) * C1); w.w = pk2(bflo(w.w) * C1, bfhi(w.w) * C1);
      qf[g][ks] = __builtin_bit_cast(bf16x8, w);
    }
  f32x4 o[NQ][4]; float mrun[NQ]; f32x4 lrun[NQ];
#pragma unroll
  for (int g = 0; g < NQ; ++g) { mrun[g] = 0.f; lrun[g] = (f32x4){0.f, 0.f, 0.f, 0.f};
#pragma unroll
    for (int dt = 0; dt < 4; ++dt) o[g][dt] = (f32x4){0.f, 0.f, 0.f, 0.f}; }
  u32x4 rkA[NLD], rvA[NLD], rkB[NLD], rvB[NLD];
  const int ltid = (MODE == 0) ? half * 256 + tid : tid;
  const int lrow = ltid >> 3, lc = ltid & 7;
  auto glK = [&](int t, u32x4 (&rk)[NLD]) {
    const bf16_t* kp; int st;
    if constexpr (MODE == 1) { if (t < 8) kp = kC + (size_t)t * 4096; else kp = kU + (size_t)min(nat_rs + t - 8, 63) * 4096; st = 64; }
    else { if (t < NLOC) { kp = kU + (size_t)t * 64 * 64; st = 64; } else { kp = kC + (size_t)(t - NLOC) * 64 * cstride; st = cstride; } }
#pragma unroll
    for (int i = 0; i < NLD; ++i) rk[i] = *(const u32x4*)(kp + (size_t)(lrow + i * 32) * st + lc * 8);
  };
  auto glV = [&](int t, u32x4 (&rv)[NLD]) {
    const bf16_t* vp; int st;
    if constexpr (MODE == 1) { if (t < 8) vp = vC + (size_t)t * 4096; else vp = vU + (size_t)min(nat_rs + t - 8, 63) * 4096; st = 64; }
    else { if (t < NLOC) { vp = vU + (size_t)t * 64 * 64; st = 64; } else { vp = vC + (size_t)(t - NLOC) * 64 * cstride; st = cstride; } }
#pragma unroll
    for (int i = 0; i < NLD; ++i) rv[i] = *(const u32x4*)(vp + (size_t)(lrow + i * 32) * st + lc * 8);
  };
  auto stK = [&](int buf, const u32x4 (&rk)[NLD]) {
#pragma unroll
    for (int i = 0; i < NLD; ++i) *(u32x4*)(smem + buf * 8192 + kswz(lrow + i * 32, lc)) = rk[i];
  };
  auto stV = [&](int buf, const u32x4 (&rv)[NLD]) {
#pragma unroll
    for (int i = 0; i < NLD; ++i) *(u32x4*)(smem + 16384 + buf * 10240 + (lrow + i * 32) * 160 + lc * 16) = rv[i];
  };
  const float* bl = (const float*)(smem + 36864);
  const int kcw = (wid == 0) ? 0 : (wid == 1) ? 8 : (wid == 2) ? 24 : 32;
  auto qk = [&](int t, f32x4 (&sd)[NQ][4]) {
    const char* kb = smem + (t & 1) * 8192;
    if constexpr (MODE == 1) { if (t < 8) qk_tile<2, 4>(kb, 0, qf, sd, fr, fq, mrun); else qk_tile<2, 2>(kb, kcw, qf, sd, fr, fq, mrun); }
    else qk_tile<NQ, 4>(kb, 0, qf, sd, fr, fq, mrun);
  };
  auto smx = [&](int t, f32x4 (&sd)[NQ][4]) {
    if constexpr (MODE == 1) {
      if (t < 8) sm_max<2, 4, false>(sd, 0, o, mrun, lrun, fq, nullptr, nullptr, true, true, 0, t == 0);
      else {
        const int kr = nat_rs + t - 8;
        const int rs1 = min(max(nat_r - 3, 0), 56);
        const bool gv0 = (kr < nat_rs + 8) && (kr < 64), gv1 = (kr >= rs1) && (kr < rs1 + 8) && (kr < 64);
        const int dr0 = min(max(kr - nat_r + 7, 0), 14), dr1 = min(max(kr - nat_r + 6, 0), 14);
        sm_max<2, 2, true>(sd, kcw, o, mrun, lrun, fq, bl + dr0 * 31, bl + dr1 * 31, gv0, gv1, wid * 16 + fr, false);
      }
    } else sm_max<NQ, 4, false>(sd, 0, o, mrun, lrun, fq, nullptr, nullptr, true, true, 0, t == 0);
  };
  auto spv = [&](int t, f32x4 (&sd)[NQ][4]) {
    const char* vs = smem + 16384 + (t & 1) * 10240;
    if constexpr (MODE == 1) {
      if (t < 8) sm_exp_pv<2, 4, false>(vs, 0, sd, o, mrun, lrun, fr, fq);
      else sm_exp_pv<2, 2, true>(vs, kcw, sd, o, mrun, lrun, fr, fq);
    } else sm_exp_pv<NQ, 4, false>(vs, 0, sd, o, mrun, lrun, fr, fq);
  };
  auto iter = [&](int t, f32x4 (&sc)[NQ][4], f32x4 (&sn)[NQ][4], u32x4 (&rkX)[NLD], u32x4 (&rvX)[NLD], u32x4 (&rkY)[NLD], u32x4 (&rvY)[NLD]) {
    glK(min(t + 3, NT - 1), rkX);
    glV(min(t + 2, NT - 1), rvX);
    smx(t, sc);
    qk(t + 1, sn);
    spv(t, sc);
#if SGB_N > 0
    if constexpr (MODE != 1) {
#pragma unroll
      for (int i = 0; i < SGB_N; ++i) { __builtin_amdgcn_sched_group_barrier(0x008, 1, 0); __builtin_amdgcn_sched_group_barrier(0x002, SGB_V, 0); }
    }
#endif
#if PROBE_T == 1
    if constexpr (MODE == 0) { const unsigned long long t0_ = __builtin_amdgcn_s_memrealtime(); asm volatile("s_waitcnt vmcnt(2)" ::: "memory"); const unsigned long long t1_ = __builtin_amdgcn_s_memrealtime(); if (threadIdx.x == 0) *(volatile unsigned long long*)(smem0 + 131072 + 256) += t1_ - t0_; }
#endif
    stK(t & 1, rkY);
    stV((t + 1) & 1, rvY);
#if PROBE_T == 2
    if constexpr (MODE == 0) { asm volatile("s_waitcnt lgkmcnt(0)" ::: "memory"); const unsigned long long t0_ = __builtin_amdgcn_s_memrealtime(); __syncthreads(); const unsigned long long t1_ = __builtin_amdgcn_s_memrealtime(); if (threadIdx.x == 0) *(volatile unsigned long long*)(smem0 + 131072 + 256) += t1_ - t0_; } else
#endif
    __syncthreads();
  };
#if PROBE_T == 3
  const unsigned long long tu0_ = __builtin_amdgcn_s_memrealtime();
#endif
  glK(0, rkA); glV(0, rvA); stK(0, rkA); stV(0, rvA);
  glK(1, rkA); stK(1, rkA);
  glK(2, rkB); glV(1, rvB);
  __syncthreads();
  f32x4 sA[NQ][4], sB[NQ][4];
  qk(0, sA);
#pragma unroll 1
  for (int t = 0; t < NT; t += 2) { iter(t, sA, sB, rkA, rvA, rkB, rvB); iter(t + 1, sB, sA, rkB, rvB, rkA, rvA); }
#if PROBE_T == 3
  if constexpr (MODE == 0) { if (threadIdx.x == 0) *(volatile unsigned long long*)(smem0 + 131072 + 256) += __builtin_amdgcn_s_memrealtime() - tu0_; }
#endif
#pragma unroll
  for (int g = 0; g < NQ; ++g) {
    const float inv = __builtin_amdgcn_rcpf(lrun[g][0]);
    const int row = qrow0 + g * QGS + fr;
#pragma unroll
    for (int dt = 0; dt < 4; ++dt) {
      const int d0 = dt * 16 + 4 * fq;
      const u32x2 gw = *(const u32x2*)(P_U + (size_t)row * NIN + gcol + d0);
      u32x2 w;
      w.x = pk2(o[g][dt][0] * inv * silu_f(bflo(gw.x)), o[g][dt][1] * inv * silu_f(bfhi(gw.x)));
      w.y = pk2(o[g][dt][2] * inv * silu_f(bflo(gw.y)), o[g][dt][3] * inv * silu_f(bfhi(gw.y)));
      *(u32x2*)(P_MX + (size_t)row * DM + ocol + d0) = w;
    }
  }
}

DEV void pool_unit(const Params& p, int l, int u, char* smem) {
  const int tid = get_tid(), lane = tid & 63, wid = tid >> 6, fr = lane & 15, fq = lane >> 4;
  const int R0 = u * 32;
  int L, sb;
  if (R0 < TP) { L = 256; sb = R0 & ~255; } else { L = 4096; sb = TP + ((R0 - TP) & ~4095); }
  const int t0 = R0 - sb;
  bf16_t* xs = (bf16_t*)smem;
  bf16_t* ya = (bf16_t*)(smem + 24576);
  const bf16_t* wt = P_poolT + (size_t)(l * 4 + wid) * 4096;
  bf16x8 bfr[2][4];
#pragma unroll
  for (int ks = 0; ks < 2; ++ks)
#pragma unroll
    for (int n = 0; n < 4; ++n) bfr[ks][n] = *(const bf16x8*)(wt + (n * 16 + fr) * 64 + ks * 32 + fq * 8);
  u32x2 gwv[2][4];
#pragma unroll
  for (int m = 0; m < 2; ++m)
#pragma unroll
    for (int n = 0; n < 4; ++n) gwv[m][n] = *(const u32x2*)(P_U + (size_t)(R0 + m * 16 + fr) * NIN + 256 + wid * 64 + n * 16 + 4 * fq);
#pragma unroll
  for (int k = 0; k < 6; ++k) {
    const int idx = tid + k * 256, i = idx >> 5, c8 = (idx & 31) * 8, t = t0 - 8 + i;
    u32x4 w = {0u, 0u, 0u, 0u};
    if (t >= 0 && t < L) w = *(const u32x4*)(P_U + (size_t)(sb + t) * NIN + c8);
    *(u32x4*)(xs + i * 256 + c8) = w;
  }
  __syncthreads();
  {
    const int c = tid, g = c >> 6, win = 2 << g, half = win >> 1;
    float sum = 0.f;
    for (int i = 0; i < win; ++i) sum += bf2f(xs[(8 - half + i) * 256 + c]);
#pragma unroll 8
    for (int tt = 0; tt < 32; ++tt) {
      const int t = t0 + tt;
      const int lo = max(t - half, 0), hi = min(t - half + win, L);
      const float y = sum / (float)(hi - lo) - bf2f(xs[(tt + 8) * 256 + c]);
      ya[tt * 264 + c] = f2bf(y);
      sum += bf2f(xs[(tt + 8 - half + win) * 256 + c]) - bf2f(xs[(tt + 8 - half) * 256 + c]);
    }
  }
  __syncthreads();
  const int g = wid;
  f32x4 acc[2][4];
#pragma unroll
  for (int m = 0; m < 2; ++m)
#pragma unroll
    for (int n = 0; n < 4; ++n) acc[m][n] = (f32x4){0.f, 0.f, 0.f, 0.f};
#pragma unroll
  for (int ks = 0; ks < 2; ++ks) {
    bf16x8 af[2];
#pragma unroll
    for (int m = 0; m < 2; ++m) af[m] = *(const bf16x8*)(smem + 24576 + (m * 16 + fr) * 528 + (g * 64 + ks * 32 + fq * 8) * 2);
#pragma unroll
    for (int m = 0; m < 2; ++m)
#pragma unroll
      for (int n = 0; n < 4; ++n) acc[m][n] = mfma16(bfr[ks][n], af[m], acc[m][n]);
  }
#pragma unroll
  for (int m = 0; m < 2; ++m) {
    const int row = R0 + m * 16 + fr;
#pragma unroll
    for (int n = 0; n < 4; ++n) {
      const int ch = g * 64 + n * 16 + 4 * fq;
      const f32x4 sc = *(const f32x4*)(p.pool_scale + l * 256 + ch);
      const u32x2 gw = gwv[m][n];
      u32x2 w;
      w.x = pk2(acc[m][n][0] * sc[0] * silu_f(bflo(gw.x)), acc[m][n][1] * sc[1] * silu_f(bfhi(gw.x)));
      w.y = pk2(acc[m][n][2] * sc[2] * silu_f(bflo(gw.y)), acc[m][n][3] * sc[3] * silu_f(bfhi(gw.y)));
      *(u32x2*)(P_MX + (size_t)row * DM + ch) = w;
    }
  }
  __syncthreads();
}

DEV void conv_unit(const Params& p, int l, int u, char* smem) {
  const int tid = get_tid(), lane = tid & 63, wid = tid >> 6, fr = lane & 15, fq = lane >> 4;
  const int R0 = u * 64;
  int L, sb;
  if (R0 < TP) { L = 256; sb = R0 & ~255; } else { L = 4096; sb = TP + ((R0 - TP) & ~4095); }
  const int t0 = R0 - sb;
  bf16_t* zs = (bf16_t*)smem;
  bf16_t* za = (bf16_t*)smem;
  float* cs = (float*)(smem + 48128);
  float* red = (float*)(smem + 64768);
#pragma unroll 6
  for (int it = 0; it < 12; ++it) {
    const int idx = min(tid + it * 256, 94 * 32 - 1);
    const int i = idx >> 5, c8 = (idx & 31) * 8, t = t0 - 15 + i;
    u32x4 w = {0u, 0u, 0u, 0u};
    if (t >= 0 && t < L) {
      const bf16_t* ur = P_U + (size_t)(sb + t) * NIN;
      const u32x4 vv = *(const u32x4*)(ur + 1536 + c8), gg = *(const u32x4*)(ur + 1792 + c8);
      w.x = pk2(bflo(vv.x) * sigm_f(bflo(gg.x)), bfhi(vv.x) * sigm_f(bfhi(gg.x)));
      w.y = pk2(bflo(vv.y) * sigm_f(bflo(gg.y)), bfhi(vv.y) * sigm_f(bfhi(gg.y)));
      w.z = pk2(bflo(vv.z) * sigm_f(bflo(gg.z)), bfhi(vv.z) * sigm_f(bfhi(gg.z)));
      w.w = pk2(bflo(vv.w) * sigm_f(bflo(gg.w)), bfhi(vv.w) * sigm_f(bfhi(gg.w)));
    }
    *(u32x4*)(zs + i * 256 + c8) = w;
  }
  __syncthreads();
  const int c = tid;
  float wj[31];
#pragma unroll
  for (int j = 0; j < 31; ++j) wj[j] = p.conv_w[(size_t)(l * 31 + j) * 256 + c];
  const float cb = p.conv_b[l * 256 + c], lg = p.conv_ln_g[l * 256 + c], lb = p.conv_ln_b[l * 256 + c];
  float a[4][16];
#pragma unroll
  for (int ch = 0; ch < 4; ++ch) {
    float zr[46];
#pragma unroll
    for (int i = 0; i < 46; ++i) zr[i] = bf2f(zs[(ch * 16 + i) * 256 + c]);
#pragma unroll
    for (int i = 0; i < 16; ++i) {
      float s = cb;
#pragma unroll
      for (int j = 0; j < 31; ++j) s += zr[i + j] * wj[j];
      a[ch][i] = s;
      cs[i * 260 + c] = s;
    }
    __syncthreads();
    {
      const int i2 = tid >> 4, sl = tid & 15;
      float s1 = 0.f, s2 = 0.f;
#pragma unroll
      for (int q = 0; q < 4; ++q) {
        const f32x4 v = *(const f32x4*)(cs + i2 * 260 + sl * 16 + q * 4);
        s1 += (v[0] + v[1]) + (v[2] + v[3]);
        s2 += (v[0] * v[0] + v[1] * v[1]) + (v[2] * v[2] + v[3] * v[3]);
      }
      s1 += __shfl_xor(s1, 1); s2 += __shfl_xor(s2, 1);
      s1 += __shfl_xor(s1, 2); s2 += __shfl_xor(s2, 2);
      s1 += __shfl_xor(s1, 4); s2 += __shfl_xor(s2, 4);
      s1 += __shfl_xor(s1, 8); s2 += __shfl_xor(s2, 8);
      if (sl == 0) { red[(ch * 16 + i2) * 2] = s1; red[(ch * 16 + i2) * 2 + 1] = s2; }
    }
    __syncthreads();
  }
#pragma unroll
  for (int ch = 0; ch < 4; ++ch)
#pragma unroll
    for (int i = 0; i < 16; ++i) {
      const int tt = ch * 16 + i;
      const float mean = red[tt * 2] * (1.f / 256.f);
      const float var = fmaxf(red[tt * 2 + 1] * (1.f / 256.f) - mean * mean, 0.f);
      const float rstd = rsqrtf(var + 1e-5f);
      const float v = (a[ch][i] - mean) * rstd * lg + lb;
      za[tt * 264 + c] = f2bf(silu_f(v));
    }
  __syncthreads();
  f32x4 acc[4][4];
#pragma unroll
  for (int m = 0; m < 4; ++m)
#pragma unroll
    for (int n = 0; n < 4; ++n) acc[m][n] = (f32x4){0.f, 0.f, 0.f, 0.f};
  const bf16_t* wt = P_pwT + (size_t)l * 65536 + (size_t)(wid * 64 + fr) * 256 + fq * 8;
  bf16x8 bq[3][4];
#pragma unroll
  for (int n = 0; n < 4; ++n) { bq[0][n] = *(const bf16x8*)(wt + (size_t)n * 16 * 256); bq[1][n] = *(const bf16x8*)(wt + (size_t)n * 16 * 256 + 32); }
  u32x2 gwv[4][4];
#pragma unroll
  for (int m = 0; m < 4; ++m)
#pragma unroll
    for (int n = 0; n < 4; ++n) gwv[m][n] = *(const u32x2*)(P_U + (size_t)(R0 + m * 16 + fr) * NIN + 2048 + wid * 64 + n * 16 + 4 * fq);
#pragma unroll
  for (int ks = 0; ks < 8; ++ks) {
    if (ks + 2 < 8) {
#pragma unroll
      for (int n = 0; n < 4; ++n) bq[(ks + 2) % 3][n] = *(const bf16x8*)(wt + (size_t)n * 16 * 256 + (ks + 2) * 32);
    }
    bf16x8 af[4];
#pragma unroll
    for (int m = 0; m < 4; ++m) af[m] = *(const bf16x8*)(smem + (m * 16 + fr) * 528 + (ks * 32 + fq * 8) * 2);
#pragma unroll
    for (int m = 0; m < 4; ++m)
#pragma unroll
      for (int n = 0; n < 4; ++n) acc[m][n] = mfma16(bq[ks % 3][n], af[m], acc[m][n]);
  }
#pragma unroll
  for (int m = 0; m < 4; ++m) {
    const int row = R0 + m * 16 + fr;
#pragma unroll
    for (int n = 0; n < 4; ++n) {
      const int ch = wid * 64 + n * 16 + 4 * fq;
      const u32x2 gw = gwv[m][n];
      u32x2 w;
      w.x = pk2(acc[m][n][0] * silu_f(bflo(gw.x)), acc[m][n][1] * silu_f(bfhi(gw.x)));
      w.y = pk2(acc[m][n][2] * silu_f(bflo(gw.y)), acc[m][n][3] * silu_f(bfhi(gw.y)));
      *(u32x2*)(P_MX + (size_t)row * DM + 512 + ch) = w;
    }
  }
  __syncthreads();
}

constexpr int P0_WIN = 3072, P0_WOUT = 1024, P0_PW = 64, P0_POOL = 16, P0_CVT = 768, P0_MOD = 192;
constexpr int P0_UNITS = P0_WIN + P0_WOUT + P0_PW + P0_POOL + P0_CVT + P0_MOD;

DEV void phase0(const Params& p, char* smem) {
  if (blockIdx.x == 0) for (int i = threadIdx.x; i < 1280 + 64; i += 512) P_cnt[i] = 0u;
  const int half = get_half();
  smem += half * 65536;
  for (int pr = blockIdx.x; pr < P0_UNITS / 2; pr += gridDim.x) {
    int v = pr * 2 + half;
    if (v < P0_MOD) { mod_unit(p, v, smem); continue; }
    v -= P0_MOD;
    if (v < P0_WIN) { const int l = v / 768, r = v % 768, kt = r / 48, nt = r % 48;
      tconv_tile(p.w_in + ((size_t)l * 1024 + kt * 64) * 3072 + nt * 64, 3072, P_WinT + ((size_t)l * 3072 + nt * 64) * 1024 + kt * 64, 1024, smem); continue; }
    v -= P0_WIN;
    if (v < P0_WOUT) { const int l = v >> 8, r = v & 255, kt = r >> 4, nt = r & 15;
      tconv_tile(p.w_out + ((size_t)l * 1024 + kt * 64) * 1024 + nt * 64, 1024, P_WoutT + ((size_t)l * 1024 + nt * 64) * 1024 + kt * 64, 1024, smem); continue; }
    v -= P0_WOUT;
    if (v < P0_PW) { const int l = v >> 4, r = v & 15, kt = r >> 2, nt = r & 3;
      tconv_tile(p.conv_pw + ((size_t)l * 256 + kt * 64) * 256 + nt * 64, 256, P_pwT + ((size_t)l * 256 + nt * 64) * 256 + kt * 64, 256, smem); continue; }
    v -= P0_PW;
    if (v < P0_POOL) { tconv_tile(p.pool_w + (size_t)v * 4096, 64, P_poolT + (size_t)v * 4096, 64, smem); continue; }
    v -= P0_POOL;
    if (v < 256) { cvt_unit(p.cnk, P_cnk_b, v, 4); continue; }
    v -= 256;
    if (v < 256) { cvt_unit(p.cnv, P_cnv_b, v, 4); continue; }
    v -= 256;
    if (v < 128) { cvt_unit(p.cgk, P_cgk_b, v, 2); continue; }
    v -= 128;
    cvt_unit(p.cgv, P_cgv_b, v, 2);
  }
}

constexpr int XB_GQA = 128, XB_NAT = 128, XB_CONV = 80, XB_PATT = 64, XB_POOL = 160;
constexpr int XB_UNITS = XB_GQA + XB_NAT + XB_CONV + XB_PATT + XB_POOL;

DEV void phaseB(char* ws0, int l_in, char* smem, int qofs, int ubeg = 0, int uend = XB_UNITS) {
  const int xcd = blockIdx.x & 7;
  unsigned* q = (unsigned*)(ws0 + WS_CNT) + 1280 + qofs + l_in * 8 + xcd;
  int* slot = (int*)(smem + 131072);
  const int half = get_half();
  char* smem0 = smem;
  smem += half * 65536;
  for (;;) {
    if (threadIdx.x == 0) *slot = (int)atomicAdd(q, 1u);
    __syncthreads();
    int u = ubeg + *slot * 2 + half;
    __syncthreads();
    if (u >= uend) break;
    int l = l_in; asm volatile("" : "+s"(l));
    const Params p = load_params(ws0);
    if (u < XB_GQA) { attn_unit<0>(p, l, xcd * XB_GQA + u, smem, smem0, half); continue; }
    u -= XB_GQA;
    if (u < XB_NAT) { attn_unit<1>(p, l, xcd * XB_NAT + u, smem, smem0, half); continue; }
    u -= XB_NAT;
    if (u < XB_CONV) { conv_unit(p, l, xcd * XB_CONV + u, smem); continue; }
    u -= XB_CONV;
    if (u < XB_PATT) { attn_unit<2>(p, l, xcd * XB_PATT + u, smem, smem0, half); continue; }
    u -= XB_PATT;
    pool_unit(p, l, xcd * XB_POOL + u, smem);
  }
}

constexpr int LDS_BYTES = 131072 + 1024;
__global__ void __launch_bounds__(512, 2) mega(Params p0) {
  extern __shared__ __attribute__((aligned(16))) char smem[];
  cg::grid_group grid = cg::this_grid();
  const int ph0 = p0.ph0, ph1 = p0.ph1;
  char* const ws0 = p0.ws;
  if (blockIdx.x == 0 && threadIdx.x == 0) *(Params*)(ws0 + WS_PARAMS) = p0;
#define PP() load_params(ws0)
  const int half = get_half();
  volatile LAS unsigned* xst = (volatile LAS unsigned*)(smem + 131072 + 64);
  if (threadIdx.x == 0) { xst[0] = 0u; xst[1] = 0u; *(volatile unsigned long long*)(smem + 131072 + 256) = 0ull; }
  __syncthreads();
  const XcdBarrier xb = xcd_barrier_post((unsigned*)(ws0 + WS_BAR), xst);
  if (ph0 <= 0 && 0 < ph1) { for (int rep = 0; rep < (PROBE_X == 4 ? 2 : 1); ++rep) { phase0(p0, smem); if (1 < ph1) grid.sync(); } }
  if (ph0 <= 1 && 1 < ph1) { for (int u = blockIdx.x; u < TT / 64; u += gridDim.x) { const Params pl = PP(); h0_unit(pl, u * 2 + half); } if (2 < ph1) xcd_barrier(xb); }
  for (int li = 0; li < NLAYER; ++li) {
    int l = li; asm volatile("" : "+s"(l));
    const int pa = 2 + 3 * li;
    if (ph0 <= pa && pa < ph1) {
      const Params p = PP();
      pg8::Gemm g; g.A = P_H; g.Bt = P_WinT + (size_t)l * 3072 * 1024; g.M = TT; g.N = NIN; g.K = DM;
      pg8::StaticOrder S; S.init(TT, NIN, (int)gridDim.x, (int)blockIdx.x);
      EpiA E{ws0, l};
      for (int rep = 0; rep < (PROBE_X == 1 ? 2 : 1); ++rep) {
        pg8::gemm_phase<EpiA, pg8::StaticOrder, true, true>((PG8_LAS unsigned char*)smem, g, S, E);
        if (pa + 1 < ph1) xcd_barrier(xb);
      }
    }
    if (ph0 <= pa + 1 && pa + 1 < ph1) { phaseB(ws0, l, smem, 0); if (pa + 2 < ph1) xcd_barrier(xb); }
#if PROBE_SYNC
    for (int i = 0; i < 8; ++i) xcd_barrier(xb);
#endif
#if PROBE_B
    { constexpr int lo[7] = {0, 0, 128, 256, 336, 400, 0}, hi[7] = {0, 128, 256, 336, 400, 560, 560}; phaseB(ws0, l, smem, 32, lo[PROBE_B], hi[PROBE_B]); xcd_barrier(xb); }
#endif
    if (ph0 <= pa + 2 && pa + 2 < ph1) {
      const Params p = PP();
      pg8::Gemm g; g.A = P_MX; g.Bt = P_WoutT + (size_t)l * 1024 * 1024; g.M = TT; g.N = DM; g.K = DM;
      pg8::StaticOrder S; S.init(TT, DM, (int)gridDim.x, (int)blockIdx.x);
      EpiC E{ws0, l, smem + 131072 + 128};
      for (int rep = 0; rep < ((PROBE_X == 2 && li == 0) ? 2 : 1); ++rep) {
        pg8::gemm_phase<EpiC, pg8::StaticOrder, true, true>((PG8_LAS unsigned char*)smem, g, S, E);
#if FUSE_LN
        if (pa + 3 < ph1) xcd_barrier(xb);
#else
        xcd_barrier(xb);
#endif
      }
#if !FUSE_LN
      for (int rep = 0; rep < ((PROBE_X == 3 && li < 3) ? 2 : 1); ++rep) {
        for (int u = blockIdx.x; u < TT / (8 * LN_UR); u += gridDim.x) { const Params pl = PP(); ln_unit(pl, l, u * 2 + half); }
        if (pa + 3 < ph1) xcd_barrier(xb);
      }
#endif
    }
  }
#if PROBE_T
  if (blockIdx.x == 0 && threadIdx.x == 0) { const unsigned long long acc_ = *(volatile unsigned long long*)(smem + 131072 + 256) * PROBE_MUL; const unsigned long long ts_ = __builtin_amdgcn_s_memrealtime(); while (__builtin_amdgcn_s_memrealtime() - ts_ < acc_) __builtin_amdgcn_s_sleep(8); }
#endif
}

#ifndef ONE_LAUNCH
#define ONE_LAUNCH 1
#endif

extern "C" void kernel_launch(void* const* d_in, const int* in_sizes, int n_in, void* d_out, int out_size, void* d_ws, size_t ws_size,
                              hipStream_t stream) {
  static int grid_blocks = 0;
  if (!grid_blocks) {
    int dev = 0, cus = 0, per_cu = 0;
    hipGetDevice(&dev);
    hipDeviceGetAttribute(&cus, hipDeviceAttributeMultiprocessorCount, dev);
    hipFuncSetAttribute((const void*)mega, hipFuncAttributeMaxDynamicSharedMemorySize, LDS_BYTES);
    hipOccupancyMaxActiveBlocksPerMultiprocessor(&per_cu, mega, 512, LDS_BYTES);
    if (per_cu > 1) per_cu = 1;
    if (per_cu < 1) per_cu = 1;
    grid_blocks = cus * per_cu;
  }
  if (ws_size < WS_END) { fprintf(stderr, "kernel_launch: workspace too small (%zu < %zu); nothing launched\n", ws_size, (size_t)WS_END); return; }
  Params p{};
  const float* const* in = (const float* const*)d_in;
  p.x_prompt = in[0]; p.x_sample = in[1]; p.c = in[2]; p.cnk = in[3]; p.cnv = in[4]; p.cgk = in[5]; p.cgv = in[6]; p.c_ctx = in[7];
  p.w_mod = in[8]; p.b_mod = in[9]; p.w_in = in[10]; p.b_in = in[11]; p.pool_w = in[12]; p.pool_scale = in[13]; p.nat_bias = in[14];
  p.q_norm = in[15]; p.k_norm = in[16]; p.conv_w = in[17]; p.conv_b = in[18]; p.conv_ln_g = in[19]; p.conv_ln_b = in[20]; p.conv_pw = in[21];
  p.w_out = in[22]; p.b_out = in[23]; p.ln_g = in[24]; p.ln_b = in[25];
  p.out = (float*)d_out;
  p.ws = (char*)d_ws;
  hipMemsetAsync((char*)d_ws + WS_BAR, 0, XCD_BAR_WORDS * sizeof(unsigned), stream);
#if ONE_LAUNCH
  p.ph0 = 0; p.ph1 = 14;
  void* args[] = {&p};
  hipError_t e = hipLaunchCooperativeKernel((void*)mega, dim3(grid_blocks), dim3(512), args, LDS_BYTES, stream);
  if (e != hipSuccess) fprintf(stderr, "cooperative launch failed: %s (grid %d)\n", hipGetErrorString(e), grid_blocks);
#else
  for (int ph = 0; ph < 14; ++ph) { p.ph0 = ph; p.ph1 = ph + 1; mega<<<grid_blocks, 512, LDS_BYTES, stream>>>(p); }
#endif
}
```

```cpp
#define SGB_N 0
#define SGB_V 6
#define LN_UR 2
#include <hip/hip_runtime.h>
#include <hip/hip_cooperative_groups.h>
#include <cstdio>
#include <cstdint>
namespace cg = cooperative_groups;

typedef unsigned short bf16_t;
typedef short bf16x8 __attribute__((ext_vector_type(8)));
typedef short s16x4 __attribute__((ext_vector_type(4)));
typedef float f32x4 __attribute__((ext_vector_type(4)));
typedef float f32x2 __attribute__((ext_vector_type(2)));
typedef __bf16 bf16x2_t __attribute__((ext_vector_type(2)));
typedef unsigned u32x4 __attribute__((ext_vector_type(4)));
typedef unsigned u32x2 __attribute__((ext_vector_type(2)));
#define DEV __device__ __forceinline__
__device__ const float ROPE_COS[1024] = {
1.f,1.f,1.f,1.f,1.f,1.f,1.f,1.f,
1.f,1.f,1.f,1.f,1.f,1.f,1.f,1.f,
0.540302277f,0.846009135f,0.950415254f,0.98423022f,0.995004177f,0.998419285f,0.999500036f,0.999841869f,
0.999949992f,0.999984205f,0.999994993f,0.999998391f,0.999999523f,0.999999821f,0.99999994f,1.f,
-0.416146845f,0.431462824f,0.806578398f,0.937418282f,0.980066597f,0.993682086f,0.998000681f,0.999367595f,
0.999800026f,0.999936759f,0.999979973f,0.999993682f,0.999997973f,0.999999344f,0.999999821f,0.99999994f,
-0.989992499f,-0.115966164f,0.582753658f,0.861040652f,0.955336511f,0.985803485f,0.995503366f,0.998577297f,
0.999550045f,0.999857724f,0.999954998f,0.999985754f,0.99999553f,0.999998569f,0.999999523f,0.999999881f,
-0.653643608f,-0.627679706f,0.301137477f,0.757506192f,0.921060979f,0.974808276f,0.992010653f,0.997471273f,
0.999200106f,0.999747038f,0.999920011f,0.999974728f,0.999992013f,0.999997497f,0.999999225f,0.999999762f,
0.2836622f,-0.946079254f,-0.0103423381f,0.630080283f,0.87758255f,0.960731268f,0.987526f,0.996049762f,
0.998750269f,0.999604762f,0.999875009f,0.999960482f,0.999987483f,0.999996066f,0.999998748f,0.999999583f,
0.960170269f,-0.973103702f,-0.3207964f,0.482782036f,0.825335622f,0.943616986f,0.982053936f,0.9943133f,
0.998200536f,0.999430835f,0.999819994f,0.999943078f,0.999981999f,0.999994338f,0.999998212f,0.999999404f,
0.753902256f,-0.700429797f,-0.599437475f,0.320257008f,0.764842212f,0.923519433f,0.975599885f,0.992262423f,
0.997551024f,0.999225318f,0.999755025f,0.999922514f,0.999975502f,0.999992251f,0.999997556f,0.999999225f,
-0.145500034f,-0.212036446f,-0.818632424f,0.147631213f,0.696706712f,0.900502324f,0.968170285f,0.989897788f,
0.996801734f,0.998988271f,0.999680042f,0.999898791f,0.999967992f,0.999989867f,0.999996781f,0.999998987f,
-0.91113025f,0.341660261f,-0.956644177f,-0.0296507962f,0.621609926f,0.874638259f,0.959772646f,0.987220109f,
0.995952725f,0.998719573f,0.999595046f,0.99987191f,0.999959528f,0.999987185f,0.999995947f,0.999998748f,
-0.839071512f,0.790131867f,-0.999786079f,-0.205997631f,0.540302277f,0.846009135f,0.950415313f,0.98423022f,
0.995004177f,0.998419285f,0.999500036f,0.999841869f,0.999949992f,0.999984205f,0.999994993f,0.999998391f,
0.00442569796f,0.995257378f,-0.943779767f,-0.375847399f,0.453596085f,0.814705312f,0.940107584f,0.980929136f,
0.993956089f,0.998087406f,0.999395072f,0.999808669f,0.999939501f,0.999980867f,0.99999392f,0.999998093f,
0.843853951f,0.893861592f,-0.79417938f,-0.53384304f,0.362357706f,0.780825913f,0.92885989f,0.97731787f,
0.99280864f,0.997723997f,0.999280095f,0.99977231f,0.999927998f,0.999977231f,0.999992788f,0.999997735f,
0.907446802f,0.517172873f,-0.565820515f,-0.675001681f,0.267498761f,0.744477987f,0.916683376f,0.973397553f,
0.99156189f,0.997329056f,0.999155104f,0.999732792f,0.999915481f,0.999973297f,0.999991536f,0.999997318f,
0.136737213f,-0.0187961515f,-0.28134948f,-0.794870913f,0.16996716f,0.705776393f,0.903590262f,0.969169438f,
0.990216017f,0.996902585f,0.999020159f,0.999690115f,0.99990201f,0.999969006f,0.999990225f,0.999996901f,
-0.759687901f,-0.548975468f,0.0310223512f,-0.889670432f,0.070737198f,0.6648435f,0.889593601f,0.964634836f,
0.988771081f,0.996444523f,0.998875201f,0.999644279f,0.999887526f,0.999964416f,0.999988735f,0.999996424f,
-0.957659483f,-0.910081089f,0.340318173f,-0.95641005f,-0.0291995462f,0.621808827f,0.87470746f,0.959795177f,
0.987227261f,0.99595499f,0.998720288f,0.999595284f,0.999872029f,0.999959528f,0.999987185f,0.999995947f,
-0.275163352f,-0.990897954f,0.615864813f,-0.99298501f,-0.128844544f,0.576808274f,0.858946681f,0.954652011f,
0.985584795f,0.995433986f,0.998555362f,0.999543071f,0.999855518f,0.999954283f,0.999985576f,0.99999541f,
0.660316706f,-0.766536534f,0.830336154f,-0.998241663f,-0.227202162f,0.529984176f,0.842327058f,0.949207008f,
0.983843684f,0.994881511f,0.998380423f,0.999487758f,0.999837995f,0.9999488f,0.999983788f,0.999994874f,
0.988704622f,-0.306095392f,0.962463796f,-0.972014248f,-0.323289543f,0.481484592f,0.824865162f,0.943461835f,
0.982004225f,0.994297504f,0.998195529f,0.999429286f,0.999819517f,0.999942899f,0.99998194f,0.999994278f,
0.408082068f,0.248616725f,0.999144375f,-0.91512996f,-0.416146845f,0.431462824f,0.806578457f,0.937418282f,
0.980066597f,0.993682086f,0.998000681f,0.999367595f,0.999800026f,0.999936759f,0.999979973f,0.999993682f,
-0.547729254f,0.726760268f,0.936740458f,-0.829382956f,-0.504846215f,0.380077004f,0.787485182f,0.931078374f,
0.97803092f,0.993035257f,0.99779582f,0.999302804f,0.999779522f,0.999930263f,0.999977946f,0.999993026f,
-0.99996084f,0.981074572f,0.781440377f,-0.717477441f,-0.588501155f,0.327489585f,0.767604589f,0.92444396f,
0.975897431f,0.992357016f,0.997581005f,0.999234855f,0.999758005f,0.999923468f,0.999975801f,0.999992371f,
-0.53283304f,0.933235765f,0.548645258f,-0.582943261f,-0.666275978f,0.273866832f,0.746956408f,0.917517304f,
0.97366637f,0.991647422f,0.997356176f,0.999163687f,0.999735534f,0.999916375f,0.999973536f,0.999991655f,
0.424179018f,0.597977161f,0.261441678f,-0.430023283f,-0.737393796f,0.219378278f,0.725561321f,0.910300434f,
0.971337974f,0.990906477f,0.997121394f,0.99908942f,0.99971199f,0.999908924f,0.999971211f,0.99999088f,
0.991202831f,0.078552261f,-0.0516893305f,-0.263540596f,-0.801143587f,0.164196163f,0.703440726f,0.902795732f,
0.968912423f,0.99013412f,0.996876657f,0.999011934f,0.999687493f,0.999901175f,0.999968767f,0.999990106f,
0.64691931f,-0.465064496f,-0.359694332f,-0.0887455046f,-0.856888831f,0.108494945f,0.680616796f,0.895005584f,
0.966389954f,0.98933053f,0.996621907f,0.998931348f,0.999662042f,0.999893129f,0.999966204f,0.999989331f,
-0.292138815f,-0.865450621f,-0.632028639f,0.088848114f,-0.904072165f,0.0524506159f,0.6571123f,0.886932373f,
0.963770926f,0.988495648f,0.996357203f,0.998847544f,0.999635518f,0.999884725f,0.999963522f,0.999988496f,
-0.962605894f,-0.999293387f,-0.841684937f,0.26363951f,-0.942222297f,-0.00375941908f,0.632950664f,0.878578722f,
0.961055458f,0.987629473f,0.996082544f,0.998760641f,0.99960804f,0.999876022f,0.99996078f,0.999987602f,
-0.748057544f,-0.825371623f,-0.967871487f,0.430115849f,-0.970958173f,-0.0599575676f,0.608156204f,0.869947195f,
0.958243906f,0.986732066f,0.995797932f,0.998670578f,0.999579549f,0.999867022f,0.999957979f,0.999986708f,
0.154251456f,-0.397251874f,-0.998075247f,0.583026946f,-0.989992499f,-0.115966164f,0.582753658f,0.861040652f,
0.955336511f,0.985803485f,0.995503366f,0.998577297f,0.999550045f,0.999857724f,0.999954998f,0.999985754f,
0.914742351f,0.153215483f,-0.929300308f,0.717549205f,-0.999135137f,-0.171608135f,0.556768358f,0.851861775f,
0.95233357f,0.984843671f,0.995198846f,0.998480916f,0.999519527f,0.999848068f,0.999951959f,0.999984801f,
0.83422339f,0.656495154f,-0.768367112f,0.829440355f,-0.998294771f,-0.226707578f,0.53022635f,0.842413545f,
0.949235439f,0.983852804f,0.994884372f,0.998381376f,0.999488056f,0.999838114f,0.9999488f,0.999983788f,
-0.0132767474f,0.95758605f,-0.531235278f,0.915171385f,-0.987479806f,-0.281090319f,0.503154159f,0.832698941f,
0.946042359f,0.982830763f,0.994559944f,0.998278618f,0.999455571f,0.999827802f,0.999945521f,0.999982774f,
-0.848570287f,0.963757515f,-0.241421118f,0.972038329f,-0.966798186f,-0.334584385f,0.475578904f,0.822721004f,
0.942754686f,0.981777668f,0.994225562f,0.99817276f,0.999422073f,0.999817252f,0.999942183f,0.999981701f,
-0.903692186f,0.673110247f,0.0723346695f,0.998247743f,-0.93645668f,-0.387020677f,0.447528064f,0.812482953f,
0.939372718f,0.980693519f,0.993881226f,0.998063743f,0.999387562f,0.999806345f,0.999938726f,0.999980628f,
-0.127963692f,0.175156534f,0.378916174f,0.992972851f,-0.896758378f,-0.438233554f,0.419029742f,0.801987886f,
0.935896814f,0.979578316f,0.993526995f,0.997951567f,0.999352098f,0.999795079f,0.99993521f,0.999979496f,
0.765414059f,-0.376742303f,0.647921681f,0.95638001f,-0.848100007f,-0.488060862f,0.39011243f,0.791239262f,
0.93232733f,0.978432178f,0.993162811f,0.997836173f,0.99931556f,0.999783576f,0.999931574f,0.999978364f,
0.955073655f,-0.812611222f,0.852673113f,0.889623463f,-0.790967762f,-0.536345184f,0.360805035f,0.780240417f,
0.928664625f,0.977255106f,0.992788672f,0.997717679f,0.999278069f,0.999771714f,0.999927819f,0.999977171f,
0.266642928f,-0.998210371f,0.972865343f,0.794808388f,-0.72593224f,-0.582933903f,0.331136853f,0.768994927f,
0.924909055f,0.976047099f,0.99240464f,0.997596025f,0.999239624f,0.999759495f,0.999923944f,0.999975979f,
-0.666938066f,-0.87637943f,0.996578991f,0.674925625f,-0.653643608f,-0.627679706f,0.301137596f,0.757506192f,
0.921060979f,0.974808276f,0.992010653f,0.997471273f,0.999200106f,0.999747038f,0.999920011f,0.999974728f,
-0.987339258f,-0.484639406f,0.921462357f,0.533756077f,-0.574824035f,-0.670441091f,0.270837069f,0.745777905f,
0.917120814f,0.973538578f,0.991606772f,0.997343302f,0.999159634f,0.999734223f,0.999915957f,0.999973416f,
-0.399985313f,0.0563609414f,0.754965365f,0.375752151f,-0.490260571f,-0.711082935f,0.240265876f,0.733813822f,
0.913088918f,0.972238123f,0.991192937f,0.997212172f,0.999118149f,0.99972111f,0.999911785f,0.999972105f,
0.555113316f,0.580003142f,0.513598442f,0.205897167f,-0.400799006f,-0.749476731f,0.209454417f,0.721617639f,
0.908965766f,0.970906913f,0.990769207f,0.997077882f,0.999075651f,0.999707639f,0.999907553f,0.999970794f,
0.999843299f,0.925014675f,0.221298173f,0.0295478199f,-0.307332784f,-0.785501122f,0.178433523f,0.709193349f,
0.904751658f,0.969545007f,0.990335584f,0.996940494f,0.99903214f,0.99969393f,0.999903202f,0.999969363f,
0.52532196f,0.985138178f,-0.0929481089f,-0.147732988f,-0.210795805f,-0.819042206f,0.147234216f,0.696544766f,
0.90044713f,0.968152404f,0.989892066f,0.996799886f,0.998987675f,0.999679863f,0.999898732f,0.999967992f,
-0.432177931f,0.741858006f,-0.397976756f,-0.320354372f,-0.112152621f,-0.849993885f,0.115887694f,0.683675885f,
0.89605248f,0.966729224f,0.989438653f,0.996656179f,0.998942196f,0.999665439f,0.999894202f,0.999966562f,
-0.992335498f,0.270098448f,-0.663538277f,-0.48287195f,-0.0123883775f,-0.878258407f,0.0844252855f,0.670590878f,
0.891568303f,0.965275466f,0.988975346f,0.996509314f,0.998895705f,0.999650776f,0.999889553f,0.999965072f,
-0.640144348f,-0.284846604f,-0.863296509f,-0.630159974f,0.0874991715f,-0.903746367f,0.0528784581f,0.657293737f,
0.886994898f,0.963791192f,0.988502085f,0.996359289f,0.9988482f,0.999635756f,0.999884784f,0.999963582f,
0.300592542f,-0.75206399f,-0.977442741f,-0.757573068f,0.18651247f,-0.926377118f,0.0212787576f,0.643788815f,
0.882332861f,0.962276459f,0.98801899f,0.996206105f,0.998799741f,0.999620378f,0.999879956f,0.999962032f,
0.964965999f,-0.987659097f,-0.994656444f,-0.861092687f,0.2836622f,-0.946079254f,-0.0103422189f,0.630080283f,
0.87758255f,0.960731268f,0.987526f,0.996049762f,0.998750269f,0.999604762f,0.999875009f,0.999960482f,
0.742154181f,-0.919073522f,-0.913230121f,-0.937454224f,0.377977669f,-0.96279037f,-0.0419528559f,0.616172493f,
0.872744501f,0.959155679f,0.987023175f,0.99589026f,0.998699784f,0.999588788f,0.999869943f,0.999958873f,
-0.162990779f,-0.567430019f,-0.741239965f,-0.984248459f,0.468516916f,-0.976457715f,-0.0735215396f,0.602069914f,
0.86781919f,0.95754981f,0.986510456f,0.995727658f,0.998648286f,0.999572515f,0.999864817f,0.999957263f,
-0.918282807f,-0.0410281904f,-0.495741814f,-1.f,0.554374516f,-0.987038016f,-0.105016708f,0.587776959f,
0.862807095f,0.955913603f,0.985987842f,0.995561838f,0.998595834f,0.999555886f,0.999859571f,0.999955595f,
-0.829309821f,0.498009592f,-0.201079622f,-0.984212041f,0.634692967f,-0.994497895f,-0.136406869f,0.573298037f,
0.857708693f,0.954247177f,0.985455394f,0.995392919f,0.998542368f,0.999538958f,0.999854207f,0.999953866f,
0.0221267566f,0.883669317f,0.113521777f,-0.937382519f,0.708669782f,-0.998813629f,-0.167660639f,0.558637917f,
0.852524519f,0.95255059f,0.984913111f,0.99522084f,0.99848789f,0.999521732f,0.999848783f,0.999952197f,
0.853220105f,0.997174621f,0.416867077f,-0.860988438f,0.775565803f,-0.999971747f,-0.198746875f,0.543801069f,
0.847255111f,0.950823903f,0.984360933f,0.995045662f,0.998432398f,0.999504209f,0.99984318f,0.999950409f,
0.899866819f,0.803569078f,0.678870201f,-0.757439196f,0.834712923f,-0.997968495f,-0.22963427f,0.528792322f,
0.841901004f,0.949067116f,0.983798921f,0.994867265f,0.998375952f,0.999486327f,0.999837577f,0.999948621f,
0.119180135f,0.362476677f,0.873550534f,-0.63000071f,0.885519624f,-0.99281019f,-0.260292053f,0.513616323f,
0.836462677f,0.947280347f,0.983227074f,0.994685769f,0.998318493f,0.999468148f,0.999831796f,0.999946833f,
-0.771080196f,-0.1902491f,0.981602073f,-0.482692331f,0.927478492f,-0.984513164f,-0.290689558f,0.498277903f,
0.830940723f,0.945463598f,0.982645452f,0.994501114f,0.998260021f,0.99944967f,0.999825954f,0.999944985f,
-0.952412963f,-0.684381902f,0.992308319f,-0.320159167f,0.960170269f,-0.973103702f,-0.3207964f,0.482782036f,
0.825335622f,0.943616986f,0.982053936f,0.9943133f,0.998200536f,0.999430835f,0.999819994f,0.999943078f,
-0.258101642f,-0.967739642f,0.904607594f,-0.1475292f,0.98326844f,-0.958617806f,-0.350582451f,0.467133403f,
0.819648027f,0.941740453f,0.981452644f,0.994122326f,0.998140097f,0.999411702f,0.999813974f,0.99994117f,
0.673507154f,-0.953050017f,0.727198064f,0.0297537707f,0.996542096f,-0.941101313f,-0.380017966f,0.451337039f,
0.813878477f,0.939834237f,0.980841517f,0.993928254f,0.998078644f,0.999392271f,0.999807835f,0.999939203f,
0.985896587f,-0.644837022f,0.477671444f,0.206098333f,0.999858618f,-0.920609534f,-0.409073502f,0.435397953f,
0.808027506f,0.937898219f,0.980220556f,0.993731022f,0.998016179f,0.999372482f,0.999801576f,0.999937236f,
};
__device__ const float ROPE_SIN[1024] = {
0.f,0.f,0.f,0.f,0.f,0.f,0.f,0.f,
0.f,0.f,0.f,0.f,0.f,0.f,0.f,0.f,
0.841470957f,0.533168435f,0.310983598f,0.176892191f,0.0998334214f,0.0562044978f,0.0316175036f,0.0177818574f,
0.00999983307f,0.00562338345f,0.00316227227f,0.0017782785f,0.000999999931f,0.000562341243f,0.000316227757f,0.00017782794f,
0.909297407f,0.902130723f,0.591127098f,0.348205268f,0.198669329f,0.112231314f,0.0632033944f,0.0355580896f,
0.0199986659f,0.011246589f,0.00632451288f,0.00355655141f,0.0019999987f,0.00112468237f,0.000632455456f,0.00035565588f,
0.141120002f,0.993253171f,0.812648892f,0.5085361f,0.295520216f,0.167903304f,0.0947260857f,0.0533230826f,
0.0299954992f,0.0168694388f,0.00948669016f,0.00533481315f,0.0029999956f,0.00168702309f,0.000948683126f,0.000533483806f,
-0.756802499f,0.778471708f,0.953580737f,0.652827978f,0.389418334f,0.223044485f,0.126154065f,0.0710712075f,
0.0399893336f,0.0224917568f,0.0126487734f,0.00711305765f,0.00399998948f,0.00224936334f,0.00126491068f,0.000711311703f,
-0.958924294f,0.32393527f,0.999946535f,0.776529968f,0.47942555f,0.277480543f,0.157455876f,0.0887968615f,
0.0499791652f,0.0281133614f,0.0158107281f,0.00889127981f,0.0049999794f,0.0028117029f,0.00158113812f,0.000889139599f,
-0.279415488f,-0.230367512f,0.947148204f,0.875740528f,0.564642489f,0.33103931f,0.188600272f,0.106494442f,
0.0599640049f,0.0337340795f,0.0189725272f,0.0106694745f,0.0059999642f,0.00337404152f,0.00189736532f,0.00106696738f,
0.656986594f,-0.713721275f,0.800421596f,0.947330713f,0.64421767f,0.383551568f,0.219556093f,0.124158338f,
0.0699428469f,0.0393537246f,0.0221341345f,0.0124476347f,0.00699994294f,0.00393637875f,0.00221359241f,0.00124479528f,
0.989358246f,-0.977261782f,0.574317753f,0.989042461f,0.717356086f,0.434851229f,0.250292331f,0.141782969f,
0.0799146891f,0.0449721329f,0.0252955221f,0.0142257558f,0.0079999147f,0.00449871505f,0.00252981926f,0.00142262306f,
0.412118495f,-0.939823508f,0.291259229f,0.999560297f,0.783326924f,0.484776139f,0.280778319f,0.159362778f,
0.0898785442f,0.0505891182f,0.0284566563f,0.0160038304f,0.00899987947f,0.00506105041f,0.00284604589f,0.00160045072f,
-0.54402113f,-0.612936914f,-0.0206835698f,0.978552461f,0.841470957f,0.533168435f,0.310983568f,0.176892191f,
0.099833414f,0.0562044978f,0.0316175036f,0.0177818574f,0.009999834f,0.00562338345f,0.00316227227f,0.0017782785f,
-0.999990225f,-0.0972764567f,-0.33057496f,0.926681578f,0.891207397f,0.579875171f,0.340877861f,0.19436565f,
0.1097783f,0.0618181042f,0.0347780399f,0.0195598267f,0.0109997792f,0.00618571462f,0.00347849843f,0.00195610616f,
-0.536572933f,0.448342979f,-0.60768342f,0.845583618f,0.932039082f,0.624748647f,0.370431304f,0.211777672f,
0.119712204f,0.0674297586f,0.0379382223f,0.0213377345f,0.0119997123f,0.0067480444f,0.00379472389f,0.00213393359f,
0.420167029f,0.855880976f,-0.824528456f,0.737816215f,0.963558197f,0.667647004f,0.399614304f,0.229122713f,
0.129634142f,0.0730392784f,0.0410980321f,0.0231155735f,0.0129996343f,0.00731037185f,0.00411094911f,0.00231176103f,
0.990607381f,0.999823332f,-0.959605396f,0.606778562f,0.985449731f,0.708434701f,0.428397775f,0.246395305f,
0.139543116f,0.078646481f,0.0442574248f,0.0248933397f,0.0139995432f,0.00787269697f,0.00442717411f,0.00248958869f,
0.650287867f,0.835838437f,-0.999518692f,0.456603259f,0.997494996f,0.746982634f,0.456752867f,0.263589978f,
0.149438128f,0.0842512026f,0.0474163815f,0.0266710296f,0.0149994381f,0.00843502022f,0.00474339863f,0.00266741589f,
-0.287903309f,0.414430231f,-0.940310359f,0.292027086f,0.999573588f,0.783169091f,0.484651238f,0.280701309f,
0.159318209f,0.0898532644f,0.0505748577f,0.028448632f,0.015999319f,0.00899733976f,0.00505962269f,0.00284524332f,
-0.961397469f,-0.134615138f,-0.78785187f,0.11824052f,0.991664827f,0.81687957f,0.512064993f,0.29772386f,
0.169182345f,0.09545248f,0.0537328273f,0.0302261449f,0.0169991814f,0.00955965649f,0.00537584582f,0.00302307028f,
-0.750987232f,-0.642200708f,-0.557262897f,-0.0592755191f,0.973847628f,0.84800756f,0.538966715f,0.314652264f,
0.179029569f,0.101048686f,0.0568902642f,0.0320035629f,0.0179990288f,0.0101219704f,0.00569206895f,0.00320089748f,
0.149877205f,-0.952000856f,-0.271410108f,-0.234921798f,0.946300089f,0.876454532f,0.565329552f,0.331481189f,
0.188858896f,0.10664168f,0.060047131f,0.0337808803f,0.0189988576f,0.0106842816f,0.00600829115f,0.00337872445f,
0.912945271f,-0.968601942f,0.0413582884f,-0.403158993f,0.909297407f,0.902130723f,0.591127038f,0.348205268f,
0.198669314f,0.112231314f,0.0632033944f,0.0355580896f,0.0199986678f,0.011246589f,0.00632451288f,0.00355655141f,
0.836655617f,-0.686891198f,0.35002476f,-0.558680534f,0.863209307f,0.924954832f,0.616333544f,0.364819258f,
0.208459899f,0.117817394f,0.0663590282f,0.0373351872f,0.0209984574f,0.0118088927f,0.00664073415f,0.00373437814f,
-0.00885130931f,-0.193630233f,0.623979926f,-0.696581721f,0.808496356f,0.944854796f,0.640923738f,0.381317884f,
0.218229622f,0.123399742f,0.0695140064f,0.0391121693f,0.0219982266f,0.0123711927f,0.00695695449f,0.00391220488f,
-0.846220434f,0.359264523f,0.836055279f,-0.812512875f,0.745705247f,0.961767614f,0.664873064f,0.397695929f,
0.227977514f,0.128978193f,0.0726682767f,0.0408890247f,0.0229979735f,0.0129334899f,0.00727317436f,0.00409003161f,
-0.905578375f,0.801513135f,0.965219259f,-0.902817786f,0.67546314f,0.97563988f,0.688157499f,0.413948208f,
0.237702623f,0.134552568f,0.0758218244f,0.0426657498f,0.0239976961f,0.0134957815f,0.0075893933f,0.00426785741f,
-0.132351756f,0.996909976f,0.998663187f,-0.964648306f,0.598472118f,0.986427724f,0.710753918f,0.430069596f,
0.247403964f,0.140122697f,0.0789746121f,0.0444423407f,0.0249973964f,0.0140580693f,0.00790561177f,0.00444568414f,
0.76255846f,0.885276794f,0.933070183f,-0.996054351f,0.515501261f,0.994096994f,0.732639611f,0.446054995f,
0.257080555f,0.145688385f,0.0821266174f,0.0462187938f,0.0259970706f,0.0146203535f,0.00822182931f,0.00462350994f,
0.956375957f,0.500994205f,0.774945021f,-0.996045172f,0.427379847f,0.99862349f,0.753792703f,0.46189931f,
0.266731411f,0.151249468f,0.0852777958f,0.0479951017f,0.0269967206f,0.015182632f,0.00853804592f,0.00480133574f,
0.270905793f,-0.0375856608f,0.539968967f,-0.964621305f,0.334988207f,0.999992907f,0.774192095f,0.477597594f,
0.276355654f,0.156805754f,0.0884281173f,0.049771253f,0.0279963426f,0.0157449059f,0.0088542616f,0.00497916201f,
-0.663633883f,-0.564589798f,0.251445323f,-0.902773678f,0.239249229f,0.998200953f,0.793817401f,0.49314484f,
0.28595221f,0.162357092f,0.0915775672f,0.0515472479f,0.0289959367f,0.0163071752f,0.00917047635f,0.00515698735f,
-0.988031626f,-0.917709649f,-0.0620148405f,-0.812452853f,0.141120002f,0.993253171f,0.812648892f,0.5085361f,
0.295520186f,0.167903304f,0.0947260931f,0.0533230826f,0.029995501f,0.0168694388f,0.00948669016f,0.00533481315f,
-0.404037654f,-0.988192797f,-0.369325012f,-0.696507812f,0.0415805206f,0.985165298f,0.830667794f,0.523766637f,
0.305058628f,0.173444211f,0.0978736654f,0.055098746f,0.0309950355f,0.0174316969f,0.00980290305f,0.00551263802f,
0.551426709f,-0.754330218f,-0.640009403f,-0.5585953f,-0.0583741926f,0.973962843f,0.847856104f,0.538831532f,
0.314566553f,0.17897962f,0.101020269f,0.0568742342f,0.0319945402f,0.0179939512f,0.0101191159f,0.00569046335f,
0.999911845f,-0.28814739f,-0.847224355f,-0.403064936f,-0.157745644f,0.959681332f,0.864196658f,0.553726017f,
0.324043006f,0.184509367f,0.10416586f,0.0586495437f,0.0329940096f,0.0185561981f,0.010435327f,0.00586828869f,
0.529082716f,0.266779721f,-0.97042042f,-0.234822124f,-0.255541205f,0.942365825f,0.879673064f,0.568445385f,
0.333487093f,0.190033287f,0.107310407f,0.0604246669f,0.0339934528f,0.0191184394f,0.010751537f,0.00604611309f,
-0.428182662f,0.739542127f,-0.997380435f,-0.0591726787f,-0.350783229f,0.92207104f,0.894269884f,0.582984984f,
0.342897803f,0.195551202f,0.110453881f,0.0621996038f,0.034992855f,0.0196806751f,0.0110677453f,0.00622393796f,
-0.991778851f,0.984540582f,-0.925431013f,0.118342586f,-0.442520559f,0.89886117f,0.907972515f,0.597340286f,
0.352274209f,0.201062918f,0.113596253f,0.0639743358f,0.0359922275f,0.0202429052f,0.0113839535f,0.0064017619f,
-0.643538117f,0.926318109f,-0.761706948f,0.292125374f,-0.529836178f,0.872809589f,0.920767248f,0.611506701f,
0.361615449f,0.206568271f,0.116737492f,0.0657488778f,0.036991559f,0.0208051261f,0.0117001599f,0.0065795863f,
0.296368569f,0.58280617f,-0.522444785f,0.456694692f,-0.611857831f,0.84399873f,0.932641268f,0.625479698f,
0.370920479f,0.212067112f,0.119877554f,0.0675232038f,0.0379908569f,0.0213673431f,0.0120163653f,0.00675741071f,
0.963795364f,0.0598003156f,-0.231372014f,0.606860459f,-0.687766254f,0.81251961f,0.943582714f,0.639254928f,
0.380188406f,0.217559248f,0.123016424f,0.0692973137f,0.0389901139f,0.0219295528f,0.0123325698f,0.00693523418f,
0.745113134f,-0.481621295f,0.0826458037f,0.737885714f,-0.756802499f,0.778471708f,0.953580678f,0.652827978f,
0.389418334f,0.223044485f,0.126154065f,0.0710712075f,0.0399893373f,0.0224917568f,0.0126487734f,0.00711305765f,
-0.158622667f,-0.874714017f,0.388467699f,0.845638454f,-0.818277061f,0.74196279f,0.962625206f,0.666194677f,
0.39860931f,0.228522688f,0.129290432f,0.0728448778f,0.0409885161f,0.0230539497f,0.0129649751f,0.00729088066f,
-0.916521549f,-0.998410463f,0.655764699f,0.926720202f,-0.871575892f,0.703108132f,0.970707119f,0.679350674f,
0.407760441f,0.233993664f,0.132425532f,0.0746183172f,0.0419876575f,0.0236161388f,0.0132811759f,0.00746870413f,
-0.831774771f,-0.814614236f,0.858030677f,0.97857362f,-0.916166008f,0.662030637f,0.977818429f,0.692291796f,
0.416870773f,0.23945722f,0.135559291f,0.0763915181f,0.0429867506f,0.0241783205f,0.0135973748f,0.00764652714f,
0.0177019257f,-0.37993139f,0.975206196f,0.999563396f,-0.951602101f,0.618860185f,0.983951986f,0.70501405f,
0.425939471f,0.244913206f,0.138691694f,0.0781644881f,0.0439858064f,0.0247404929f,0.0139135728f,0.00782434922f,
0.850903511f,0.171763569f,0.995670974f,0.989027262f,-0.977530122f,0.57373327f,0.989101648f,0.717513323f,
0.434965521f,0.250361472f,0.141822711f,0.0799371973f,0.0449848175f,0.0253026579f,0.0142297689f,0.00800217129f,
0.901788354f,0.670557022f,0.917395473f,0.947297752f,-0.993690968f,0.526792526f,0.993262351f,0.72978574f,
0.44394809f,0.255801797f,0.144952312f,0.0817096606f,0.0459837839f,0.0258648153f,0.0145459641f,0.0081799943f,
0.123573124f,0.962832689f,0.748142362f,0.875690997f,-0.999923289f,0.478186339f,0.996429801f,0.741827428f,
0.452886283f,0.261234075f,0.148080453f,0.0834818557f,0.0469827019f,0.0264269635f,0.0148621574f,0.00835781638f,
-0.768254638f,0.958573103f,0.504697084f,0.776465356f,-0.99616462f,0.428068399f,0.99860096f,0.753634512f,
0.461779177f,0.266658038f,0.151207119f,0.0852537975f,0.0479815714f,0.0269891042f,0.0151783489f,0.00853563752f,
-0.953752637f,0.659090102f,0.211200655f,0.652750373f,-0.982452571f,0.376597136f,0.999773562f,0.765203178f,
0.470625877f,0.272073567f,0.15433228f,0.087025471f,0.0489803962f,0.0275512375f,0.0154945394f,0.0087134596f,
-0.262374848f,0.156619072f,-0.10324046f,0.508447945f,-0.958924294f,0.32393527f,0.999946535f,0.776529968f,
0.47942555f,0.277480543f,0.157455891f,0.0887968615f,0.0499791689f,0.0281133596f,0.0158107281f,0.00889127981f,
0.670229197f,-0.394086063f,-0.407444149f,0.3481085f,-0.925814748f,0.270249337f,0.99911958f,0.787611187f,
0.48817724f,0.282878697f,0.160577938f,0.0905679762f,0.0509778969f,0.0286754742f,0.0161269177f,0.00906910095f,
0.986627579f,-0.823421597f,-0.671240151f,0.176790684f,-0.883454502f,0.215709001f,0.997293651f,0.798443377f,
0.496880114f,0.28826794f,0.163698375f,0.0923388004f,0.051976569f,0.0292375814f,0.0164431017f,0.00924692024f,
0.395925164f,-0.999157965f,-0.868469954f,-0.000103020677f,-0.832267344f,0.160486728f,0.994470477f,0.809023023f,
0.505533338f,0.293648034f,0.166817173f,0.0941093415f,0.0529751927f,0.0297996756f,0.0167592876f,0.00942474138f,
-0.558789074f,-0.867171526f,-0.979574919f,-0.176993474f,-0.772764444f,0.104756832f,0.990652919f,0.819346905f,
0.514135957f,0.29901889f,0.169934288f,0.0958795771f,0.0539737605f,0.0303617641f,0.0170754679f,0.00960256159f,
-0.999755144f,-0.468111664f,-0.993535519f,-0.348301649f,-0.705540299f,0.0486960001f,0.985844791f,0.829411685f,
0.522687256f,0.304380238f,0.173049718f,0.0976495072f,0.0549722798f,0.0309238415f,0.01739165f,0.00978038087f,
-0.521551013f,0.0751182064f,-0.908967435f,-0.508624554f,-0.631266713f,-0.00751878507f,0.980050862f,0.839214146f,
0.531186223f,0.30973196f,0.17616342f,0.0994191393f,0.0559707358f,0.0314859077f,0.0177078284f,0.00995820016f,
0.436164767f,0.595211506f,-0.734258294f,-0.652905703f,-0.550685287f,-0.0637097955f,0.973276973f,0.848751247f,
0.539632022f,0.315073937f,0.179275364f,0.101188451f,0.0569691435f,0.0320479684f,0.0180240069f,0.0101360194f,
0.992872655f,0.931992829f,-0.486733496f,-0.776594579f,-0.464602023f,-0.119699396f,0.965529919f,0.858020008f,
0.548023939f,0.3204059f,0.182385504f,0.102957435f,0.0579674877f,0.0326100141f,0.0183401816f,0.0103138378f,
0.636738002f,0.981735826f,-0.190938011f,-0.87579f,-0.373876572f,-0.175310582f,0.956817448f,0.867017388f,
0.55636102f,0.325727791f,0.185493827f,0.104726106f,0.0589657798f,0.0331720486f,0.0186563563f,0.0104916561f,
-0.304810613f,0.729123712f,0.12379095f,-0.947363734f,-0.279415488f,-0.230367512f,0.947148204f,0.875740528f,
0.564642429f,0.33103931f,0.188600287f,0.106494442f,0.0599640086f,0.0337340795f,0.0189725272f,0.0106694745f,
-0.966117799f,0.251952261f,0.426245421f,-0.98905772f,-0.182162598f,-0.284696162f,0.936531842f,0.884186864f,
0.572867453f,0.336340427f,0.191704854f,0.108262435f,0.0609621815f,0.0342960916f,0.0192886982f,0.0108472919f,
-0.739180684f,-0.302812874f,0.686427653f,-0.999557257f,-0.0830891207f,-0.338124752f,0.924979091f,0.892353535f,
0.581035137f,0.341630876f,0.194807529f,0.110030092f,0.0619602874f,0.0348580964f,0.0196048655f,0.0110251084f,
0.167355701f,-0.764320076f,0.878538549f,-0.978531301f,0.0168140903f,-0.390484393f,0.912501454f,0.900238097f,
0.589144766f,0.346910536f,0.197908238f,0.111797392f,0.0629583374f,0.0354200937f,0.0199210308f,0.0112029258f,
};
#define XB_TMO      128
#define XB_XCNT(j)  (256  + 64 * (j))
#define XB_XSUB(j)  (1280 + 64 * (j))
#define XB_XGEN(j)  (2304 + 64 * (j))
#define XB_TOP      3328
#define XB_TOPGEN   3392
#define XCD_BAR_WORDS 3456
#define XB_SPIN_CAP (1u << 18)
#define LAS __attribute__((address_space(3)))

__device__ __forceinline__ unsigned xb_ld(unsigned* p)              { return __hip_atomic_load(p, __ATOMIC_RELAXED, __HIP_MEMORY_SCOPE_AGENT); }
__device__ __forceinline__ unsigned xb_add(unsigned* p, unsigned v) { return __hip_atomic_fetch_add(p, v, __ATOMIC_RELAXED, __HIP_MEMORY_SCOPE_AGENT); }
__device__ __forceinline__ unsigned xb_xcc_id() { return (unsigned)__builtin_amdgcn_s_getreg((3 << 11) | 20) & 0xFu; }
#define XB_SPIN(cond, bar) do { unsigned _sp = 0; while (cond) { __builtin_amdgcn_s_sleep(1); \
    if ((++_sp & 255u) == 0u) { if (xb_ld(&(bar)[XB_TMO])) break; if (_sp > XB_SPIN_CAP) { atomicAdd(&(bar)[XB_TMO], 1u); break; } } } } while (0)

struct XcdBarrier {
    unsigned* bar; unsigned x;
    volatile LAS unsigned* st;
};

__device__ __forceinline__ XcdBarrier xcd_barrier_post(unsigned* bar, volatile LAS unsigned* st) {
    XcdBarrier b; b.bar = bar; b.x = xb_xcc_id(); b.st = st;
    if (threadIdx.x == 0) (void)xb_add(&bar[XB_XCNT(b.x)], 1u);
    return b;
}
__device__ __forceinline__ void xcd_barrier_complete(unsigned* bar, unsigned x, unsigned& nloc, unsigned& nx) {
    const unsigned G = gridDim.x * gridDim.y * gridDim.z;
    unsigned sum, cnt, mine, sp = 0u;
    for (;;) {
        sum = 0u; cnt = 0u; mine = 0u;
#pragma unroll
        for (unsigned j = 0; j < 16; ++j) { const unsigned c = xb_ld(&bar[XB_XCNT(j)]); sum += c; cnt += (c > 0u) ? 1u : 0u; mine = (j == x) ? c : mine; }
        if (sum == G) break;
        __builtin_amdgcn_s_sleep(1);
        if ((++sp & 255u) == 0u) { if (xb_ld(&bar[XB_TMO])) break; if (sp > XB_SPIN_CAP) { atomicAdd(&bar[XB_TMO], 1u); break; } }
    }
    nloc = mine > 0u ? mine : 1u; nx = cnt > 0u ? cnt : 1u;
}

__device__ __forceinline__ void xcd_barrier(const XcdBarrier& b) {
    asm volatile("s_waitcnt vmcnt(0)" ::: "memory");
    __syncthreads();
    if (threadIdx.x == 0) {
        unsigned* bar = b.bar;
        __builtin_amdgcn_s_waitcnt(0);
        unsigned nloc = b.st[0], nx = b.st[1];
        if (nloc == 0u) { xcd_barrier_complete(bar, b.x, nloc, nx); b.st[0] = nloc; b.st[1] = nx; }
        const unsigned old = xb_add(&bar[XB_XSUB(b.x)], 1u);
        const unsigned gen = old / nloc;
        if (old + 1u == (gen + 1u) * nloc) {
            __builtin_amdgcn_fence(__ATOMIC_RELEASE, "agent");
            asm volatile("s_waitcnt vmcnt(0)" ::: "memory");
            const unsigned og = xb_add(&bar[XB_TOP], 1u);
            const unsigned tg = og / nx;
            if (og + 1u == (tg + 1u) * nx) xb_add(&bar[XB_TOPGEN], 1u);
            else XB_SPIN(xb_ld(&bar[XB_TOPGEN]) == tg, bar);
            __builtin_amdgcn_fence(__ATOMIC_ACQUIRE, "agent");
            xb_add(&bar[XB_XGEN(b.x)], 1u);
            asm volatile("s_waitcnt vmcnt(0)" ::: "memory");
        } else {
            XB_SPIN(xb_ld(&bar[XB_XGEN(b.x)]) == gen, bar);
            __builtin_amdgcn_fence(__ATOMIC_ACQUIRE, "agent");
            asm volatile("s_waitcnt vmcnt(0)" ::: "memory");
        }
    }
    __syncthreads();
}

namespace pg8 {
#define PG8_LAS __attribute__((address_space(3)))
typedef unsigned short bf16_t;
typedef short bf16x8 __attribute__((ext_vector_type(8)));
typedef float f32x4 __attribute__((ext_vector_type(4)));
typedef unsigned u32x4 __attribute__((ext_vector_type(4)));
constexpr int BM = 256, BK = 64, HALF = 128, HTB = HALF * BK * 2  , STAGE_BYTES = 8 * HTB, NXCD = 8, WGM = 8;

__host__ __device__ __forceinline__ int lds_byte(int r, int c) { const int st = (r >> 4) * 2 + (c >> 5), rr = r & 15, cc = c & 31, ob = rr * 64 + cc * 2; return st * 1024 + (ob ^ (((ob >> 9) & 1) << 5)); }
__host__ __device__ __forceinline__ void stage_rc(int b, int& R, int& C) { const int st = b / 1024, sb = b % 1024, swz = sb ^ (((sb >> 9) & 1) << 5); R = (st >> 1) * 16 + swz / 64; C = (st & 1) * 32 + (swz % 64) / 2; }
__host__ __device__ __forceinline__ int perm32(int rho) { const int n = rho >> 4, i = rho & 15; return 8 * (i >> 2) + 4 * n + (i & 3); }

struct Unit { int pm, pn; };
struct Gemm { const bf16_t* A; const bf16_t* Bt; int M, N, K; };

struct StaticOrder {
    int nM, nN, nwg, G, c;
    __host__ __device__ void init(int M, int N, int G_, int c_) { nM = M / BM; nN = N / BM; nwg = nM * nN; G = G_; c = c_; }
    __host__ __device__ bool next(int i, Unit& u) const {
        const long L = (long)i * G + c; if (L >= nwg) return false;
        int wgid = (int)L; { const int q = nwg / NXCD, r = nwg % NXCD, xcd = wgid % NXCD, off = wgid / NXCD; wgid = (xcd < r ? xcd * (q + 1) : r * (q + 1) + (xcd - r) * q) + off; }
        const int nig = WGM * nN, gid = wgid / nig, fm = gid * WGM, gsz = (nM - fm) < WGM ? (nM - fm) : WGM;
        u.pm = fm + ((wgid % nig) % gsz); u.pn = (wgid % nig) / gsz; return true;
    }
    __device__ __forceinline__ void a_ready(const Unit&) const {}
    __device__ __forceinline__ void done(const Unit&) const {}
};
template <class Epi, class Sched, bool ALIGN_EPI = false, bool SP2 = false>
__device__ __forceinline__ void gemm_phase(PG8_LAS unsigned char* lds, const Gemm g, const Sched& S, const Epi& E) {
    int tid = threadIdx.x; asm volatile("" : "+v"(tid)); const int wid = __builtin_amdgcn_readfirstlane(tid >> 6), lane = tid & 63, wr = wid >> 2, wc = wid & 3, fr = lane & 15, fq = lane >> 4;
    const int K = g.K, nt = K / BK;
    unsigned voffA[2], voffB[2];
#pragma unroll
    for (int i = 0; i < 2; ++i) { int R, C; stage_rc(tid * 16 + i * 8192, R, C); const int Rb = (R >> 5) * 64 + perm32(R & 31);
        voffA[i] = (unsigned)(R * K + C) * 2u; voffB[i] = (unsigned)(Rb * K + C) * 2u; }
    const size_t kstep = (size_t)(BK * 2);
    const size_t hstep = (size_t)HALF * K * 2; const size_t bhstep = (size_t)32 * K * 2;
    const size_t tstep = 2 * hstep;
    const unsigned ldsw = (unsigned)wid * 1024u;
    const int aoff = lds_byte(wr * 64 + fr, fq * 8), boff = lds_byte(wc * 32 + fr, fq * 8);
#define PG8_SA(b, h) (((b) * 2 + (h)) * HTB)
#define PG8_SB(b, h) ((4 + (b) * 2 + (h)) * HTB)
#define PG8_STAGE(bufoff, gbase, voff) do { _Pragma("unroll") for (int _i = 0; _i < 2; ++_i) \
        __builtin_amdgcn_global_load_lds((const unsigned*)((const char*)(gbase) + (voff)[_i]), (PG8_LAS unsigned*)(lds + (bufoff) + ldsw + _i * 8192), 16, 0, 0); } while (0)
#define PG8_LDA(dst, b, h) do { _Pragma("unroll") for (int m = 0; m < 4; ++m) _Pragma("unroll") for (int k = 0; k < 2; ++k) dst[m][k] = *(const PG8_LAS bf16x8*)(lds + PG8_SA(b, h) + aoff + m * 2048 + k * 1024); } while (0)
#define PG8_LDB(dst, b, h) do { _Pragma("unroll") for (int n = 0; n < 2; ++n) _Pragma("unroll") for (int k = 0; k < 2; ++k) dst[n][k] = *(const PG8_LAS bf16x8*)(lds + PG8_SB(b, h) + boff + n * 2048 + k * 1024); } while (0)
#define PG8_MMA(ai, bj, At, Bt) do { __builtin_amdgcn_s_setprio(1); _Pragma("unroll") for (int m = 0; m < 4; ++m) _Pragma("unroll") for (int n = 0; n < 2; ++n) _Pragma("unroll") for (int k = 0; k < 2; ++k) \
        acc[ai][bj][m][n] = __builtin_amdgcn_mfma_f32_16x16x32_bf16(Bt[n][k], At[m][k], acc[ai][bj][m][n], 0, 0, 0); __builtin_amdgcn_s_setprio(0); } while (0)
#define PG8_WAIT_V(n) asm volatile("s_waitcnt vmcnt(" #n ")" ::: "memory")
#define PG8_WAIT_L(n) asm volatile("s_waitcnt lgkmcnt(" #n ")" ::: "memory")
#define PG8_BAR __builtin_amdgcn_s_barrier()
#define PG8_SCHED __builtin_amdgcn_sched_barrier(0)
    Unit cur, nxt; int ui = 0;
    if (!S.next(0, cur)) return;
    f32x4 acc[2][2][4][2];
#pragma unroll
    for (int a = 0; a < 2; ++a)
#pragma unroll
        for (int b = 0; b < 2; ++b)
#pragma unroll
            for (int m = 0; m < 4; ++m)
#pragma unroll
                for (int n = 0; n < 2; ++n) acc[a][b][m][n] = (f32x4){0.f, 0.f, 0.f, 0.f};
    bf16x8 At[4][2], B0[2][2], B1[2][2];
    const char* cA = (const char*)g.A + (size_t)cur.pm * tstep; const char* cB = (const char*)g.Bt + (size_t)cur.pn * tstep;
    S.a_ready(cur);
    if constexpr (SP2) {
        PG8_STAGE(PG8_SB(0, 0), cB, voffB); PG8_STAGE(PG8_SB(0, 1), cB + bhstep, voffB); PG8_STAGE(PG8_SA(0, 0), cA, voffA); PG8_STAGE(PG8_SA(0, 1), cA + hstep, voffA);
        if (wr == 1) PG8_BAR;
        PG8_WAIT_V(2); PG8_BAR;
        PG8_STAGE(PG8_SB(1, 0), cB + kstep, voffB); PG8_STAGE(PG8_SA(1, 0), cA + kstep, voffA); PG8_STAGE(PG8_SB(1, 1), cB + bhstep + kstep, voffB);
        PG8_WAIT_V(6); PG8_BAR;
    } else {
        PG8_STAGE(PG8_SB(0, 0), cB, voffB); PG8_STAGE(PG8_SA(0, 0), cA, voffA); PG8_STAGE(PG8_SB(0, 1), cB + bhstep, voffB); PG8_STAGE(PG8_SA(0, 1), cA + hstep, voffA);
        if (wr == 1) PG8_BAR;
        PG8_WAIT_V(4); PG8_BAR;
        PG8_STAGE(PG8_SB(1, 0), cB + kstep, voffB); PG8_STAGE(PG8_SA(1, 0), cA + kstep, voffA); PG8_STAGE(PG8_SB(1, 1), cB + bhstep + kstep, voffB);
        PG8_WAIT_V(6); PG8_BAR;
    }
    for (;;) {
        const bool has_next = S.next(ui + 1, nxt);
        const char* nA = has_next ? (const char*)g.A + (size_t)nxt.pm * tstep : cA; const char* nB = has_next ? (const char*)g.Bt + (size_t)nxt.pn * tstep : cB;
        for (int t = 0; t < nt; t += 2) {
            const bool last = (t == nt - 2);
            const char* a1 = cA + (size_t)(t + 1) * kstep;
            const char* a2 = last ? nA : cA + (size_t)(t + 2) * kstep; const char* b2 = last ? nB : cB + (size_t)(t + 2) * kstep;
            const char* a3 = a2 + kstep; const char* b3 = b2 + kstep;
            if (last && has_next) S.a_ready(nxt);
            if constexpr (SP2) {
            PG8_LDB(B0, 0, 0); PG8_LDB(B1, 0, 1); PG8_SCHED; PG8_LDA(At, 0, 0); PG8_STAGE(PG8_SA(1, 1), a1 + hstep, voffA);
            PG8_WAIT_V(8); PG8_WAIT_L(0); PG8_BAR; PG8_MMA(0, 0, At, B0); PG8_MMA(0, 1, At, B1); PG8_BAR; PG8_SCHED;
            PG8_LDA(At, 0, 1); PG8_STAGE(PG8_SB(0, 0), b2, voffB); PG8_STAGE(PG8_SB(0, 1), b2 + bhstep, voffB); PG8_STAGE(PG8_SA(0, 0), a2, voffA);
            PG8_WAIT_V(8); PG8_WAIT_L(0); PG8_BAR; PG8_MMA(1, 0, At, B0); PG8_MMA(1, 1, At, B1); PG8_BAR; PG8_SCHED;
            PG8_LDB(B0, 1, 0); PG8_LDB(B1, 1, 1); PG8_SCHED; PG8_LDA(At, 1, 0); PG8_STAGE(PG8_SA(0, 1), a2 + hstep, voffA);
            PG8_WAIT_V(8); PG8_WAIT_L(0); PG8_BAR; PG8_MMA(0, 0, At, B0); PG8_MMA(0, 1, At, B1); PG8_BAR; PG8_SCHED;
            PG8_LDA(At, 1, 1); PG8_STAGE(PG8_SB(1, 0), b3, voffB); PG8_STAGE(PG8_SB(1, 1), b3 + bhstep, voffB); PG8_STAGE(PG8_SA(1, 0), a3, voffA);
            PG8_WAIT_V(8); PG8_WAIT_L(0); PG8_BAR; PG8_MMA(1, 0, At, B0); PG8_MMA(1, 1, At, B1); PG8_BAR; PG8_SCHED;
            } else {
            PG8_LDB(B0, 0, 0); PG8_SCHED; PG8_LDA(At, 0, 0); PG8_STAGE(PG8_SA(1, 1), a1 + hstep, voffA);
            PG8_WAIT_L(8); PG8_BAR; PG8_WAIT_L(0); PG8_MMA(0, 0, At, B0); PG8_BAR; PG8_SCHED;
            PG8_LDB(B1, 0, 1); PG8_STAGE(PG8_SB(0, 0), b2, voffB);
            PG8_BAR; PG8_WAIT_L(0); PG8_MMA(0, 1, At, B1); PG8_BAR;
            PG8_LDA(At, 0, 1); PG8_STAGE(PG8_SA(0, 0), a2, voffA);
            PG8_BAR; PG8_WAIT_L(0); PG8_MMA(1, 0, At, B0); PG8_BAR; PG8_SCHED;
            PG8_STAGE(PG8_SB(0, 1), b2 + bhstep, voffB);
            PG8_WAIT_V(6); PG8_BAR; PG8_MMA(1, 1, At, B1); PG8_BAR;
            PG8_LDB(B0, 1, 0); PG8_SCHED; PG8_LDA(At, 1, 0); PG8_STAGE(PG8_SA(0, 1), a2 + hstep, voffA);
            PG8_WAIT_L(8); PG8_BAR; PG8_WAIT_L(0); PG8_MMA(0, 0, At, B0); PG8_BAR; PG8_SCHED;
            PG8_LDB(B1, 1, 1); PG8_STAGE(PG8_SB(1, 0), b3, voffB);
            PG8_BAR; PG8_WAIT_L(0); PG8_MMA(0, 1, At, B1); PG8_BAR;
            PG8_LDA(At, 1, 1); PG8_STAGE(PG8_SA(1, 0), a3, voffA);
            PG8_BAR; PG8_WAIT_L(0); PG8_MMA(1, 0, At, B0); PG8_BAR; PG8_SCHED;
            PG8_STAGE(PG8_SB(1, 1), b3 + bhstep, voffB);
            PG8_WAIT_V(6); PG8_BAR; PG8_MMA(1, 1, At, B1); PG8_BAR;
            }
        }
        if constexpr (ALIGN_EPI) { if (wr == 0) PG8_BAR; }
        if constexpr (!Epi::AFTER_DRAIN) { E(acc, cur, wr, wc, fr, fq); S.done(cur); }
        if (!has_next) break;
#pragma unroll
        for (int a = 0; a < 2; ++a)
#pragma unroll
            for (int b = 0; b < 2; ++b)
#pragma unroll
                for (int m = 0; m < 4; ++m)
#pragma unroll
                    for (int n = 0; n < 2; ++n) acc[a][b][m][n] = (f32x4){0.f, 0.f, 0.f, 0.f};
        cur = nxt; cA = nA; cB = nB; ++ui;
        if constexpr (ALIGN_EPI) { if (wr == 1) PG8_BAR; }
    }
    PG8_WAIT_V(0);
    if constexpr (!ALIGN_EPI) { if (wr == 0) PG8_BAR; }
    PG8_BAR;
    if constexpr (Epi::AFTER_DRAIN) { E.fused(acc, cur, wr, wc, fr, fq, lds, wid, lane); S.done(cur); }
#undef PG8_SA
#undef PG8_SB
#undef PG8_STAGE
#undef PG8_LDA
#undef PG8_LDB
#undef PG8_MMA
#undef PG8_WAIT_V
#undef PG8_WAIT_L
#undef PG8_BAR
#undef PG8_SCHED
}
}

#ifndef PG8_SP2
#define PG8_SP2 true
#endif
#ifndef PG8_ALIGN
#define PG8_ALIGN true
#endif
#ifndef PROBE_B
#define PROBE_B 0
#endif
#ifndef LN_UR
#define LN_UR 2
#endif
#ifndef LN_NR
#define LN_NR 2
#endif
#ifndef FUSE_LN
#define FUSE_LN 0
#endif
#ifndef NT_STORE
#define NT_STORE 0
#endif
#ifndef PROBE_T
#define PROBE_T 0
#endif
#ifndef PROBE_MUL
#define PROBE_MUL 1
#endif
#ifndef SGB_R
#define SGB_R 24
#endif
#ifndef ATT_PIPE
#define ATT_PIPE 0
#endif
#ifndef GQA2
#define GQA2 1
#endif
#ifndef SGB_N
#define SGB_N 0
#endif
#ifndef SGB_V
#define SGB_V 14
#endif
#ifndef PROBE_X
#define PROBE_X 0
#endif
#ifndef PROBE_SYNC
#define PROBE_SYNC 0
#endif

constexpr int TP = 8192;
constexpr int TS = 32768;
constexpr int TT = TP + TS;
constexpr int DM = 1024;
constexpr int NIN = 3072;
constexpr int NLAYER = 4;
constexpr float ALPHA = 1.6817928305074292f;
constexpr float LOG2E = 1.4426950408889634f;
constexpr float C1 = 0.125f * LOG2E;
constexpr size_t OUT_NK = (size_t)TT * DM;
constexpr size_t OUT_NV = OUT_NK + (size_t)32 * 4 * 256 * 256;
constexpr size_t OUT_GK = OUT_NV + (size_t)32 * 4 * 256 * 256;
constexpr size_t OUT_GV = OUT_GK + (size_t)32 * 4 * 256 * 128;

struct Params {
  const float *x_prompt, *x_sample, *c, *cnk, *cnv, *cgk, *cgv, *c_ctx, *w_mod, *b_mod, *w_in, *b_in, *pool_w, *pool_scale,
      *nat_bias, *q_norm, *k_norm, *conv_w, *conv_b, *conv_ln_g, *conv_ln_b, *conv_pw, *w_out, *b_out, *ln_g, *ln_b;
  float* out;
  char* ws;
  int ph0, ph1;
};
constexpr size_t WS_WINT = 0;
constexpr size_t WS_WOUTT = WS_WINT + (size_t)4 * 3072 * 1024 * 2;
constexpr size_t WS_PWT = WS_WOUTT + (size_t)4 * 1024 * 1024 * 2;
constexpr size_t WS_POOLT = WS_PWT + (size_t)4 * 256 * 256 * 2;
constexpr size_t WS_CNK = WS_POOLT + (size_t)16 * 4096 * 2;
constexpr size_t WS_CNV = WS_CNK + (size_t)4194304 * 2;
constexpr size_t WS_CGK = WS_CNV + (size_t)4194304 * 2;
constexpr size_t WS_CGV = WS_CGK + (size_t)2097152 * 2;
constexpr size_t WS_U = WS_CGV + (size_t)2097152 * 2;
constexpr size_t WS_H = WS_U + (size_t)TT * NIN * 2;
constexpr size_t WS_MX = WS_H;
constexpr size_t WS_MOD = WS_MX + (size_t)TT * DM * 2;
constexpr size_t WS_STATS = WS_MOD + (size_t)4 * 9 * 3072 * 4;
constexpr size_t WS_CNT = WS_STATS + (size_t)TT * 2 * 4;
constexpr size_t WS_BAR = WS_CNT + 8192;
constexpr size_t WS_KN = WS_BAR + 16384;
constexpr size_t WS_VN = WS_KN + (size_t)4 * TT * 64 * 2;
constexpr size_t WS_KG = WS_VN + (size_t)4 * TT * 64 * 2;
constexpr size_t WS_VG = WS_KG + (size_t)2 * TT * 64 * 2;
constexpr size_t WS_PARAMS = WS_VG + (size_t)2 * TT * 64 * 2;
constexpr size_t WS_END = WS_PARAMS + 4096;
#define P_WinT ((bf16_t*)(p.ws + WS_WINT))
#define P_WoutT ((bf16_t*)(p.ws + WS_WOUTT))
#define P_pwT ((bf16_t*)(p.ws + WS_PWT))
#define P_poolT ((bf16_t*)(p.ws + WS_POOLT))
#define P_cnk_b ((bf16_t*)(p.ws + WS_CNK))
#define P_cnv_b ((bf16_t*)(p.ws + WS_CNV))
#define P_cgk_b ((bf16_t*)(p.ws + WS_CGK))
#define P_cgv_b ((bf16_t*)(p.ws + WS_CGV))
#define P_U ((bf16_t*)(p.ws + WS_U))
#define P_H ((bf16_t*)(p.ws + WS_H))
#define P_MX ((bf16_t*)(p.ws + WS_MX))
#define P_mod ((float*)(p.ws + WS_MOD))
#define P_stats ((float*)(p.ws + WS_STATS))
#define P_cnt ((unsigned*)(p.ws + WS_CNT))
#define P_bar ((unsigned*)(p.ws + WS_BAR))
#define P_KN ((bf16_t*)(p.ws + WS_KN))
#define P_VN ((bf16_t*)(p.ws + WS_VN))
#define P_KG ((bf16_t*)(p.ws + WS_KG))
#define P_VG ((bf16_t*)(p.ws + WS_VG))

DEV Params load_params(char* ws0) {
#if defined(__HIP_DEVICE_COMPILE__)
  typedef const __attribute__((address_space(4))) unsigned long long cu64;
  cu64* q = (cu64*)(ws0 + WS_PARAMS);
  asm volatile("" : "+s"(q));
  Params r;
  unsigned long long* d = (unsigned long long*)&r;
  static_assert(sizeof(Params) % 8 == 0, "Params is a whole number of 8-byte words");
#pragma unroll
  for (int i = 0; i < (int)(sizeof(Params) / 8); ++i) d[i] = q[i];
  return r;
#else
  return *(const Params*)(ws0 + WS_PARAMS);
#endif
}
DEV float bf2f(bf16_t h) { return __uint_as_float(((unsigned)h) << 16); }
DEV unsigned pk2(float lo, float hi) { f32x2 v = {lo, hi}; bf16x2_t b = __builtin_convertvector(v, bf16x2_t); return __builtin_bit_cast(unsigned, b); }
DEV bf16_t f2bf(float f) { return (bf16_t)(pk2(f, 0.f) & 0xffffu); }
DEV float bflo(unsigned w) { return __uint_as_float(w << 16); }
DEV float bfhi(unsigned w) { return __uint_as_float(w & 0xffff0000u); }
DEV float silu_f(float x) { return x * __builtin_amdgcn_rcpf(1.f + __expf(-x)); }
DEV float sigm_f(float x) { return __builtin_amdgcn_rcpf(1.f + __expf(-x)); }
DEV f32x4 mfma16(bf16x8 a, bf16x8 b, f32x4 c) { return __builtin_amdgcn_mfma_f32_16x16x32_bf16(a, b, c, 0, 0, 0); }
typedef short v4i16_t __attribute__((ext_vector_type(4)));
DEV s16x4 tr16(const char* p) {
  return __builtin_bit_cast(s16x4, __builtin_amdgcn_ds_read_tr16_b64_v4i16((__attribute__((address_space(3))) v4i16_t*)p));
}
DEV float xr16(float v, bool mx) {
  auto r = __builtin_amdgcn_permlane16_swap(__float_as_uint(v), __float_as_uint(v), false, false);
  const float a = __uint_as_float(r[0]), b = __uint_as_float(r[1]);
  return mx ? fmaxf(a, b) : a + b;
}
DEV float xr32(float v, bool mx) {
  auto r = __builtin_amdgcn_permlane32_swap(__float_as_uint(v), __float_as_uint(v), false, false);
  const float a = __uint_as_float(r[0]), b = __uint_as_float(r[1]);
  return mx ? fmaxf(a, b) : a + b;
}
DEV float wave_sum(float v) {
  v += __shfl_xor(v, 1); v += __shfl_xor(v, 2); v += __shfl_xor(v, 4); v += __shfl_xor(v, 8); v += __shfl_xor(v, 16); v += __shfl_xor(v, 32);
  return v;
}
DEV int get_tid() { int t = threadIdx.x & 255; asm volatile("" : "+v"(t)); return t; }
DEV int get_half() { return __builtin_amdgcn_readfirstlane((int)(threadIdx.x >> 8)); }
DEV int cond_of_row(int row) { return row < TP ? 0 : 1 + ((row - TP) >> 12); }

DEV void tconv_tile(const float* src, int sld, bf16_t* dst, int dld, char* smem) {
  float* t = (float*)smem;
  const int tid = get_tid();
#pragma unroll
  for (int i = 0; i < 16; ++i) { int idx = tid + i * 256; int r = idx >> 6, c = idx & 63; t[r * 65 + c] = src[(size_t)r * sld + c]; }
  __syncthreads();
#pragma unroll
  for (int i = 0; i < 4; ++i) {
    const int idx = tid + i * 256, n = idx >> 4, k = (idx & 15) * 4;
    u32x2 w; w.x = pk2(t[k * 65 + n], t[(k + 1) * 65 + n]); w.y = pk2(t[(k + 2) * 65 + n], t[(k + 3) * 65 + n]);
    *(u32x2*)(dst + (size_t)n * dld + k) = w;
  }
  __syncthreads();
}

DEV void cvt_unit(const float* src, bf16_t* dst, int u, int nh) {
  const size_t base = (size_t)u * 16384;
  const int tid = get_tid();
#pragma unroll
  for (int i = 0; i < 16; ++i) {
    const size_t e = base + (size_t)(i * 256 + tid) * 4;
    f32x4 v = *(const f32x4*)(src + e);
    u32x2 w; w.x = pk2(v[0], v[1]); w.y = pk2(v[2], v[3]);
    const size_t d = e & 63, hh = (e >> 6) % nh, sidx = (e / (64 * nh)) & 511, bl = e / ((size_t)64 * nh * 512);
    *(u32x2*)(dst + ((bl * nh + hh) * 512 + sidx) * 64 + d) = w;
  }
}

DEV void mod_unit(const Params& p, int u, char* smem) {
  const int l = u / 48, n0 = (u % 48) * 64, tid = get_tid();
  float* sc = (float*)smem;
  float* red = (float*)(smem + 36864);
  for (int i = tid; i < 9216; i += 256) { int c = i >> 10, k = i & 1023; float v = (c == 0) ? p.c_ctx[k] : p.c[(c - 1) * 1024 + k]; sc[i] = silu_f(v); }
  __syncthreads();
  const int kq = tid >> 6, col = n0 + (tid & 63);
  float acc[9];
#pragma unroll
  for (int c = 0; c < 9; ++c) acc[c] = 0.f;
  const float* wp = p.w_mod + ((size_t)l * 1024 + kq * 256) * 3072 + col;
#pragma unroll 8
  for (int k = 0; k < 256; ++k) {
    float w = wp[(size_t)k * 3072];
#pragma unroll
    for (int c = 0; c < 9; ++c) acc[c] += sc[c * 1024 + kq * 256 + k] * w;
  }
#pragma unroll
  for (int c = 0; c < 9; ++c) red[(kq * 9 + c) * 64 + (tid & 63)] = acc[c];
  __syncthreads();
  for (int i = tid; i < 576; i += 256) {
    int c = i >> 6, j = i & 63;
    float s = red[(0 * 9 + c) * 64 + j] + red[(1 * 9 + c) * 64 + j] + red[(2 * 9 + c) * 64 + j] + red[(3 * 9 + c) * 64 + j];
    P_mod[((size_t)l * 9 + c) * 3072 + n0 + j] = s + p.b_mod[l * 3072 + n0 + j];
  }
  __syncthreads();
}

DEV void h0_unit(const Params& p, int u) {
  const int tid = get_tid(), col = (tid & 127) * 8, rpar = tid >> 7;
  const int row0 = u * 32;
  const int cond = cond_of_row(row0);
  const float* md = P_mod + (size_t)cond * 3072;
  const f32x4 sh0 = *(const f32x4*)(md + col), sh1 = *(const f32x4*)(md + col + 4), sc0 = *(const f32x4*)(md + 1024 + col), sc1 = *(const f32x4*)(md + 1024 + col + 4);
#pragma unroll 4
  for (int i = 0; i < 16; ++i) {
    const int row = row0 + i * 2 + rpar;
    const float* xr = (row < TP) ? p.x_prompt + (size_t)row * DM : p.x_sample + (size_t)(row - TP) * DM;
    const f32x4 x0 = *(const f32x4*)(xr + col), x1 = *(const f32x4*)(xr + col + 4);
    const f32x4 h0v = x0 * (sc0 + 1.f) + sh0, h1v = x1 * (sc1 + 1.f) + sh1;
    u32x4 w; w.x = pk2(h0v[0], h0v[1]); w.y = pk2(h0v[2], h0v[3]); w.z = pk2(h1v[0], h1v[1]); w.w = pk2(h1v[2], h1v[3]);
    *(u32x4*)(P_H + (size_t)row * DM + col) = w;
  }
}

template <int NR>
DEV void ln_rowsN(const Params& p, int l, int row0, int lane) {
  float* Y = p.out;
  f32x4 v[NR][4];
#pragma unroll
  for (int r = 0; r < NR; ++r)
#pragma unroll
    for (int q = 0; q < 4; ++q) v[r][q] = *(const f32x4*)(Y + (size_t)(row0 + r) * DM + q * 256 + lane * 4);
  const int cond = cond_of_row(row0);
#pragma unroll
  for (int r = 0; r < NR; ++r) {
    const int row = row0 + r;
    float sm = 0.f;
#pragma unroll
    for (int q = 0; q < 4; ++q) sm += (v[r][q][0] + v[r][q][1]) + (v[r][q][2] + v[r][q][3]);
    const float mean = wave_sum(sm) * (1.f / 1024.f);
    float s2 = 0.f;
#pragma unroll
    for (int q = 0; q < 4; ++q) { v[r][q] = v[r][q] - mean; s2 += (v[r][q][0] * v[r][q][0] + v[r][q][1] * v[r][q][1]) + (v[r][q][2] * v[r][q][2] + v[r][q][3] * v[r][q][3]); }
    const float rstd = rsqrtf(wave_sum(s2) * (1.f / 1024.f) + 1e-5f);
#pragma unroll
    for (int q = 0; q < 4; ++q) {
      const int col = q * 256 + lane * 4;
      const f32x4 g = *(const f32x4*)(p.ln_g + l * 1024 + col), b = *(const f32x4*)(p.ln_b + l * 1024 + col);
      f32x4 x = v[r][q] * rstd * g + b;
      if (l < NLAYER - 1) {
        const float* md = P_mod + ((size_t)(l + 1) * 9 + cond) * 3072;
        const f32x4 sh = *(const f32x4*)(md + col), sc = *(const f32x4*)(md + 1024 + col);
        f32x4 h = x * (sc + 1.f) + sh;
        u32x2 w; w.x = pk2(h[0], h[1]); w.y = pk2(h[2], h[3]);
        *(u32x2*)(P_H + (size_t)row * DM + col) = w;
      } else {
        *(f32x4*)(Y + (size_t)row * DM + col) = x;
      }
    }
    if (l < NLAYER - 1 && lane == 0) { P_stats[row * 2] = mean; P_stats[row * 2 + 1] = rstd; }
  }
}

struct EpiA {
  static constexpr bool PERM = false, AFTER_DRAIN = false;
  char* ws0; int l_in;
  DEV void operator()(f32x4 (&acc)[2][2][4][2], const pg8::Unit& u, int wr, int wc, int, int) const {
    const int lane_ = (int)__builtin_amdgcn_mbcnt_hi(~0u, __builtin_amdgcn_mbcnt_lo(~0u, 0u)), fr = lane_ & 15, fq = lane_ >> 4;
    const Params p = load_params(ws0);
    int l = l_in; asm volatile("" : "+s"(l));
    const int colb = u.pn * 256 + wc * 64;
    const int reg = colb >> 6;
    const bool prompt = (u.pm * 256) < TP;
    f32x4 bias[2][2];
#pragma unroll
    for (int bj = 0; bj < 2; ++bj)
#pragma unroll
      for (int n = 0; n < 2; ++n) bias[bj][n] = *(const f32x4*)(p.b_in + l * 3072 + colb + bj * 32 + 8 * fq + 4 * n);
    const bool rms = (reg >= 36 && reg < 42);
    const float* gptr = (reg < 40 ? p.q_norm : p.k_norm) + l * 64;
    bf16_t* kvb = nullptr;
    if (reg >= 12 && reg < 16) kvb = P_KN + (size_t)(reg - 12) * TT * 64;
    else if (reg >= 16 && reg < 20) kvb = P_VN + (size_t)(reg - 16) * TT * 64;
    else if (reg >= 40 && reg < 42) kvb = P_KG + (size_t)(reg - 40) * TT * 64;
    else if (reg >= 42 && reg < 44) kvb = P_VG + (size_t)(reg - 42) * TT * 64;
    float* ob = nullptr; int hw = 0, cofs = 0;
    if (prompt) {
      if (reg >= 12 && reg < 16) { ob = p.out + OUT_NK; hw = 256; cofs = colb - 768; }
      else if (reg >= 16 && reg < 20) { ob = p.out + OUT_NV; hw = 256; cofs = colb - 1024; }
      else if (reg >= 40 && reg < 42) { ob = p.out + OUT_GK; hw = 128; cofs = colb - 2560; }
      else if (reg >= 42 && reg < 44) { ob = p.out + OUT_GV; hw = 128; cofs = colb - 2688; }
    }
#pragma unroll
    for (int ai = 0; ai < 2; ++ai)
#pragma unroll
      for (int m = 0; m < 4; ++m) {
        const int row = u.pm * 256 + ai * 128 + wr * 64 + m * 16 + fr;
        f32x4 v[2][2];
#pragma unroll
        for (int bj = 0; bj < 2; ++bj)
#pragma unroll
          for (int n = 0; n < 2; ++n) v[bj][n] = acc[ai][bj][m][n] + bias[bj][n];
        if (rms) {
          float ss = 0.f;
#pragma unroll
          for (int bj = 0; bj < 2; ++bj)
#pragma unroll
            for (int n = 0; n < 2; ++n)
#pragma unroll
              for (int j = 0; j < 4; ++j) ss += v[bj][n][j] * v[bj][n][j];
          ss += __shfl_xor(ss, 16); ss += __shfl_xor(ss, 32);
          const float r = rsqrtf(ss * (1.f / 64.f) + 1e-6f);
#pragma unroll
          for (int bj = 0; bj < 2; ++bj)
#pragma unroll
            for (int n = 0; n < 2; ++n) v[bj][n] = v[bj][n] * r * *(const f32x4*)(gptr + bj * 32 + 8 * fq + 4 * n);
          if (!prompt) {
            const int t = (row - TP) & 4095, pr = t >> 6, pc = t & 63;
            const float sg = (fq < 2) ? -1.f : 1.f;
#pragma unroll
            for (int bj = 0; bj < 2; ++bj)
#pragma unroll
              for (int n = 0; n < 2; ++n) {
                const int pos = bj ? pc : pr;
                const f32x4 c = *(const f32x4*)(ROPE_COS + pos * 16 + 8 * (fq & 1) + 4 * n), sn = *(const f32x4*)(ROPE_SIN + pos * 16 + 8 * (fq & 1) + 4 * n);
                f32x4 other;
#pragma unroll
                for (int j = 0; j < 4; ++j) {
                  auto r = __builtin_amdgcn_permlane32_swap(__float_as_uint(v[bj][n][j]), __float_as_uint(v[bj][n][j]), false, false);
                  other[j] = __uint_as_float((fq < 2) ? r[1] : r[0]);
                }
                v[bj][n] = v[bj][n] * c + other * sn * sg;
              }
          }
        }
        bf16_t* up = kvb ? kvb + (size_t)row * 64 + 8 * fq : P_U + (size_t)row * NIN + colb + 8 * fq;
#pragma unroll
        for (int bj = 0; bj < 2; ++bj) {
          u32x4 w; w.x = pk2(v[bj][0][0], v[bj][0][1]); w.y = pk2(v[bj][0][2], v[bj][0][3]); w.z = pk2(v[bj][1][0], v[bj][1][1]); w.w = pk2(v[bj][1][2], v[bj][1][3]);
          *(u32x4*)(up + bj * 32) = w;
        }
        if (ob) {
          const int b = row >> 8, sq = row & 255;
          float* op = ob + ((size_t)(b * 4 + l) * 256 + sq) * hw + cofs + 8 * fq;
#pragma unroll
          for (int bj = 0; bj < 2; ++bj)
#pragma unroll
            for (int n = 0; n < 2; ++n) *(f32x4*)(op + bj * 32 + n * 4) = v[bj][n];
        }
      }
  }
};

struct EpiC {
  static constexpr bool PERM = false, AFTER_DRAIN = false;
  char* ws0; int l_in; char* lds_x;
  DEV void operator()(f32x4 (&acc)[2][2][4][2], const pg8::Unit& u, int wr, int wc, int, int) const {
    const int lane_ = (int)__builtin_amdgcn_mbcnt_hi(~0u, __builtin_amdgcn_mbcnt_lo(~0u, 0u)), fr = lane_ & 15, fq = lane_ >> 4;
    const Params p = load_params(ws0);
    int l = l_in; asm volatile("" : "+s"(l));
    const int colb = u.pn * 256 + wc * 64 + 8 * fq;
    const int cond = cond_of_row(u.pm * 256);
    const float* gatep = P_mod + ((size_t)l * 9 + cond) * 3072 + 2048;
    float* Y = p.out;
    auto xrow = [&](int it) -> const float* {
      const int row = u.pm * 256 + (it >> 2) * 128 + wr * 64 + (it & 3) * 16 + fr;
      if (l == 0) return (row < TP) ? p.x_prompt + (size_t)row * DM : p.x_sample + (size_t)(row - TP) * DM;
      return Y + (size_t)row * DM;
    };
    f32x4 xq[2][4]; f32x2 st[2];
    {
      const float* xr = xrow(0);
#pragma unroll
      for (int k = 0; k < 4; ++k) xq[0][k] = *(const f32x4*)(xr + colb + (k >> 1) * 32 + (k & 1) * 4);
      st[0] = (l > 0) ? *(const f32x2*)(P_stats + (size_t)(u.pm * 256 + wr * 64 + fr) * 2) : (f32x2){0.f, 1.f};
    }
#pragma unroll
    for (int it = 0; it < 8; ++it) {
      const int ai = it >> 2, m = it & 3;
      const int row = u.pm * 256 + ai * 128 + wr * 64 + m * 16 + fr;
      if (it + 1 < 8) {
        const float* xr = xrow(it + 1);
#pragma unroll
        for (int k = 0; k < 4; ++k) xq[(it + 1) & 1][k] = *(const f32x4*)(xr + colb + (k >> 1) * 32 + (k & 1) * 4);
        const int rown = u.pm * 256 + ((it + 1) >> 2) * 128 + wr * 64 + ((it + 1) & 3) * 16 + fr;
        st[(it + 1) & 1] = (l > 0) ? *(const f32x2*)(P_stats + (size_t)rown * 2) : (f32x2){0.f, 1.f};
      }
      const float mean = st[it & 1][0], rstd = st[it & 1][1];
#pragma unroll
      for (int bj = 0; bj < 2; ++bj)
#pragma unroll
        for (int n = 0; n < 2; ++n) {
          const int col = colb + bj * 32 + n * 4;
          f32x4 xo = xq[it & 1][bj * 2 + n];
          if (l > 0) {
            const f32x4 g = *(const f32x4*)(p.ln_g + (l - 1) * 1024 + col), b = *(const f32x4*)(p.ln_b + (l - 1) * 1024 + col);
            xo = (xo - mean) * rstd * g + b;
          }
          const f32x4 gt = *(const f32x4*)(gatep + col), bo = *(const f32x4*)(p.b_out + l * 1024 + col);
          const f32x4 y = xo * ALPHA + gt * (acc[ai][bj][m][n] + bo);
#if FUSE_LN
          asm volatile("global_store_dwordx4 %0, %1, off sc1\n\ts_nop 1" :: "v"(Y + (size_t)row * DM + col), "v"(y) : "memory");
#else
          *(f32x4*)(Y + (size_t)row * DM + col) = y;
#endif
        }
    }
#if FUSE_LN
    asm volatile("s_waitcnt vmcnt(0)" ::: "memory");
    __syncthreads();
    volatile LAS unsigned* fl = (volatile LAS unsigned*)(lds_x);
    const int wave = wr * 4 + wc, lane = fq * 16 + fr;
    if (wave == 0 && lane == 0) { const unsigned old = __hip_atomic_fetch_add(P_cnt + l * 160 + u.pm, 1u, __ATOMIC_RELAXED, __HIP_MEMORY_SCOPE_AGENT); *fl = (old == 3u) ? 1u : 0u; }
    __syncthreads();
    if (*fl != 0u) {
      __builtin_amdgcn_fence(__ATOMIC_ACQUIRE, "agent");
      asm volatile("s_waitcnt vmcnt(0)" ::: "memory");
      for (int i = 0; i < 32 / LN_NR; ++i) ln_rowsN<LN_NR>(p, l, u.pm * 256 + wave * 32 + i * LN_NR, lane);
    }
    __syncthreads();
#endif
  }
};

DEV void ln_unit(const Params& p, int l, int u) {
  const int tid = get_tid(), lane = tid & 63, wid = tid >> 6;
  ln_rowsN<LN_UR>(p, l, (u * 4 + wid) * LN_UR, lane);
}

DEV int kswz(int key, int ch) {
  const int ob = (key & 15) * 64 + (ch & 3) * 16;
  return ((key >> 4) * 2 + (ch >> 2)) * 1024 + (ob ^ (((ob >> 9) & 1) << 5));
}
template <int NQ, int NKT>
DEV void qk_tile(const char* kb, int koff, const bf16x8 (&qf)[NQ][2], f32x4 (&s)[NQ][4], int fr, int fq, const float (&mb)[NQ]) {
#pragma unroll
  for (int t = 0; t < NKT; ++t) {
    const int key = koff + 16 * t + fr;
    const bf16x8 k0 = *(const bf16x8*)(kb + kswz(key, fq)), k1 = *(const bf16x8*)(kb + kswz(key, 4 + fq));
#pragma unroll
    for (int g = 0; g < NQ; ++g) { const float nb = -mb[g]; f32x4 z = {nb, nb, nb, nb}; z = mfma16(k0, qf[g][0], z); z = mfma16(k1, qf[g][1], z); s[g][t] = z; }
  }
#pragma unroll
  for (int t = NKT; t < 4; ++t)
#pragma unroll
    for (int g = 0; g < NQ; ++g) s[g][t] = (f32x4){0.f, 0.f, 0.f, 0.f};
}
template <int NQ, int NKT, bool NATL>
DEV void sm_max(f32x4 (&s)[NQ][4], int koff, f32x4 (&o)[NQ][4], float (&mrun)[NQ], f32x4 (&osum)[NQ], int fq, const float* br0, const float* br1, bool gv0, bool gv1, int qc, bool first) {
#pragma unroll
  for (int g = 0; g < NQ; ++g) {
    float mx = -1e30f;
    if (NATL) {
      const int cs = min(max(qc - 8, 0), 48);
      const float* biasrow = g ? br1 : br0;
      const bool gv = g ? gv1 : gv0;
#pragma unroll
      for (int t = 0; t < NKT; ++t)
#pragma unroll
        for (int j = 0; j < 4; ++j) {
          const int kc = koff + 16 * t + 4 * fq + j;
          const bool valid = gv && (kc >= cs) && (kc < cs + 16);
          const int dc = min(max(kc - qc + 15, 0), 30);
          const float bv = biasrow[dc];
          const float x = valid ? s[g][t][j] + bv : -1e30f;
          s[g][t][j] = x; mx = fmaxf(mx, x);
        }
    } else {
#pragma unroll
      for (int t = 0; t < NKT; ++t)
#pragma unroll
        for (int j = 0; j < 4; ++j) mx = fmaxf(mx, s[g][t][j]);
    }
    mx = xr16(mx, true); mx = xr32(mx, true);
    if (__builtin_amdgcn_ballot_w64(first || mx > 8.0f) != 0ull) {
      const float d = first ? mx : fmaxf(mx, 0.f);
      const float al = first ? 1.f : __builtin_amdgcn_exp2f(-d);
      mrun[g] += d; osum[g] = osum[g] * al;
#pragma unroll
      for (int dt = 0; dt < 4; ++dt) o[g][dt] = o[g][dt] * al;
#pragma unroll
      for (int t = 0; t < NKT; ++t) s[g][t] = s[g][t] - d;
    }
  }
}
template <int NQ, int NKT, bool NATL>
DEV void sm_exp_pv(const char* vs, int koff, f32x4 (&s)[NQ][4], f32x4 (&o)[NQ][4], const float (&mrun)[NQ], f32x4 (&osum)[NQ], int fr, int fq) {
#pragma unroll
  for (int g = 0; g < NQ; ++g)
#pragma unroll
    for (int t = 0; t < NKT; ++t)
#pragma unroll
      for (int j = 0; j < 4; ++j) s[g][t][j] = __builtin_amdgcn_exp2f(s[g][t][j]);
  const short one = (short)0x3f80;
  const bf16x8 ones = {one, one, one, one, one, one, one, one};
#pragma unroll
  for (int u = 0; u < NKT / 2; ++u) {
    bf16x8 pf[NQ];
#pragma unroll
    for (int g = 0; g < NQ; ++g) {
      u32x4 w;
      w.x = pk2(s[g][2 * u][0], s[g][2 * u][1]); w.y = pk2(s[g][2 * u][2], s[g][2 * u][3]);
      w.z = pk2(s[g][2 * u + 1][0], s[g][2 * u + 1][1]); w.w = pk2(s[g][2 * u + 1][2], s[g][2 * u + 1][3]);
      pf[g] = __builtin_bit_cast(bf16x8, w);
      osum[g] = mfma16(ones, pf[g], osum[g]);
    }
#pragma unroll
    for (int dt = 0; dt < 4; ++dt) {
      const char* vp = vs + (koff + 32 * u + 4 * fq + (fr >> 2)) * 160 + dt * 32 + (fr & 3) * 8;
      const s16x4 lo = tr16(vp), hi = tr16(vp + 16 * 160);
      const bf16x8 vf = {lo[0], lo[1], lo[2], lo[3], hi[0], hi[1], hi[2], hi[3]};
#pragma unroll
      for (int g = 0; g < NQ; ++g) o[g][dt] = mfma16(vf, pf[g], o[g][dt]);
    }
  }
}

template <int MODE>
DEV void attn_unit(const Params& p, int l, int u, char* smem, char* smem0, int half) {
  constexpr int NQ = 2;
  constexpr int QGS = (MODE == 1) ? 64 : 16;
  constexpr int KPS = (GQA2 && MODE == 0) ? 2 : 1;
  constexpr int NLD = (MODE == 0 && KPS == 1) ? 1 : 2;
  constexpr int RSTEP = (MODE == 0) ? 64 : 32;
  constexpr int VB = 16384 * KPS;
  if constexpr (MODE == 0) smem = smem0;
  const int tid = get_tid(), lane = tid & 63, wid = tid >> 6, fr = lane & 15, fq = lane >> 4;
  int qrow0, qcol, gcol, ocol, NT, NLOC, cstride = 0;
  const bf16_t *kU, *vU, *kC = nullptr, *vC = nullptr;
  int nat_r = 0, nat_rs = 0;
  if (MODE == 0) {
    const int g = u & 1, qb = (u >> 1) & 31, kvh = (u >> 6) & 1, b = u >> 7, h = kvh * 2 + g;
    qrow0 = TP + b * 4096 + qb * 128 + wid * 32; qcol = 2304 + h * 64; gcol = 2816 + h * 64; ocol = 768 + h * 64;
    kU = P_KG + ((size_t)kvh * TT + TP + b * 4096) * 64; vU = P_VG + ((size_t)kvh * TT + TP + b * 4096) * 64; NLOC = 64; NT = 72;
    kC = P_cgk_b + ((size_t)((b * 4 + l) * 2 + kvh) * 512) * 64; vC = P_cgv_b + ((size_t)((b * 4 + l) * 2 + kvh) * 512) * 64; cstride = 64;
  } else if (MODE == 1) {
    const int rp = u & 31, h = (u >> 5) & 3, b = u >> 7, r = 2 * rp;
    nat_r = r; nat_rs = min(max(r - 4, 0), 56);
    qrow0 = TP + b * 4096 + r * 64 + wid * 16; qcol = 512 + h * 64; gcol = 1280 + h * 64; ocol = 256 + h * 64;
    kU = P_KN + ((size_t)h * TT + TP + b * 4096) * 64; vU = P_VN + ((size_t)h * TT + TP + b * 4096) * 64; NLOC = 8; NT = 18;
    kC = P_cnk_b + ((size_t)((b * 4 + l) * 4 + h) * 512) * 64; vC = P_cnv_b + ((size_t)((b * 4 + l) * 4 + h) * 512) * 64; cstride = 64;
    float* blw = (float*)(smem + 36864);
    for (int i = tid; i < 465; i += 256) blw[i] = p.nat_bias[(size_t)(l * 4 + h) * 465 + i] * LOG2E;
  } else {
    const int qb = u & 1, hh = (u >> 1) & 7, b = u >> 4;
    qrow0 = b * 256 + qb * 128 + wid * 32; NLOC = 4; NT = 4;
    if (hh < 4) { qcol = 512 + hh * 64; gcol = 1280 + hh * 64; ocol = 256 + hh * 64; kU = P_KN + ((size_t)hh * TT + b * 256) * 64; vU = P_VN + ((size_t)hh * TT + b * 256) * 64; }
    else { const int h = hh - 4; qcol = 2304 + h * 64; gcol = 2816 + h * 64; ocol = 768 + h * 64; kU = P_KG + ((size_t)(h >> 1) * TT + b * 256) * 64; vU = P_VG + ((size_t)(h >> 1) * TT + b * 256) * 64; }
  }
  bf16x8 qf[NQ][2];
#pragma unroll
  for (int g = 0; g < NQ; ++g)
#pragma unroll
    for (int ks = 0; ks < 2; ++ks) qf[g][ks] = *(const bf16x8*)(P_U + (size_t)(qrow0 + g * QGS + fr) * NIN + qcol + ks * 32 + fq * 8);
#pragma unroll
  for (int g = 0; g < NQ; ++g)
#pragma unroll
    for (int ks = 0; ks < 2; ++ks) asm volatile("" : "+v"(qf[g][ks]));
#pragma unroll
  for (int g = 0; g < NQ; ++g)
#pragma unroll
    for (int ks = 0; ks < 2; ++ks) {
      u32x4 w = __builtin_bit_cast(u32x4, qf[g][ks]);
      w.x = pk2(bflo(w.x) * C1, bfhi(w.x) * C1); w.y = pk2(bflo(w.y) * C1, bfhi(w.y) * C1);
      w.z = pk2(bflo(w.z) * C1, bfhi(w.z) * C1); w.w = pk2(bflo(w.w) * C1, bfhi(w.w) * C1);
      qf[g][ks] = __builtin_bit_cast(bf16x8, w);
    }
  f32x4 o[NQ][4]; float mrun[NQ]; f32x4 lrun[NQ];
#pragma unroll
  for (int g = 0; g < NQ; ++g) { mrun[g] = 0.f; lrun[g] = (f32x4){0.f, 0.f, 0.f, 0.f};
#pragma unroll
    for (int dt = 0; dt < 4; ++dt) o[g][dt] = (f32x4){0.f, 0.f, 0.f, 0.f}; }
  u32x4 rkA[NLD], rvA[NLD], rkB[NLD], rvB[NLD];
  const int ltid = (MODE == 0) ? half * 256 + tid : tid;
  const int lrow = ltid >> 3, lc = ltid & 7;
  auto glK = [&](int t, u32x4 (&rk)[NLD]) {
    const bf16_t* kp; int st;
    if constexpr (MODE == 1) { if (t < 8) kp = kC + (size_t)t * 4096; else kp = kU + (size_t)min(nat_rs + t - 8, 63) * 4096; st = 64; }
    else { if (t < NLOC / KPS) { kp = kU + (size_t)t * KPS * 64 * 64; st = 64; } else { kp = kC + (size_t)(t - NLOC / KPS) * KPS * 64 * cstride; st = cstride; } }
#pragma unroll
    for (int i = 0; i < NLD; ++i) rk[i] = *(const u32x4*)(kp + (size_t)(lrow + i * RSTEP) * st + lc * 8);
  };
  auto glV = [&](int t, u32x4 (&rv)[NLD]) {
    const bf16_t* vp; int st;
    if constexpr (MODE == 1) { if (t < 8) vp = vC + (size_t)t * 4096; else vp = vU + (size_t)min(nat_rs + t - 8, 63) * 4096; st = 64; }
    else { if (t < NLOC / KPS) { vp = vU + (size_t)t * KPS * 64 * 64; st = 64; } else { vp = vC + (size_t)(t - NLOC / KPS) * KPS * 64 * cstride; st = cstride; } }
#pragma unroll
    for (int i = 0; i < NLD; ++i) rv[i] = *(const u32x4*)(vp + (size_t)(lrow + i * RSTEP) * st + lc * 8);
  };
  auto stK = [&](int buf, const u32x4 (&rk)[NLD]) {
#pragma unroll
    for (int i = 0; i < NLD; ++i) *(u32x4*)(smem + buf * 8192 * KPS + ((lrow + i * RSTEP) >> 6) * 8192 + kswz((lrow + i * RSTEP) & 63, lc)) = rk[i];
  };
  auto stV = [&](int buf, const u32x4 (&rv)[NLD]) {
#pragma unroll
    for (int i = 0; i < NLD; ++i) *(u32x4*)(smem + VB + buf * 10240 * KPS + (lrow + i * RSTEP) * 160 + lc * 16) = rv[i];
  };
  const float* bl = (const float*)(smem + 36864);
  const int kcw = (wid == 0) ? 0 : (wid == 1) ? 8 : (wid == 2) ? 24 : 32;
  auto qk = [&](int t, f32x4 (&sd)[NQ][4], int sub = 0) {
    const char* kb = smem + (t & 1) * 8192 * KPS + sub * 8192;
    if constexpr (MODE == 1) { if (t < 8) qk_tile<2, 4>(kb, 0, qf, sd, fr, fq, mrun); else qk_tile<2, 2>(kb, kcw, qf, sd, fr, fq, mrun); }
    else qk_tile<NQ, 4>(kb, 0, qf, sd, fr, fq, mrun);
  };
  auto smx = [&](int t, f32x4 (&sd)[NQ][4], bool first) {
    if constexpr (MODE == 1) {
      if (t < 8) sm_max<2, 4, false>(sd, 0, o, mrun, lrun, fq, nullptr, nullptr, true, true, 0, first);
      else {
        const int kr = nat_rs + t - 8;
        const int rs1 = min(max(nat_r - 3, 0), 56);
        const bool gv0 = (kr < nat_rs + 8) && (kr < 64), gv1 = (kr >= rs1) && (kr < rs1 + 8) && (kr < 64);
        const int dr0 = min(max(kr - nat_r + 7, 0), 14), dr1 = min(max(kr - nat_r + 6, 0), 14);
        sm_max<2, 2, true>(sd, kcw, o, mrun, lrun, fq, bl + dr0 * 31, bl + dr1 * 31, gv0, gv1, wid * 16 + fr, false);
      }
    } else sm_max<NQ, 4, false>(sd, 0, o, mrun, lrun, fq, nullptr, nullptr, true, true, 0, first);
  };
  auto spv = [&](int t, f32x4 (&sd)[NQ][4], int sub = 0) {
    const char* vs = smem + VB + (t & 1) * 10240 * KPS + sub * 10240;
    if constexpr (MODE == 1) {
      if (t < 8) sm_exp_pv<2, 4, false>(vs, 0, sd, o, mrun, lrun, fr, fq);
      else sm_exp_pv<2, 2, true>(vs, kcw, sd, o, mrun, lrun, fr, fq);
    } else sm_exp_pv<NQ, 4, false>(vs, 0, sd, o, mrun, lrun, fr, fq);
  };
  auto iter = [&](int t, f32x4 (&sc)[NQ][4], f32x4 (&sn)[NQ][4], u32x4 (&rkX)[NLD], u32x4 (&rvX)[NLD], u32x4 (&rkY)[NLD], u32x4 (&rvY)[NLD]) {
#if ATT_PIPE
    glK(min(t + 3, NT / KPS - 1), rkX);
#else
    glK(min(t + 2, NT / KPS - 1), rkX);
#endif
    glV(min(t + 2, NT / KPS - 1), rvX);
#if ATT_PIPE
    smx(t, sc, t == 0);
    qk(t + 1, sn);
    spv(t, sc);
#else
#pragma unroll
    for (int sub = 0; sub < KPS; ++sub) {
      qk(t, sc, sub);
      smx(t, sc, t == 0 && sub == 0);
      spv(t, sc, sub);
    }
#endif
#if SGB_N > 0
    if constexpr (MODE != 1) {
#pragma unroll
      for (int i = 0; i < SGB_N; ++i) { __builtin_amdgcn_sched_group_barrier(0x008, 1, 0); __builtin_amdgcn_sched_group_barrier(0x002, SGB_V, 0); }
    }
#endif
#if PROBE_T == 1
    if constexpr (MODE == 0) { const unsigned long long t0_ = __builtin_amdgcn_s_memrealtime(); asm volatile("s_waitcnt vmcnt(2)" ::: "memory"); const unsigned long long t1_ = __builtin_amdgcn_s_memrealtime(); if (threadIdx.x == 0) *(volatile unsigned long long*)(smem0 + 131072 + 256) += t1_ - t0_; }
#endif
#if ATT_PIPE
    stK(t & 1, rkY);
#else
    stK((t + 1) & 1, rkY);
#endif
    stV((t + 1) & 1, rvY);
#if PROBE_T == 2
    if constexpr (MODE == 0) { asm volatile("s_waitcnt lgkmcnt(0)" ::: "memory"); const unsigned long long t0_ = __builtin_amdgcn_s_memrealtime(); __syncthreads(); const unsigned long long t1_ = __builtin_amdgcn_s_memrealtime(); if (threadIdx.x == 0) *(volatile unsigned long long*)(smem0 + 131072 + 256) += t1_ - t0_; } else
#endif
    __syncthreads();
  };
#if PROBE_T == 3
  const unsigned long long tu0_ = __builtin_amdgcn_s_memrealtime();
#endif
  glK(0, rkA); glV(0, rvA); stK(0, rkA); stV(0, rvA);
#if ATT_PIPE
  glK(1, rkA); stK(1, rkA);
  glK(2, rkB); glV(1, rvB);
#else
  glK(1, rkB); glV(1, rvB);
#endif
  __syncthreads();
  f32x4 sA[NQ][4], sB[NQ][4];
#if ATT_PIPE
  qk(0, sA);
#endif
#pragma unroll 1
  for (int t = 0; t < NT / KPS; t += 2) { iter(t, sA, sB, rkA, rvA, rkB, rvB); iter(t + 1, sB, sA, rkB, rvB, rkA, rvA); }
#if PROBE_T == 3
  if constexpr (MODE == 0) { if (threadIdx.x == 0) *(volatile unsigned long long*)(smem0 + 131072 + 256) += __builtin_amdgcn_s_memrealtime() - tu0_; }
#endif
#pragma unroll
  for (int g = 0; g < NQ; ++g) {
    const float inv = __builtin_amdgcn_rcpf(lrun[g][0]);
    const int row = qrow0 + g * QGS + fr;
#pragma unroll
    for (int dt = 0; dt < 4; ++dt) {
      const int d0 = dt * 16 + 4 * fq;
      const u32x2 gw = *(const u32x2*)(P_U + (size_t)row * NIN + gcol + d0);
      u32x2 w;
      w.x = pk2(o[g][dt][0] * inv * silu_f(bflo(gw.x)), o[g][dt][1] * inv * silu_f(bfhi(gw.x)));
      w.y = pk2(o[g][dt][2] * inv * silu_f(bflo(gw.y)), o[g][dt][3] * inv * silu_f(bfhi(gw.y)));
      *(u32x2*)(P_MX + (size_t)row * DM + ocol + d0) = w;
    }
  }
}

DEV void pool_unit(const Params& p, int l, int u, char* smem) {
  const int tid = get_tid(), lane = tid & 63, wid = tid >> 6, fr = lane & 15, fq = lane >> 4;
  const int R0 = u * 32;
  int L, sb;
  if (R0 < TP) { L = 256; sb = R0 & ~255; } else { L = 4096; sb = TP + ((R0 - TP) & ~4095); }
  const int t0 = R0 - sb;
  bf16_t* xs = (bf16_t*)smem;
  bf16_t* ya = (bf16_t*)(smem + 24576);
  const bf16_t* wt = P_poolT + (size_t)(l * 4 + wid) * 4096;
  bf16x8 bfr[2][4];
#pragma unroll
  for (int ks = 0; ks < 2; ++ks)
#pragma unroll
    for (int n = 0; n < 4; ++n) bfr[ks][n] = *(const bf16x8*)(wt + (n * 16 + fr) * 64 + ks * 32 + fq * 8);
  u32x2 gwv[2][4];
#pragma unroll
  for (int m = 0; m < 2; ++m)
#pragma unroll
    for (int n = 0; n < 4; ++n) gwv[m][n] = *(const u32x2*)(P_U + (size_t)(R0 + m * 16 + fr) * NIN + 256 + wid * 64 + n * 16 + 4 * fq);
#pragma unroll
  for (int k = 0; k < 6; ++k) {
    const int idx = tid + k * 256, i = idx >> 5, c8 = (idx & 31) * 8, t = t0 - 8 + i;
    u32x4 w = {0u, 0u, 0u, 0u};
    if (t >= 0 && t < L) w = *(const u32x4*)(P_U + (size_t)(sb + t) * NIN + c8);
    *(u32x4*)(xs + i * 256 + c8) = w;
  }
  __syncthreads();
  {
    const int c = tid, g = c >> 6, win = 2 << g, half = win >> 1;
    float sum = 0.f;
    for (int i = 0; i < win; ++i) sum += bf2f(xs[(8 - half + i) * 256 + c]);
#pragma unroll 8
    for (int tt = 0; tt < 32; ++tt) {
      const int t = t0 + tt;
      const int lo = max(t - half, 0), hi = min(t - half + win, L);
      const float y = sum / (float)(hi - lo) - bf2f(xs[(tt + 8) * 256 + c]);
      ya[tt * 264 + c] = f2bf(y);
      sum += bf2f(xs[(tt + 8 - half + win) * 256 + c]) - bf2f(xs[(tt + 8 - half) * 256 + c]);
    }
  }
  __syncthreads();
  const int g = wid;
  f32x4 acc[2][4];
#pragma unroll
  for (int m = 0; m < 2; ++m)
#pragma unroll
    for (int n = 0; n < 4; ++n) acc[m][n] = (f32x4){0.f, 0.f, 0.f, 0.f};
#pragma unroll
  for (int ks = 0; ks < 2; ++ks) {
    bf16x8 af[2];
#pragma unroll
    for (int m = 0; m < 2; ++m) af[m] = *(const bf16x8*)(smem + 24576 + (m * 16 + fr) * 528 + (g * 64 + ks * 32 + fq * 8) * 2);
#pragma unroll
    for (int m = 0; m < 2; ++m)
#pragma unroll
      for (int n = 0; n < 4; ++n) acc[m][n] = mfma16(bfr[ks][n], af[m], acc[m][n]);
  }
#pragma unroll
  for (int m = 0; m < 2; ++m) {
    const int row = R0 + m * 16 + fr;
#pragma unroll
    for (int n = 0; n < 4; ++n) {
      const int ch = g * 64 + n * 16 + 4 * fq;
      const f32x4 sc = *(const f32x4*)(p.pool_scale + l * 256 + ch);
      const u32x2 gw = gwv[m][n];
      u32x2 w;
      w.x = pk2(acc[m][n][0] * sc[0] * silu_f(bflo(gw.x)), acc[m][n][1] * sc[1] * silu_f(bfhi(gw.x)));
      w.y = pk2(acc[m][n][2] * sc[2] * silu_f(bflo(gw.y)), acc[m][n][3] * sc[3] * silu_f(bfhi(gw.y)));
      *(u32x2*)(P_MX + (size_t)row * DM + ch) = w;
    }
  }
  __syncthreads();
}

DEV void conv_unit(const Params& p, int l, int u, char* smem) {
  const int tid = get_tid(), lane = tid & 63, wid = tid >> 6, fr = lane & 15, fq = lane >> 4;
  const int R0 = u * 64;
  int L, sb;
  if (R0 < TP) { L = 256; sb = R0 & ~255; } else { L = 4096; sb = TP + ((R0 - TP) & ~4095); }
  const int t0 = R0 - sb;
  bf16_t* zs = (bf16_t*)smem;
  bf16_t* za = (bf16_t*)smem;
  float* cs = (float*)(smem + 48128);
  float* red = (float*)(smem + 64768);
#pragma unroll 6
  for (int it = 0; it < 12; ++it) {
    const int idx = min(tid + it * 256, 94 * 32 - 1);
    const int i = idx >> 5, c8 = (idx & 31) * 8, t = t0 - 15 + i;
    u32x4 w = {0u, 0u, 0u, 0u};
    if (t >= 0 && t < L) {
      const bf16_t* ur = P_U + (size_t)(sb + t) * NIN;
      const u32x4 vv = *(const u32x4*)(ur + 1536 + c8), gg = *(const u32x4*)(ur + 1792 + c8);
      w.x = pk2(bflo(vv.x) * sigm_f(bflo(gg.x)), bfhi(vv.x) * sigm_f(bfhi(gg.x)));
      w.y = pk2(bflo(vv.y) * sigm_f(bflo(gg.y)), bfhi(vv.y) * sigm_f(bfhi(gg.y)));
      w.z = pk2(bflo(vv.z) * sigm_f(bflo(gg.z)), bfhi(vv.z) * sigm_f(bfhi(gg.z)));
      w.w = pk2(bflo(vv.w) * sigm_f(bflo(gg.w)), bfhi(vv.w) * sigm_f(bfhi(gg.w)));
    }
    *(u32x4*)(zs + i * 256 + c8) = w;
  }
  __syncthreads();
  const int c = tid;
  float wj[31];
#pragma unroll
  for (int j = 0; j < 31; ++j) wj[j] = p.conv_w[(size_t)(l * 31 + j) * 256 + c];
  const float cb = p.conv_b[l * 256 + c], lg = p.conv_ln_g[l * 256 + c], lb = p.conv_ln_b[l * 256 + c];
  float a[4][16];
#pragma unroll
  for (int ch = 0; ch < 4; ++ch) {
    float zr[46];
#pragma unroll
    for (int i = 0; i < 46; ++i) zr[i] = bf2f(zs[(ch * 16 + i) * 256 + c]);
#pragma unroll
    for (int i = 0; i < 16; ++i) {
      float s = cb;
#pragma unroll
      for (int j = 0; j < 31; ++j) s += zr[i + j] * wj[j];
      a[ch][i] = s;
      cs[i * 260 + c] = s;
    }
    __syncthreads();
    {
      const int i2 = tid >> 4, sl = tid & 15;
      float s1 = 0.f, s2 = 0.f;
#pragma unroll
      for (int q = 0; q < 4; ++q) {
        const f32x4 v = *(const f32x4*)(cs + i2 * 260 + sl * 16 + q * 4);
        s1 += (v[0] + v[1]) + (v[2] + v[3]);
        s2 += (v[0] * v[0] + v[1] * v[1]) + (v[2] * v[2] + v[3] * v[3]);
      }
      s1 += __shfl_xor(s1, 1); s2 += __shfl_xor(s2, 1);
      s1 += __shfl_xor(s1, 2); s2 += __shfl_xor(s2, 2);
      s1 += __shfl_xor(s1, 4); s2 += __shfl_xor(s2, 4);
      s1 += __shfl_xor(s1, 8); s2 += __shfl_xor(s2, 8);
      if (sl == 0) { red[(ch * 16 + i2) * 2] = s1; red[(ch * 16 + i2) * 2 + 1] = s2; }
    }
    __syncthreads();
  }
#pragma unroll
  for (int ch = 0; ch < 4; ++ch)
#pragma unroll
    for (int i = 0; i < 16; ++i) {
      const int tt = ch * 16 + i;
      const float mean = red[tt * 2] * (1.f / 256.f);
      const float var = fmaxf(red[tt * 2 + 1] * (1.f / 256.f) - mean * mean, 0.f);
      const float rstd = rsqrtf(var + 1e-5f);
      const float v = (a[ch][i] - mean) * rstd * lg + lb;
      za[tt * 264 + c] = f2bf(silu_f(v));
    }
  __syncthreads();
  f32x4 acc[4][4];
#pragma unroll
  for (int m = 0; m < 4; ++m)
#pragma unroll
    for (int n = 0; n < 4; ++n) acc[m][n] = (f32x4){0.f, 0.f, 0.f, 0.f};
  const bf16_t* wt = P_pwT + (size_t)l * 65536 + (size_t)(wid * 64 + fr) * 256 + fq * 8;
  bf16x8 bq[3][4];
#pragma unroll
  for (int n = 0; n < 4; ++n) { bq[0][n] = *(const bf16x8*)(wt + (size_t)n * 16 * 256); bq[1][n] = *(const bf16x8*)(wt + (size_t)n * 16 * 256 + 32); }
  u32x2 gwv[4][4];
#pragma unroll
  for (int m = 0; m < 4; ++m)
#pragma unroll
    for (int n = 0; n < 4; ++n) gwv[m][n] = *(const u32x2*)(P_U + (size_t)(R0 + m * 16 + fr) * NIN + 2048 + wid * 64 + n * 16 + 4 * fq);
#pragma unroll
  for (int ks = 0; ks < 8; ++ks) {
    if (ks + 2 < 8) {
#pragma unroll
      for (int n = 0; n < 4; ++n) bq[(ks + 2) % 3][n] = *(const bf16x8*)(wt + (size_t)n * 16 * 256 + (ks + 2) * 32);
    }
    bf16x8 af[4];
#pragma unroll
    for (int m = 0; m < 4; ++m) af[m] = *(const bf16x8*)(smem + (m * 16 + fr) * 528 + (ks * 32 + fq * 8) * 2);
#pragma unroll
    for (int m = 0; m < 4; ++m)
#pragma unroll
      for (int n = 0; n < 4; ++n) acc[m][n] = mfma16(bq[ks % 3][n], af[m], acc[m][n]);
  }
#pragma unroll
  for (int m = 0; m < 4; ++m) {
    const int row = R0 + m * 16 + fr;
#pragma unroll
    for (int n = 0; n < 4; ++n) {
      const int ch = wid * 64 + n * 16 + 4 * fq;
      const u32x2 gw = gwv[m][n];
      u32x2 w;
      w.x = pk2(acc[m][n][0] * silu_f(bflo(gw.x)), acc[m][n][1] * silu_f(bfhi(gw.x)));
      w.y = pk2(acc[m][n][2] * silu_f(bflo(gw.y)), acc[m][n][3] * silu_f(bfhi(gw.y)));
      *(u32x2*)(P_MX + (size_t)row * DM + 512 + ch) = w;
    }
  }
  __syncthreads();
}

constexpr int P0_WIN = 3072, P0_WOUT = 1024, P0_PW = 64, P0_POOL = 16, P0_CVT = 768, P0_MOD = 192;
constexpr int P0_UNITS = P0_WIN + P0_WOUT + P0_PW + P0_POOL + P0_CVT + P0_MOD;

DEV void phase0(const Params& p, char* smem) {
  if (blockIdx.x == 0) for (int i = threadIdx.x; i < 1280 + 64; i += 512) P_cnt[i] = 0u;
  const int half = get_half();
  smem += half * 65536;
  for (int pr = blockIdx.x; pr < P0_UNITS / 2; pr += gridDim.x) {
    int v = pr * 2 + half;
    if (v < P0_MOD) { mod_unit(p, v, smem); continue; }
    v -= P0_MOD;
    if (v < P0_WIN) { const int l = v / 768, r = v % 768, kt = r / 48, nt = r % 48;
      tconv_tile(p.w_in + ((size_t)l * 1024 + kt * 64) * 3072 + nt * 64, 3072, P_WinT + ((size_t)l * 3072 + nt * 64) * 1024 + kt * 64, 1024, smem); continue; }
    v -= P0_WIN;
    if (v < P0_WOUT) { const int l = v >> 8, r = v & 255, kt = r >> 4, nt = r & 15;
      tconv_tile(p.w_out + ((size_t)l * 1024 + kt * 64) * 1024 + nt * 64, 1024, P_WoutT + ((size_t)l * 1024 + nt * 64) * 1024 + kt * 64, 1024, smem); continue; }
    v -= P0_WOUT;
    if (v < P0_PW) { const int l = v >> 4, r = v & 15, kt = r >> 2, nt = r & 3;
      tconv_tile(p.conv_pw + ((size_t)l * 256 + kt * 64) * 256 + nt * 64, 256, P_pwT + ((size_t)l * 256 + nt * 64) * 256 + kt * 64, 256, smem); continue; }
    v -= P0_PW;
    if (v < P0_POOL) { tconv_tile(p.pool_w + (size_t)v * 4096, 64, P_poolT + (size_t)v * 4096, 64, smem); continue; }
    v -= P0_POOL;
    if (v < 256) { cvt_unit(p.cnk, P_cnk_b, v, 4); continue; }
    v -= 256;
    if (v < 256) { cvt_unit(p.cnv, P_cnv_b, v, 4); continue; }
    v -= 256;
    if (v < 128) { cvt_unit(p.cgk, P_cgk_b, v, 2); continue; }
    v -= 128;
    cvt_unit(p.cgv, P_cgv_b, v, 2);
  }
}

constexpr int XB_GQA = 128, XB_NAT = 128, XB_CONV = 80, XB_PATT = 64, XB_POOL = 160;
constexpr int XB_UNITS = XB_GQA + XB_NAT + XB_CONV + XB_PATT + XB_POOL;

DEV void phaseB(char* ws0, int l_in, char* smem, int qofs, int ubeg = 0, int uend = XB_UNITS) {
  const int xcd = blockIdx.x & 7;
  unsigned* q = (unsigned*)(ws0 + WS_CNT) + 1280 + qofs + l_in * 8 + xcd;
  int* slot = (int*)(smem + 131072);
  const int half = get_half();
  char* smem0 = smem;
  smem += half * 65536;
  for (;;) {
    if (threadIdx.x == 0) *slot = (int)atomicAdd(q, 1u);
    __syncthreads();
    int u = ubeg + *slot * 2 + half;
    __syncthreads();
    if (u >= uend) break;
    int l = l_in; asm volatile("" : "+s"(l));
    const Params p = load_params(ws0);
    if (u < XB_GQA) { attn_unit<0>(p, l, xcd * XB_GQA + u, smem, smem0, half); continue; }
    u -= XB_GQA;
    if (u < XB_NAT) { attn_unit<1>(p, l, xcd * XB_NAT + u, smem, smem0, half); continue; }
    u -= XB_NAT;
    if (u < XB_CONV) { conv_unit(p, l, xcd * XB_CONV + u, smem); continue; }
    u -= XB_CONV;
    if (u < XB_PATT) { attn_unit<2>(p, l, xcd * XB_PATT + u, smem, smem0, half); continue; }
    u -= XB_PATT;
    pool_unit(p, l, xcd * XB_POOL + u, smem);
  }
}

constexpr int LDS_BYTES = 131072 + 1024;
__global__ void __launch_bounds__(512, 2) mega(Params p0) {
  extern __shared__ __attribute__((aligned(16))) char smem[];
  cg::grid_group grid = cg::this_grid();
  const int ph0 = p0.ph0, ph1 = p0.ph1;
  char* const ws0 = p0.ws;
  if (blockIdx.x == 0 && threadIdx.x == 0) *(Params*)(ws0 + WS_PARAMS) = p0;
#define PP() load_params(ws0)
  const int half = get_half();
  volatile LAS unsigned* xst = (volatile LAS unsigned*)(smem + 131072 + 64);
  if (threadIdx.x == 0) { xst[0] = 0u; xst[1] = 0u; *(volatile unsigned long long*)(smem + 131072 + 256) = 0ull; }
  __syncthreads();
  const XcdBarrier xb = xcd_barrier_post((unsigned*)(ws0 + WS_BAR), xst);
  if (ph0 <= 0 && 0 < ph1) { for (int rep = 0; rep < (PROBE_X == 4 ? 2 : 1); ++rep) { phase0(p0, smem); if (1 < ph1) grid.sync(); } }
  if (ph0 <= 1 && 1 < ph1) { for (int u = blockIdx.x; u < TT / 64; u += gridDim.x) { const Params pl = PP(); h0_unit(pl, u * 2 + half); } if (2 < ph1) xcd_barrier(xb); }
  for (int li = 0; li < NLAYER; ++li) {
    int l = li; asm volatile("" : "+s"(l));
    const int pa = 2 + 3 * li;
    if (ph0 <= pa && pa < ph1) {
      const Params p = PP();
      pg8::Gemm g; g.A = P_H; g.Bt = P_WinT + (size_t)l * 3072 * 1024; g.M = TT; g.N = NIN; g.K = DM;
      pg8::StaticOrder S; S.init(TT, NIN, (int)gridDim.x, (int)blockIdx.x);
      EpiA E{ws0, l};
      for (int rep = 0; rep < (PROBE_X == 1 ? 2 : 1); ++rep) {
        pg8::gemm_phase<EpiA, pg8::StaticOrder, true, true>((PG8_LAS unsigned char*)smem, g, S, E);
        if (pa + 1 < ph1) xcd_barrier(xb);
      }
    }
    if (ph0 <= pa + 1 && pa + 1 < ph1) { phaseB(ws0, l, smem, 0); if (pa + 2 < ph1) xcd_barrier(xb); }
#if PROBE_SYNC
    for (int i = 0; i < 8; ++i) xcd_barrier(xb);
#endif
#if PROBE_B
    { constexpr int lo[7] = {0, 0, 128, 256, 336, 400, 0}, hi[7] = {0, 128, 256, 336, 400, 560, 560}; phaseB(ws0, l, smem, 32, lo[PROBE_B], hi[PROBE_B]); xcd_barrier(xb); }
#endif
    if (ph0 <= pa + 2 && pa + 2 < ph1) {
      const Params p = PP();
      pg8::Gemm g; g.A = P_MX; g.Bt = P_WoutT + (size_t)l * 1024 * 1024; g.M = TT; g.N = DM; g.K = DM;
      pg8::StaticOrder S; S.init(TT, DM, (int)gridDim.x, (int)blockIdx.x);
      EpiC E{ws0, l, smem + 131072 + 128};
      for (int rep = 0; rep < ((PROBE_X == 2 && li == 0) ? 2 : 1); ++rep) {
        pg8::gemm_phase<EpiC, pg8::StaticOrder, true, true>((PG8_LAS unsigned char*)smem, g, S, E);
#if FUSE_LN
        if (pa + 3 < ph1) xcd_barrier(xb);
#else
        xcd_barrier(xb);
#endif
      }
#if !FUSE_LN
      for (int rep = 0; rep < ((PROBE_X == 3 && li < 3) ? 2 : 1); ++rep) {
        for (int u = blockIdx.x; u < TT / (8 * LN_UR); u += gridDim.x) { const Params pl = PP(); ln_unit(pl, l, u * 2 + half); }
        if (pa + 3 < ph1) xcd_barrier(xb);
      }
#endif
    }
  }
#if PROBE_T
  if (blockIdx.x == 0 && threadIdx.x == 0) { const unsigned long long acc_ = *(volatile unsigned long long*)(smem + 131072 + 256) * PROBE_MUL; const unsigned long long ts_ = __builtin_amdgcn_s_memrealtime(); while (__builtin_amdgcn_s_memrealtime() - ts_ < acc_) __builtin_amdgcn_s_sleep(8); }
#endif
}

#ifndef ONE_LAUNCH
#define ONE_LAUNCH 1
#endif

extern "C" void kernel_launch(void* const* d_in, const int* in_sizes, int n_in, void* d_out, int out_size, void* d_ws, size_t ws_size,
                              hipStream_t stream) {
  static int grid_blocks = 0;
  if (!grid_blocks) {
    int dev = 0, cus = 0, per_cu = 0;
    hipGetDevice(&dev);
    hipDeviceGetAttribute(&cus, hipDeviceAttributeMultiprocessorCount, dev);
    hipFuncSetAttribute((const void*)mega, hipFuncAttributeMaxDynamicSharedMemorySize, LDS_BYTES);
    hipOccupancyMaxActiveBlocksPerMultiprocessor(&per_cu, mega, 512, LDS_BYTES);
    if (per_cu > 1) per_cu = 1;
    if (per_cu < 1) per_cu = 1;
    grid_blocks = cus * per_cu;
  }
  if (ws_size < WS_END) { fprintf(stderr, "kernel_launch: workspace too small (%zu < %zu); nothing launched\n", ws_size, (size_t)WS_END); return; }
  Params p{};
  const float* const* in = (const float* const*)d_in;
  p.x_prompt = in[0]; p.x_sample = in[1]; p.c = in[2]; p.cnk = in[3]; p.cnv = in[4]; p.cgk = in[5]; p.cgv = in[6]; p.c_ctx = in[7];
  p.w_mod = in[8]; p.b_mod = in[9]; p.w_in = in[10]; p.b_in = in[11]; p.pool_w = in[12]; p.pool_scale = in[13]; p.nat_bias = in[14];
  p.q_norm = in[15]; p.k_norm = in[16]; p.conv_w = in[17]; p.conv_b = in[18]; p.conv_ln_g = in[19]; p.conv_ln_b = in[20]; p.conv_pw = in[21];
  p.w_out = in[22]; p.b_out = in[23]; p.ln_g = in[24]; p.ln_b = in[25];
  p.out = (float*)d_out;
  p.ws = (char*)d_ws;
  hipMemsetAsync((char*)d_ws + WS_BAR, 0, XCD_BAR_WORDS * sizeof(unsigned), stream);
#if ONE_LAUNCH
  p.ph0 = 0; p.ph1 = 14;
  void* args[] = {&p};
  hipError_t e = hipLaunchCooperativeKernel((void*)mega, dim3(grid_blocks), dim3(512), args, LDS_BYTES, stream);
  if (e != hipSuccess) fprintf(stderr, "cooperative launch failed: %s (grid %d)\n", hipGetErrorString(e), grid_blocks);
#else
  for (int ph = 0; ph < 14; ++ph) { p.ph0 = ph; p.ph1 = ph + 1; mega<<<grid_blocks, 512, LDS_BYTES, stream>>>(p); }
#endif
}
```

```cpp
#define SGB_N 0
#define SGB_V 6
#define LN_UR 2
#include <hip/hip_runtime.h>
#include <hip/hip_cooperative_groups.h>
#include <cstdio>
#include <cstdint>
namespace cg = cooperative_groups;

typedef unsigned short bf16_t;
typedef short bf16x8 __attribute__((ext_vector_type(8)));
typedef short s16x4 __attribute__((ext_vector_type(4)));
typedef float f32x4 __attribute__((ext_vector_type(4)));
typedef float f32x2 __attribute__((ext_vector_type(2)));
typedef __bf16 bf16x2_t __attribute__((ext_vector_type(2)));
typedef unsigned u32x4 __attribute__((ext_vector_type(4)));
typedef unsigned u32x2 __attribute__((ext_vector_type(2)));
#define DEV __device__ __forceinline__
__device__ const float ROPE_COS[1024] = {
1.f,1.f,1.f,1.f,1.f,1.f,1.f,1.f,
1.f,1.f,1.f,1.f,1.f,1.f,1.f,1.f,
0.540302277f,0.846009135f,0.950415254f,0.98423022f,0.995004177f,0.998419285f,0.999500036f,0.999841869f,
0.999949992f,0.999984205f,0.999994993f,0.999998391f,0.999999523f,0.999999821f,0.99999994f,1.f,
-0.416146845f,0.431462824f,0.806578398f,0.937418282f,0.980066597f,0.993682086f,0.998000681f,0.999367595f,
0.999800026f,0.999936759f,0.999979973f,0.999993682f,0.999997973f,0.999999344f,0.999999821f,0.99999994f,
-0.989992499f,-0.115966164f,0.582753658f,0.861040652f,0.955336511f,0.985803485f,0.995503366f,0.998577297f,
0.999550045f,0.999857724f,0.999954998f,0.999985754f,0.99999553f,0.999998569f,0.999999523f,0.999999881f,
-0.653643608f,-0.627679706f,0.301137477f,0.757506192f,0.921060979f,0.974808276f,0.992010653f,0.997471273f,
0.999200106f,0.999747038f,0.999920011f,0.999974728f,0.999992013f,0.999997497f,0.999999225f,0.999999762f,
0.2836622f,-0.946079254f,-0.0103423381f,0.630080283f,0.87758255f,0.960731268f,0.987526f,0.996049762f,
0.998750269f,0.999604762f,0.999875009f,0.999960482f,0.999987483f,0.999996066f,0.999998748f,0.999999583f,
0.960170269f,-0.973103702f,-0.3207964f,0.482782036f,0.825335622f,0.943616986f,0.982053936f,0.9943133f,
0.998200536f,0.999430835f,0.999819994f,0.999943078f,0.999981999f,0.999994338f,0.999998212f,0.999999404f,
0.753902256f,-0.700429797f,-0.599437475f,0.320257008f,0.764842212f,0.923519433f,0.975599885f,0.992262423f,
0.997551024f,0.999225318f,0.999755025f,0.999922514f,0.999975502f,0.999992251f,0.999997556f,0.999999225f,
-0.145500034f,-0.212036446f,-0.818632424f,0.147631213f,0.696706712f,0.900502324f,0.968170285f,0.989897788f,
0.996801734f,0.998988271f,0.999680042f,0.999898791f,0.999967992f,0.999989867f,0.999996781f,0.999998987f,
-0.91113025f,0.341660261f,-0.956644177f,-0.0296507962f,0.621609926f,0.874638259f,0.959772646f,0.987220109f,
0.995952725f,0.998719573f,0.999595046f,0.99987191f,0.999959528f,0.999987185f,0.999995947f,0.999998748f,
-0.839071512f,0.790131867f,-0.999786079f,-0.205997631f,0.540302277f,0.846009135f,0.950415313f,0.98423022f,
0.995004177f,0.998419285f,0.999500036f,0.999841869f,0.999949992f,0.999984205f,0.999994993f,0.999998391f,
0.00442569796f,0.995257378f,-0.943779767f,-0.375847399f,0.453596085f,0.814705312f,0.940107584f,0.980929136f,
0.993956089f,0.998087406f,0.999395072f,0.999808669f,0.999939501f,0.999980867f,0.99999392f,0.999998093f,
0.843853951f,0.893861592f,-0.79417938f,-0.53384304f,0.362357706f,0.780825913f,0.92885989f,0.97731787f,
0.99280864f,0.997723997f,0.999280095f,0.99977231f,0.999927998f,0.999977231f,0.999992788f,0.999997735f,
0.907446802f,0.517172873f,-0.565820515f,-0.675001681f,0.267498761f,0.744477987f,0.916683376f,0.973397553f,
0.99156189f,0.997329056f,0.999155104f,0.999732792f,0.999915481f,0.999973297f,0.999991536f,0.999997318f,
0.136737213f,-0.0187961515f,-0.28134948f,-0.794870913f,0.16996716f,0.705776393f,0.903590262f,0.969169438f,
0.990216017f,0.996902585f,0.999020159f,0.999690115f,0.99990201f,0.999969006f,0.999990225f,0.999996901f,
-0.759687901f,-0.548975468f,0.0310223512f,-0.889670432f,0.070737198f,0.6648435f,0.889593601f,0.964634836f,
0.988771081f,0.996444523f,0.998875201f,0.999644279f,0.999887526f,0.999964416f,0.999988735f,0.999996424f,
-0.957659483f,-0.910081089f,0.340318173f,-0.95641005f,-0.0291995462f,0.621808827f,0.87470746f,0.959795177f,
0.987227261f,0.99595499f,0.998720288f,0.999595284f,0.999872029f,0.999959528f,0.999987185f,0.999995947f,
-0.275163352f,-0.990897954f,0.615864813f,-0.99298501f,-0.128844544f,0.576808274f,0.858946681f,0.954652011f,
0.985584795f,0.995433986f,0.998555362f,0.999543071f,0.999855518f,0.999954283f,0.999985576f,0.99999541f,
0.660316706f,-0.766536534f,0.830336154f,-0.998241663f,-0.227202162f,0.529984176f,0.842327058f,0.949207008f,
0.983843684f,0.994881511f,0.998380423f,0.999487758f,0.999837995f,0.9999488f,0.999983788f,0.999994874f,
0.988704622f,-0.306095392f,0.962463796f,-0.972014248f,-0.323289543f,0.481484592f,0.824865162f,0.943461835f,
0.982004225f,0.994297504f,0.998195529f,0.999429286f,0.999819517f,0.999942899f,0.99998194f,0.999994278f,
0.408082068f,0.248616725f,0.999144375f,-0.91512996f,-0.416146845f,0.431462824f,0.806578457f,0.937418282f,
0.980066597f,0.993682086f,0.998000681f,0.999367595f,0.999800026f,0.999936759f,0.999979973f,0.999993682f,
-0.547729254f,0.726760268f,0.936740458f,-0.829382956f,-0.504846215f,0.380077004f,0.787485182f,0.931078374f,
0.97803092f,0.993035257f,0.99779582f,0.999302804f,0.999779522f,0.999930263f,0.999977946f,0.999993026f,
-0.99996084f,0.981074572f,0.781440377f,-0.717477441f,-0.588501155f,0.327489585f,0.767604589f,0.92444396f,
0.975897431f,0.992357016f,0.997581005f,0.999234855f,0.999758005f,0.999923468f,0.999975801f,0.999992371f,
-0.53283304f,0.933235765f,0.548645258f,-0.582943261f,-0.666275978f,0.273866832f,0.746956408f,0.917517304f,
0.97366637f,0.991647422f,0.997356176f,0.999163687f,0.999735534f,0.999916375f,0.999973536f,0.999991655f,
0.424179018f,0.597977161f,0.261441678f,-0.430023283f,-0.737393796f,0.219378278f,0.725561321f,0.910300434f,
0.971337974f,0.990906477f,0.997121394f,0.99908942f,0.99971199f,0.999908924f,0.999971211f,0.99999088f,
0.991202831f,0.078552261f,-0.0516893305f,-0.263540596f,-0.801143587f,0.164196163f,0.703440726f,0.902795732f,
0.968912423f,0.99013412f,0.996876657f,0.999011934f,0.999687493f,0.999901175f,0.999968767f,0.999990106f,
0.64691931f,-0.465064496f,-0.359694332f,-0.0887455046f,-0.856888831f,0.108494945f,0.680616796f,0.895005584f,
0.966389954f,0.98933053f,0.996621907f,0.998931348f,0.999662042f,0.999893129f,0.999966204f,0.999989331f,
-0.292138815f,-0.865450621f,-0.632028639f,0.088848114f,-0.904072165f,0.0524506159f,0.6571123f,0.886932373f,
0.963770926f,0.988495648f,0.996357203f,0.998847544f,0.999635518f,0.999884725f,0.999963522f,0.999988496f,
-0.962605894f,-0.999293387f,-0.841684937f,0.26363951f,-0.942222297f,-0.00375941908f,0.632950664f,0.878578722f,
0.961055458f,0.987629473f,0.996082544f,0.998760641f,0.99960804f,0.999876022f,0.99996078f,0.999987602f,
-0.748057544f,-0.825371623f,-0.967871487f,0.430115849f,-0.970958173f,-0.0599575676f,0.608156204f,0.869947195f,
0.958243906f,0.986732066f,0.995797932f,0.998670578f,0.999579549f,0.999867022f,0.999957979f,0.999986708f,
0.154251456f,-0.397251874f,-0.998075247f,0.583026946f,-0.989992499f,-0.115966164f,0.582753658f,0.861040652f,
0.955336511f,0.985803485f,0.995503366f,0.998577297f,0.999550045f,0.999857724f,0.999954998f,0.999985754f,
0.914742351f,0.153215483f,-0.929300308f,0.717549205f,-0.999135137f,-0.171608135f,0.556768358f,0.851861775f,
0.95233357f,0.984843671f,0.995198846f,0.998480916f,0.999519527f,0.999848068f,0.999951959f,0.999984801f,
0.83422339f,0.656495154f,-0.768367112f,0.829440355f,-0.998294771f,-0.226707578f,0.53022635f,0.842413545f,
0.949235439f,0.983852804f,0.994884372f,0.998381376f,0.999488056f,0.999838114f,0.9999488f,0.999983788f,
-0.0132767474f,0.95758605f,-0.531235278f,0.915171385f,-0.987479806f,-0.281090319f,0.503154159f,0.832698941f,
0.946042359f,0.982830763f,0.994559944f,0.998278618f,0.999455571f,0.999827802f,0.999945521f,0.999982774f,
-0.848570287f,0.963757515f,-0.241421118f,0.972038329f,-0.966798186f,-0.334584385f,0.475578904f,0.822721004f,
0.942754686f,0.981777668f,0.994225562f,0.99817276f,0.999422073f,0.999817252f,0.999942183f,0.999981701f,
-0.903692186f,0.673110247f,0.0723346695f,0.998247743f,-0.93645668f,-0.387020677f,0.447528064f,0.812482953f,
0.939372718f,0.980693519f,0.993881226f,0.998063743f,0.999387562f,0.999806345f,0.999938726f,0.999980628f,
-0.127963692f,0.175156534f,0.378916174f,0.992972851f,-0.896758378f,-0.438233554f,0.419029742f,0.801987886f,
0.935896814f,0.979578316f,0.993526995f,0.997951567f,0.999352098f,0.999795079f,0.99993521f,0.999979496f,
0.765414059f,-0.376742303f,0.647921681f,0.95638001f,-0.848100007f,-0.488060862f,0.39011243f,0.791239262f,
0.93232733f,0.978432178f,0.993162811f,0.997836173f,0.99931556f,0.999783576f,0.999931574f,0.999978364f,
0.955073655f,-0.812611222f,0.852673113f,0.889623463f,-0.790967762f,-0.536345184f,0.360805035f,0.780240417f,
0.928664625f,0.977255106f,0.992788672f,0.997717679f,0.999278069f,0.999771714f,0.999927819f,0.999977171f,
0.266642928f,-0.998210371f,0.972865343f,0.794808388f,-0.72593224f,-0.582933903f,0.331136853f,0.768994927f,
0.924909055f,0.976047099f,0.99240464f,0.997596025f,0.999239624f,0.999759495f,0.999923944f,0.999975979f,
-0.666938066f,-0.87637943f,0.996578991f,0.674925625f,-0.653643608f,-0.627679706f,0.301137596f,0.757506192f,
0.921060979f,0.974808276f,0.992010653f,0.997471273f,0.999200106f,0.999747038f,0.999920011f,0.999974728f,
-0.987339258f,-0.484639406f,0.921462357f,0.533756077f,-0.574824035f,-0.670441091f,0.270837069f,0.745777905f,
0.917120814f,0.973538578f,0.991606772f,0.997343302f,0.999159634f,0.999734223f,0.999915957f,0.999973416f,
-0.399985313f,0.0563609414f,0.754965365f,0.375752151f,-0.490260571f,-0.711082935f,0.240265876f,0.733813822f,
0.913088918f,0.972238123f,0.991192937f,0.997212172f,0.999118149f,0.99972111f,0.999911785f,0.999972105f,
0.555113316f,0.580003142f,0.513598442f,0.205897167f,-0.400799006f,-0.749476731f,0.209454417f,0.721617639f,
0.908965766f,0.970906913f,0.990769207f,0.997077882f,0.999075651f,0.999707639f,0.999907553f,0.999970794f,
0.999843299f,0.925014675f,0.221298173f,0.0295478199f,-0.307332784f,-0.785501122f,0.178433523f,0.709193349f,
0.904751658f,0.969545007f,0.990335584f,0.996940494f,0.99903214f,0.99969393f,0.999903202f,0.999969363f,
0.52532196f,0.985138178f,-0.0929481089f,-0.147732988f,-0.210795805f,-0.819042206f,0.147234216f,0.696544766f,
0.90044713f,0.968152404f,0.989892066f,0.996799886f,0.998987675f,0.999679863f,0.999898732f,0.999967992f,
-0.432177931f,0.741858006f,-0.397976756f,-0.320354372f,-0.112152621f,-0.849993885f,0.115887694f,0.683675885f,
0.89605248f,0.966729224f,0.989438653f,0.996656179f,0.998942196f,0.999665439f,0.999894202f,0.999966562f,
-0.992335498f,0.270098448f,-0.663538277f,-0.48287195f,-0.0123883775f,-0.878258407f,0.0844252855f,0.670590878f,
0.891568303f,0.965275466f,0.988975346f,0.996509314f,0.998895705f,0.999650776f,0.999889553f,0.999965072f,
-0.640144348f,-0.284846604f,-0.863296509f,-0.630159974f,0.0874991715f,-0.903746367f,0.0528784581f,0.657293737f,
0.886994898f,0.963791192f,0.988502085f,0.996359289f,0.9988482f,0.999635756f,0.999884784f,0.999963582f,
0.300592542f,-0.75206399f,-0.977442741f,-0.757573068f,0.18651247f,-0.926377118f,0.0212787576f,0.643788815f,
0.882332861f,0.962276459f,0.98801899f,0.996206105f,0.998799741f,0.999620378f,0.999879956f,0.999962032f,
0.964965999f,-0.987659097f,-0.994656444f,-0.861092687f,0.2836622f,-0.946079254f,-0.0103422189f,0.630080283f,
0.87758255f,0.960731268f,0.987526f,0.996049762f,0.998750269f,0.999604762f,0.999875009f,0.999960482f,
0.742154181f,-0.919073522f,-0.913230121f,-0.937454224f,0.377977669f,-0.96279037f,-0.0419528559f,0.616172493f,
0.872744501f,0.959155679f,0.987023175f,0.99589026f,0.998699784f,0.999588788f,0.999869943f,0.999958873f,
-0.162990779f,-0.567430019f,-0.741239965f,-0.984248459f,0.468516916f,-0.976457715f,-0.0735215396f,0.602069914f,
0.86781919f,0.95754981f,0.986510456f,0.995727658f,0.998648286f,0.999572515f,0.999864817f,0.999957263f,
-0.918282807f,-0.0410281904f,-0.495741814f,-1.f,0.554374516f,-0.987038016f,-0.105016708f,0.587776959f,
0.862807095f,0.955913603f,0.985987842f,0.995561838f,0.998595834f,0.999555886f,0.999859571f,0.999955595f,
-0.829309821f,0.498009592f,-0.201079622f,-0.984212041f,0.634692967f,-0.994497895f,-0.136406869f,0.573298037f,
0.857708693f,0.954247177f,0.985455394f,0.995392919f,0.998542368f,0.999538958f,0.999854207f,0.999953866f,
0.0221267566f,0.883669317f,0.113521777f,-0.937382519f,0.708669782f,-0.998813629f,-0.167660639f,0.558637917f,
0.852524519f,0.95255059f,0.984913111f,0.99522084f,0.99848789f,0.999521732f,0.999848783f,0.999952197f,
0.853220105f,0.997174621f,0.416867077f,-0.860988438f,0.775565803f,-0.999971747f,-0.198746875f,0.543801069f,
0.847255111f,0.950823903f,0.984360933f,0.995045662f,0.998432398f,0.999504209f,0.99984318f,0.999950409f,
0.899866819f,0.803569078f,0.678870201f,-0.757439196f,0.834712923f,-0.997968495f,-0.22963427f,0.528792322f,
0.841901004f,0.949067116f,0.983798921f,0.994867265f,0.998375952f,0.999486327f,0.999837577f,0.999948621f,
0.119180135f,0.362476677f,0.873550534f,-0.63000071f,0.885519624f,-0.99281019f,-0.260292053f,0.513616323f,
0.836462677f,0.947280347f,0.983227074f,0.994685769f,0.998318493f,0.999468148f,0.999831796f,0.999946833f,
-0.771080196f,-0.1902491f,0.981602073f,-0.482692331f,0.927478492f,-0.984513164f,-0.290689558f,0.498277903f,
0.830940723f,0.945463598f,0.982645452f,0.994501114f,0.998260021f,0.99944967f,0.999825954f,0.999944985f,
-0.952412963f,-0.684381902f,0.992308319f,-0.320159167f,0.960170269f,-0.973103702f,-0.3207964f,0.482782036f,
0.825335622f,0.943616986f,0.982053936f,0.9943133f,0.998200536f,0.999430835f,0.999819994f,0.999943078f,
-0.258101642f,-0.967739642f,0.904607594f,-0.1475292f,0.98326844f,-0.958617806f,-0.350582451f,0.467133403f,
0.819648027f,0.941740453f,0.981452644f,0.994122326f,0.998140097f,0.999411702f,0.999813974f,0.99994117f,
0.673507154f,-0.953050017f,0.727198064f,0.0297537707f,0.996542096f,-0.941101313f,-0.380017966f,0.451337039f,
0.813878477f,0.939834237f,0.980841517f,0.993928254f,0.998078644f,0.999392271f,0.999807835f,0.999939203f,
0.985896587f,-0.644837022f,0.477671444f,0.206098333f,0.999858618f,-0.920609534f,-0.409073502f,0.435397953f,
0.808027506f,0.937898219f,0.980220556f,0.993731022f,0.998016179f,0.999372482f,0.999801576f,0.999937236f,
};
__device__ const float ROPE_SIN[1024] = {
0.f,0.f,0.f,0.f,0.f,0.f,0.f,0.f,
0.f,0.f,0.f,0.f,0.f,0.f,0.f,0.f,
0.841470957f,0.533168435f,0.310983598f,0.176892191f,0.0998334214f,0.0562044978f,0.0316175036f,0.0177818574f,
0.00999983307f,0.00562338345f,0.00316227227f,0.0017782785f,0.000999999931f,0.000562341243f,0.000316227757f,0.00017782794f,
0.909297407f,0.902130723f,0.591127098f,0.348205268f,0.198669329f,0.112231314f,0.0632033944f,0.0355580896f,
0.0199986659f,0.011246589f,0.00632451288f,0.00355655141f,0.0019999987f,0.00112468237f,0.000632455456f,0.00035565588f,
0.141120002f,0.993253171f,0.812648892f,0.5085361f,0.295520216f,0.167903304f,0.0947260857f,0.0533230826f,
0.0299954992f,0.0168694388f,0.00948669016f,0.00533481315f,0.0029999956f,0.00168702309f,0.000948683126f,0.000533483806f,
-0.756802499f,0.778471708f,0.953580737f,0.652827978f,0.389418334f,0.223044485f,0.126154065f,0.0710712075f,
0.0399893336f,0.0224917568f,0.0126487734f,0.00711305765f,0.00399998948f,0.00224936334f,0.00126491068f,0.000711311703f,
-0.958924294f,0.32393527f,0.999946535f,0.776529968f,0.47942555f,0.277480543f,0.157455876f,0.0887968615f,
0.0499791652f,0.0281133614f,0.0158107281f,0.00889127981f,0.0049999794f,0.0028117029f,0.00158113812f,0.000889139599f,
-0.279415488f,-0.230367512f,0.947148204f,0.875740528f,0.564642489f,0.33103931f,0.188600272f,0.106494442f,
0.0599640049f,0.0337340795f,0.0189725272f,0.0106694745f,0.0059999642f,0.00337404152f,0.00189736532f,0.00106696738f,
0.656986594f,-0.713721275f,0.800421596f,0.947330713f,0.64421767f,0.383551568f,0.219556093f,0.124158338f,
0.0699428469f,0.0393537246f,0.0221341345f,0.0124476347f,0.00699994294f,0.00393637875f,0.00221359241f,0.00124479528f,
0.989358246f,-0.977261782f,0.574317753f,0.989042461f,0.717356086f,0.434851229f,0.250292331f,0.141782969f,
0.0799146891f,0.0449721329f,0.0252955221f,0.0142257558f,0.0079999147f,0.00449871505f,0.00252981926f,0.00142262306f,
0.412118495f,-0.939823508f,0.291259229f,0.999560297f,0.783326924f,0.484776139f,0.280778319f,0.159362778f,
0.0898785442f,0.0505891182f,0.0284566563f,0.0160038304f,0.00899987947f,0.00506105041f,0.00284604589f,0.00160045072f,
-0.54402113f,-0.612936914f,-0.0206835698f,0.978552461f,0.841470957f,0.533168435f,0.310983568f,0.176892191f,
0.099833414f,0.0562044978f,0.0316175036f,0.0177818574f,0.009999834f,0.00562338345f,0.00316227227f,0.0017782785f,
-0.999990225f,-0.0972764567f,-0.33057496f,0.926681578f,0.891207397f,0.579875171f,0.340877861f,0.19436565f,
0.1097783f,0.0618181042f,0.0347780399f,0.0195598267f,0.0109997792f,0.00618571462f,0.00347849843f,0.00195610616f,
-0.536572933f,0.448342979f,-0.60768342f,0.845583618f,0.932039082f,0.624748647f,0.370431304f,0.211777672f,
0.119712204f,0.0674297586f,0.0379382223f,0.0213377345f,0.0119997123f,0.0067480444f,0.00379472389f,0.00213393359f,
0.420167029f,0.855880976f,-0.824528456f,0.737816215f,0.963558197f,0.667647004f,0.399614304f,0.229122713f,
0.129634142f,0.0730392784f,0.0410980321f,0.0231155735f,0.0129996343f,0.00731037185f,0.00411094911f,0.00231176103f,
0.990607381f,0.999823332f,-0.959605396f,0.606778562f,0.985449731f,0.708434701f,0.428397775f,0.246395305f,
0.139543116f,0.078646481f,0.0442574248f,0.0248933397f,0.0139995432f,0.00787269697f,0.00442717411f,0.00248958869f,
0.650287867f,0.835838437f,-0.999518692f,0.456603259f,0.997494996f,0.746982634f,0.456752867f,0.263589978f,
0.149438128f,0.0842512026f,0.0474163815f,0.0266710296f,0.0149994381f,0.00843502022f,0.00474339863f,0.00266741589f,
-0.287903309f,0.414430231f,-0.940310359f,0.292027086f,0.999573588f,0.783169091f,0.484651238f,0.280701309f,
0.159318209f,0.0898532644f,0.0505748577f,0.028448632f,0.015999319f,0.00899733976f,0.00505962269f,0.00284524332f,
-0.961397469f,-0.134615138f,-0.78785187f,0.11824052f,0.991664827f,0.81687957f,0.512064993f,0.29772386f,
0.169182345f,0.09545248f,0.0537328273f,0.0302261449f,0.0169991814f,0.00955965649f,0.00537584582f,0.00302307028f,
-0.750987232f,-0.642200708f,-0.557262897f,-0.0592755191f,0.973847628f,0.84800756f,0.538966715f,0.314652264f,
0.179029569f,0.101048686f,0.0568902642f,0.0320035629f,0.0179990288f,0.0101219704f,0.00569206895f,0.00320089748f,
0.149877205f,-0.952000856f,-0.271410108f,-0.234921798f,0.946300089f,0.876454532f,0.565329552f,0.331481189f,
0.188858896f,0.10664168f,0.060047131f,0.0337808803f,0.0189988576f,0.0106842816f,0.00600829115f,0.00337872445f,
0.912945271f,-0.968601942f,0.0413582884f,-0.403158993f,0.909297407f,0.902130723f,0.591127038f,0.348205268f,
0.198669314f,0.112231314f,0.0632033944f,0.0355580896f,0.0199986678f,0.011246589f,0.00632451288f,0.00355655141f,
0.836655617f,-0.686891198f,0.35002476f,-0.558680534f,0.863209307f,0.924954832f,0.616333544f,0.364819258f,
0.208459899f,0.117817394f,0.0663590282f,0.0373351872f,0.0209984574f,0.0118088927f,0.00664073415f,0.00373437814f,
-0.00885130931f,-0.193630233f,0.623979926f,-0.696581721f,0.808496356f,0.944854796f,0.640923738f,0.381317884f,
0.218229622f,0.123399742f,0.0695140064f,0.0391121693f,0.0219982266f,0.0123711927f,0.00695695449f,0.00391220488f,
-0.846220434f,0.359264523f,0.836055279f,-0.812512875f,0.745705247f,0.961767614f,0.664873064f,0.397695929f,
0.227977514f,0.128978193f,0.0726682767f,0.0408890247f,0.0229979735f,0.0129334899f,0.00727317436f,0.00409003161f,
-0.905578375f,0.801513135f,0.965219259f,-0.902817786f,0.67546314f,0.97563988f,0.688157499f,0.413948208f,
0.237702623f,0.134552568f,0.0758218244f,0.0426657498f,0.0239976961f,0.0134957815f,0.0075893933f,0.00426785741f,
-0.132351756f,0.996909976f,0.998663187f,-0.964648306f,0.598472118f,0.986427724f,0.710753918f,0.430069596f,
0.247403964f,0.140122697f,0.0789746121f,0.0444423407f,0.0249973964f,0.0140580693f,0.00790561177f,0.00444568414f,
0.76255846f,0.885276794f,0.933070183f,-0.996054351f,0.515501261f,0.994096994f,0.732639611f,0.446054995f,
0.257080555f,0.145688385f,0.0821266174f,0.0462187938f,0.0259970706f,0.0146203535f,0.00822182931f,0.00462350994f,
0.956375957f,0.500994205f,0.774945021f,-0.996045172f,0.427379847f,0.99862349f,0.753792703f,0.46189931f,
0.266731411f,0.151249468f,0.0852777958f,0.0479951017f,0.0269967206f,0.015182632f,0.00853804592f,0.00480133574f,
0.270905793f,-0.0375856608f,0.539968967f,-0.964621305f,0.334988207f,0.999992907f,0.774192095f,0.477597594f,
0.276355654f,0.156805754f,0.0884281173f,0.049771253f,0.0279963426f,0.0157449059f,0.0088542616f,0.00497916201f,
-0.663633883f,-0.564589798f,0.251445323f,-0.902773678f,0.239249229f,0.998200953f,0.793817401f,0.49314484f,
0.28595221f,0.162357092f,0.0915775672f,0.0515472479f,0.0289959367f,0.0163071752f,0.00917047635f,0.00515698735f,
-0.988031626f,-0.917709649f,-0.0620148405f,-0.812452853f,0.141120002f,0.993253171f,0.812648892f,0.5085361f,
0.295520186f,0.167903304f,0.0947260931f,0.0533230826f,0.029995501f,0.0168694388f,0.00948669016f,0.00533481315f,
-0.404037654f,-0.988192797f,-0.369325012f,-0.696507812f,0.0415805206f,0.985165298f,0.830667794f,0.523766637f,
0.305058628f,0.173444211f,0.0978736654f,0.055098746f,0.0309950355f,0.0174316969f,0.00980290305f,0.00551263802f,
0.551426709f,-0.754330218f,-0.640009403f,-0.5585953f,-0.0583741926f,0.973962843f,0.847856104f,0.538831532f,
0.314566553f,0.17897962f,0.101020269f,0.0568742342f,0.0319945402f,0.0179939512f,0.0101191159f,0.00569046335f,
0.999911845f,-0.28814739f,-0.847224355f,-0.403064936f,-0.157745644f,0.959681332f,0.864196658f,0.553726017f,
0.324043006f,0.184509367f,0.10416586f,0.0586495437f,0.0329940096f,0.0185561981f,0.010435327f,0.00586828869f,
0.529082716f,0.266779721f,-0.97042042f,-0.234822124f,-0.255541205f,0.942365825f,0.879673064f,0.568445385f,
0.333487093f,0.190033287f,0.107310407f,0.0604246669f,0.0339934528f,0.0191184394f,0.010751537f,0.00604611309f,
-0.428182662f,0.739542127f,-0.997380435f,-0.0591726787f,-0.350783229f,0.92207104f,0.894269884f,0.582984984f,
0.342897803f,0.195551202f,0.110453881f,0.0621996038f,0.034992855f,0.0196806751f,0.0110677453f,0.00622393796f,
-0.991778851f,0.984540582f,-0.925431013f,0.118342586f,-0.442520559f,0.89886117f,0.907972515f,0.597340286f,
0.352274209f,0.201062918f,0.113596253f,0.0639743358f,0.0359922275f,0.0202429052f,0.0113839535f,0.0064017619f,
-0.643538117f,0.926318109f,-0.761706948f,0.292125374f,-0.529836178f,0.872809589f,0.920767248f,0.611506701f,
0.361615449f,0.206568271f,0.116737492f,0.0657488778f,0.036991559f,0.0208051261f,0.0117001599f,0.0065795863f,
0.296368569f,0.58280617f,-0.522444785f,0.456694692f,-0.611857831f,0.84399873f,0.932641268f,0.625479698f,
0.370920479f,0.212067112f,0.119877554f,0.0675232038f,0.0379908569f,0.0213673431f,0.0120163653f,0.00675741071f,
0.963795364f,0.0598003156f,-0.231372014f,0.606860459f,-0.687766254f,0.81251961f,0.943582714f,0.639254928f,
0.380188406f,0.217559248f,0.123016424f,0.0692973137f,0.0389901139f,0.0219295528f,0.0123325698f,0.00693523418f,
0.745113134f,-0.481621295f,0.0826458037f,0.737885714f,-0.756802499f,0.778471708f,0.953580678f,0.652827978f,
0.389418334f,0.223044485f,0.126154065f,0.0710712075f,0.0399893373f,0.0224917568f,0.0126487734f,0.00711305765f,
-0.158622667f,-0.874714017f,0.388467699f,0.845638454f,-0.818277061f,0.74196279f,0.962625206f,0.666194677f,
0.39860931f,0.228522688f,0.129290432f,0.0728448778f,0.0409885161f,0.0230539497f,0.0129649751f,0.00729088066f,
-0.916521549f,-0.998410463f,0.655764699f,0.926720202f,-0.871575892f,0.703108132f,0.970707119f,0.679350674f,
0.407760441f,0.233993664f,0.132425532f,0.0746183172f,0.0419876575f,0.0236161388f,0.0132811759f,0.00746870413f,
-0.831774771f,-0.814614236f,0.858030677f,0.97857362f,-0.916166008f,0.662030637f,0.977818429f,0.692291796f,
0.416870773f,0.23945722f,0.135559291f,0.0763915181f,0.0429867506f,0.0241783205f,0.0135973748f,0.00764652714f,
0.0177019257f,-0.37993139f,0.975206196f,0.999563396f,-0.951602101f,0.618860185f,0.983951986f,0.70501405f,
0.425939471f,0.244913206f,0.138691694f,0.0781644881f,0.0439858064f,0.0247404929f,0.0139135728f,0.00782434922f,
0.850903511f,0.171763569f,0.995670974f,0.989027262f,-0.977530122f,0.57373327f,0.989101648f,0.717513323f,
0.434965521f,0.250361472f,0.141822711f,0.0799371973f,0.0449848175f,0.0253026579f,0.0142297689f,0.00800217129f,
0.901788354f,0.670557022f,0.917395473f,0.947297752f,-0.993690968f,0.526792526f,0.993262351f,0.72978574f,
0.44394809f,0.255801797f,0.144952312f,0.0817096606f,0.0459837839f,0.0258648153f,0.0145459641f,0.0081799943f,
0.123573124f,0.962832689f,0.748142362f,0.875690997f,-0.999923289f,0.478186339f,0.996429801f,0.741827428f,
0.452886283f,0.261234075f,0.148080453f,0.0834818557f,0.0469827019f,0.0264269635f,0.0148621574f,0.00835781638f,
-0.768254638f,0.958573103f,0.504697084f,0.776465356f,-0.99616462f,0.428068399f,0.99860096f,0.753634512f,
0.461779177f,0.266658038f,0.151207119f,0.0852537975f,0.0479815714f,0.0269891042f,0.0151783489f,0.00853563752f,
-0.953752637f,0.659090102f,0.211200655f,0.652750373f,-0.982452571f,0.376597136f,0.999773562f,0.765203178f,
0.470625877f,0.272073567f,0.15433228f,0.087025471f,0.0489803962f,0.0275512375f,0.0154945394f,0.0087134596f,
-0.262374848f,0.156619072f,-0.10324046f,0.508447945f,-0.958924294f,0.32393527f,0.999946535f,0.776529968f,
0.47942555f,0.277480543f,0.157455891f,0.0887968615f,0.0499791689f,0.0281133596f,0.0158107281f,0.00889127981f,
0.670229197f,-0.394086063f,-0.407444149f,0.3481085f,-0.925814748f,0.270249337f,0.99911958f,0.787611187f,
0.48817724f,0.282878697f,0.160577938f,0.0905679762f,0.0509778969f,0.0286754742f,0.0161269177f,0.00906910095f,
0.986627579f,-0.823421597f,-0.671240151f,0.176790684f,-0.883454502f,0.215709001f,0.997293651f,0.798443377f,
0.496880114f,0.28826794f,0.163698375f,0.0923388004f,0.051976569f,0.0292375814f,0.0164431017f,0.00924692024f,
0.395925164f,-0.999157965f,-0.868469954f,-0.000103020677f,-0.832267344f,0.160486728f,0.994470477f,0.809023023f,
0.505533338f,0.293648034f,0.166817173f,0.0941093415f,0.0529751927f,0.0297996756f,0.0167592876f,0.00942474138f,
-0.558789074f,-0.867171526f,-0.979574919f,-0.176993474f,-0.772764444f,0.104756832f,0.990652919f,0.819346905f,
0.514135957f,0.29901889f,0.169934288f,0.0958795771f,0.0539737605f,0.0303617641f,0.0170754679f,0.00960256159f,
-0.999755144f,-0.468111664f,-0.993535519f,-0.348301649f,-0.705540299f,0.0486960001f,0.985844791f,0.829411685f,
0.522687256f,0.304380238f,0.173049718f,0.0976495072f,0.0549722798f,0.0309238415f,0.01739165f,0.00978038087f,
-0.521551013f,0.0751182064f,-0.908967435f,-0.508624554f,-0.631266713f,-0.00751878507f,0.980050862f,0.839214146f,
0.531186223f,0.30973196f,0.17616342f,0.0994191393f,0.0559707358f,0.0314859077f,0.0177078284f,0.00995820016f,
0.436164767f,0.595211506f,-0.734258294f,-0.652905703f,-0.550685287f,-0.0637097955f,0.973276973f,0.848751247f,
0.539632022f,0.315073937f,0.179275364f,0.101188451f,0.0569691435f,0.0320479684f,0.0180240069f,0.0101360194f,
0.992872655f,0.931992829f,-0.486733496f,-0.776594579f,-0.464602023f,-0.119699396f,0.965529919f,0.858020008f,
0.548023939f,0.3204059f,0.182385504f,0.102957435f,0.0579674877f,0.0326100141f,0.0183401816f,0.0103138378f,
0.636738002f,0.981735826f,-0.190938011f,-0.87579f,-0.373876572f,-0.175310582f,0.956817448f,0.867017388f,
0.55636102f,0.325727791f,0.185493827f,0.104726106f,0.0589657798f,0.0331720486f,0.0186563563f,0.0104916561f,
-0.304810613f,0.729123712f,0.12379095f,-0.947363734f,-0.279415488f,-0.230367512f,0.947148204f,0.875740528f,
0.564642429f,0.33103931f,0.188600287f,0.106494442f,0.0599640086f,0.0337340795f,0.0189725272f,0.0106694745f,
-0.966117799f,0.251952261f,0.426245421f,-0.98905772f,-0.182162598f,-0.284696162f,0.936531842f,0.884186864f,
0.572867453f,0.336340427f,0.191704854f,0.108262435f,0.0609621815f,0.0342960916f,0.0192886982f,0.0108472919f,
-0.739180684f,-0.302812874f,0.686427653f,-0.999557257f,-0.0830891207f,-0.338124752f,0.924979091f,0.892353535f,
0.581035137f,0.341630876f,0.194807529f,0.110030092f,0.0619602874f,0.0348580964f,0.0196048655f,0.0110251084f,
0.167355701f,-0.764320076f,0.878538549f,-0.978531301f,0.0168140903f,-0.390484393f,0.912501454f,0.900238097f,
0.589144766f,0.346910536f,0.197908238f,0.111797392f,0.0629583374f,0.0354200937f,0.0199210308f,0.0112029258f,
};
#define XB_TMO      128
#define XB_XCNT(j)  (256  + 64 * (j))
#define XB_XSUB(j)  (1280 + 64 * (j))
#define XB_XGEN(j)  (2304 + 64 * (j))
#define XB_TOP      3328
#define XB_TOPGEN   3392
#define XCD_BAR_WORDS 3456
#define XB_SPIN_CAP (1u << 18)
#define LAS __attribute__((address_space(3)))

__device__ __forceinline__ unsigned xb_ld(unsigned* p)              { return __hip_atomic_load(p, __ATOMIC_RELAXED, __HIP_MEMORY_SCOPE_AGENT); }
__device__ __forceinline__ unsigned xb_add(unsigned* p, unsigned v) { return __hip_atomic_fetch_add(p, v, __ATOMIC_RELAXED, __HIP_MEMORY_SCOPE_AGENT); }
__device__ __forceinline__ unsigned xb_xcc_id() { return (unsigned)__builtin_amdgcn_s_getreg((3 << 11) | 20) & 0xFu; }
#define XB_SPIN(cond, bar) do { unsigned _sp = 0; while (cond) { __builtin_amdgcn_s_sleep(1); \
    if ((++_sp & 255u) == 0u) { if (xb_ld(&(bar)[XB_TMO])) break; if (_sp > XB_SPIN_CAP) { atomicAdd(&(bar)[XB_TMO], 1u); break; } } } } while (0)

struct XcdBarrier {
    unsigned* bar; unsigned x;
    volatile LAS unsigned* st;
};

__device__ __forceinline__ XcdBarrier xcd_barrier_post(unsigned* bar, volatile LAS unsigned* st) {
    XcdBarrier b; b.bar = bar; b.x = xb_xcc_id(); b.st = st;
    if (threadIdx.x == 0) (void)xb_add(&bar[XB_XCNT(b.x)], 1u);
    return b;
}
__device__ __forceinline__ void xcd_barrier_complete(unsigned* bar, unsigned x, unsigned& nloc, unsigned& nx) {
    const unsigned G = gridDim.x * gridDim.y * gridDim.z;
    unsigned sum, cnt, mine, sp = 0u;
    for (;;) {
        sum = 0u; cnt = 0u; mine = 0u;
#pragma unroll
        for (unsigned j = 0; j < 16; ++j) { const unsigned c = xb_ld(&bar[XB_XCNT(j)]); sum += c; cnt += (c > 0u) ? 1u : 0u; mine = (j == x) ? c : mine; }
        if (sum == G) break;
        __builtin_amdgcn_s_sleep(1);
        if ((++sp & 255u) == 0u) { if (xb_ld(&bar[XB_TMO])) break; if (sp > XB_SPIN_CAP) { atomicAdd(&bar[XB_TMO], 1u); break; } }
    }
    nloc = mine > 0u ? mine : 1u; nx = cnt > 0u ? cnt : 1u;
}

__device__ __forceinline__ void xcd_barrier(const XcdBarrier& b) {
    asm volatile("s_waitcnt vmcnt(0)" ::: "memory");
    __syncthreads();
    if (threadIdx.x == 0) {
        unsigned* bar = b.bar;
        __builtin_amdgcn_s_waitcnt(0);
        unsigned nloc = b.st[0], nx = b.st[1];
        if (nloc == 0u) { xcd_barrier_complete(bar, b.x, nloc, nx); b.st[0] = nloc; b.st[1] = nx; }
        const unsigned old = xb_add(&bar[XB_XSUB(b.x)], 1u);
        const unsigned gen = old / nloc;
        if (old + 1u == (gen + 1u) * nloc) {
            __builtin_amdgcn_fence(__ATOMIC_RELEASE, "agent");
            asm volatile("s_waitcnt vmcnt(0)" ::: "memory");
            const unsigned og = xb_add(&bar[XB_TOP], 1u);
            const unsigned tg = og / nx;
            if (og + 1u == (tg + 1u) * nx) xb_add(&bar[XB_TOPGEN], 1u);
            else XB_SPIN(xb_ld(&bar[XB_TOPGEN]) == tg, bar);
            __builtin_amdgcn_fence(__ATOMIC_ACQUIRE, "agent");
            xb_add(&bar[XB_XGEN(b.x)], 1u);
            asm volatile("s_waitcnt vmcnt(0)" ::: "memory");
        } else {
            XB_SPIN(xb_ld(&bar[XB_XGEN(b.x)]) == gen, bar);
            __builtin_amdgcn_fence(__ATOMIC_ACQUIRE, "agent");
            asm volatile("s_waitcnt vmcnt(0)" ::: "memory");
        }
    }
    __syncthreads();
}

namespace pg8 {
#define PG8_LAS __attribute__((address_space(3)))
typedef unsigned short bf16_t;
typedef short bf16x8 __attribute__((ext_vector_type(8)));
typedef float f32x4 __attribute__((ext_vector_type(4)));
typedef unsigned u32x4 __attribute__((ext_vector_type(4)));
constexpr int BM = 256, BK = 64, HALF = 128, HTB = HALF * BK * 2  , STAGE_BYTES = 8 * HTB, NXCD = 8, WGM = 8;

__host__ __device__ __forceinline__ int lds_byte(int r, int c) { const int st = (r >> 4) * 2 + (c >> 5), rr = r & 15, cc = c & 31, ob = rr * 64 + cc * 2; return st * 1024 + (ob ^ (((ob >> 9) & 1) << 5)); }
__host__ __device__ __forceinline__ void stage_rc(int b, int& R, int& C) { const int st = b / 1024, sb = b % 1024, swz = sb ^ (((sb >> 9) & 1) << 5); R = (st >> 1) * 16 + swz / 64; C = (st & 1) * 32 + (swz % 64) / 2; }
__host__ __device__ __forceinline__ int perm32(int rho) { const int n = rho >> 4, i = rho & 15; return 8 * (i >> 2) + 4 * n + (i & 3); }

struct Unit { int pm, pn; };
struct Gemm { const bf16_t* A; const bf16_t* Bt; int M, N, K; };

struct StaticOrder {
    int nM, nN, nwg, G, c;
    __host__ __device__ void init(int M, int N, int G_, int c_) { nM = M / BM; nN = N / BM; nwg = nM * nN; G = G_; c = c_; }
    __host__ __device__ bool next(int i, Unit& u) const {
        const long L = (long)i * G + c; if (L >= nwg) return false;
        int wgid = (int)L; { const int q = nwg / NXCD, r = nwg % NXCD, xcd = wgid % NXCD, off = wgid / NXCD; wgid = (xcd < r ? xcd * (q + 1) : r * (q + 1) + (xcd - r) * q) + off; }
        const int nig = WGM * nN, gid = wgid / nig, fm = gid * WGM, gsz = (nM - fm) < WGM ? (nM - fm) : WGM;
        u.pm = fm + ((wgid % nig) % gsz); u.pn = (wgid % nig) / gsz; return true;
    }
    __device__ __forceinline__ void a_ready(const Unit&) const {}
    __device__ __forceinline__ void done(const Unit&) const {}
};
template <class Epi, class Sched, bool ALIGN_EPI = false, bool SP2 = false>
__device__ __forceinline__ void gemm_phase(PG8_LAS unsigned char* lds, const Gemm g, const Sched& S, const Epi& E) {
    int tid = threadIdx.x; asm volatile("" : "+v"(tid)); const int wid = __builtin_amdgcn_readfirstlane(tid >> 6), lane = tid & 63, wr = wid >> 2, wc = wid & 3, fr = lane & 15, fq = lane >> 4;
    const int K = g.K, nt = K / BK;
    unsigned voffA[2], voffB[2];
#pragma unroll
    for (int i = 0; i < 2; ++i) { int R, C; stage_rc(tid * 16 + i * 8192, R, C); const int Rb = (R >> 5) * 64 + perm32(R & 31);
        voffA[i] = (unsigned)(R * K + C) * 2u; voffB[i] = (unsigned)(Rb * K + C) * 2u; }
    const size_t kstep = (size_t)(BK * 2);
    const size_t hstep = (size_t)HALF * K * 2; const size_t bhstep = (size_t)32 * K * 2;
    const size_t tstep = 2 * hstep;
    const unsigned ldsw = (unsigned)wid * 1024u;
    const int aoff = lds_byte(wr * 64 + fr, fq * 8), boff = lds_byte(wc * 32 + fr, fq * 8);
#define PG8_SA(b, h) (((b) * 2 + (h)) * HTB)
#define PG8_SB(b, h) ((4 + (b) * 2 + (h)) * HTB)
#define PG8_STAGE(bufoff, gbase, voff) do { _Pragma("unroll") for (int _i = 0; _i < 2; ++_i) \
        __builtin_amdgcn_global_load_lds((const unsigned*)((const char*)(gbase) + (voff)[_i]), (PG8_LAS unsigned*)(lds + (bufoff) + ldsw + _i * 8192), 16, 0, 0); } while (0)
#define PG8_LDA(dst, b, h) do { _Pragma("unroll") for (int m = 0; m < 4; ++m) _Pragma("unroll") for (int k = 0; k < 2; ++k) dst[m][k] = *(const PG8_LAS bf16x8*)(lds + PG8_SA(b, h) + aoff + m * 2048 + k * 1024); } while (0)
#define PG8_LDB(dst, b, h) do { _Pragma("unroll") for (int n = 0; n < 2; ++n) _Pragma("unroll") for (int k = 0; k < 2; ++k) dst[n][k] = *(const PG8_LAS bf16x8*)(lds + PG8_SB(b, h) + boff + n * 2048 + k * 1024); } while (0)
#define PG8_MMA(ai, bj, At, Bt) do { __builtin_amdgcn_s_setprio(1); _Pragma("unroll") for (int m = 0; m < 4; ++m) _Pragma("unroll") for (int n = 0; n < 2; ++n) _Pragma("unroll") for (int k = 0; k < 2; ++k) \
        acc[ai][bj][m][n] = __builtin_amdgcn_mfma_f32_16x16x32_bf16(Bt[n][k], At[m][k], acc[ai][bj][m][n], 0, 0, 0); __builtin_amdgcn_s_setprio(0); } while (0)
#define PG8_WAIT_V(n) asm volatile("s_waitcnt vmcnt(" #n ")" ::: "memory")
#define PG8_WAIT_L(n) asm volatile("s_waitcnt lgkmcnt(" #n ")" ::: "memory")
#define PG8_BAR __builtin_amdgcn_s_barrier()
#define PG8_SCHED __builtin_amdgcn_sched_barrier(0)
    Unit cur, nxt; int ui = 0;
    if (!S.next(0, cur)) return;
    f32x4 acc[2][2][4][2];
#pragma unroll
    for (int a = 0; a < 2; ++a)
#pragma unroll
        for (int b = 0; b < 2; ++b)
#pragma unroll
            for (int m = 0; m < 4; ++m)
#pragma unroll
                for (int n = 0; n < 2; ++n) acc[a][b][m][n] = (f32x4){0.f, 0.f, 0.f, 0.f};
    bf16x8 At[4][2], B0[2][2], B1[2][2];
    const char* cA = (const char*)g.A + (size_t)cur.pm * tstep; const char* cB = (const char*)g.Bt + (size_t)cur.pn * tstep;
    S.a_ready(cur);
    if constexpr (SP2) {
        PG8_STAGE(PG8_SB(0, 0), cB, voffB); PG8_STAGE(PG8_SB(0, 1), cB + bhstep, voffB); PG8_STAGE(PG8_SA(0, 0), cA, voffA); PG8_STAGE(PG8_SA(0, 1), cA + hstep, voffA);
        if (wr == 1) PG8_BAR;
        PG8_WAIT_V(2); PG8_BAR;
        PG8_STAGE(PG8_SB(1, 0), cB + kstep, voffB); PG8_STAGE(PG8_SA(1, 0), cA + kstep, voffA); PG8_STAGE(PG8_SB(1, 1), cB + bhstep + kstep, voffB);
        PG8_WAIT_V(6); PG8_BAR;
    } else {
        PG8_STAGE(PG8_SB(0, 0), cB, voffB); PG8_STAGE(PG8_SA(0, 0), cA, voffA); PG8_STAGE(PG8_SB(0, 1), cB + bhstep, voffB); PG8_STAGE(PG8_SA(0, 1), cA + hstep, voffA);
        if (wr == 1) PG8_BAR;
        PG8_WAIT_V(4); PG8_BAR;
        PG8_STAGE(PG8_SB(1, 0), cB + kstep, voffB); PG8_STAGE(PG8_SA(1, 0), cA + kstep, voffA); PG8_STAGE(PG8_SB(1, 1), cB + bhstep + kstep, voffB);
        PG8_WAIT_V(6); PG8_BAR;
    }
    for (;;) {
        const bool has_next = S.next(ui + 1, nxt);
        const char* nA = has_next ? (const char*)g.A + (size_t)nxt.pm * tstep : cA; const char* nB = has_next ? (const char*)g.Bt + (size_t)nxt.pn * tstep : cB;
        for (int t = 0; t < nt; t += 2) {
            const bool last = (t == nt - 2);
            const char* a1 = cA + (size_t)(t + 1) * kstep;
            const char* a2 = last ? nA : cA + (size_t)(t + 2) * kstep; const char* b2 = last ? nB : cB + (size_t)(t + 2) * kstep;
            const char* a3 = a2 + kstep; const char* b3 = b2 + kstep;
            if (last && has_next) S.a_ready(nxt);
            if constexpr (SP2) {
            PG8_LDB(B0, 0, 0); PG8_LDB(B1, 0, 1); PG8_SCHED; PG8_LDA(At, 0, 0); PG8_STAGE(PG8_SA(1, 1), a1 + hstep, voffA);
            PG8_WAIT_V(8); PG8_WAIT_L(0); PG8_BAR; PG8_MMA(0, 0, At, B0); PG8_MMA(0, 1, At, B1); PG8_BAR; PG8_SCHED;
            PG8_LDA(At, 0, 1); PG8_STAGE(PG8_SB(0, 0), b2, voffB); PG8_STAGE(PG8_SB(0, 1), b2 + bhstep, voffB); PG8_STAGE(PG8_SA(0, 0), a2, voffA);
            PG8_WAIT_V(8); PG8_WAIT_L(0); PG8_BAR; PG8_MMA(1, 0, At, B0); PG8_MMA(1, 1, At, B1); PG8_BAR; PG8_SCHED;
            PG8_LDB(B0, 1, 0); PG8_LDB(B1, 1, 1); PG8_SCHED; PG8_LDA(At, 1, 0); PG8_STAGE(PG8_SA(0, 1), a2 + hstep, voffA);
            PG8_WAIT_V(8); PG8_WAIT_L(0); PG8_BAR; PG8_MMA(0, 0, At, B0); PG8_MMA(0, 1, At, B1); PG8_BAR; PG8_SCHED;
            PG8_LDA(At, 1, 1); PG8_STAGE(PG8_SB(1, 0), b3, voffB); PG8_STAGE(PG8_SB(1, 1), b3 + bhstep, voffB); PG8_STAGE(PG8_SA(1, 0), a3, voffA);
            PG8_WAIT_V(8); PG8_WAIT_L(0); PG8_BAR; PG8_MMA(1, 0, At, B0); PG8_MMA(1, 1, At, B1); PG8_BAR; PG8_SCHED;
            } else {
            PG8_LDB(B0, 0, 0); PG8_SCHED; PG8_LDA(At, 0, 0); PG8_STAGE(PG8_SA(1, 1), a1 + hstep, voffA);
            PG8_WAIT_L(8); PG8_BAR; PG8_WAIT_L(0); PG8_MMA(0, 0, At, B0); PG8_BAR; PG8_SCHED;
            PG8_LDB(B1, 0, 1); PG8_STAGE(PG8_SB(0, 0), b2, voffB);
            PG8_BAR; PG8_WAIT_L(0); PG8_MMA(0, 1, At, B1); PG8_BAR;
            PG8_LDA(At, 0, 1); PG8_STAGE(PG8_SA(0, 0), a2, voffA);
            PG8_BAR; PG8_WAIT_L(0); PG8_MMA(1, 0, At, B0); PG8_BAR; PG8_SCHED;
            PG8_STAGE(PG8_SB(0, 1), b2 + bhstep, voffB);
            PG8_WAIT_V(6); PG8_BAR; PG8_MMA(1, 1, At, B1); PG8_BAR;
            PG8_LDB(B0, 1, 0); PG8_SCHED; PG8_LDA(At, 1, 0); PG8_STAGE(PG8_SA(0, 1), a2 + hstep, voffA);
            PG8_WAIT_L(8); PG8_BAR; PG8_WAIT_L(0); PG8_MMA(0, 0, At, B0); PG8_BAR; PG8_SCHED;
            PG8_LDB(B1, 1, 1); PG8_STAGE(PG8_SB(1, 0), b3, voffB);
            PG8_BAR; PG8_WAIT_L(0); PG8_MMA(0, 1, At, B1); PG8_BAR;
            PG8_LDA(At, 1, 1); PG8_STAGE(PG8_SA(1, 0), a3, voffA);
            PG8_BAR; PG8_WAIT_L(0); PG8_MMA(1, 0, At, B0); PG8_BAR; PG8_SCHED;
            PG8_STAGE(PG8_SB(1, 1), b3 + bhstep, voffB);
            PG8_WAIT_V(6); PG8_BAR; PG8_MMA(1, 1, At, B1); PG8_BAR;
            }
        }
        if constexpr (ALIGN_EPI) { if (wr == 0) PG8_BAR; }
        if constexpr (!Epi::AFTER_DRAIN) { E(acc, cur, wr, wc, fr, fq); S.done(cur); }
        if (!has_next) break;
#pragma unroll
        for (int a = 0; a < 2; ++a)
#pragma unroll
            for (int b = 0; b < 2; ++b)
#pragma unroll
                for (int m = 0; m < 4; ++m)
#pragma unroll
                    for (int n = 0; n < 2; ++n) acc[a][b][m][n] = (f32x4){0.f, 0.f, 0.f, 0.f};
        cur = nxt; cA = nA; cB = nB; ++ui;
        if constexpr (ALIGN_EPI) { if (wr == 1) PG8_BAR; }
    }
    PG8_WAIT_V(0);
    if constexpr (!ALIGN_EPI) { if (wr == 0) PG8_BAR; }
    PG8_BAR;
    if constexpr (Epi::AFTER_DRAIN) { E.fused(acc, cur, wr, wc, fr, fq, lds, wid, lane); S.done(cur); }
#undef PG8_SA
#undef PG8_SB
#undef PG8_STAGE
#undef PG8_LDA
#undef PG8_LDB
#undef PG8_MMA
#undef PG8_WAIT_V
#undef PG8_WAIT_L
#undef PG8_BAR
#undef PG8_SCHED
}
}

#ifndef PG8_SP2
#define PG8_SP2 true
#endif
#ifndef PG8_ALIGN
#define PG8_ALIGN true
#endif
#ifndef PROBE_B
#define PROBE_B 0
#endif
#ifndef LN_UR
#define LN_UR 2
#endif
#ifndef LN_NR
#define LN_NR 2
#endif
#ifndef FUSE_LN
#define FUSE_LN 0
#endif
#ifndef NT_STORE
#define NT_STORE 0
#endif
#ifndef PROBE_T
#define PROBE_T 0
#endif
#ifndef PROBE_MUL
#define PROBE_MUL 1
#endif
#ifndef SGB_R
#define SGB_R 24
#endif
#ifndef ATT_PIPE
#define ATT_PIPE 0
#endif
#ifndef GQA2
#define GQA2 1
#endif
#ifndef GQA_NQ4
#define GQA_NQ4 1
#endif
#ifndef SGB_N
#define SGB_N 0
#endif
#ifndef SGB_V
#define SGB_V 14
#endif
#ifndef PROBE_X
#define PROBE_X 0
#endif
#ifndef PROBE_SYNC
#define PROBE_SYNC 0
#endif

constexpr int TP = 8192;
constexpr int TS = 32768;
constexpr int TT = TP + TS;
constexpr int DM = 1024;
constexpr int NIN = 3072;
constexpr int NLAYER = 4;
constexpr float ALPHA = 1.6817928305074292f;
constexpr float LOG2E = 1.4426950408889634f;
constexpr float C1 = 0.125f * LOG2E;
constexpr size_t OUT_NK = (size_t)TT * DM;
constexpr size_t OUT_NV = OUT_NK + (size_t)32 * 4 * 256 * 256;
constexpr size_t OUT_GK = OUT_NV + (size_t)32 * 4 * 256 * 256;
constexpr size_t OUT_GV = OUT_GK + (size_t)32 * 4 * 256 * 128;

struct Params {
  const float *x_prompt, *x_sample, *c, *cnk, *cnv, *cgk, *cgv, *c_ctx, *w_mod, *b_mod, *w_in, *b_in, *pool_w, *pool_scale,
      *nat_bias, *q_norm, *k_norm, *conv_w, *conv_b, *conv_ln_g, *conv_ln_b, *conv_pw, *w_out, *b_out, *ln_g, *ln_b;
  float* out;
  char* ws;
  int ph0, ph1;
};
constexpr size_t WS_WINT = 0;
constexpr size_t WS_WOUTT = WS_WINT + (size_t)4 * 3072 * 1024 * 2;
constexpr size_t WS_PWT = WS_WOUTT + (size_t)4 * 1024 * 1024 * 2;
constexpr size_t WS_POOLT = WS_PWT + (size_t)4 * 256 * 256 * 2;
constexpr size_t WS_CNK = WS_POOLT + (size_t)16 * 4096 * 2;
constexpr size_t WS_CNV = WS_CNK + (size_t)4194304 * 2;
constexpr size_t WS_CGK = WS_CNV + (size_t)4194304 * 2;
constexpr size_t WS_CGV = WS_CGK + (size_t)2097152 * 2;
constexpr size_t WS_U = WS_CGV + (size_t)2097152 * 2;
constexpr size_t WS_H = WS_U + (size_t)TT * NIN * 2;
constexpr size_t WS_MX = WS_H;
constexpr size_t WS_MOD = WS_MX + (size_t)TT * DM * 2;
constexpr size_t WS_STATS = WS_MOD + (size_t)4 * 9 * 3072 * 4;
constexpr size_t WS_CNT = WS_STATS + (size_t)TT * 2 * 4;
constexpr size_t WS_BAR = WS_CNT + 8192;
constexpr size_t WS_KN = WS_BAR + 16384;
constexpr size_t WS_VN = WS_KN + (size_t)4 * TT * 64 * 2;
constexpr size_t WS_KG = WS_VN + (size_t)4 * TT * 64 * 2;
constexpr size_t WS_VG = WS_KG + (size_t)2 * TT * 64 * 2;
constexpr size_t WS_PARAMS = WS_VG + (size_t)2 * TT * 64 * 2;
constexpr size_t WS_END = WS_PARAMS + 4096;
#define P_WinT ((bf16_t*)(p.ws + WS_WINT))
#define P_WoutT ((bf16_t*)(p.ws + WS_WOUTT))
#define P_pwT ((bf16_t*)(p.ws + WS_PWT))
#define P_poolT ((bf16_t*)(p.ws + WS_POOLT))
#define P_cnk_b ((bf16_t*)(p.ws + WS_CNK))
#define P_cnv_b ((bf16_t*)(p.ws + WS_CNV))
#define P_cgk_b ((bf16_t*)(p.ws + WS_CGK))
#define P_cgv_b ((bf16_t*)(p.ws + WS_CGV))
#define P_U ((bf16_t*)(p.ws + WS_U))
#define P_H ((bf16_t*)(p.ws + WS_H))
#define P_MX ((bf16_t*)(p.ws + WS_MX))
#define P_mod ((float*)(p.ws + WS_MOD))
#define P_stats ((float*)(p.ws + WS_STATS))
#define P_cnt ((unsigned*)(p.ws + WS_CNT))
#define P_bar ((unsigned*)(p.ws + WS_BAR))
#define P_KN ((bf16_t*)(p.ws + WS_KN))
#define P_VN ((bf16_t*)(p.ws + WS_VN))
#define P_KG ((bf16_t*)(p.ws + WS_KG))
#define P_VG ((bf16_t*)(p.ws + WS_VG))

DEV Params load_params(char* ws0) {
#if defined(__HIP_DEVICE_COMPILE__)
  typedef const __attribute__((address_space(4))) unsigned long long cu64;
  cu64* q = (cu64*)(ws0 + WS_PARAMS);
  asm volatile("" : "+s"(q));
  Params r;
  unsigned long long* d = (unsigned long long*)&r;
  static_assert(sizeof(Params) % 8 == 0, "Params is a whole number of 8-byte words");
#pragma unroll
  for (int i = 0; i < (int)(sizeof(Params) / 8); ++i) d[i] = q[i];
  return r;
#else
  return *(const Params*)(ws0 + WS_PARAMS);
#endif
}
DEV float bf2f(bf16_t h) { return __uint_as_float(((unsigned)h) << 16); }
DEV unsigned pk2(float lo, float hi) { f32x2 v = {lo, hi}; bf16x2_t b = __builtin_convertvector(v, bf16x2_t); return __builtin_bit_cast(unsigned, b); }
DEV bf16_t f2bf(float f) { return (bf16_t)(pk2(f, 0.f) & 0xffffu); }
DEV float bflo(unsigned w) { return __uint_as_float(w << 16); }
DEV float bfhi(unsigned w) { return __uint_as_float(w & 0xffff0000u); }
DEV float silu_f(float x) { return x * __builtin_amdgcn_rcpf(1.f + __expf(-x)); }
DEV float sigm_f(float x) { return __builtin_amdgcn_rcpf(1.f + __expf(-x)); }
DEV f32x4 mfma16(bf16x8 a, bf16x8 b, f32x4 c) { return __builtin_amdgcn_mfma_f32_16x16x32_bf16(a, b, c, 0, 0, 0); }
typedef short v4i16_t __attribute__((ext_vector_type(4)));
DEV s16x4 tr16(const char* p) {
  return __builtin_bit_cast(s16x4, __builtin_amdgcn_ds_read_tr16_b64_v4i16((__attribute__((address_space(3))) v4i16_t*)p));
}
DEV float xr16(float v, bool mx) {
  auto r = __builtin_amdgcn_permlane16_swap(__float_as_uint(v), __float_as_uint(v), false, false);
  const float a = __uint_as_float(r[0]), b = __uint_as_float(r[1]);
  return mx ? fmaxf(a, b) : a + b;
}
DEV float xr32(float v, bool mx) {
  auto r = __builtin_amdgcn_permlane32_swap(__float_as_uint(v), __float_as_uint(v), false, false);
  const float a = __uint_as_float(r[0]), b = __uint_as_float(r[1]);
  return mx ? fmaxf(a, b) : a + b;
}
DEV float wave_sum(float v) {
  v += __shfl_xor(v, 1); v += __shfl_xor(v, 2); v += __shfl_xor(v, 4); v += __shfl_xor(v, 8); v += __shfl_xor(v, 16); v += __shfl_xor(v, 32);
  return v;
}
DEV int get_tid() { int t = threadIdx.x & 255; asm volatile("" : "+v"(t)); return t; }
DEV int get_half() { return __builtin_amdgcn_readfirstlane((int)(threadIdx.x >> 8)); }
DEV int cond_of_row(int row) { return row < TP ? 0 : 1 + ((row - TP) >> 12); }

DEV void tconv_tile(const float* src, int sld, bf16_t* dst, int dld, char* smem) {
  float* t = (float*)smem;
  const int tid = get_tid();
#pragma unroll
  for (int i = 0; i < 16; ++i) { int idx = tid + i * 256; int r = idx >> 6, c = idx & 63; t[r * 65 + c] = src[(size_t)r * sld + c]; }
  __syncthreads();
#pragma unroll
  for (int i = 0; i < 4; ++i) {
    const int idx = tid + i * 256, n = idx >> 4, k = (idx & 15) * 4;
    u32x2 w; w.x = pk2(t[k * 65 + n], t[(k + 1) * 65 + n]); w.y = pk2(t[(k + 2) * 65 + n], t[(k + 3) * 65 + n]);
    *(u32x2*)(dst + (size_t)n * dld + k) = w;
  }
  __syncthreads();
}

DEV void cvt_unit(const float* src, bf16_t* dst, int u, int nh) {
  const size_t base = (size_t)u * 16384;
  const int tid = get_tid();
#pragma unroll
  for (int i = 0; i < 16; ++i) {
    const size_t e = base + (size_t)(i * 256 + tid) * 4;
    f32x4 v = *(const f32x4*)(src + e);
    u32x2 w; w.x = pk2(v[0], v[1]); w.y = pk2(v[2], v[3]);
    const size_t d = e & 63, hh = (e >> 6) % nh, sidx = (e / (64 * nh)) & 511, bl = e / ((size_t)64 * nh * 512);
    *(u32x2*)(dst + ((bl * nh + hh) * 512 + sidx) * 64 + d) = w;
  }
}

DEV void mod_unit(const Params& p, int u, char* smem) {
  const int l = u / 48, n0 = (u % 48) * 64, tid = get_tid();
  float* sc = (float*)smem;
  float* red = (float*)(smem + 36864);
  for (int i = tid; i < 9216; i += 256) { int c = i >> 10, k = i & 1023; float v = (c == 0) ? p.c_ctx[k] : p.c[(c - 1) * 1024 + k]; sc[i] = silu_f(v); }
  __syncthreads();
  const int kq = tid >> 6, col = n0 + (tid & 63);
  float acc[9];
#pragma unroll
  for (int c = 0; c < 9; ++c) acc[c] = 0.f;
  const float* wp = p.w_mod + ((size_t)l * 1024 + kq * 256) * 3072 + col;
#pragma unroll 8
  for (int k = 0; k < 256; ++k) {
    float w = wp[(size_t)k * 3072];
#pragma unroll
    for (int c = 0; c < 9; ++c) acc[c] += sc[c * 1024 + kq * 256 + k] * w;
  }
#pragma unroll
  for (int c = 0; c < 9; ++c) red[(kq * 9 + c) * 64 + (tid & 63)] = acc[c];
  __syncthreads();
  for (int i = tid; i < 576; i += 256) {
    int c = i >> 6, j = i & 63;
    float s = red[(0 * 9 + c) * 64 + j] + red[(1 * 9 + c) * 64 + j] + red[(2 * 9 + c) * 64 + j] + red[(3 * 9 + c) * 64 + j];
    P_mod[((size_t)l * 9 + c) * 3072 + n0 + j] = s + p.b_mod[l * 3072 + n0 + j];
  }
  __syncthreads();
}

DEV void h0_unit(const Params& p, int u) {
  const int tid = get_tid(), col = (tid & 127) * 8, rpar = tid >> 7;
  const int row0 = u * 32;
  const int cond = cond_of_row(row0);
  const float* md = P_mod + (size_t)cond * 3072;
  const f32x4 sh0 = *(const f32x4*)(md + col), sh1 = *(const f32x4*)(md + col + 4), sc0 = *(const f32x4*)(md + 1024 + col), sc1 = *(const f32x4*)(md + 1024 + col + 4);
#pragma unroll 4
  for (int i = 0; i < 16; ++i) {
    const int row = row0 + i * 2 + rpar;
    const float* xr = (row < TP) ? p.x_prompt + (size_t)row * DM : p.x_sample + (size_t)(row - TP) * DM;
    const f32x4 x0 = *(const f32x4*)(xr + col), x1 = *(const f32x4*)(xr + col + 4);
    const f32x4 h0v = x0 * (sc0 + 1.f) + sh0, h1v = x1 * (sc1 + 1.f) + sh1;
    u32x4 w; w.x = pk2(h0v[0], h0v[1]); w.y = pk2(h0v[2], h0v[3]); w.z = pk2(h1v[0], h1v[1]); w.w = pk2(h1v[2], h1v[3]);
    *(u32x4*)(P_H + (size_t)row * DM + col) = w;
  }
}

template <int NR>
DEV void ln_rowsN(const Params& p, int l, int row0, int lane) {
  float* Y = p.out;
  f32x4 v[NR][4];
#pragma unroll
  for (int r = 0; r < NR; ++r)
#pragma unroll
    for (int q = 0; q < 4; ++q) v[r][q] = *(const f32x4*)(Y + (size_t)(row0 + r) * DM + q * 256 + lane * 4);
  const int cond = cond_of_row(row0);
#pragma unroll
  for (int r = 0; r < NR; ++r) {
    const int row = row0 + r;
    float sm = 0.f;
#pragma unroll
    for (int q = 0; q < 4; ++q) sm += (v[r][q][0] + v[r][q][1]) + (v[r][q][2] + v[r][q][3]);
    const float mean = wave_sum(sm) * (1.f / 1024.f);
    float s2 = 0.f;
#pragma unroll
    for (int q = 0; q < 4; ++q) { v[r][q] = v[r][q] - mean; s2 += (v[r][q][0] * v[r][q][0] + v[r][q][1] * v[r][q][1]) + (v[r][q][2] * v[r][q][2] + v[r][q][3] * v[r][q][3]); }
    const float rstd = rsqrtf(wave_sum(s2) * (1.f / 1024.f) + 1e-5f);
#pragma unroll
    for (int q = 0; q < 4; ++q) {
      const int col = q * 256 + lane * 4;
      const f32x4 g = *(const f32x4*)(p.ln_g + l * 1024 + col), b = *(const f32x4*)(p.ln_b + l * 1024 + col);
      f32x4 x = v[r][q] * rstd * g + b;
      if (l < NLAYER - 1) {
        const float* md = P_mod + ((size_t)(l + 1) * 9 + cond) * 3072;
        const f32x4 sh = *(const f32x4*)(md + col), sc = *(const f32x4*)(md + 1024 + col);
        f32x4 h = x * (sc + 1.f) + sh;
        u32x2 w; w.x = pk2(h[0], h[1]); w.y = pk2(h[2], h[3]);
        *(u32x2*)(P_H + (size_t)row * DM + col) = w;
      } else {
        *(f32x4*)(Y + (size_t)row * DM + col) = x;
      }
    }
    if (l < NLAYER - 1 && lane == 0) { P_stats[row * 2] = mean; P_stats[row * 2 + 1] = rstd; }
  }
}

struct EpiA {
  static constexpr bool PERM = false, AFTER_DRAIN = false;
  char* ws0; int l_in;
  DEV void operator()(f32x4 (&acc)[2][2][4][2], const pg8::Unit& u, int wr, int wc, int, int) const {
    const int lane_ = (int)__builtin_amdgcn_mbcnt_hi(~0u, __builtin_amdgcn_mbcnt_lo(~0u, 0u)), fr = lane_ & 15, fq = lane_ >> 4;
    const Params p = load_params(ws0);
    int l = l_in; asm volatile("" : "+s"(l));
    const int colb = u.pn * 256 + wc * 64;
    const int reg = colb >> 6;
    const bool prompt = (u.pm * 256) < TP;
    f32x4 bias[2][2];
#pragma unroll
    for (int bj = 0; bj < 2; ++bj)
#pragma unroll
      for (int n = 0; n < 2; ++n) bias[bj][n] = *(const f32x4*)(p.b_in + l * 3072 + colb + bj * 32 + 8 * fq + 4 * n);
    const bool rms = (reg >= 36 && reg < 42);
    const float* gptr = (reg < 40 ? p.q_norm : p.k_norm) + l * 64;
    bf16_t* kvb = nullptr;
    if (reg >= 12 && reg < 16) kvb = P_KN + (size_t)(reg - 12) * TT * 64;
    else if (reg >= 16 && reg < 20) kvb = P_VN + (size_t)(reg - 16) * TT * 64;
    else if (reg >= 40 && reg < 42) kvb = P_KG + (size_t)(reg - 40) * TT * 64;
    else if (reg >= 42 && reg < 44) kvb = P_VG + (size_t)(reg - 42) * TT * 64;
    float* ob = nullptr; int hw = 0, cofs = 0;
    if (prompt) {
      if (reg >= 12 && reg < 16) { ob = p.out + OUT_NK; hw = 256; cofs = colb - 768; }
      else if (reg >= 16 && reg < 20) { ob = p.out + OUT_NV; hw = 256; cofs = colb - 1024; }
      else if (reg >= 40 && reg < 42) { ob = p.out + OUT_GK; hw = 128; cofs = colb - 2560; }
      else if (reg >= 42 && reg < 44) { ob = p.out + OUT_GV; hw = 128; cofs = colb - 2688; }
    }
#pragma unroll
    for (int ai = 0; ai < 2; ++ai)
#pragma unroll
      for (int m = 0; m < 4; ++m) {
        const int row = u.pm * 256 + ai * 128 + wr * 64 + m * 16 + fr;
        f32x4 v[2][2];
#pragma unroll
        for (int bj = 0; bj < 2; ++bj)
#pragma unroll
          for (int n = 0; n < 2; ++n) v[bj][n] = acc[ai][bj][m][n] + bias[bj][n];
        if (rms) {
          float ss = 0.f;
#pragma unroll
          for (int bj = 0; bj < 2; ++bj)
#pragma unroll
            for (int n = 0; n < 2; ++n)
#pragma unroll
              for (int j = 0; j < 4; ++j) ss += v[bj][n][j] * v[bj][n][j];
          ss += __shfl_xor(ss, 16); ss += __shfl_xor(ss, 32);
          const float r = rsqrtf(ss * (1.f / 64.f) + 1e-6f);
#pragma unroll
          for (int bj = 0; bj < 2; ++bj)
#pragma unroll
            for (int n = 0; n < 2; ++n) v[bj][n] = v[bj][n] * r * *(const f32x4*)(gptr + bj * 32 + 8 * fq + 4 * n);
          if (!prompt) {
            const int t = (row - TP) & 4095, pr = t >> 6, pc = t & 63;
            const float sg = (fq < 2) ? -1.f : 1.f;
#pragma unroll
            for (int bj = 0; bj < 2; ++bj)
#pragma unroll
              for (int n = 0; n < 2; ++n) {
                const int pos = bj ? pc : pr;
                const f32x4 c = *(const f32x4*)(ROPE_COS + pos * 16 + 8 * (fq & 1) + 4 * n), sn = *(const f32x4*)(ROPE_SIN + pos * 16 + 8 * (fq & 1) + 4 * n);
                f32x4 other;
#pragma unroll
                for (int j = 0; j < 4; ++j) {
                  auto r = __builtin_amdgcn_permlane32_swap(__float_as_uint(v[bj][n][j]), __float_as_uint(v[bj][n][j]), false, false);
                  other[j] = __uint_as_float((fq < 2) ? r[1] : r[0]);
                }
                v[bj][n] = v[bj][n] * c + other * sn * sg;
              }
          }
        }
        bf16_t* up = kvb ? kvb + (size_t)row * 64 + 8 * fq : P_U + (size_t)row * NIN + colb + 8 * fq;
#pragma unroll
        for (int bj = 0; bj < 2; ++bj) {
          u32x4 w; w.x = pk2(v[bj][0][0], v[bj][0][1]); w.y = pk2(v[bj][0][2], v[bj][0][3]); w.z = pk2(v[bj][1][0], v[bj][1][1]); w.w = pk2(v[bj][1][2], v[bj][1][3]);
          *(u32x4*)(up + bj * 32) = w;
        }
        if (ob) {
          const int b = row >> 8, sq = row & 255;
          float* op = ob + ((size_t)(b * 4 + l) * 256 + sq) * hw + cofs + 8 * fq;
#pragma unroll
          for (int bj = 0; bj < 2; ++bj)
#pragma unroll
            for (int n = 0; n < 2; ++n) *(f32x4*)(op + bj * 32 + n * 4) = v[bj][n];
        }
      }
  }
};

struct EpiC {
  static constexpr bool PERM = false, AFTER_DRAIN = false;
  char* ws0; int l_in; char* lds_x;
  DEV void operator()(f32x4 (&acc)[2][2][4][2], const pg8::Unit& u, int wr, int wc, int, int) const {
    const int lane_ = (int)__builtin_amdgcn_mbcnt_hi(~0u, __builtin_amdgcn_mbcnt_lo(~0u, 0u)), fr = lane_ & 15, fq = lane_ >> 4;
    const Params p = load_params(ws0);
    int l = l_in; asm volatile("" : "+s"(l));
    const int colb = u.pn * 256 + wc * 64 + 8 * fq;
    const int cond = cond_of_row(u.pm * 256);
    const float* gatep = P_mod + ((size_t)l * 9 + cond) * 3072 + 2048;
    float* Y = p.out;
    auto xrow = [&](int it) -> const float* {
      const int row = u.pm * 256 + (it >> 2) * 128 + wr * 64 + (it & 3) * 16 + fr;
      if (l == 0) return (row < TP) ? p.x_prompt + (size_t)row * DM : p.x_sample + (size_t)(row - TP) * DM;
      return Y + (size_t)row * DM;
    };
    f32x4 xq[2][4]; f32x2 st[2];
    {
      const float* xr = xrow(0);
#pragma unroll
      for (int k = 0; k < 4; ++k) xq[0][k] = *(const f32x4*)(xr + colb + (k >> 1) * 32 + (k & 1) * 4);
      st[0] = (l > 0) ? *(const f32x2*)(P_stats + (size_t)(u.pm * 256 + wr * 64 + fr) * 2) : (f32x2){0.f, 1.f};
    }
#pragma unroll
    for (int it = 0; it < 8; ++it) {
      const int ai = it >> 2, m = it & 3;
      const int row = u.pm * 256 + ai * 128 + wr * 64 + m * 16 + fr;
      if (it + 1 < 8) {
        const float* xr = xrow(it + 1);
#pragma unroll
        for (int k = 0; k < 4; ++k) xq[(it + 1) & 1][k] = *(const f32x4*)(xr + colb + (k >> 1) * 32 + (k & 1) * 4);
        const int rown = u.pm * 256 + ((it + 1) >> 2) * 128 + wr * 64 + ((it + 1) & 3) * 16 + fr;
        st[(it + 1) & 1] = (l > 0) ? *(const f32x2*)(P_stats + (size_t)rown * 2) : (f32x2){0.f, 1.f};
      }
      const float mean = st[it & 1][0], rstd = st[it & 1][1];
#pragma unroll
      for (int bj = 0; bj < 2; ++bj)
#pragma unroll
        for (int n = 0; n < 2; ++n) {
          const int col = colb + bj * 32 + n * 4;
          f32x4 xo = xq[it & 1][bj * 2 + n];
          if (l > 0) {
            const f32x4 g = *(const f32x4*)(p.ln_g + (l - 1) * 1024 + col), b = *(const f32x4*)(p.ln_b + (l - 1) * 1024 + col);
            xo = (xo - mean) * rstd * g + b;
          }
          const f32x4 gt = *(const f32x4*)(gatep + col), bo = *(const f32x4*)(p.b_out + l * 1024 + col);
          const f32x4 y = xo * ALPHA + gt * (acc[ai][bj][m][n] + bo);
#if FUSE_LN
          asm volatile("global_store_dwordx4 %0, %1, off sc1\n\ts_nop 1" :: "v"(Y + (size_t)row * DM + col), "v"(y) : "memory");
#else
          *(f32x4*)(Y + (size_t)row * DM + col) = y;
#endif
        }
    }
#if FUSE_LN
    asm volatile("s_waitcnt vmcnt(0)" ::: "memory");
    __syncthreads();
    volatile LAS unsigned* fl = (volatile LAS unsigned*)(lds_x);
    const int wave = wr * 4 + wc, lane = fq * 16 + fr;
    if (wave == 0 && lane == 0) { const unsigned old = __hip_atomic_fetch_add(P_cnt + l * 160 + u.pm, 1u, __ATOMIC_RELAXED, __HIP_MEMORY_SCOPE_AGENT); *fl = (old == 3u) ? 1u : 0u; }
    __syncthreads();
    if (*fl != 0u) {
      __builtin_amdgcn_fence(__ATOMIC_ACQUIRE, "agent");
      asm volatile("s_waitcnt vmcnt(0)" ::: "memory");
      for (int i = 0; i < 32 / LN_NR; ++i) ln_rowsN<LN_NR>(p, l, u.pm * 256 + wave * 32 + i * LN_NR, lane);
    }
    __syncthreads();
#endif
  }
};

DEV void ln_unit(const Params& p, int l, int u) {
  const int tid = get_tid(), lane = tid & 63, wid = tid >> 6;
  ln_rowsN<LN_UR>(p, l, (u * 4 + wid) * LN_UR, lane);
}

DEV int kswz(int key, int ch) {
  const int ob = (key & 15) * 64 + (ch & 3) * 16;
  return ((key >> 4) * 2 + (ch >> 2)) * 1024 + (ob ^ (((ob >> 9) & 1) << 5));
}
template <int NQ, int NKT>
DEV void qk_tile(const char* kb, int koff, const bf16x8 (&qf)[NQ][2], f32x4 (&s)[NQ][4], int fr, int fq, const float (&mb)[NQ]) {
#pragma unroll
  for (int t = 0; t < NKT; ++t) {
    const int key = koff + 16 * t + fr;
    const bf16x8 k0 = *(const bf16x8*)(kb + kswz(key, fq)), k1 = *(const bf16x8*)(kb + kswz(key, 4 + fq));
#pragma unroll
    for (int g = 0; g < NQ; ++g) { const float nb = -mb[g]; f32x4 z = {nb, nb, nb, nb}; z = mfma16(k0, qf[g][0], z); z = mfma16(k1, qf[g][1], z); s[g][t] = z; }
  }
#pragma unroll
  for (int t = NKT; t < 4; ++t)
#pragma unroll
    for (int g = 0; g < NQ; ++g) s[g][t] = (f32x4){0.f, 0.f, 0.f, 0.f};
}
template <int NQ, int NKT, bool NATL>
DEV void sm_max(f32x4 (&s)[NQ][4], int koff, f32x4 (&o)[NQ][4], float (&mrun)[NQ], f32x4 (&osum)[NQ], int fq, const float* br0, const float* br1, bool gv0, bool gv1, int qc, bool first) {
#pragma unroll
  for (int g = 0; g < NQ; ++g) {
    float mx = -1e30f;
    if (NATL) {
      const int cs = min(max(qc - 8, 0), 48);
      const float* biasrow = g ? br1 : br0;
      const bool gv = g ? gv1 : gv0;
#pragma unroll
      for (int t = 0; t < NKT; ++t)
#pragma unroll
        for (int j = 0; j < 4; ++j) {
          const int kc = koff + 16 * t + 4 * fq + j;
          const bool valid = gv && (kc >= cs) && (kc < cs + 16);
          const int dc = min(max(kc - qc + 15, 0), 30);
          const float bv = biasrow[dc];
          const float x = valid ? s[g][t][j] + bv : -1e30f;
          s[g][t][j] = x; mx = fmaxf(mx, x);
        }
    } else {
#pragma unroll
      for (int t = 0; t < NKT; ++t)
#pragma unroll
        for (int j = 0; j < 4; ++j) mx = fmaxf(mx, s[g][t][j]);
    }
    mx = xr16(mx, true); mx = xr32(mx, true);
    if (__builtin_amdgcn_ballot_w64(first || mx > 8.0f) != 0ull) {
      const float d = first ? mx : fmaxf(mx, 0.f);
      const float al = first ? 1.f : __builtin_amdgcn_exp2f(-d);
      mrun[g] += d; osum[g] = osum[g] * al;
#pragma unroll
      for (int dt = 0; dt < 4; ++dt) o[g][dt] = o[g][dt] * al;
#pragma unroll
      for (int t = 0; t < NKT; ++t) s[g][t] = s[g][t] - d;
    }
  }
}
template <int NQ, int NKT, bool NATL>
DEV void sm_exp_pv(const char* vs, int koff, f32x4 (&s)[NQ][4], f32x4 (&o)[NQ][4], const float (&mrun)[NQ], f32x4 (&osum)[NQ], int fr, int fq) {
#pragma unroll
  for (int g = 0; g < NQ; ++g)
#pragma unroll
    for (int t = 0; t < NKT; ++t)
#pragma unroll
      for (int j = 0; j < 4; ++j) s[g][t][j] = __builtin_amdgcn_exp2f(s[g][t][j]);
  const short one = (short)0x3f80;
  const bf16x8 ones = {one, one, one, one, one, one, one, one};
#pragma unroll
  for (int u = 0; u < NKT / 2; ++u) {
    bf16x8 pf[NQ];
#pragma unroll
    for (int g = 0; g < NQ; ++g) {
      u32x4 w;
      w.x = pk2(s[g][2 * u][0], s[g][2 * u][1]); w.y = pk2(s[g][2 * u][2], s[g][2 * u][3]);
      w.z = pk2(s[g][2 * u + 1][0], s[g][2 * u + 1][1]); w.w = pk2(s[g][2 * u + 1][2], s[g][2 * u + 1][3]);
      pf[g] = __builtin_bit_cast(bf16x8, w);
      osum[g] = mfma16(ones, pf[g], osum[g]);
    }
#pragma unroll
    for (int dt = 0; dt < 4; ++dt) {
      const char* vp = vs + (koff + 32 * u + 4 * fq + (fr >> 2)) * 160 + dt * 32 + (fr & 3) * 8;
      const s16x4 lo = tr16(vp), hi = tr16(vp + 16 * 160);
      const bf16x8 vf = {lo[0], lo[1], lo[2], lo[3], hi[0], hi[1], hi[2], hi[3]};
#pragma unroll
      for (int g = 0; g < NQ; ++g) o[g][dt] = mfma16(vf, pf[g], o[g][dt]);
    }
  }
}

template <int MODE>
DEV void attn_unit(const Params& p, int l, int u, char* smem, char* smem0, int half) {
  constexpr int NQ = (GQA_NQ4 && MODE == 0) ? 4 : 2;
  constexpr bool SS = (GQA_NQ4 && MODE == 0);
  constexpr int QGS = (MODE == 1) ? 64 : 16;
  constexpr int KPS = (GQA2 && !GQA_NQ4 && MODE == 0) ? 2 : 1;
  constexpr int NLD = (MODE == 0 && KPS == 1) ? 1 : 2;
  constexpr int RSTEP = (MODE == 0) ? 64 : 32;
  constexpr int VB = 16384 * KPS;
  if constexpr (MODE == 0) smem = smem0;
  const int tid = get_tid(), lane = tid & 63, wid = tid >> 6, fr = lane & 15, fq = lane >> 4;
  int qrow0, qcol, gcol, ocol, NT, NLOC, cstride = 0;
  const bf16_t *kU, *vU, *kC = nullptr, *vC = nullptr;
  int nat_r = 0, nat_rs = 0;
  if (MODE == 0) {
    int g, qb, kvh, b;
    if (GQA_NQ4) { g = u & 1; qb = (u >> 1) & 15; kvh = (u >> 5) & 1; b = u >> 6; } else { g = u & 1; qb = (u >> 1) & 31; kvh = (u >> 6) & 1; b = u >> 7; }
    const int h = kvh * 2 + g;
    qrow0 = TP + b * 4096 + qb * (64 * NQ) + wid * (16 * NQ); qcol = 2304 + h * 64; gcol = 2816 + h * 64; ocol = 768 + h * 64;
    kU = P_KG + ((size_t)kvh * TT + TP + b * 4096) * 64; vU = P_VG + ((size_t)kvh * TT + TP + b * 4096) * 64; NLOC = 64; NT = 72;
    kC = P_cgk_b + ((size_t)((b * 4 + l) * 2 + kvh) * 512) * 64; vC = P_cgv_b + ((size_t)((b * 4 + l) * 2 + kvh) * 512) * 64; cstride = 64;
  } else if (MODE == 1) {
    const int rp = u & 31, h = (u >> 5) & 3, b = u >> 7, r = 2 * rp;
    nat_r = r; nat_rs = min(max(r - 4, 0), 56);
    qrow0 = TP + b * 4096 + r * 64 + wid * 16; qcol = 512 + h * 64; gcol = 1280 + h * 64; ocol = 256 + h * 64;
    kU = P_KN + ((size_t)h * TT + TP + b * 4096) * 64; vU = P_VN + ((size_t)h * TT + TP + b * 4096) * 64; NLOC = 8; NT = 18;
    kC = P_cnk_b + ((size_t)((b * 4 + l) * 4 + h) * 512) * 64; vC = P_cnv_b + ((size_t)((b * 4 + l) * 4 + h) * 512) * 64; cstride = 64;
    float* blw = (float*)(smem + 36864);
    for (int i = tid; i < 465; i += 256) blw[i] = p.nat_bias[(size_t)(l * 4 + h) * 465 + i] * LOG2E;
  } else {
    const int qb = u & 1, hh = (u >> 1) & 7, b = u >> 4;
    qrow0 = b * 256 + qb * 128 + wid * 32; NLOC = 4; NT = 4;
    if (hh < 4) { qcol = 512 + hh * 64; gcol = 1280 + hh * 64; ocol = 256 + hh * 64; kU = P_KN + ((size_t)hh * TT + b * 256) * 64; vU = P_VN + ((size_t)hh * TT + b * 256) * 64; }
    else { const int h = hh - 4; qcol = 2304 + h * 64; gcol = 2816 + h * 64; ocol = 768 + h * 64; kU = P_KG + ((size_t)(h >> 1) * TT + b * 256) * 64; vU = P_VG + ((size_t)(h >> 1) * TT + b * 256) * 64; }
  }
  bf16x8 qf[NQ][2];
#pragma unroll
  for (int g = 0; g < NQ; ++g)
#pragma unroll
    for (int ks = 0; ks < 2; ++ks) qf[g][ks] = *(const bf16x8*)(P_U + (size_t)(qrow0 + g * QGS + fr) * NIN + qcol + ks * 32 + fq * 8);
#pragma unroll
  for (int g = 0; g < NQ; ++g)
#pragma unroll
    for (int ks = 0; ks < 2; ++ks) asm volatile("" : "+v"(qf[g][ks]));
#pragma unroll
  for (int g = 0; g < NQ; ++g)
#pragma unroll
    for (int ks = 0; ks < 2; ++ks) {
      u32x4 w = __builtin_bit_cast(u32x4, qf[g][ks]);
      w.x = pk2(bflo(w.x) * C1, bfhi(w.x) * C1); w.y = pk2(bflo(w.y) * C1, bfhi(w.y) * C1);
      w.z = pk2(bflo(w.z) * C1, bfhi(w.z) * C1); w.w = pk2(bflo(w.w) * C1, bfhi(w.w) * C1);
      qf[g][ks] = __builtin_bit_cast(bf16x8, w);
    }
  f32x4 o[NQ][4]; float mrun[NQ]; f32x4 lrun[NQ];
#pragma unroll
  for (int g = 0; g < NQ; ++g) { mrun[g] = 0.f; lrun[g] = (f32x4){0.f, 0.f, 0.f, 0.f};
#pragma unroll
    for (int dt = 0; dt < 4; ++dt) o[g][dt] = (f32x4){0.f, 0.f, 0.f, 0.f}; }
  u32x4 rkA[NLD], rvA[NLD], rkB[NLD], rvB[NLD];
  const int ltid = (MODE == 0) ? half * 256 + tid : tid;
  const int lrow = ltid >> 3, lc = ltid & 7;
  auto glK = [&](int t, u32x4 (&rk)[NLD]) {
    const bf16_t* kp; int st;
    if constexpr (MODE == 1) { if (t < 8) kp = kC + (size_t)t * 4096; else kp = kU + (size_t)min(nat_rs + t - 8, 63) * 4096; st = 64; }
    else { if (t < NLOC / KPS) { kp = kU + (size_t)t * KPS * 64 * 64; st = 64; } else { kp = kC + (size_t)(t - NLOC / KPS) * KPS * 64 * cstride; st = cstride; } }
#pragma unroll
    for (int i = 0; i < NLD; ++i) rk[i] = *(const u32x4*)(kp + (size_t)(lrow + i * RSTEP) * st + lc * 8);
  };
  auto glV = [&](int t, u32x4 (&rv)[NLD]) {
    const bf16_t* vp; int st;
    if constexpr (MODE == 1) { if (t < 8) vp = vC + (size_t)t * 4096; else vp = vU + (size_t)min(nat_rs + t - 8, 63) * 4096; st = 64; }
    else { if (t < NLOC / KPS) { vp = vU + (size_t)t * KPS * 64 * 64; st = 64; } else { vp = vC + (size_t)(t - NLOC / KPS) * KPS * 64 * cstride; st = cstride; } }
#pragma unroll
    for (int i = 0; i < NLD; ++i) rv[i] = *(const u32x4*)(vp + (size_t)(lrow + i * RSTEP) * st + lc * 8);
  };
  auto stK = [&](int buf, const u32x4 (&rk)[NLD]) {
#pragma unroll
    for (int i = 0; i < NLD; ++i) *(u32x4*)(smem + buf * 8192 * KPS + ((lrow + i * RSTEP) >> 6) * 8192 + kswz((lrow + i * RSTEP) & 63, lc)) = rk[i];
  };
  auto stV = [&](int buf, const u32x4 (&rv)[NLD]) {
#pragma unroll
    for (int i = 0; i < NLD; ++i) *(u32x4*)(smem + VB + buf * 10240 * KPS + (lrow + i * RSTEP) * 160 + lc * 16) = rv[i];
  };
  const float* bl = (const float*)(smem + 36864);
  const int kcw = (wid == 0) ? 0 : (wid == 1) ? 8 : (wid == 2) ? 24 : 32;
  auto qk = [&](int t, f32x4 (&sd)[NQ][4], int sub = 0) {
    const char* kb = smem + (t & 1) * 8192 * KPS + sub * 8192;
    if constexpr (MODE == 1) { if (t < 8) qk_tile<2, 4>(kb, 0, qf, sd, fr, fq, mrun); else qk_tile<2, 2>(kb, kcw, qf, sd, fr, fq, mrun); }
    else qk_tile<NQ, 4>(kb, 0, qf, sd, fr, fq, mrun);
  };
  auto smx = [&](int t, f32x4 (&sd)[NQ][4], bool first) {
    if constexpr (MODE == 1) {
      if (t < 8) sm_max<2, 4, false>(sd, 0, o, mrun, lrun, fq, nullptr, nullptr, true, true, 0, first);
      else {
        const int kr = nat_rs + t - 8;
        const int rs1 = min(max(nat_r - 3, 0), 56);
        const bool gv0 = (kr < nat_rs + 8) && (kr < 64), gv1 = (kr >= rs1) && (kr < rs1 + 8) && (kr < 64);
        const int dr0 = min(max(kr - nat_r + 7, 0), 14), dr1 = min(max(kr - nat_r + 6, 0), 14);
        sm_max<2, 2, true>(sd, kcw, o, mrun, lrun, fq, bl + dr0 * 31, bl + dr1 * 31, gv0, gv1, wid * 16 + fr, false);
      }
    } else sm_max<NQ, 4, false>(sd, 0, o, mrun, lrun, fq, nullptr, nullptr, true, true, 0, first);
  };
  auto spv = [&](int t, f32x4 (&sd)[NQ][4], int sub = 0) {
    const char* vs = smem + VB + (t & 1) * 10240 * KPS + sub * 10240;
    if constexpr (MODE == 1) {
      if (t < 8) sm_exp_pv<2, 4, false>(vs, 0, sd, o, mrun, lrun, fr, fq);
      else sm_exp_pv<2, 2, true>(vs, kcw, sd, o, mrun, lrun, fr, fq);
    } else sm_exp_pv<NQ, 4, false>(vs, 0, sd, o, mrun, lrun, fr, fq);
  };
  auto iter = [&](int t, f32x4 (&sc)[NQ][4], f32x4 (&sn)[NQ][4], u32x4 (&rkX)[NLD], u32x4 (&rvX)[NLD], u32x4 (&rkY)[NLD], u32x4 (&rvY)[NLD]) {
#if ATT_PIPE
    glK(min(t + 3, NT / KPS - 1), rkX);
#else
    glK(min(t + (SS ? 1 : 2), NT / KPS - 1), rkX);
#endif
    glV(min(t + (SS ? 1 : 2), NT / KPS - 1), rvX);
#if ATT_PIPE
    smx(t, sc, t == 0);
    qk(t + 1, sn);
    spv(t, sc);
#else
#pragma unroll
    for (int sub = 0; sub < KPS; ++sub) {
      qk(t, sc, sub);
      smx(t, sc, t == 0 && sub == 0);
      spv(t, sc, sub);
    }
#endif
#if SGB_N > 0
    if constexpr (MODE != 1) {
#pragma unroll
      for (int i = 0; i < SGB_N; ++i) { __builtin_amdgcn_sched_group_barrier(0x008, 1, 0); __builtin_amdgcn_sched_group_barrier(0x002, SGB_V, 0); }
    }
#endif
#if PROBE_T == 1
    if constexpr (MODE == 0) { const unsigned long long t0_ = __builtin_amdgcn_s_memrealtime(); asm volatile("s_waitcnt vmcnt(2)" ::: "memory"); const unsigned long long t1_ = __builtin_amdgcn_s_memrealtime(); if (threadIdx.x == 0) *(volatile unsigned long long*)(smem0 + 131072 + 256) += t1_ - t0_; }
#endif
#if ATT_PIPE
    stK(t & 1, rkY);
#else
    if constexpr (SS) stK((t + 1) & 1, rkX); else stK((t + 1) & 1, rkY);
#endif
    if constexpr (SS) stV((t + 1) & 1, rvX); else stV((t + 1) & 1, rvY);
#if PROBE_T == 2
    if constexpr (MODE == 0) { asm volatile("s_waitcnt lgkmcnt(0)" ::: "memory"); const unsigned long long t0_ = __builtin_amdgcn_s_memrealtime(); __syncthreads(); const unsigned long long t1_ = __builtin_amdgcn_s_memrealtime(); if (threadIdx.x == 0) *(volatile unsigned long long*)(smem0 + 131072 + 256) += t1_ - t0_; } else
#endif
    __syncthreads();
  };
#if PROBE_T == 3
  const unsigned long long tu0_ = __builtin_amdgcn_s_memrealtime();
#endif
  glK(0, rkA); glV(0, rvA); stK(0, rkA); stV(0, rvA);
#if ATT_PIPE
  glK(1, rkA); stK(1, rkA);
  glK(2, rkB); glV(1, rvB);
#else
  if constexpr (!SS) { glK(1, rkB); glV(1, rvB); }
#endif
  __syncthreads();
  f32x4 sA[NQ][4], sB[NQ][4];
#if ATT_PIPE
  qk(0, sA);
#endif
#pragma unroll 1
  for (int t = 0; t < NT / KPS; t += 2) { iter(t, sA, sB, rkA, rvA, rkB, rvB); iter(t + 1, sB, sA, rkB, rvB, rkA, rvA); }
#if PROBE_T == 3
  if constexpr (MODE == 0) { if (threadIdx.x == 0) *(volatile unsigned long long*)(smem0 + 131072 + 256) += __builtin_amdgcn_s_memrealtime() - tu0_; }
#endif
#pragma unroll
  for (int g = 0; g < NQ; ++g) {
    const float inv = __builtin_amdgcn_rcpf(lrun[g][0]);
    const int row = qrow0 + g * QGS + fr;
#pragma unroll
    for (int dt = 0; dt < 4; ++dt) {
      const int d0 = dt * 16 + 4 * fq;
      const u32x2 gw = *(const u32x2*)(P_U + (size_t)row * NIN + gcol + d0);
      u32x2 w;
      w.x = pk2(o[g][dt][0] * inv * silu_f(bflo(gw.x)), o[g][dt][1] * inv * silu_f(bfhi(gw.x)));
      w.y = pk2(o[g][dt][2] * inv * silu_f(bflo(gw.y)), o[g][dt][3] * inv * silu_f(bfhi(gw.y)));
      *(u32x2*)(P_MX + (size_t)row * DM + ocol + d0) = w;
    }
  }
}

DEV void pool_unit(const Params& p, int l, int u, char* smem) {
  const int tid = get_tid(), lane = tid & 63, wid = tid >> 6, fr = lane & 15, fq = lane >> 4;
  const int R0 = u * 32;
  int L, sb;
  if (R0 < TP) { L = 256; sb = R0 & ~255; } else { L = 4096; sb = TP + ((R0 - TP) & ~4095); }
  const int t0 = R0 - sb;
  bf16_t* xs = (bf16_t*)smem;
  bf16_t* ya = (bf16_t*)(smem + 24576);
  const bf16_t* wt = P_poolT + (size_t)(l * 4 + wid) * 4096;
  bf16x8 bfr[2][4];
#pragma unroll
  for (int ks = 0; ks < 2; ++ks)
#pragma unroll
    for (int n = 0; n < 4; ++n) bfr[ks][n] = *(const bf16x8*)(wt + (n * 16 + fr) * 64 + ks * 32 + fq * 8);
  u32x2 gwv[2][4];
#pragma unroll
  for (int m = 0; m < 2; ++m)
#pragma unroll
    for (int n = 0; n < 4; ++n) gwv[m][n] = *(const u32x2*)(P_U + (size_t)(R0 + m * 16 + fr) * NIN + 256 + wid * 64 + n * 16 + 4 * fq);
#pragma unroll
  for (int k = 0; k < 6; ++k) {
    const int idx = tid + k * 256, i = idx >> 5, c8 = (idx & 31) * 8, t = t0 - 8 + i;
    u32x4 w = {0u, 0u, 0u, 0u};
    if (t >= 0 && t < L) w = *(const u32x4*)(P_U + (size_t)(sb + t) * NIN + c8);
    *(u32x4*)(xs + i * 256 + c8) = w;
  }
  __syncthreads();
  {
    const int c = tid, g = c >> 6, win = 2 << g, half = win >> 1;
    float sum = 0.f;
    for (int i = 0; i < win; ++i) sum += bf2f(xs[(8 - half + i) * 256 + c]);
#pragma unroll 8
    for (int tt = 0; tt < 32; ++tt) {
      const int t = t0 + tt;
      const int lo = max(t - half, 0), hi = min(t - half + win, L);
      const float y = sum / (float)(hi - lo) - bf2f(xs[(tt + 8) * 256 + c]);
      ya[tt * 264 + c] = f2bf(y);
      sum += bf2f(xs[(tt + 8 - half + win) * 256 + c]) - bf2f(xs[(tt + 8 - half) * 256 + c]);
    }
  }
  __syncthreads();
  const int g = wid;
  f32x4 acc[2][4];
#pragma unroll
  for (int m = 0; m < 2; ++m)
#pragma unroll
    for (int n = 0; n < 4; ++n) acc[m][n] = (f32x4){0.f, 0.f, 0.f, 0.f};
#pragma unroll
  for (int ks = 0; ks < 2; ++ks) {
    bf16x8 af[2];
#pragma unroll
    for (int m = 0; m < 2; ++m) af[m] = *(const bf16x8*)(smem + 24576 + (m * 16 + fr) * 528 + (g * 64 + ks * 32 + fq * 8) * 2);
#pragma unroll
    for (int m = 0; m < 2; ++m)
#pragma unroll
      for (int n = 0; n < 4; ++n) acc[m][n] = mfma16(bfr[ks][n], af[m], acc[m][n]);
  }
#pragma unroll
  for (int m = 0; m < 2; ++m) {
    const int row = R0 + m * 16 + fr;
#pragma unroll
    for (int n = 0; n < 4; ++n) {
      const int ch = g * 64 + n * 16 + 4 * fq;
      const f32x4 sc = *(const f32x4*)(p.pool_scale + l * 256 + ch);
      const u32x2 gw = gwv[m][n];
      u32x2 w;
      w.x = pk2(acc[m][n][0] * sc[0] * silu_f(bflo(gw.x)), acc[m][n][1] * sc[1] * silu_f(bfhi(gw.x)));
      w.y = pk2(acc[m][n][2] * sc[2] * silu_f(bflo(gw.y)), acc[m][n][3] * sc[3] * silu_f(bfhi(gw.y)));
      *(u32x2*)(P_MX + (size_t)row * DM + ch) = w;
    }
  }
  __syncthreads();
}

DEV void conv_unit(const Params& p, int l, int u, char* smem) {
  const int tid = get_tid(), lane = tid & 63, wid = tid >> 6, fr = lane & 15, fq = lane >> 4;
  const int R0 = u * 64;
  int L, sb;
  if (R0 < TP) { L = 256; sb = R0 & ~255; } else { L = 4096; sb = TP + ((R0 - TP) & ~4095); }
  const int t0 = R0 - sb;
  bf16_t* zs = (bf16_t*)smem;
  bf16_t* za = (bf16_t*)smem;
  float* cs = (float*)(smem + 48128);
  float* red = (float*)(smem + 64768);
#pragma unroll 6
  for (int it = 0; it < 12; ++it) {
    const int idx = min(tid + it * 256, 94 * 32 - 1);
    const int i = idx >> 5, c8 = (idx & 31) * 8, t = t0 - 15 + i;
    u32x4 w = {0u, 0u, 0u, 0u};
    if (t >= 0 && t < L) {
      const bf16_t* ur = P_U + (size_t)(sb + t) * NIN;
      const u32x4 vv = *(const u32x4*)(ur + 1536 + c8), gg = *(const u32x4*)(ur + 1792 + c8);
      w.x = pk2(bflo(vv.x) * sigm_f(bflo(gg.x)), bfhi(vv.x) * sigm_f(bfhi(gg.x)));
      w.y = pk2(bflo(vv.y) * sigm_f(bflo(gg.y)), bfhi(vv.y) * sigm_f(bfhi(gg.y)));
      w.z = pk2(bflo(vv.z) * sigm_f(bflo(gg.z)), bfhi(vv.z) * sigm_f(bfhi(gg.z)));
      w.w = pk2(bflo(vv.w) * sigm_f(bflo(gg.w)), bfhi(vv.w) * sigm_f(bfhi(gg.w)));
    }
    *(u32x4*)(zs + i * 256 + c8) = w;
  }
  __syncthreads();
  const int c = tid;
  float wj[31];
#pragma unroll
  for (int j = 0; j < 31; ++j) wj[j] = p.conv_w[(size_t)(l * 31 + j) * 256 + c];
  const float cb = p.conv_b[l * 256 + c], lg = p.conv_ln_g[l * 256 + c], lb = p.conv_ln_b[l * 256 + c];
  float a[4][16];
#pragma unroll
  for (int ch = 0; ch < 4; ++ch) {
    float zr[46];
#pragma unroll
    for (int i = 0; i < 46; ++i) zr[i] = bf2f(zs[(ch * 16 + i) * 256 + c]);
#pragma unroll
    for (int i = 0; i < 16; ++i) {
      float s = cb;
#pragma unroll
      for (int j = 0; j < 31; ++j) s += zr[i + j] * wj[j];
      a[ch][i] = s;
      cs[i * 260 + c] = s;
    }
    __syncthreads();
    {
      const int i2 = tid >> 4, sl = tid & 15;
      float s1 = 0.f, s2 = 0.f;
#pragma unroll
      for (int q = 0; q < 4; ++q) {
        const f32x4 v = *(const f32x4*)(cs + i2 * 260 + sl * 16 + q * 4);
        s1 += (v[0] + v[1]) + (v[2] + v[3]);
        s2 += (v[0] * v[0] + v[1] * v[1]) + (v[2] * v[2] + v[3] * v[3]);
      }
      s1 += __shfl_xor(s1, 1); s2 += __shfl_xor(s2, 1);
      s1 += __shfl_xor(s1, 2); s2 += __shfl_xor(s2, 2);
      s1 += __shfl_xor(s1, 4); s2 += __shfl_xor(s2, 4);
      s1 += __shfl_xor(s1, 8); s2 += __shfl_xor(s2, 8);
      if (sl == 0) { red[(ch * 16 + i2) * 2] = s1; red[(ch * 16 + i2) * 2 + 1] = s2; }
    }
    __syncthreads();
  }
#pragma unroll
  for (int ch = 0; ch < 4; ++ch)
#pragma unroll
    for (int i = 0; i < 16; ++i) {
      const int tt = ch * 16 + i;
      const float mean = red[tt * 2] * (1.f / 256.f);
      const float var = fmaxf(red[tt * 2 + 1] * (1.f / 256.f) - mean * mean, 0.f);
      const float rstd = rsqrtf(var + 1e-5f);
      const float v = (a[ch][i] - mean) * rstd * lg + lb;
      za[tt * 264 + c] = f2bf(silu_f(v));
    }
  __syncthreads();
  f32x4 acc[4][4];
#pragma unroll
  for (int m = 0; m < 4; ++m)
#pragma unroll
    for (int n = 0; n < 4; ++n) acc[m][n] = (f32x4){0.f, 0.f, 0.f, 0.f};
  const bf16_t* wt = P_pwT + (size_t)l * 65536 + (size_t)(wid * 64 + fr) * 256 + fq * 8;
  bf16x8 bq[3][4];
#pragma unroll
  for (int n = 0; n < 4; ++n) { bq[0][n] = *(const bf16x8*)(wt + (size_t)n * 16 * 256); bq[1][n] = *(const bf16x8*)(wt + (size_t)n * 16 * 256 + 32); }
  u32x2 gwv[4][4];
#pragma unroll
  for (int m = 0; m < 4; ++m)
#pragma unroll
    for (int n = 0; n < 4; ++n) gwv[m][n] = *(const u32x2*)(P_U + (size_t)(R0 + m * 16 + fr) * NIN + 2048 + wid * 64 + n * 16 + 4 * fq);
#pragma unroll
  for (int ks = 0; ks < 8; ++ks) {
    if (ks + 2 < 8) {
#pragma unroll
      for (int n = 0; n < 4; ++n) bq[(ks + 2) % 3][n] = *(const bf16x8*)(wt + (size_t)n * 16 * 256 + (ks + 2) * 32);
    }
    bf16x8 af[4];
#pragma unroll
    for (int m = 0; m < 4; ++m) af[m] = *(const bf16x8*)(smem + (m * 16 + fr) * 528 + (ks * 32 + fq * 8) * 2);
#pragma unroll
    for (int m = 0; m < 4; ++m)
#pragma unroll
      for (int n = 0; n < 4; ++n) acc[m][n] = mfma16(bq[ks % 3][n], af[m], acc[m][n]);
  }
#pragma unroll
  for (int m = 0; m < 4; ++m) {
    const int row = R0 + m * 16 + fr;
#pragma unroll
    for (int n = 0; n < 4; ++n) {
      const int ch = wid * 64 + n * 16 + 4 * fq;
      const u32x2 gw = gwv[m][n];
      u32x2 w;
      w.x = pk2(acc[m][n][0] * silu_f(bflo(gw.x)), acc[m][n][1] * silu_f(bfhi(gw.x)));
      w.y = pk2(acc[m][n][2] * silu_f(bflo(gw.y)), acc[m][n][3] * silu_f(bfhi(gw.y)));
      *(u32x2*)(P_MX + (size_t)row * DM + 512 + ch) = w;
    }
  }
  __syncthreads();
}

constexpr int P0_WIN = 3072, P0_WOUT = 1024, P0_PW = 64, P0_POOL = 16, P0_CVT = 768, P0_MOD = 192;
constexpr int P0_UNITS = P0_WIN + P0_WOUT + P0_PW + P0_POOL + P0_CVT + P0_MOD;

DEV void phase0(const Params& p, char* smem) {
  if (blockIdx.x == 0) for (int i = threadIdx.x; i < 1280 + 64; i += 512) P_cnt[i] = 0u;
  const int half = get_half();
  smem += half * 65536;
  for (int pr = blockIdx.x; pr < P0_UNITS / 2; pr += gridDim.x) {
    int v = pr * 2 + half;
    if (v < P0_MOD) { mod_unit(p, v, smem); continue; }
    v -= P0_MOD;
    if (v < P0_WIN) { const int l = v / 768, r = v % 768, kt = r / 48, nt = r % 48;
      tconv_tile(p.w_in + ((size_t)l * 1024 + kt * 64) * 3072 + nt * 64, 3072, P_WinT + ((size_t)l * 3072 + nt * 64) * 1024 + kt * 64, 1024, smem); continue; }
    v -= P0_WIN;
    if (v < P0_WOUT) { const int l = v >> 8, r = v & 255, kt = r >> 4, nt = r & 15;
      tconv_tile(p.w_out + ((size_t)l * 1024 + kt * 64) * 1024 + nt * 64, 1024, P_WoutT + ((size_t)l * 1024 + nt * 64) * 1024 + kt * 64, 1024, smem); continue; }
    v -= P0_WOUT;
    if (v < P0_PW) { const int l = v >> 4, r = v & 15, kt = r >> 2, nt = r & 3;
      tconv_tile(p.conv_pw + ((size_t)l * 256 + kt * 64) * 256 + nt * 64, 256, P_pwT + ((size_t)l * 256 + nt * 64) * 256 + kt * 64, 256, smem); continue; }
    v -= P0_PW;
    if (v < P0_POOL) { tconv_tile(p.pool_w + (size_t)v * 4096, 64, P_poolT + (size_t)v * 4096, 64, smem); continue; }
    v -= P0_POOL;
    if (v < 256) { cvt_unit(p.cnk, P_cnk_b, v, 4); continue; }
    v -= 256;
    if (v < 256) { cvt_unit(p.cnv, P_cnv_b, v, 4); continue; }
    v -= 256;
    if (v < 128) { cvt_unit(p.cgk, P_cgk_b, v, 2); continue; }
    v -= 128;
    cvt_unit(p.cgv, P_cgv_b, v, 2);
  }
}

constexpr int XB_GQA = GQA_NQ4 ? 64 : 128, XB_NAT = 128, XB_CONV = 80, XB_PATT = 64, XB_POOL = 160;
constexpr int XB_UNITS = XB_GQA + XB_NAT + XB_CONV + XB_PATT + XB_POOL;

DEV void phaseB(char* ws0, int l_in, char* smem, int qofs, int ubeg = 0, int uend = XB_UNITS) {
  const int xcd = blockIdx.x & 7;
  unsigned* q = (unsigned*)(ws0 + WS_CNT) + 1280 + qofs + l_in * 8 + xcd;
  int* slot = (int*)(smem + 131072);
  const int half = get_half();
  char* smem0 = smem;
  smem += half * 65536;
  for (;;) {
    if (threadIdx.x == 0) *slot = (int)atomicAdd(q, 1u);
    __syncthreads();
    int u = ubeg + *slot * 2 + half;
    __syncthreads();
    if (u >= uend) break;
    int l = l_in; asm volatile("" : "+s"(l));
    const Params p = load_params(ws0);
    if (u < XB_GQA) { attn_unit<0>(p, l, xcd * XB_GQA + u, smem, smem0, half); continue; }
    u -= XB_GQA;
    if (u < XB_NAT) { attn_unit<1>(p, l, xcd * XB_NAT + u, smem, smem0, half); continue; }
    u -= XB_NAT;
    if (u < XB_CONV) { conv_unit(p, l, xcd * XB_CONV + u, smem); continue; }
    u -= XB_CONV;
    if (u < XB_PATT) { attn_unit<2>(p, l, xcd * XB_PATT + u, smem, smem0, half); continue; }
    u -= XB_PATT;
    pool_unit(p, l, xcd * XB_POOL + u, smem);
  }
}

constexpr int LDS_BYTES = 131072 + 1024;
__global__ void __launch_bounds__(512, 2) mega(Params p0) {
  extern __shared__ __attribute__((aligned(16))) char smem[];
  cg::grid_group grid = cg::this_grid();
  const int ph0 = p0.ph0, ph1 = p0.ph1;
  char* const ws0 = p0.ws;
  if (blockIdx.x == 0 && threadIdx.x == 0) *(Params*)(ws0 + WS_PARAMS) = p0;
#define PP() load_params(ws0)
  const int half = get_half();
  volatile LAS unsigned* xst = (volatile LAS unsigned*)(smem + 131072 + 64);
  if (threadIdx.x == 0) { xst[0] = 0u; xst[1] = 0u; *(volatile unsigned long long*)(smem + 131072 + 256) = 0ull; }
  __syncthreads();
  const XcdBarrier xb = xcd_barrier_post((unsigned*)(ws0 + WS_BAR), xst);
  if (ph0 <= 0 && 0 < ph1) { for (int rep = 0; rep < (PROBE_X == 4 ? 2 : 1); ++rep) { phase0(p0, smem); if (1 < ph1) grid.sync(); } }
  if (ph0 <= 1 && 1 < ph1) { for (int u = blockIdx.x; u < TT / 64; u += gridDim.x) { const Params pl = PP(); h0_unit(pl, u * 2 + half); } if (2 < ph1) xcd_barrier(xb); }
  for (int li = 0; li < NLAYER; ++li) {
    int l = li; asm volatile("" : "+s"(l));
    const int pa = 2 + 3 * li;
    if (ph0 <= pa && pa < ph1) {
      const Params p = PP();
      pg8::Gemm g; g.A = P_H; g.Bt = P_WinT + (size_t)l * 3072 * 1024; g.M = TT; g.N = NIN; g.K = DM;
      pg8::StaticOrder S; S.init(TT, NIN, (int)gridDim.x, (int)blockIdx.x);
      EpiA E{ws0, l};
      for (int rep = 0; rep < (PROBE_X == 1 ? 2 : 1); ++rep) {
        pg8::gemm_phase<EpiA, pg8::StaticOrder, true, true>((PG8_LAS unsigned char*)smem, g, S, E);
        if (pa + 1 < ph1) xcd_barrier(xb);
      }
    }
    if (ph0 <= pa + 1 && pa + 1 < ph1) { phaseB(ws0, l, smem, 0); if (pa + 2 < ph1) xcd_barrier(xb); }
#if PROBE_SYNC
    for (int i = 0; i < 8; ++i) xcd_barrier(xb);
#endif
#if PROBE_B
    { constexpr int lo[7] = {0, 0, 128, 256, 336, 400, 0}, hi[7] = {0, 128, 256, 336, 400, 560, 560}; phaseB(ws0, l, smem, 32, lo[PROBE_B], hi[PROBE_B]); xcd_barrier(xb); }
#endif
    if (ph0 <= pa + 2 && pa + 2 < ph1) {
      const Params p = PP();
      pg8::Gemm g; g.A = P_MX; g.Bt = P_WoutT + (size_t)l * 1024 * 1024; g.M = TT; g.N = DM; g.K = DM;
      pg8::StaticOrder S; S.init(TT, DM, (int)gridDim.x, (int)blockIdx.x);
      EpiC E{ws0, l, smem + 131072 + 128};
      for (int rep = 0; rep < ((PROBE_X == 2 && li == 0) ? 2 : 1); ++rep) {
        pg8::gemm_phase<EpiC, pg8::StaticOrder, true, true>((PG8_LAS unsigned char*)smem, g, S, E);
#if FUSE_LN
        if (pa + 3 < ph1) xcd_barrier(xb);
#else
        xcd_barrier(xb);
#endif
      }
#if !FUSE_LN
      for (int rep = 0; rep < ((PROBE_X == 3 && li < 3) ? 2 : 1); ++rep) {
        for (int u = blockIdx.x; u < TT / (8 * LN_UR); u += gridDim.x) { const Params pl = PP(); ln_unit(pl, l, u * 2 + half); }
        if (pa + 3 < ph1) xcd_barrier(xb);
      }
#endif
    }
  }
#if PROBE_T
  if (blockIdx.x == 0 && threadIdx.x == 0) { const unsigned long long acc_ = *(volatile unsigned long long*)(smem + 131072 + 256) * PROBE_MUL; const unsigned long long ts_ = __builtin_amdgcn_s_memrealtime(); while (__builtin_amdgcn_s_memrealtime() - ts_ < acc_) __builtin_amdgcn_s_sleep(8); }
#endif
}

#ifndef ONE_LAUNCH
#define ONE_LAUNCH 1
#endif

extern "C" void kernel_launch(void* const* d_in, const int* in_sizes, int n_in, void* d_out, int out_size, void* d_ws, size_t ws_size,
                              hipStream_t stream) {
  static int grid_blocks = 0;
  if (!grid_blocks) {
    int dev = 0, cus = 0, per_cu = 0;
    hipGetDevice(&dev);
    hipDeviceGetAttribute(&cus, hipDeviceAttributeMultiprocessorCount, dev);
    hipFuncSetAttribute((const void*)mega, hipFuncAttributeMaxDynamicSharedMemorySize, LDS_BYTES);
    hipOccupancyMaxActiveBlocksPerMultiprocessor(&per_cu, mega, 512, LDS_BYTES);
    if (per_cu > 1) per_cu = 1;
    if (per_cu < 1) per_cu = 1;
    grid_blocks = cus * per_cu;
  }
  if (ws_size < WS_END) { fprintf(stderr, "kernel_launch: workspace too small (%zu < %zu); nothing launched\n", ws_size, (size_t)WS_END); return; }
  Params p{};
  const float* const* in = (const float* const*)d_in;
  p.x_prompt = in[0]; p.x_sample = in[1]; p.c = in[2]; p.cnk = in[3]; p.cnv = in[4]; p.cgk = in[5]; p.cgv = in[6]; p.c_ctx = in[7];
  p.w_mod = in[8]; p.b_mod = in[9]; p.w_in = in[10]; p.b_in = in[11]; p.pool_w = in[12]; p.pool_scale = in[13]; p.nat_bias = in[14];
  p.q_norm = in[15]; p.k_norm = in[16]; p.conv_w = in[17]; p.conv_b = in[18]; p.conv_ln_g = in[19]; p.conv_ln_b = in[20]; p.conv_pw = in[21];
  p.w_out = in[22]; p.b_out = in[23]; p.ln_g = in[24]; p.ln_b = in[25];
  p.out = (float*)d_out;
  p.ws = (char*)d_ws;
  hipMemsetAsync((char*)d_ws + WS_BAR, 0, XCD_BAR_WORDS * sizeof(unsigned), stream);
#if ONE_LAUNCH
  p.ph0 = 0; p.ph1 = 14;
  void* args[] = {&p};
  hipError_t e = hipLaunchCooperativeKernel((void*)mega, dim3(grid_blocks), dim3(512), args, LDS_BYTES, stream);
  if (e != hipSuccess) fprintf(stderr, "cooperative launch failed: %s (grid %d)\n", hipGetErrorString(e), grid_blocks);
#else
  for (int ph = 0; ph < 14; ++ph) { p.ph0 = ph; p.ph1 = ph + 1; mega<<<grid_blocks, 512, LDS_BYTES, stream>>>(p); }
#endif
}
```
